# Optimizing an MI355X kernel written in HIP

```python
import math
import jax, jax.numpy as jnp
from jax import lax
import numpy as np

D_MODEL = 2048
BATCH = 1
SEQ = 8192
DEPTH = 2

SSM_WIDTH = D_MODEL // 2
SSM_GROUP = 16
SSM_GROUPS = SSM_WIDTH // SSM_GROUP
SSM_STATE = 64
DT_MIN = 0.001
DT_MAX = 0.1
ATTN_HEADS = 8
QK_DIM = 64
V_DIM = 2 * QK_DIM
ATTN_WIDTH = ATTN_HEADS * V_DIM
QK_COLS = ATTN_HEADS * 2 * QK_DIM
Q_BLOCK = 128
REL_BUCKETS = 32
REL_MAX_DIST = 128
N_EXPERTS = 16
CAPACITY_FACTOR = 2
EXPERT_FF = D_MODEL
NORM_EPS = 1e-6
IN_COLS = SSM_WIDTH + 2 * QK_COLS + ATTN_WIDTH + 2 * D_MODEL
SPLITS = [SSM_WIDTH,
          SSM_WIDTH + QK_COLS,
          SSM_WIDTH + 2 * QK_COLS,
          SSM_WIDTH + 2 * QK_COLS + ATTN_WIDTH,
          SSM_WIDTH + 2 * QK_COLS + ATTN_WIDTH + D_MODEL]

kernel_name = "hybrid_s5_diffattn_ec_moe_encoder"

F32 = jnp.float32


def rms_norm(x, gain):
    xf = x.astype(F32)
    y = xf * lax.rsqrt(jnp.mean(xf * xf, axis=-1, keepdims=True) + NORM_EPS)
    return (y * gain.astype(F32)).astype(x.dtype)


def t5_bucket(rel):
    half = REL_BUCKETS // 2
    exact = half // 2
    side = jnp.where(rel > 0, half, 0).astype(jnp.int32)
    n = jnp.abs(rel)
    nf = jnp.maximum(n, 1).astype(F32)
    large = exact + (jnp.log(nf / exact) / math.log(REL_MAX_DIST / exact)
                     * (half - exact)).astype(jnp.int32)
    large = jnp.minimum(large, half - 1)
    return side + jnp.where(n < exact, n, large).astype(jnp.int32)


def ssm_combine(c1, c2):
    a1r, a1i, b1r, b1i = c1
    a2r, a2i, b2r, b2i = c2
    return (a2r * a1r - a2i * a1i,
            a2r * a1i + a2i * a1r,
            a2r * b1r - a2i * b1i + b2r,
            a2r * b1i + a2i * b1r + b2i)


def s5_direction(u, a_re, a_im, log_dt, b_re, b_im, c_re, c_im, reverse):
    a_re = a_re.astype(F32)
    a_im = a_im.astype(F32)
    dt = jnp.exp(log_dt.astype(F32))[:, None]
    mag = jnp.exp(a_re * dt)
    ang = a_im * dt
    abar_re = mag * jnp.cos(ang)
    abar_im = mag * jnp.sin(ang)
    den = a_re * a_re + a_im * a_im
    nr = abar_re - 1.0
    ni = abar_im
    coef_re = ((nr * a_re + ni * a_im) / den)[..., None]
    coef_im = ((ni * a_re - nr * a_im) / den)[..., None]
    b_re = b_re.astype(F32)
    b_im = b_im.astype(F32)
    bb_re = coef_re * b_re - coef_im * b_im
    bb_im = coef_re * b_im + coef_im * b_re
    bu_re = jnp.einsum('bsgp,gnp->bsgn', u, bb_re)
    bu_im = jnp.einsum('bsgp,gnp->bsgn', u, bb_im)
    shape = bu_re.shape
    elems = (jnp.broadcast_to(abar_re, shape), jnp.broadcast_to(abar_im, shape), bu_re, bu_im)
    _, _, s_re, s_im = lax.associative_scan(ssm_combine, elems, reverse=reverse, axis=1)
    return (jnp.einsum('bsgn,gpn->bsgp', s_re, c_re.astype(F32))
            - jnp.einsum('bsgn,gpn->bsgp', s_im, c_im.astype(F32)))


def diff_attention(q, k, v, rel_bias, lam):
    b, s, h = q.shape[0], q.shape[1], q.shape[2]
    nb = s // Q_BLOCK
    q = q * (QK_DIM ** -0.5)
    k1 = jnp.transpose(k[..., 0, :], (0, 2, 1, 3))
    k2 = jnp.transpose(k[..., 1, :], (0, 2, 1, 3))

    def to_blocks(t):
        t = jnp.transpose(t, (0, 2, 1, 3)).reshape(b, h, nb, Q_BLOCK, QK_DIM)
        return jnp.transpose(t, (2, 0, 1, 3, 4))

    q1b = to_blocks(q[..., 0, :])
    q2b = to_blocks(q[..., 1, :])
    k_pos = jnp.arange(s, dtype=jnp.int32)

    def block(args):
        q1_blk, q2_blk, blk = args
        q_pos = blk * Q_BLOCK + jnp.arange(Q_BLOCK, dtype=jnp.int32)
        bias = rel_bias[t5_bucket(k_pos[None, :] - q_pos[:, None])]
        bias = jnp.transpose(bias, (2, 0, 1)).astype(F32)[None]
        s1 = jnp.einsum('bhqd,bhkd->bhqk', q1_blk, k1).astype(F32) + bias
        s2 = jnp.einsum('bhqd,bhkd->bhqk', q2_blk, k2).astype(F32) + bias
        p = jax.nn.softmax(s1, axis=-1) - lam * jax.nn.softmax(s2, axis=-1)
        return jnp.einsum('bhqk,bhkd->bhqd', p.astype(v.dtype), v)

    o = lax.map(block, (q1b, q2b, jnp.arange(nb, dtype=jnp.int32)))
    return jnp.transpose(o, (1, 0, 3, 2, 4)).reshape(b, s, h, V_DIM)


def expert_choice_ffn(h, w_router, w_gate, w_up, w_down):
    b, s, d = h.shape
    cap = CAPACITY_FACTOR * s // N_EXPERTS
    aff = jax.nn.softmax(h.astype(F32) @ w_router.astype(F32), axis=-1)
    gate, idx = lax.top_k(jnp.swapaxes(aff, 1, 2), cap)
    xg = jax.vmap(lambda hb, ib: hb[ib])(h, idx)
    hid = (jax.nn.silu(jnp.einsum('becd,edf->becf', xg, w_gate))
           * jnp.einsum('becd,edf->becf', xg, w_up))
    y = jnp.einsum('becf,efd->becd', hid, w_down) * gate[..., None].astype(h.dtype)
    return jax.vmap(lambda yb, ib: jnp.zeros((s, d), yb.dtype)
                    .at[ib.reshape(-1)].add(yb.reshape(-1, d)))(y, idx)


def setup_inputs(seed: int = 0) -> dict:
    key = jax.random.key(seed)
    ks = jax.random.split(key, 32)
    L, G, N, P, E, F, D = DEPTH, SSM_GROUPS, SSM_STATE, SSM_GROUP, N_EXPERTS, EXPERT_FF, D_MODEL
    nrm = lambda k, shape, scale: jax.random.normal(k, shape, F32) * scale
    x = jax.random.normal(ks[0], (BATCH, SEQ, D), F32)
    w_in = nrm(ks[1], (L, D, IN_COLS), D ** -0.5)
    ssm_a_re = -0.5 * jnp.exp(nrm(ks[2], (L, 2, G, N), 0.05))
    ssm_a_im = math.pi * jnp.arange(N, dtype=F32) + nrm(ks[3], (L, 2, G, N), 0.01)
    ssm_log_dt = jax.random.uniform(ks[4], (L, 2, G), F32, math.log(DT_MIN), math.log(DT_MAX))
    ssm_b_re = nrm(ks[5], (L, 2, G, N, P), (2.0 * P) ** -0.5)
    ssm_b_im = nrm(ks[6], (L, 2, G, N, P), (2.0 * P) ** -0.5)
    ssm_c_re = nrm(ks[7], (L, 2, G, P, N), N ** -0.5)
    ssm_c_im = nrm(ks[8], (L, 2, G, P, N), N ** -0.5)
    ssm_d = nrm(ks[9], (L, SSM_WIDTH), 1.0)
    w_glu = nrm(ks[10], (L, SSM_WIDTH, SSM_WIDTH), SSM_WIDTH ** -0.5)
    w_ssm_branch = nrm(ks[11], (L, SSM_WIDTH, D), SSM_WIDTH ** -0.5)
    q_gain = 1.0 + nrm(ks[12], (L, QK_DIM), 0.02)
    k_gain = 1.0 + nrm(ks[13], (L, QK_DIM), 0.02)
    lambda_q1 = nrm(ks[14], (L, QK_DIM), 0.1)
    lambda_k1 = nrm(ks[15], (L, QK_DIM), 0.1)
    lambda_q2 = nrm(ks[16], (L, QK_DIM), 0.1)
    lambda_k2 = nrm(ks[17], (L, QK_DIM), 0.1)
    subln_gain = 1.0 + nrm(ks[18], (L, V_DIM), 0.02)
    w_attn_branch = nrm(ks[19], (L, ATTN_WIDTH, D), ATTN_WIDTH ** -0.5)
    rel_bias = nrm(ks[20], (REL_BUCKETS, ATTN_HEADS), 0.5)
    w_out = nrm(ks[21], (L, D, D), D ** -0.5)
    norm_mix = 1.0 + nrm(ks[22], (L, D), 0.02)
    norm_ffn = 1.0 + nrm(ks[23], (L, D), 0.02)
    w_router = nrm(ks[24], (L, D, E), D ** -0.5)
    w_expert_gate = nrm(ks[25], (L, E, D, F), D ** -0.5)
    w_expert_up = nrm(ks[26], (L, E, D, F), D ** -0.5)
    w_expert_down = nrm(ks[27], (L, E, F, D), F ** -0.5)
    return {"x": x, "w_in": w_in, "ssm_a_re": ssm_a_re, "ssm_a_im": ssm_a_im,
            "ssm_log_dt": ssm_log_dt, "ssm_b_re": ssm_b_re, "ssm_b_im": ssm_b_im,
            "ssm_c_re": ssm_c_re, "ssm_c_im": ssm_c_im, "ssm_d": ssm_d, "w_glu": w_glu,
            "w_ssm_branch": w_ssm_branch, "q_gain": q_gain, "k_gain": k_gain,
            "lambda_q1": lambda_q1, "lambda_k1": lambda_k1, "lambda_q2": lambda_q2,
            "lambda_k2": lambda_k2, "subln_gain": subln_gain, "w_attn_branch": w_attn_branch,
            "rel_bias": rel_bias, "w_out": w_out, "norm_mix": norm_mix, "norm_ffn": norm_ffn,
            "w_router": w_router, "w_expert_gate": w_expert_gate, "w_expert_up": w_expert_up,
            "w_expert_down": w_expert_down}


def reference(x, w_in, ssm_a_re, ssm_a_im, ssm_log_dt, ssm_b_re, ssm_b_im, ssm_c_re, ssm_c_im,
              ssm_d, w_glu, w_ssm_branch, q_gain, k_gain, lambda_q1, lambda_k1, lambda_q2,
              lambda_k2, subln_gain, w_attn_branch, rel_bias, w_out, norm_mix, norm_ffn,
              w_router, w_expert_gate, w_expert_up, w_expert_down):
    b, s, _ = x.shape
    for l in range(DEPTH):
        lam_init = 0.8 - 0.6 * math.exp(-0.3 * l)
        h = rms_norm(x, norm_mix[l])
        proj = h @ w_in[l]
        u, q, k, v, g_ssm, g_attn = jnp.split(proj, SPLITS, axis=-1)

        uf = u.astype(F32)
        ug = uf.reshape(b, s, SSM_GROUPS, SSM_GROUP)
        y = (s5_direction(ug, ssm_a_re[l, 0], ssm_a_im[l, 0], ssm_log_dt[l, 0],
                          ssm_b_re[l, 0], ssm_b_im[l, 0], ssm_c_re[l, 0], ssm_c_im[l, 0], False)
             + s5_direction(ug, ssm_a_re[l, 1], ssm_a_im[l, 1], ssm_log_dt[l, 1],
                            ssm_b_re[l, 1], ssm_b_im[l, 1], ssm_c_re[l, 1], ssm_c_im[l, 1], True))
        y = y.reshape(b, s, SSM_WIDTH) + ssm_d[l].astype(F32) * uf
        y = jax.nn.gelu(y).astype(x.dtype)
        y = y * jax.nn.sigmoid(y @ w_glu[l])
        ssm_out = y @ w_ssm_branch[l]

        qn = rms_norm(q.reshape(b, s, ATTN_HEADS, 2, QK_DIM), q_gain[l])
        kn = rms_norm(k.reshape(b, s, ATTN_HEADS, 2, QK_DIM), k_gain[l])
        vh = jnp.transpose(v.reshape(b, s, ATTN_HEADS, V_DIM), (0, 2, 1, 3))
        lam = (jnp.exp(jnp.sum(lambda_q1[l].astype(F32) * lambda_k1[l].astype(F32)))
               - jnp.exp(jnp.sum(lambda_q2[l].astype(F32) * lambda_k2[l].astype(F32)))
               + lam_init)
        o = diff_attention(qn, kn, vh, rel_bias, lam)
        o = rms_norm(o, subln_gain[l]) * (1.0 - lam_init)
        attn_out = o.reshape(b, s, ATTN_WIDTH) @ w_attn_branch[l]

        merged = jax.nn.sigmoid(g_ssm) * ssm_out + jax.nn.sigmoid(g_attn) * attn_out
        x = x + merged @ w_out[l]

        h2 = rms_norm(x, norm_ffn[l])
        x = x + expert_choice_ffn(h2, w_router[l], w_expert_gate[l], w_expert_up[l],
                                  w_expert_down[l])
    return x
```

```cpp
#include <hip/hip_runtime.h>
#include <cstdio>
#include <cstdint>

#define REP_MASK 7168
#ifndef MK_PER_PHASE
#define MK_PER_PHASE 0
#endif

#define LAS __attribute__((address_space(3)))
#define GAS __attribute__((address_space(1)))
typedef unsigned short bf16_t;
typedef short bf16x8 __attribute__((ext_vector_type(8)));
typedef short s16x4 __attribute__((ext_vector_type(4)));
typedef float f32x4 __attribute__((ext_vector_type(4)));
typedef float f32x2 __attribute__((ext_vector_type(2)));
typedef float f32x16 __attribute__((ext_vector_type(16)));
typedef unsigned u32x4 __attribute__((ext_vector_type(4)));
typedef unsigned u32x2 __attribute__((ext_vector_type(2)));

constexpr int S = 8192, D = 2048, NL = 2;
constexpr int SSMW = 1024, NGRP = 64, GP = 16, NST = 64;
constexpr int NH = 8, QKD = 64, VD = 128;
constexpr int NE = 16, CAP = 1024, FF = 2048;
constexpr int INC = 8192;
constexpr float EPS = 1e-6f;
constexpr int TC = 32, NCH = S / TC;
constexpr int UAW = TC * GP + 256;
constexpr float LOG2E = 1.4426950408889634f;

constexpr size_t MiB = 1u << 20;
constexpr size_t WS_CTL = 0, CTL_BYTES = 1 * MiB;
constexpr size_t LW_WIN = 0, LW_WGLU = 32 * MiB, LW_WBR = 34 * MiB, LW_WOUT = 42 * MiB, LW_WGU = 50 * MiB, LW_WD = 306 * MiB,
                 LW_F = 434 * MiB, LW_BO = 450 * MiB, LW_KTAB = 498 * MiB, LW_WRT = 502 * MiB, LW_SIZE = 503 * MiB;
constexpr size_t WS_LW = 1 * MiB;
constexpr size_t WS_ACT = WS_LW + 2 * LW_SIZE;
constexpr size_t A_XB = 0, A_XB1 = 32 * MiB, A_UA = 64 * MiB, A_Q = 88 * MiB, A_K = 104 * MiB, A_V = 120 * MiB, A_G = 136 * MiB,
                 A_SSUM = 200 * MiB, A_Y = 216 * MiB, A_YO = 232 * MiB, A_O1 = 264 * MiB, A_MG = 296 * MiB, A_XA = 328 * MiB,
                 A_XG = 392 * MiB, A_H = 456 * MiB, A_YX = 520 * MiB, A_SMALL = 584 * MiB, A_END = 588 * MiB;
constexpr size_t SM_RINV = 0, SM_RINV2 = 64 * 1024, SM_AFFT = 128 * 1024, SM_IDX = 640 * 1024, SM_GATE = 704 * 1024, SM_RSL = 768 * 1024,
                 SM_INV = 1024 * 1024, SM_BTAB = 1536 * 1024, SM_LAM = 1600 * 1024;
constexpr size_t WS_END = WS_ACT + A_END;

constexpr int RING_BYTES = 131072;
constexpr int LDS_BYTES = 163840;
constexpr int MISC_OFF = 155648;

typedef __bf16 bf16v2_t __attribute__((ext_vector_type(2)));
__device__ __forceinline__ unsigned cvt_pk_bf16(float lo, float hi) { const f32x2 v = {lo, hi}; return __builtin_bit_cast(unsigned, __builtin_convertvector(v, bf16v2_t)); }
__device__ __forceinline__ float bf_lo(unsigned w) { return __uint_as_float(w << 16); }
__device__ __forceinline__ float bf_hi(unsigned w) { return __uint_as_float(w & 0xffff0000u); }
__device__ __forceinline__ unsigned short f2bf(float f) { return (unsigned short)(cvt_pk_bf16(f, 0.f) & 0xffffu); }
__device__ __forceinline__ float fast_sigmoid(float x) { return __builtin_amdgcn_rcpf(1.f + __builtin_amdgcn_exp2f(-x * LOG2E)); }
__device__ __forceinline__ float wave_sum(float v) {
#pragma unroll
    for (int o = 1; o < 64; o <<= 1) v += __shfl_xor(v, o);
    return v;
}
template <int X> __device__ __forceinline__ float swz_xor(float v) { return __int_as_float(__builtin_amdgcn_ds_swizzle(__float_as_int(v), (X << 10) | 0x1F)); }
__device__ __forceinline__ u32x2 pack8_fp8(const f32x4 a, const f32x4 b) { int w0 = 0, w1 = 0;
    w0 = __builtin_amdgcn_cvt_pk_fp8_f32(a[0], a[1], w0, false); w0 = __builtin_amdgcn_cvt_pk_fp8_f32(a[2], a[3], w0, true);
    w1 = __builtin_amdgcn_cvt_pk_fp8_f32(b[0], b[1], w1, false); w1 = __builtin_amdgcn_cvt_pk_fp8_f32(b[2], b[3], w1, true);
    u32x2 r; r.x = (unsigned)w0; r.y = (unsigned)w1; return r; }
constexpr float W8_SCALE = 64.f, H8_SCALE = 16.f;
constexpr int E8_ONE = 0x7F7F7F7F, E8_W = 0x79797979  , E8_H = 0x7B7B7B7B  ;
#define LDS_WAIT() asm volatile("s_waitcnt lgkmcnt(0)" ::: "memory")
#define VM_WAIT() asm volatile("s_waitcnt vmcnt(0)" ::: "memory")

#define XB_TMO      128
#define XB_XCNT(j)  (256  + 64 * (j))
#define XB_XSUB(j)  (1280 + 64 * (j))
#define XB_XGEN(j)  (2304 + 64 * (j))
#define XB_TOP      3328
#define XB_TOPGEN   3392
#define XCD_BAR_WORDS 3456
#define XB_SPIN_CAP (1u << 22)
__device__ __forceinline__ unsigned xb_ld(unsigned* p)              { return __hip_atomic_load(p, __ATOMIC_RELAXED, __HIP_MEMORY_SCOPE_AGENT); }
__device__ __forceinline__ unsigned xb_add(unsigned* p, unsigned v) { return __hip_atomic_fetch_add(p, v, __ATOMIC_RELAXED, __HIP_MEMORY_SCOPE_AGENT); }
__device__ __forceinline__ unsigned xb_xcc_id() { return (unsigned)__builtin_amdgcn_s_getreg((3 << 11) | 20) & 0xFu; }
#define XB_SPIN(cond, bar) do { unsigned _sp = 0; while (cond) { __builtin_amdgcn_s_sleep(1); \
    if ((++_sp & 255u) == 0u) { if (xb_ld(&(bar)[XB_TMO])) break; if (_sp > XB_SPIN_CAP) { atomicAdd(&(bar)[XB_TMO], 1u); break; } } } } while (0)
struct XcdBarrier { unsigned* bar; unsigned x; volatile LAS unsigned* st; };
__device__ __forceinline__ XcdBarrier xcd_barrier_post(unsigned* bar, volatile LAS unsigned* st) {
    XcdBarrier b; b.bar = bar; b.x = xb_xcc_id(); b.st = st;
    if (threadIdx.x == 0) (void)xb_add(&bar[XB_XCNT(b.x)], 1u);
    return b;
}
__device__ __forceinline__ void xcd_barrier_complete(unsigned* bar, unsigned x, unsigned& nloc, unsigned& nx) {
    const unsigned G = gridDim.x * gridDim.y * gridDim.z;
    unsigned sum, cnt, mine, sp = 0u;
    for (;;) {
        sum = 0u; cnt = 0u; mine = 0u;
#pragma unroll
        for (unsigned j = 0; j < 16; ++j) { const unsigned c = xb_ld(&bar[XB_XCNT(j)]); sum += c; cnt += (c > 0u) ? 1u : 0u; mine = (j == x) ? c : mine; }
        if (sum == G) break;
        __builtin_amdgcn_s_sleep(1);
        if ((++sp & 255u) == 0u) { if (xb_ld(&bar[XB_TMO])) break; if (sp > XB_SPIN_CAP) { atomicAdd(&bar[XB_TMO], 1u); break; } }
    }
    nloc = mine > 0u ? mine : 1u; nx = cnt > 0u ? cnt : 1u;
}
__device__ __forceinline__ void xcd_barrier(const XcdBarrier& b) {
    asm volatile("s_waitcnt vmcnt(0)" ::: "memory");
    __syncthreads();
    if (threadIdx.x == 0) {
        unsigned* bar = b.bar;
        __builtin_amdgcn_s_waitcnt(0);
        unsigned nloc = b.st[0], nx = b.st[1];
        if (nloc == 0u) { xcd_barrier_complete(bar, b.x, nloc, nx); b.st[0] = nloc; b.st[1] = nx; }
        const unsigned old = xb_add(&bar[XB_XSUB(b.x)], 1u);
        const unsigned gen = old / nloc;
        if (old + 1u == (gen + 1u) * nloc) {
            __builtin_amdgcn_fence(__ATOMIC_RELEASE, "agent");
            asm volatile("s_waitcnt vmcnt(0)" ::: "memory");
            const unsigned og = xb_add(&bar[XB_TOP], 1u);
            const unsigned tg = og / nx;
            if (og + 1u == (tg + 1u) * nx) xb_add(&bar[XB_TOPGEN], 1u);
            else XB_SPIN(xb_ld(&bar[XB_TOPGEN]) == tg, bar);
            __builtin_amdgcn_fence(__ATOMIC_ACQUIRE, "agent");
            xb_add(&bar[XB_XGEN(b.x)], 1u);
            asm volatile("s_waitcnt vmcnt(0)" ::: "memory");
        } else {
            XB_SPIN(xb_ld(&bar[XB_XGEN(b.x)]) == gen, bar);
            __builtin_amdgcn_fence(__ATOMIC_ACQUIRE, "agent");
            asm volatile("s_waitcnt vmcnt(0)" ::: "memory");
        }
    }
    __syncthreads();
}

namespace pg {
constexpr int BM = 256, BK = 64, HALF = 128, HTB = HALF * BK * 2, STAGE_BYTES = 8 * HTB;
__device__ __forceinline__ int lds_byte(int r, int c) { const int st = (r >> 4) * 2 + (c >> 5), rr = r & 15, cc = c & 31, ob = rr * 64 + cc * 2; return st * 1024 + (ob ^ (((ob >> 9) & 1) << 5)); }
__device__ __forceinline__ void stage_rc(int b, int& R, int& C) { const int st = b / 1024, sb = b % 1024, swz = sb ^ (((sb >> 9) & 1) << 5); R = (st >> 1) * 16 + swz / 64; C = (st & 1) * 32 + (swz % 64) / 2; }
__device__ __forceinline__ int perm32(int rho) { const int n = rho >> 4, i = rho & 15; return 8 * (i >> 2) + 4 * n + (i & 3); }
struct Unit { const char* a; const char* b; int pm, pn, grp; };
typedef f32x4 Acc[2][2][4][2];

typedef int v8i_t __attribute__((ext_vector_type(8)));
template <class Epi, class Sched, bool F8 = false, int SA_ = 0x7F7F7F7F, int SB_ = 0x7F7F7F7F>
__device__ __forceinline__ void gemm_phase(LAS unsigned char* lds, const int K, const int lda, const int ldb, const Sched& S, const Epi& E) {
    int tz_ = threadIdx.x; asm volatile("" : "+v"(tz_));
    const int tid = tz_, wid = __builtin_amdgcn_readfirstlane(tid >> 6), lane = tid & 63, wr = wid >> 2, wc = wid & 3, fr = lane & 15, fq = lane >> 4;
    constexpr int ESZ = F8 ? 1 : 2;
    const int nt = K * ESZ / (BK * 2);
    unsigned voffA[2], voffB[2];
#pragma unroll
    for (int i = 0; i < 2; ++i) { int R, C; stage_rc(tid * 16 + i * 8192, R, C);
        voffA[i] = (unsigned)(R * lda * ESZ + C * 2); voffB[i] = (unsigned)((64 * (R >> 5) + perm32(R & 31)) * ldb * ESZ + C * 2); }
    const size_t kstep = (size_t)(BK * 2);
    const size_t hstepA = (size_t)HALF * lda * ESZ;
    const size_t hstepB = (size_t)32 * ldb * ESZ;
    const unsigned ldsw = (unsigned)wid * 1024u;
    const int aoff = F8 ? lds_byte(wr * 64 + fr, fq * 16) : lds_byte(wr * 64 + fr, fq * 8), boff = F8 ? lds_byte(wc * 32 + fr, fq * 16) : lds_byte(wc * 32 + fr, fq * 8);
#define PG8_SA(b, h) (((b) * 2 + (h)) * HTB)
#define PG8_SB(b, h) ((4 + (b) * 2 + (h)) * HTB)
#define PG8_STAGE(bufoff, gbase, voff) do { _Pragma("unroll") for (int _i = 0; _i < 2; ++_i) \
        __builtin_amdgcn_global_load_lds((const unsigned*)((const char*)(gbase) + (voff)[_i]), (LAS unsigned*)(lds + (bufoff) + ldsw + _i * 8192), 16, 0, 0); } while (0)
    typedef v8i_t v8i_a16 __attribute__((aligned(16)));
#define PG8_LDA(dst, b, h) do { if constexpr (F8) { _Pragma("unroll") for (int m = 0; m < 4; ++m) dst##8[m] = *(const LAS v8i_a16*)(lds + PG8_SA(b, h) + aoff + m * 2048); } \
        else { _Pragma("unroll") for (int m = 0; m < 4; ++m) _Pragma("unroll") for (int k = 0; k < 2; ++k) dst[m][k] = *(const LAS bf16x8*)(lds + PG8_SA(b, h) + aoff + m * 2048 + k * 1024); } } while (0)
#define PG8_LDB(dst, b, h) do { if constexpr (F8) { _Pragma("unroll") for (int n = 0; n < 2; ++n) dst##8[n] = *(const LAS v8i_a16*)(lds + PG8_SB(b, h) + boff + n * 2048); } \
        else { _Pragma("unroll") for (int n = 0; n < 2; ++n) _Pragma("unroll") for (int k = 0; k < 2; ++k) dst[n][k] = *(const LAS bf16x8*)(lds + PG8_SB(b, h) + boff + n * 2048 + k * 1024); } } while (0)
#define PG8_MMA(ai, bj, At, Bt) do { __builtin_amdgcn_s_setprio(1); \
        if constexpr (F8) { _Pragma("unroll") for (int m = 0; m < 4; ++m) _Pragma("unroll") for (int n = 0; n < 2; ++n) \
            asm volatile("v_mfma_scale_f32_16x16x128_f8f6f4 %0, %1, %2, %0, %3, %4 op_sel_hi:[0,0,0]" : "+v"(acc[ai][bj][m][n]) : "v"(Bt##8[n]), "v"(At##8[m]), "v"(sbv), "v"(sav)); } \
        else { _Pragma("unroll") for (int m = 0; m < 4; ++m) _Pragma("unroll") for (int n = 0; n < 2; ++n) _Pragma("unroll") for (int k = 0; k < 2; ++k) \
            acc[ai][bj][m][n] = __builtin_amdgcn_mfma_f32_16x16x32_bf16(Bt[n][k], At[m][k], acc[ai][bj][m][n], 0, 0, 0); } \
        __builtin_amdgcn_s_setprio(0); } while (0)
#define PG8_WAIT_V(n) asm volatile("s_waitcnt vmcnt(" #n ")" ::: "memory")
#define PG8_WAIT_L(n) asm volatile("s_waitcnt lgkmcnt(" #n ")" ::: "memory")
#define PG8_BAR __builtin_amdgcn_s_barrier()
#define PG8_SCHED __builtin_amdgcn_sched_barrier(0)
    Unit cur, nxt; int ui = 0;
    if (!S.next(0, cur)) return;
    Acc acc;
#pragma unroll
    for (int a = 0; a < 2; ++a)
#pragma unroll
        for (int b = 0; b < 2; ++b)
#pragma unroll
            for (int m = 0; m < 4; ++m)
#pragma unroll
                for (int n = 0; n < 2; ++n) acc[a][b][m][n] = (f32x4){0.f, 0.f, 0.f, 0.f};
    bf16x8 At[4][2], B0[2][2], B1[2][2]; v8i_t At8[4], B08[2], B18[2];
    const int sav = SA_, sbv = SB_;
    const char* cA = cur.a; const char* cB = cur.b;
    PG8_STAGE(PG8_SB(0, 0), cB, voffB); PG8_STAGE(PG8_SA(0, 0), cA, voffA); PG8_STAGE(PG8_SB(0, 1), cB + hstepB, voffB); PG8_STAGE(PG8_SA(0, 1), cA + hstepA, voffA);
    if (wr == 1) PG8_BAR;
    PG8_WAIT_V(4); PG8_BAR;
    PG8_STAGE(PG8_SB(1, 0), cB + kstep, voffB); PG8_STAGE(PG8_SA(1, 0), cA + kstep, voffA); PG8_STAGE(PG8_SB(1, 1), cB + hstepB + kstep, voffB);
    PG8_WAIT_V(6); PG8_BAR;
    for (;;) {
        const bool has_next = S.next(ui + 1, nxt);
        const char* nA = has_next ? nxt.a : cA; const char* nB = has_next ? nxt.b : cB;
        for (int t = 0; t < nt; t += 2) {
            const bool last = (t == nt - 2);
            const char* a1 = cA + (size_t)(t + 1) * kstep;
            const char* a2 = last ? nA : cA + (size_t)(t + 2) * kstep; const char* b2 = last ? nB : cB + (size_t)(t + 2) * kstep;
            const char* a3 = a2 + kstep; const char* b3 = b2 + kstep;
            if constexpr (Epi::HAS_MID) { if (t == nt / 2) E.mid(acc, cur, wr, wc, fr, fq); }
            PG8_LDB(B0, 0, 0); PG8_SCHED; PG8_LDA(At, 0, 0); PG8_STAGE(PG8_SA(1, 1), a1 + hstepA, voffA);
            PG8_WAIT_L(8); PG8_BAR; PG8_WAIT_L(0); PG8_MMA(0, 0, At, B0); PG8_BAR; PG8_SCHED;
            PG8_LDB(B1, 0, 1); PG8_STAGE(PG8_SB(0, 0), b2, voffB);
            PG8_BAR; PG8_WAIT_L(0); PG8_MMA(0, 1, At, B1); PG8_BAR;
            PG8_LDA(At, 0, 1); PG8_STAGE(PG8_SA(0, 0), a2, voffA);
            PG8_BAR; PG8_WAIT_L(0); PG8_MMA(1, 0, At, B0); PG8_BAR; PG8_SCHED;
            PG8_STAGE(PG8_SB(0, 1), b2 + hstepB, voffB);
            PG8_WAIT_V(6); PG8_BAR; PG8_MMA(1, 1, At, B1); PG8_BAR;
            PG8_LDB(B0, 1, 0); PG8_SCHED; PG8_LDA(At, 1, 0); PG8_STAGE(PG8_SA(0, 1), a2 + hstepA, voffA);
            PG8_WAIT_L(8); PG8_BAR; PG8_WAIT_L(0); PG8_MMA(0, 0, At, B0); PG8_BAR; PG8_SCHED;
            PG8_LDB(B1, 1, 1); PG8_STAGE(PG8_SB(1, 0), b3, voffB);
            PG8_BAR; PG8_WAIT_L(0); PG8_MMA(0, 1, At, B1); PG8_BAR;
            PG8_LDA(At, 1, 1); PG8_STAGE(PG8_SA(1, 0), a3, voffA);
            PG8_BAR; PG8_WAIT_L(0); PG8_MMA(1, 0, At, B0); PG8_BAR; PG8_SCHED;
            PG8_STAGE(PG8_SB(1, 1), b3 + hstepB, voffB);
            PG8_WAIT_V(6); PG8_BAR; PG8_MMA(1, 1, At, B1); PG8_BAR;
        }
        if constexpr (F8) asm volatile("s_nop 15\n\ts_nop 15" ::: "memory");
        E(acc, cur, wr, wc, fr, fq);
        if (!has_next) break;
#pragma unroll
        for (int a = 0; a < 2; ++a)
#pragma unroll
            for (int b = 0; b < 2; ++b)
#pragma unroll
                for (int m = 0; m < 4; ++m)
#pragma unroll
                    for (int n = 0; n < 2; ++n) acc[a][b][m][n] = (f32x4){0.f, 0.f, 0.f, 0.f};
        cur = nxt; cA = nA; cB = nB; ++ui;
    }
    PG8_WAIT_V(0);
    if (wr == 0) PG8_BAR;
    PG8_BAR;
#undef PG8_SA
#undef PG8_SB
#undef PG8_STAGE
#undef PG8_LDA
#undef PG8_LDB
#undef PG8_MMA
#undef PG8_WAIT_V
#undef PG8_WAIT_L
#undef PG8_BAR
#undef PG8_SCHED
}

struct SchedGrid {
    const char* A; const char* B; size_t tstepA, tstepB; int nM, nN, nwg, G, c; bool mix32 = false;
    __device__ void init(const void* A_, int lda, const void* B_, int ldb, int M, int N, int G_, int c_, int esz = 2) {
        A = (const char*)A_; B = (const char*)B_; tstepA = (size_t)256 * lda * esz; tstepB = (size_t)256 * ldb * esz; nM = M / 256; nN = N / 256; nwg = nM * nN; G = G_; c = c_; }
    __device__ __forceinline__ bool next(int i, Unit& u) const {
        const long L = (long)i * G + c; if (L >= nwg) return false;
        int wgid = (int)L; { const int q = nwg / 8, r = nwg % 8, xcd = wgid % 8, off = wgid / 8; wgid = (xcd < r ? xcd * (q + 1) : r * (q + 1) + (xcd - r) * q) + off; }
        const int nig = 8 * nN, gid = wgid / nig, fm = gid * 8, gsz = (nM - fm) < 8 ? (nM - fm) : 8;
        u.pm = fm + ((wgid % nig) % gsz); u.pn = (wgid % nig) / gsz; u.grp = 0;
        if (mix32) { const int a = u.pn >> 4, r4 = (u.pn >> 2) & 3, r = u.pn & 3; u.pn = ((r4 & 1) << 4) | (a << 3) | ((r4 >> 1) << 2) | r; }
        u.a = A + (size_t)u.pm * tstepA; u.b = B + (size_t)u.pn * tstepB; return true;
    }
};
struct SchedGroup {
    const char* A; const char* B; size_t tstepA, tstepB, gstepA, gstepB; int nM, nN, total, G, c;
    __device__ void init(const void* A_, int lda, size_t gA, const void* B_, int ldb, size_t gB, int nM_, int nN_, int NG, int G_, int c_, int esz = 2) {
        A = (const char*)A_; B = (const char*)B_; tstepA = (size_t)256 * lda * esz; tstepB = (size_t)256 * ldb * esz; gstepA = gA; gstepB = gB; nM = nM_; nN = nN_; total = NG * nM_ * nN_; G = G_; c = c_; }
    __device__ __forceinline__ bool next(int i, Unit& u) const {
        const long L = (long)i * G + c; if (L >= total) return false;
        const int per = nM * nN, g = (int)L / per, r = (int)L % per;
        u.grp = g; u.pm = r % nM; u.pn = r / nM;
        u.a = A + (size_t)g * gstepA + (size_t)u.pm * tstepA; u.b = B + (size_t)g * gstepB + (size_t)u.pn * tstepB; return true;
    }
};
}

#define EPI_LANES int tz_ = threadIdx.x; asm volatile("" : "+v"(tz_)); const int wr = tz_ >> 8, wc = (tz_ >> 6) & 3, fr = tz_ & 15, fq = (tz_ >> 4) & 3;
#define EPI_FOR _Pragma("unroll") for (int ai = 0; ai < 2; ++ai) _Pragma("unroll") for (int m = 0; m < 4; ++m)
#define EPI_RL const int rl = ai * 128 + wr * 64 + m * 16 + fr;
__device__ __forceinline__ u32x4 pack8(const f32x4 a, const f32x4 b) { u32x4 w; w.x = cvt_pk_bf16(a[0], a[1]); w.y = cvt_pk_bf16(a[2], a[3]); w.z = cvt_pk_bf16(b[0], b[1]); w.w = cvt_pk_bf16(b[2], b[3]); return w; }
__device__ __forceinline__ void unpack8(const u32x4 w, f32x4& a, f32x4& b) { a = (f32x4){bf_lo(w.x), bf_hi(w.x), bf_lo(w.y), bf_hi(w.y)}; b = (f32x4){bf_lo(w.z), bf_hi(w.z), bf_lo(w.w), bf_hi(w.w)}; }

struct EpiInProj {
    static constexpr bool HAS_MID = false;
    const float* rinv; bf16_t *UA, *Q, *Kb, *V, *G; const float *qg, *kg;
    __device__ __forceinline__ void operator()(const pg::Acc& acc, const pg::Unit& u, int, int, int, int) const { EPI_LANES
        const int pn = u.pn, row0 = u.pm * 256;
        if (pn < 4) {
            EPI_FOR { EPI_RL const int tok = row0 + rl; const float rs = rinv[tok]; const int c = tok >> 5, tau = tok & 31;
#pragma unroll
                for (int bj = 0; bj < 2; ++bj) { const int ch = 256 * pn + 64 * wc + 32 * bj + 8 * fq, g = ch >> 4, p0 = ch & 15;
                    *(u32x4*)(UA + ((size_t)(g * NCH + c) * UAW + tau * 16 + p0)) = pack8(acc[ai][bj][m][0] * rs, acc[ai][bj][m][1] * rs); } }
        } else if (pn < 12) {
            const bool isq = pn < 8; const int col0 = 256 * (pn - (isq ? 4 : 8)) + 64 * wc; const float* gp = isq ? qg : kg; const float sc = isq ? 0.125f * LOG2E : 1.f;
            bf16_t* dst = isq ? Q : Kb;
            f32x4 gv[2][2];
#pragma unroll
            for (int bj = 0; bj < 2; ++bj)
#pragma unroll
                for (int n = 0; n < 2; ++n) gv[bj][n] = *(const f32x4*)(gp + 32 * bj + 8 * fq + 4 * n) * sc;
            EPI_FOR { EPI_RL const int tok = row0 + rl; const float rs = rinv[tok];
                f32x4 v[2][2]; float ss = 0.f;
#pragma unroll
                for (int bj = 0; bj < 2; ++bj)
#pragma unroll
                    for (int n = 0; n < 2; ++n) { v[bj][n] = acc[ai][bj][m][n] * rs; ss += v[bj][n][0] * v[bj][n][0] + v[bj][n][1] * v[bj][n][1] + v[bj][n][2] * v[bj][n][2] + v[bj][n][3] * v[bj][n][3]; }
                ss += __shfl_xor(ss, 16); ss += __shfl_xor(ss, 32);
                const float r = __builtin_amdgcn_rsqf(ss * (1.f / 64.f) + EPS);
#pragma unroll
                for (int bj = 0; bj < 2; ++bj)
                    *(u32x4*)(dst + (size_t)tok * 1024 + col0 + 32 * bj + 8 * fq) = pack8(v[bj][0] * r * gv[bj][0], v[bj][1] * r * gv[bj][1]); }
        } else if (pn < 16) {
            EPI_FOR { EPI_RL const int tok = row0 + rl; const float rs = rinv[tok];
#pragma unroll
                for (int bj = 0; bj < 2; ++bj)
                    *(u32x4*)(V + (size_t)tok * 1024 + 256 * (pn - 12) + 64 * wc + 32 * bj + 8 * fq) = pack8(acc[ai][bj][m][0] * rs, acc[ai][bj][m][1] * rs); }
        } else {
            EPI_FOR { EPI_RL const int tok = row0 + rl; const float rs = rinv[tok];
#pragma unroll
                for (int bj = 0; bj < 2; ++bj) { f32x4 a = acc[ai][bj][m][0] * rs, b = acc[ai][bj][m][1] * rs;
#pragma unroll
                    for (int j = 0; j < 4; ++j) { a[j] = fast_sigmoid(a[j]); b[j] = fast_sigmoid(b[j]); }
                    *(u32x4*)(G + (size_t)tok * 4096 + 256 * (pn - 16) + 64 * wc + 32 * bj + 8 * fq) = pack8(a, b); } }
        }
    }
};
struct EpiSsum {
    static constexpr bool HAS_MID = false;
    float* SS;
    __device__ __forceinline__ void operator()(const pg::Acc& acc, const pg::Unit& u, int, int, int, int) const { EPI_LANES
        EPI_FOR { EPI_RL float* rp = SS + ((size_t)u.grp * NCH + rl) * 256 + 64 * wc + 8 * fq;
#pragma unroll
            for (int bj = 0; bj < 2; ++bj) { *(f32x4*)(rp + 32 * bj) = acc[ai][bj][m][0]; *(f32x4*)(rp + 32 * bj + 4) = acc[ai][bj][m][1]; } }
    }
};
__device__ __forceinline__ float gelu_tanh(float x) {
    const float t = 1.5957691216057308f * (x + 0.044715f * x * x * x);
    return x * fast_sigmoid(t);
}
struct EpiSsmOut {
    static constexpr bool HAS_MID = false;
    bf16_t* Y;
    __device__ __forceinline__ void operator()(const pg::Acc& acc, const pg::Unit& u, int, int, int, int) const { EPI_LANES
        EPI_FOR { EPI_RL
#pragma unroll
            for (int bj = 0; bj < 2; ++bj) { const int col = 256 * u.pn + 64 * wc + 32 * bj + 8 * fq, t = col >> 4, p0 = col & 15;
                f32x4 a = acc[ai][bj][m][0], b = acc[ai][bj][m][1];
#pragma unroll
                for (int j = 0; j < 4; ++j) { a[j] = gelu_tanh(a[j]); b[j] = gelu_tanh(b[j]); }
                *(u32x4*)(Y + (size_t)(rl * TC + t) * SSMW + u.grp * GP + p0) = pack8(a, b); } }
    }
};
struct EpiGlu {
    static constexpr bool HAS_MID = false;
    const bf16_t* Y; bf16_t* YO;
    __device__ __forceinline__ void operator()(const pg::Acc& acc, const pg::Unit& u, int, int, int, int) const { EPI_LANES
        EPI_FOR { EPI_RL const int tok = u.pm * 256 + rl;
#pragma unroll
            for (int bj = 0; bj < 2; ++bj) { const int col = 256 * u.pn + 64 * wc + 32 * bj + 8 * fq;
                f32x4 ya, yb; unpack8(*(const u32x4*)(Y + (size_t)tok * SSMW + col), ya, yb);
                f32x4 a = acc[ai][bj][m][0], b = acc[ai][bj][m][1];
#pragma unroll
                for (int j = 0; j < 4; ++j) { a[j] = ya[j] * fast_sigmoid(a[j]); b[j] = yb[j] * fast_sigmoid(b[j]); }
                *(u32x4*)(YO + (size_t)tok * 2048 + col) = pack8(a, b); } }
    }
};
struct EpiMerge {
    static constexpr bool HAS_MID = true;
    const bf16_t* G; bf16_t* MG;
    __device__ __forceinline__ void mid(pg::Acc& acc, const pg::Unit& u, int, int, int, int) const { EPI_LANES
        EPI_FOR { EPI_RL const int tok = u.pm * 256 + rl;
#pragma unroll
            for (int bj = 0; bj < 2; ++bj) { const int col = 256 * u.pn + 64 * wc + 32 * bj + 8 * fq;
                f32x4 sa, sb, ga, gb; unpack8(*(const u32x4*)(G + (size_t)tok * 4096 + col), sa, sb); unpack8(*(const u32x4*)(G + (size_t)tok * 4096 + 2048 + col), ga, gb);
#pragma unroll
                for (int j = 0; j < 4; ++j) { acc[ai][bj][m][0][j] *= sa[j] * __builtin_amdgcn_rcpf(ga[j]); acc[ai][bj][m][1][j] *= sb[j] * __builtin_amdgcn_rcpf(gb[j]); } }
            __builtin_amdgcn_sched_barrier(0); }
    }
    __device__ __forceinline__ void operator()(const pg::Acc& acc, const pg::Unit& u, int, int, int, int) const { EPI_LANES
        EPI_FOR { EPI_RL const int tok = u.pm * 256 + rl;
#pragma unroll
            for (int bj = 0; bj < 2; ++bj) { const int col = 256 * u.pn + 64 * wc + 32 * bj + 8 * fq;
                f32x4 ga, gb; unpack8(*(const u32x4*)(G + (size_t)tok * 4096 + 2048 + col), ga, gb);
                *(u32x4*)(MG + (size_t)tok * 2048 + col) = pack8(acc[ai][bj][m][0] * ga, acc[ai][bj][m][1] * gb); } }
    }
};
struct EpiOutProj {
    static constexpr bool HAS_MID = false;
    const float* XR; float* XO;
    __device__ __forceinline__ void operator()(const pg::Acc& acc, const pg::Unit& u, int, int, int, int) const { EPI_LANES
        EPI_FOR { EPI_RL const int tok = u.pm * 256 + rl;
#pragma unroll
            for (int bj = 0; bj < 2; ++bj) { const size_t o = (size_t)tok * 2048 + 256 * u.pn + 64 * wc + 32 * bj + 8 * fq;
                *(f32x4*)(XO + o) = *(const f32x4*)(XR + o) + acc[ai][bj][m][0]; *(f32x4*)(XO + o + 4) = *(const f32x4*)(XR + o + 4) + acc[ai][bj][m][1]; } }
    }
};
struct EpiExp1 {
    static constexpr bool HAS_MID = false;
    const float* RSL; bf16_t* H;
    __device__ __forceinline__ void operator()(const pg::Acc& acc, const pg::Unit& u, int, int, int, int) const { EPI_LANES
        EPI_FOR { EPI_RL const int row = u.grp * CAP + u.pm * 256 + rl; const float rs = RSL[row];
            f32x4 h[2];
#pragma unroll
            for (int n = 0; n < 2; ++n)
#pragma unroll
                for (int j = 0; j < 4; ++j) { const float g = acc[ai][0][m][n][j] * rs, up = acc[ai][1][m][n][j] * rs; h[n][j] = g * fast_sigmoid(g) * up; }
            *(u32x2*)((unsigned char*)H + (size_t)row * FF + 128 * u.pn + 32 * wc + 8 * fq) = pack8_fp8(h[0] * H8_SCALE, h[1] * H8_SCALE); }
    }
};
struct EpiExp2 {
    static constexpr bool HAS_MID = false;
    const float* GATE; bf16_t* YX;
    __device__ __forceinline__ void operator()(const pg::Acc& acc, const pg::Unit& u, int, int, int, int) const { EPI_LANES
        EPI_FOR { EPI_RL const int row = u.grp * CAP + u.pm * 256 + rl; const float gt = GATE[row];
#pragma unroll
            for (int bj = 0; bj < 2; ++bj)
                *(u32x4*)(YX + (size_t)row * D + 256 * u.pn + 64 * wc + 32 * bj + 8 * fq) = pack8(acc[ai][bj][m][0] * gt, acc[ai][bj][m][1] * gt); }
    }
};

namespace att {
constexpr int KVBLK = 64, QBLK = 32;
constexpr int SHM_T = KVBLK * 256;
constexpr int OFF_K = 0, OFF_V = 3 * SHM_T, OFF_Q = 5 * SHM_T, OFF_WS = OFF_Q + 8 * 8192, OFF_BT = OFF_WS + 8 * 64 * 4, ATT_LDS_END = OFF_BT + 2048;
#define KSWZ(row, colB) ((row) * 256 + ((colB) ^ (((row) & 7) << 4)))
#define SBAR() __builtin_amdgcn_sched_barrier(0)
__device__ __forceinline__ int crow(int r, int hi) { return (r & 3) + 8 * (r >> 2) + 4 * hi; }
__device__ __forceinline__ int v_rd_base(int lane) { return ((lane & 3) << 3) | (((lane >> 2) & 3) << 6) | (((lane >> 4) & 1) << 5) | (((lane >> 5) & 1) << 8); }
constexpr int v_rd_off(int d0, int ks, int half) { return d0 * 512 + ks * 4096 + half * 2048; }
template <int OFF> __device__ __forceinline__ s16x4 tr_read(int vb) { s16x4 r; asm volatile("ds_read_b64_tr_b16 %0, %1 offset:%2" : "=&v"(r) : "v"(vb), "i"(OFF) : "memory"); return r; }
template <int D0> __device__ __forceinline__ void pv_one(f32x16& od, int vb, bf16x8 pa0, bf16x8 pa1, bf16x8 pa2, bf16x8 pa3) {
    const s16x4 l0 = tr_read<v_rd_off(D0, 0, 0)>(vb), h0 = tr_read<v_rd_off(D0, 0, 1)>(vb), l1 = tr_read<v_rd_off(D0, 1, 0)>(vb), h1 = tr_read<v_rd_off(D0, 1, 1)>(vb);
    const s16x4 l2 = tr_read<v_rd_off(D0, 2, 0)>(vb), h2 = tr_read<v_rd_off(D0, 2, 1)>(vb), l3 = tr_read<v_rd_off(D0, 3, 0)>(vb), h3 = tr_read<v_rd_off(D0, 3, 1)>(vb);
    asm volatile("s_waitcnt lgkmcnt(0)" ::: "memory"); SBAR();
#define PK(L, H) (bf16x8){L[0], L[1], L[2], L[3], H[0], H[1], H[2], H[3]}
    od = __builtin_amdgcn_mfma_f32_32x32x16_bf16(pa0, PK(l0, h0), od, 0, 0, 0);
    od = __builtin_amdgcn_mfma_f32_32x32x16_bf16(pa1, PK(l1, h1), od, 0, 0, 0);
    od = __builtin_amdgcn_mfma_f32_32x32x16_bf16(pa2, PK(l2, h2), od, 0, 0, 0);
    od = __builtin_amdgcn_mfma_f32_32x32x16_bf16(pa3, PK(l3, h3), od, 0, 0, 0);
#undef PK
}
__device__ __forceinline__ void pv_d0(f32x16* o, int vb, bf16x8 pa0, bf16x8 pa1, bf16x8 pa2, bf16x8 pa3) {
    pv_one<0>(o[0], vb, pa0, pa1, pa2, pa3); pv_one<1>(o[1], vb, pa0, pa1, pa2, pa3); pv_one<2>(o[2], vb, pa0, pa1, pa2, pa3); pv_one<3>(o[3], vb, pa0, pa1, pa2, pa3);
}
__device__ __forceinline__ int kq_addr(int row, int c) { return (c >> 2) * 4096 + row * 64 + (((c & 3) ^ ((row >> 2) & 3)) << 4); }
template <int COMP> __device__ __forceinline__ void qkt(f32x16& p0, f32x16& p1, const LAS char* Ks, const LAS char* Qs, int kq0, int kq1) {
    p0 = (f32x16){}; p1 = (f32x16){};
#pragma unroll
    for (int d0 = 0; d0 < 4; ++d0) { const int chi = COMP * 2 + (d0 >> 1); const int a = (d0 & 1) ? kq1 : kq0;
        const bf16x8 b0 = *(const LAS bf16x8*)(Ks + a + chi * 4096);
        const bf16x8 b1 = *(const LAS bf16x8*)(Ks + a + chi * 4096 + 2048);
        const bf16x8 qf = *(const LAS bf16x8*)(Qs + a + chi * 2048);
        p0 = __builtin_amdgcn_mfma_f32_32x32x16_bf16(b0, qf, p0, 0, 0, 0);
        p1 = __builtin_amdgcn_mfma_f32_32x32x16_bf16(b1, qf, p1, 0, 0, 0); }
}
__device__ __forceinline__ void sm_exp(f32x16& p0, f32x16& p1, const LAS float* bt, int relb, int dq, int hi) {
    if (dq > -191 && dq < 158) {
        const LAS float* bp = bt + relb + 4 * hi;
#pragma unroll
        for (int a = 0; a < 4; ++a) {
            float t0[4], t1[4];
#pragma unroll
            for (int b = 0; b < 4; ++b) { t0[b] = bp[8 * a + b]; t1[b] = bp[32 + 8 * a + b]; }
#pragma unroll
            for (int b = 0; b < 4; ++b) { p0[4 * a + b] += t0[b]; p1[4 * a + b] += t1[b]; }
            SBAR();
        } }
#pragma unroll
    for (int r = 0; r < 16; ++r) p0[r] = __builtin_amdgcn_exp2f(p0[r]);
#pragma unroll
    for (int r = 0; r < 16; ++r) p1[r] = __builtin_amdgcn_exp2f(p1[r]);
}
__device__ __forceinline__ void sm_fin(f32x16& p0, f32x16& p1, float& l_reg, bf16x8& pa0, bf16x8& pa1, bf16x8& pa2, bf16x8& pa3) {
    float ps = 0;
#pragma unroll
    for (int r = 0; r < 16; ++r) ps += p0[r];
#pragma unroll
    for (int r = 0; r < 16; ++r) ps += p1[r];
    { auto rr = __builtin_amdgcn_permlane32_swap(__float_as_uint(ps), __float_as_uint(ps), false, false);
      ps = __uint_as_float(rr[0]) + __uint_as_float(rr[1]); }
    l_reg += ps;
#define PK4(P, BASE, OUT) do { unsigned a0 = cvt_pk_bf16(P[BASE + 0], P[BASE + 1]), a1 = cvt_pk_bf16(P[BASE + 2], P[BASE + 3]);   \
    unsigned b0 = cvt_pk_bf16(P[BASE + 4], P[BASE + 5]), b1 = cvt_pk_bf16(P[BASE + 6], P[BASE + 7]);                              \
    auto r0 = __builtin_amdgcn_permlane32_swap(a0, b0, false, false); auto r1 = __builtin_amdgcn_permlane32_swap(a1, b1, false, false); \
    u32x4 w = {r0[0], r1[0], r0[1], r1[1]}; OUT = *reinterpret_cast<bf16x8*>(&w); } while (0)
    PK4(p0, 0, pa0); PK4(p0, 8, pa1); PK4(p1, 0, pa2); PK4(p1, 8, pa3);
#undef PK4
}
__device__ __forceinline__ void attn_dual(f32x16 (&o1)[4], f32x16 (&o2)[4], const bf16_t* __restrict__ Qg, const bf16_t* __restrict__ Kh, const bf16_t* __restrict__ Vh, LAS char* lds, int q0w) {
    int tz_ = threadIdx.x; asm volatile("" : "+v"(tz_));
    const int tid = tz_, wid = __builtin_amdgcn_readfirstlane(tid >> 6), lane = tid & 63, r32 = lane & 31, hi = lane >> 5;
    LAS char* K_lds = lds + OFF_K; LAS char* V_lds = lds + OFF_V; LAS char* Qs = lds + OFF_Q + wid * 8192;
    LAS float* ws = (LAS float*)(lds + OFF_WS) + wid * 64; LAS float* li_l = ws;
    const LAS float* bt = (const LAS float*)(lds + OFF_BT);
    float l1 = 0.f, l2 = 0.f;
#pragma unroll
    for (int d = 0; d < 4; ++d) { o1[d] = (f32x16){}; o2[d] = (f32x16){}; }
#pragma unroll
    for (int i = 0; i < 8; ++i) { const int ci = i * 64 + lane, row = (ci >> 2) & 31, c = (ci >> 7) * 4 + ((ci & 3) ^ ((row >> 2) & 3));
        __builtin_amdgcn_global_load_lds((const unsigned*)(Qg + (size_t)row * 1024 + c * 8), (LAS unsigned*)(Qs + i * 1024), 16, 0, 0); }
    const int kq0 = r32 * 64 + ((hi ^ ((r32 >> 2) & 3)) << 4), kq1 = r32 * 64 + (((2 + hi) ^ ((r32 >> 2) & 3)) << 4);
    unsigned ko0, vo0;
    { const int p = wid * 2;
        { const int ci = p * 64 + lane, row = (ci >> 2) & 63, c = (ci >> 8) * 4 + ((ci & 3) ^ ((row >> 2) & 3)); ko0 = (unsigned)(row * 1024 + c * 8) * 2u; }
        { const int ci = p * 64 + lane, sub = ci >> 5, kk = (sub >> 2) * 8 + ((ci >> 2) & 7), c = (sub & 3) * 32 + (ci & 3) * 8;
          const int k = (kk & ~0xC) | ((kk & 4) << 1) | ((kk & 8) >> 1); vo0 = (unsigned)(k * 1024 + c) * 2u; } }
    const unsigned pw = (unsigned)wid * 2048u;
#define DMA_K(buf, k0) do { const char* g_ = (const char*)(Kh + (size_t)(k0) * 1024); \
    __builtin_amdgcn_global_load_lds((const unsigned*)(g_ + ko0), (LAS unsigned*)(K_lds + (buf) * SHM_T + pw), 16, 0, 0); \
    __builtin_amdgcn_global_load_lds((const unsigned*)(g_ + ko0 + 32768u), (LAS unsigned*)(K_lds + (buf) * SHM_T + pw + 1024), 16, 0, 0); } while (0)
#define DMA_V(buf, k0) do { const char* g_ = (const char*)(Vh + (size_t)(k0) * 1024); \
    __builtin_amdgcn_global_load_lds((const unsigned*)(g_ + vo0), (LAS unsigned*)(V_lds + (buf) * SHM_T + pw), 16, 0, 0); \
    __builtin_amdgcn_global_load_lds((const unsigned*)(g_ + vo0 + 128u), (LAS unsigned*)(V_lds + (buf) * SHM_T + pw + 1024), 16, 0, 0); } while (0)
    const int vbb = (int)(size_t)V_lds + v_rd_base(lane);
    const int relq = 256 - (q0w + r32);
    f32x16 pA0, pA1, pB0, pB1; bf16x8 pa0, pa1, pa2, pa3; constexpr int NT = S / KVBLK;
    DMA_K(0, 0); DMA_K(1, KVBLK); DMA_V(0, 0);
    asm volatile("s_waitcnt vmcnt(0) lgkmcnt(0)" ::: "memory"); __syncthreads();
    qkt<0>(pA0, pA1, K_lds, Qs, kq0, kq1); sm_exp(pA0, pA1, bt, relq, 0 - q0w, hi);
    int kb = 0, vb = 0;
    int ureg = (0 - q0w <= -191) ? 0 : ((0 - q0w >= 158) ? 2 : 1);
    for (int j = 0; j < NT; ++j) {
        asm volatile("s_waitcnt vmcnt(0)" ::: "memory"); __syncthreads();
        const int kb1 = kb == 2 ? 0 : kb + 1, kb2 = kb1 == 2 ? 0 : kb1 + 1;
        if (j + 2 < NT) DMA_K(kb2, (j + 2) * KVBLK);
        if (j + 1 < NT) DMA_V(vb ^ 1, (j + 1) * KVBLK);
        const int dq = j * KVBLK - q0w;
        { const int u = (dq <= -191) ? 0 : ((dq >= 158) ? 2 : 1);
          if (u != ureg) {
              const float cp = ureg == 0 ? bt[0] : (ureg == 2 ? bt[511] : 0.f), cn = u == 0 ? bt[0] : (u == 2 ? bt[511] : 0.f);
              const float f = __builtin_amdgcn_exp2f(cp - cn);
#pragma unroll
              for (int d = 0; d < 4; ++d) { o1[d] = o1[d] * f; o2[d] = o2[d] * f; }
              l1 *= f; l2 *= f; ureg = u; } }
        sm_fin(pA0, pA1, l1, pa0, pa1, pa2, pa3); SBAR();
        qkt<1>(pB0, pB1, K_lds + kb * SHM_T, Qs, kq0, kq1); SBAR();
        pv_d0(o1, vbb + vb * SHM_T, pa0, pa1, pa2, pa3);
        sm_exp(pB0, pB1, bt, relq + j * KVBLK, dq, hi);
        sm_fin(pB0, pB1, l2, pa0, pa1, pa2, pa3); SBAR();
        if (j + 1 < NT) { qkt<0>(pA0, pA1, K_lds + kb1 * SHM_T, Qs, kq0, kq1); SBAR(); }
        pv_d0(o2, vbb + vb * SHM_T, pa0, pa1, pa2, pa3);
        if (j + 1 < NT) sm_exp(pA0, pA1, bt, relq + (j + 1) * KVBLK, dq + KVBLK, hi);
        kb = kb1; vb ^= 1;
    }
    if (hi == 0) li_l[r32] = l1; asm volatile("s_waitcnt lgkmcnt(0)" ::: "memory");
#pragma unroll
    for (int r = 0; r < 16; ++r) { const float rl = __builtin_amdgcn_rcpf(li_l[crow(r, hi)]);
#pragma unroll
        for (int d = 0; d < 4; ++d) o1[d][r] *= rl; }
    asm volatile("s_waitcnt lgkmcnt(0)" ::: "memory");
    if (hi == 0) li_l[r32] = l2; asm volatile("s_waitcnt lgkmcnt(0)" ::: "memory");
#pragma unroll
    for (int r = 0; r < 16; ++r) { const float rl = __builtin_amdgcn_rcpf(li_l[crow(r, hi)]);
#pragma unroll
        for (int d = 0; d < 4; ++d) o2[d][r] *= rl; }
#undef DMA_K
#undef DMA_V
}
}

__device__ __forceinline__ int t5_bucket(int rel) {
    const int side = rel > 0 ? 16 : 0; const int n = rel < 0 ? -rel : rel;
    if (n < 8) return side + n;
    const float v = logf((float)n / 8.0f) / 2.7725887f * 8.0f;
    int large = 8 + (int)v; large = large < 15 ? large : 15;
    return side + large;
}

struct Args { GAS const float* in[28]; GAS float* out; GAS unsigned char* ws; int ph_lo, ph_hi; };
typedef const Args __attribute__((address_space(4))) CArgs;
struct LayerW { bf16_t *WIN, *WGLU, *WBR, *WOUT, *WGU, *WD, *F, *BO; float *KTAB, *WRT; };
__device__ __forceinline__ LayerW layer_w(unsigned char* ws, int l) {
    unsigned char* b = ws + WS_LW + (size_t)l * LW_SIZE; LayerW w;
    w.WIN = (bf16_t*)(b + LW_WIN); w.WGLU = (bf16_t*)(b + LW_WGLU); w.WBR = (bf16_t*)(b + LW_WBR); w.WOUT = (bf16_t*)(b + LW_WOUT); w.WGU = (bf16_t*)(b + LW_WGU);
    w.WD = (bf16_t*)(b + LW_WD); w.F = (bf16_t*)(b + LW_F); w.BO = (bf16_t*)(b + LW_BO); w.KTAB = (float*)(b + LW_KTAB); w.WRT = (float*)(b + LW_WRT); return w;
}
enum { I_X = 0, I_WIN, I_ARE, I_AIM, I_LDT, I_BRE, I_BIM, I_CRE, I_CIM, I_SD, I_WGLU, I_WSB, I_QG, I_KG, I_LQ1, I_LK1, I_LQ2, I_LK2, I_SUBLN, I_WAB, I_RELB, I_WOUT,
       I_NMIX, I_NFFN, I_WR, I_WEG, I_WEU, I_WED };

struct TItem { const float* src; bf16_t* dst; const float* gain; int N, ldd, rowmode, f8; };
__device__ __forceinline__ void t_load(const TItem& t, f32x4 (&v)[16], int lane) {
    const int r = lane >> 4, q = lane & 15;
#pragma unroll
    for (int j = 0; j < 16; ++j) v[j] = __builtin_nontemporal_load((const f32x4*)(t.src + (size_t)(4 * j + r) * t.N + 4 * q));
}
__device__ __forceinline__ void t_lds(const f32x4 (&v)[16], LAS float* scr, int lane) {
    const int r = lane >> 4, q = lane & 15;
#pragma unroll
    for (int j = 0; j < 16; ++j) { LAS float* s = scr + (4 * j + r) * 65 + 4 * q; s[0] = v[j][0]; s[1] = v[j][1]; s[2] = v[j][2]; s[3] = v[j][3]; }
}
__device__ __forceinline__ void t_store(const TItem& t, int n0, LAS float* scr, int lane) {
    const int c = lane & 7;
    float gn[8];
#pragma unroll
    for (int i = 0; i < 8; ++i) gn[i] = t.gain ? t.gain[8 * c + i] : 1.f;
#pragma unroll
    for (int j = 0; j < 8; ++j) { const int n = (lane >> 3) + 8 * j; const LAS float* s = scr + (8 * c) * 65 + n;
        u32x4 o; o.x = cvt_pk_bf16(s[0 * 65] * gn[0], s[1 * 65] * gn[1]); o.y = cvt_pk_bf16(s[2 * 65] * gn[2], s[3 * 65] * gn[3]);
        o.z = cvt_pk_bf16(s[4 * 65] * gn[4], s[5 * 65] * gn[5]); o.w = cvt_pk_bf16(s[6 * 65] * gn[6], s[7 * 65] * gn[7]);
        const int ng = n0 + n; const int drow = t.rowmode == 0 ? ng : ((ng >> 7) * 256 + ((ng >> 5) & 3) * 64 + (ng & 31) + (t.rowmode == 2 ? 32 : 0));
        if (t.f8) { const f32x4 a = (f32x4){s[0 * 65] * gn[0], s[1 * 65] * gn[1], s[2 * 65] * gn[2], s[3 * 65] * gn[3]} * W8_SCALE, b = (f32x4){s[4 * 65] * gn[4], s[5 * 65] * gn[5], s[6 * 65] * gn[6], s[7 * 65] * gn[7]} * W8_SCALE;
            *(u32x2*)((unsigned char*)t.dst + (size_t)drow * t.ldd + 8 * c) = pack8_fp8(a, b); }
        else *(u32x4*)(t.dst + (size_t)drow * t.ldd + 8 * c) = o; }
}

constexpr int IT_WIN = (D / 64) * (INC / 64), IT_GLU = 16 * 16, IT_BR = 16 * 32, IT_OUT = 32 * 32, IT_E = 32 * 32;
constexpr int DEF_A = 6144, DEF_B = 14336, DEF_C = 22528, DEF_UP = DEF_C - NE * IT_E;
constexpr int IT_LAYER0 = IT_WIN + IT_GLU + 2 * IT_BR + IT_OUT + 2 * NE * IT_E - DEF_UP;
constexpr int IT_DOWN = NE * IT_E;
__device__ __forceinline__ TItem make_item(const float* src, bf16_t* dst, const float* gain, int N, int ldd, int rowmode, int f8, int r, int& n0) {
    const int nblk = N / 64, k0 = 64 * (r / nblk); n0 = 64 * (r % nblk);
    TItem t; t.src = src + (size_t)k0 * N + n0; t.dst = f8 ? (bf16_t*)((unsigned char*)dst + k0) : dst + k0; t.gain = gain ? gain + k0 : nullptr; t.N = N; t.ldd = ldd; t.rowmode = rowmode; t.f8 = f8; return t; }
struct DecMain { CArgs* ap; unsigned char* ws;
    __device__ __forceinline__ TItem operator()(int it, int& n0) const { CArgs& args = *ap;
        const int l = it / IT_LAYER0; int r = it % IT_LAYER0; const LayerW w = layer_w(ws, l);
        if (r < IT_WIN) return make_item((const float*)args.in[I_WIN] + (size_t)l * D * INC, w.WIN, (const float*)args.in[I_NMIX] + l * D, INC, D, 0, 0, r, n0);
        if ((r -= IT_WIN) < IT_GLU) return make_item((const float*)args.in[I_WGLU] + (size_t)l * SSMW * SSMW, w.WGLU, nullptr, SSMW, SSMW, 0, 0, r, n0);
        if ((r -= IT_GLU) < IT_BR) return make_item((const float*)args.in[I_WSB] + (size_t)l * SSMW * D, w.WBR, nullptr, D, 2048, 0, 0, r, n0);
        if ((r -= IT_BR) < IT_BR) return make_item((const float*)args.in[I_WAB] + (size_t)l * 1024 * D, w.WBR + 1024, nullptr, D, 2048, 0, 0, r, n0);
        if ((r -= IT_BR) < IT_OUT) return make_item((const float*)args.in[I_WOUT] + (size_t)l * D * D, w.WOUT, nullptr, D, D, 0, 0, r, n0);
        r -= IT_OUT; const int which = r / (NE * IT_E), e = (r / IT_E) % NE; r = r % IT_E;   const size_t eo = ((size_t)l * NE + e) * D * FF;
        return make_item((const float*)args.in[which == 0 ? I_WEG : I_WEU] + eo, (bf16_t*)((unsigned char*)w.WGU + (size_t)e * 4096 * D), (const float*)args.in[I_NFFN] + l * D, FF, D, which == 0 ? 1 : 2, 1, r, n0); } };
struct DecDown { CArgs* ap; unsigned char* ws; int l;
    __device__ __forceinline__ TItem operator()(int it, int& n0) const { CArgs& args = *ap; const LayerW w = layer_w(ws, l);
        if (it >= IT_DOWN) { const int u = NE * IT_E - 1 - (it - IT_DOWN), e = u / IT_E; const size_t eo = ((size_t)l * NE + e) * D * FF;
            return make_item((const float*)args.in[I_WEU] + eo, (bf16_t*)((unsigned char*)w.WGU + (size_t)e * 4096 * D), (const float*)args.in[I_NFFN] + l * D, FF, D, 2, 1, u % IT_E, n0); }
        const int e = it / IT_E, r = it % IT_E; const size_t eo = ((size_t)l * NE + e) * D * FF;
        return make_item((const float*)args.in[I_WED] + eo, (bf16_t*)((unsigned char*)w.WD + (size_t)e * D * FF), nullptr, D, FF, 0, 1, r, n0); } };
template <class Dec> __device__ __forceinline__ void convert_items(const Dec& dec, int first, int end, int step, LAS float* scr, int lane) {
    f32x4 tv[16]; int n0c = 0, n0n = 0; TItem cur, nxt; cur.src = nullptr; cur.dst = nullptr; cur.gain = nullptr; cur.N = 0; cur.ldd = 0; cur.rowmode = 0; cur.f8 = 0; nxt = cur;
    int it = first;
    if (it < end) { cur = dec(it, n0c); t_load(cur, tv, lane); }
    for (; it < end; it += step) {
        t_lds(tv, scr, lane);
        if (it + step < end) { nxt = dec(it + step, n0n); t_load(nxt, tv, lane); }
        LDS_WAIT(); asm volatile("" ::: "memory");
        t_store(cur, n0c, scr, lane);
        LDS_WAIT(); asm volatile("" ::: "memory");
        cur = nxt; n0c = n0n; }
}

template <class Dec> __device__ __forceinline__ void convert_items_dyn(const Dec& dec, unsigned* cnt, int base, int end, LAS float* scr, volatile LAS unsigned* word, int wave, int lane) {
    for (;;) {
        __syncthreads();
        if (threadIdx.x == 0) *word = __hip_atomic_fetch_add(cnt, 32u, __ATOMIC_RELAXED, __HIP_MEMORY_SCOPE_AGENT);
        __syncthreads();
        const int b = base + (int)*word;
        if (b >= end) break;
        convert_items(dec, b + wave, (b + 32 < end) ? b + 32 : end, 8, scr, lane);
    }
}

template <bool ROUTER>
__device__ __forceinline__ void row_pass(const float* xrow, bf16_t* xb, float* rinv_out, const LAS float* WtL, float* afft, int row, int lane) {
    f32x4 v[8]; float ss = 0.f;
#pragma unroll
    for (int j = 0; j < 8; ++j) { v[j] = *(const f32x4*)(xrow + 4 * lane + 256 * j); ss += v[j][0] * v[j][0] + v[j][1] * v[j][1] + v[j][2] * v[j][2] + v[j][3] * v[j][3]; }
    ss = wave_sum(ss);
    const float rinv = __builtin_amdgcn_rsqf(ss * (1.f / D) + EPS);
#pragma unroll
    for (int j = 0; j < 8; ++j) { u32x2 w; w.x = cvt_pk_bf16(v[j][0], v[j][1]); w.y = cvt_pk_bf16(v[j][2], v[j][3]); *(u32x2*)(xb + 4 * lane + 256 * j) = w; }
    if (lane == 0) *rinv_out = rinv;
    if constexpr (ROUTER) {
        float lg[16];
#pragma unroll
        for (int e = 0; e < 16; ++e) { float a = 0.f;
#pragma unroll
            for (int j = 0; j < 8; ++j) { const f32x4 w = *(const LAS f32x4*)(WtL + e * 2048 + 4 * lane + 256 * j); a += v[j][0] * w[0] + v[j][1] * w[1] + v[j][2] * w[2] + v[j][3] * w[3]; }
            lg[e] = wave_sum(a) * rinv; }
        float mx = lg[0];
#pragma unroll
        for (int e = 1; e < 16; ++e) mx = fmaxf(mx, lg[e]);
        float sum = 0.f;
#pragma unroll
        for (int e = 0; e < 16; ++e) { lg[e] = __expf(lg[e] - mx); sum += lg[e]; }
        const float inv = 1.f / sum;
        float mine = 0.f;
#pragma unroll
        for (int e = 0; e < 16; ++e) mine = (lane == e) ? lg[e] * inv : mine;
        if (lane < 16) afft[(size_t)lane * S + row] = mine;
    }
}

__device__ __forceinline__ int block_sum_i(int v, LAS int* red, int wave, int lane) {
#pragma unroll
    for (int o = 1; o < 64; o <<= 1) v += __shfl_xor(v, o);
    __syncthreads();
    if (lane == 0) red[wave] = v;
    __syncthreads();
    int t = 0;
#pragma unroll
    for (int w = 0; w < 8; ++w) t += red[w];
    return t;
}

__device__ __forceinline__ void block_sum2_i(int& a, int& b, LAS int* red, int wave, int lane) {
#pragma unroll
    for (int o = 1; o < 64; o <<= 1) { a += __shfl_xor(a, o); b += __shfl_xor(b, o); }
    __syncthreads();
    if (lane == 0) { red[wave] = a; red[8 + wave] = b; }
    __syncthreads();
    int ta = 0, tb = 0;
#pragma unroll
    for (int w = 0; w < 8; ++w) { ta += red[w]; tb += red[8 + w]; }
    a = ta; b = tb;
}

__global__ void __launch_bounds__(512, 2) fwd(Args kargs) {
    extern __shared__ __attribute__((aligned(16))) unsigned char lds_raw[];
    LAS unsigned char* lds = (LAS unsigned char*)lds_raw;
    volatile LAS unsigned* MISC = (volatile LAS unsigned*)(lds + MISC_OFF);
    const int G = gridDim.x;
    unsigned* ctl = (unsigned*)((unsigned char*)kargs.ws + WS_CTL);
    if (threadIdx.x < 64) MISC[threadIdx.x] = 0u;
    __syncthreads();
    XcdBarrier bar; bar.bar = ctl + 1024; bar.x = 0; bar.st = nullptr;
    if (!MK_PER_PHASE) bar = xcd_barrier_post(ctl + 1024, MISC + 8);
    const int lo = kargs.ph_lo, hi = kargs.ph_hi;
#ifndef PH_MASK
#define PH_MASK 0xFFFF
#endif
#define PON(b) ((PH_MASK >> (b)) & 1)
#ifndef REP_MASK
#define REP_MASK 0
#endif
#define REPS(b) (((REP_MASK >> (b)) & 1) ? 2 : 1)
#define IN(k) (lo <= (k) && (k) < hi)
#define PH_ENTER int tz0_ = threadIdx.x; asm volatile("" : "+v"(tz0_)); int bz0_ = blockIdx.x; asm volatile("" : "+s"(bz0_)); \
    const int tid = tz0_, lane = tid & 63, wave = __builtin_amdgcn_readfirstlane(tid >> 6), bx = bz0_, vcu = (G % 8 == 0) ? (bx % 8) * (G / 8) + bx / 8 : bx, gw = vcu * 8 + wave, NGW = G * 8; \
    (void)lane; (void)wave; (void)bx; (void)vcu; (void)gw; (void)NGW; \
      \
    CArgs* ap_ = (CArgs*)__builtin_amdgcn_kernarg_segment_ptr(); asm volatile("" : "+s"(ap_)); CArgs& args = *ap_; \
    unsigned char* const ws = (unsigned char*)args.ws; unsigned char* const act = ws + WS_ACT; unsigned char* const sm = act + A_SMALL; (void)sm; \
    bf16_t* const XB = (bf16_t*)(act + A_XB); bf16_t* const XB1 = (bf16_t*)(act + A_XB1); bf16_t* const UA = (bf16_t*)(act + A_UA); \
    bf16_t* const Qb = (bf16_t*)(act + A_Q); bf16_t* const Kb = (bf16_t*)(act + A_K); bf16_t* const Vb = (bf16_t*)(act + A_V); bf16_t* const Gb = (bf16_t*)(act + A_G); \
    float* const SSUM = (float*)(act + A_SSUM); bf16_t* const Yb = (bf16_t*)(act + A_Y); bf16_t* const YO = (bf16_t*)(act + A_YO); \
    bf16_t* const MG = (bf16_t*)(act + A_MG); float* const XA = (float*)(act + A_XA); bf16_t* const XG = (bf16_t*)(act + A_XG); bf16_t* const Hb = (bf16_t*)(act + A_H); bf16_t* const YX = (bf16_t*)(act + A_YX); \
    float* const RINV = (float*)(sm + SM_RINV); float* const RINV2 = (float*)(sm + SM_RINV2); float* const AFFT = (float*)(sm + SM_AFFT); int* const IDX = (int*)(sm + SM_IDX); \
    float* const GATE = (float*)(sm + SM_GATE); float* const RSL = (float*)(sm + SM_RSL); int* const INV = (int*)(sm + SM_INV); float* const LAMS = (float*)(sm + SM_LAM); \
    (void)XB; (void)XB1; (void)UA; (void)Qb; (void)Kb; (void)Vb; (void)Gb; (void)SSUM; (void)Yb; (void)YO; (void)MG; (void)XA; (void)XG; (void)Hb; (void)YX; \
    (void)RINV; (void)RINV2; (void)AFFT; (void)IDX; (void)GATE; (void)RSL; (void)INV; (void)LAMS;
#define INP(i) ((const float*)args.in[i])
#define OUTP ((float*)args.out)
#define LAYER_ENTER const LayerW w = layer_w(ws, l); const float lam_init = (l == 0) ? 0.2f : 0.35550906759f;   \
    const float* const xres = (l == 0) ? INP(I_X) : XA; float* const xnew = (l == NL - 1) ? OUTP : XA; (void)w; (void)lam_init; (void)xres; (void)xnew;
#define SEAM(k) do { if (IN(k) && IN((k) + 1)) { if (!MK_PER_PHASE) xcd_barrier(bar); } } while (0)

    if (PON(0) && IN(0)) _Pragma("nounroll") for (int rep_ = 0; rep_ < REPS(0); ++rep_) { PH_ENTER
        LAS float* scr = (LAS float*)(lds + wave * 16640);
        convert_items(DecMain{ap_, ws}, gw, NL * IT_LAYER0, NGW, scr, lane);
        for (int i = gw * 64 + lane; i < NL * NE * D; i += NGW * 64) { const int l = i / (NE * D), e = (i / D) % NE, k = i % D;
            layer_w(ws, l).WRT[e * D + k] = INP(I_NFFN)[l * D + k] * INP(I_WR)[((size_t)l * D + k) * NE + e]; }
        for (int it = gw; it < NL * NGRP * 2 * TC; it += NGW) {
            const int l = it / (NGRP * 2 * TC), g = (it / (2 * TC)) % NGRP, dir = (it / TC) % 2, dl = it % TC;
            const size_t pb = ((size_t)(l * 2 + dir) * NGRP + g);
            const float are = INP(I_ARE)[pb * NST + lane], aim = INP(I_AIM)[pb * NST + lane], dt = expf(INP(I_LDT)[pb]);
            const float mag1 = expf(are * dt), ang1 = aim * dt, b1r = mag1 * cosf(ang1), b1i = mag1 * sinf(ang1);
            const float nr = b1r - 1.f, ni = b1i, den = are * are + aim * aim;
            const float cr = (nr * are + ni * aim) / den, ci = (ni * are - nr * aim) / den;
            const float magd = expf(are * dt * (float)dl), angd = aim * dt * (float)dl, pr = magd * cosf(angd), pi = magd * sinf(angd);
            const float wre = pr * cr - pi * ci, wim = pr * ci + pi * cr;
            const int p = lane >> 2, q0 = (lane & 3) * 4;
            const float* cre = INP(I_CRE) + (pb * GP + p) * NST; const float* cim = INP(I_CIM) + (pb * GP + p) * NST;
            const float* bre = INP(I_BRE) + pb * NST * GP + q0; const float* bim = INP(I_BIM) + pb * NST * GP + q0;
            f32x4 out = {0.f, 0.f, 0.f, 0.f};
            for (int n = 0; n < NST; ++n) {
                const float wr_ = __shfl(wre, n), wi_ = __shfl(wim, n);
                const float c_r = cre[n], c_i = cim[n];
                const float er = c_r * wr_ - c_i * wi_, ei = c_r * wi_ + c_i * wr_;
                const f32x4 br = *(const f32x4*)(bre + n * GP), bi = *(const f32x4*)(bim + n * GP);
                out += br * er - bi * ei;
            }
            *(f32x4*)(layer_w(ws, l).KTAB + ((((size_t)g * 2 + dir) * TC + dl) * GP + p) * GP + q0) = out;
        }
        for (int it = gw; it < NL * NGRP * 2 * TC; it += NGW) {
            const int l = it / (NGRP * 2 * TC), g = (it / (2 * TC)) % NGRP, dir = (it / TC) % 2, t = it % TC;
            const LayerW w = layer_w(ws, l);
            const size_t pb = ((size_t)(l * 2 + dir) * NGRP + g);
            const float are = INP(I_ARE)[pb * NST + lane], aim = INP(I_AIM)[pb * NST + lane], dt = expf(INP(I_LDT)[pb]);
            { const float e = dir == 0 ? (float)(t + 1) : (float)(TC - t); const float mg = expf(are * dt * e), an = aim * dt * e, pr = mg * cosf(an), pi = mg * sinf(an);
              float crv[GP], civ[GP];
#pragma unroll
              for (int p = 0; p < GP; ++p) { crv[p] = INP(I_CRE)[(pb * GP + p) * NST + lane]; civ[p] = INP(I_CIM)[(pb * GP + p) * NST + lane]; }
#pragma unroll
              for (int p = 0; p < GP; ++p) { bf16_t* o = w.BO + ((size_t)g * 512 + t * 16 + p) * UAW + 512 + dir * 128 + lane;
                  o[0] = f2bf(crv[p] * pr - civ[p] * pi); o[64] = f2bf(-(crv[p] * pi + civ[p] * pr)); } }
            { const float mag1 = expf(are * dt), ang1 = aim * dt, b1r = mag1 * cosf(ang1), b1i = mag1 * sinf(ang1);
              const float nr = b1r - 1.f, ni = b1i, den = are * are + aim * aim;
              const float cr = (nr * are + ni * aim) / den, ci = (ni * are - nr * aim) / den;
              const float e = dir == 0 ? (float)(TC - 1 - t) : (float)t; const float mg = expf(are * dt * e), an = aim * dt * e, pr = mg * cosf(an), pi = mg * sinf(an);
              const float wre = pr * cr - pi * ci, wim = pr * ci + pi * cr;
              const float* bre = INP(I_BRE) + (pb * NST + lane) * GP; const float* bim = INP(I_BIM) + (pb * NST + lane) * GP;
              f32x4 re[4], im[4];
#pragma unroll
              for (int q = 0; q < 4; ++q) { const f32x4 br = *(const f32x4*)(bre + 4 * q), bi = *(const f32x4*)(bim + 4 * q); re[q] = br * wre - bi * wim; im[q] = bi * wre + br * wim; }
              bf16_t* o = w.F + ((size_t)g * 256 + dir * 128 + lane) * 512 + t * 16;
              *(u32x4*)o = pack8(re[0], re[1]); *(u32x4*)(o + 8) = pack8(re[2], re[3]);
              *(u32x4*)(o + 64 * 512) = pack8(im[0], im[1]); *(u32x4*)(o + 64 * 512 + 8) = pack8(im[2], im[3]); }
        }
        for (int m = gw; m < S; m += NGW) row_pass<false>(INP(I_X) + (size_t)m * D, XB + (size_t)m * D, RINV + m, nullptr, nullptr, m, lane);
        if (gw < NL) { const int l = gw; const float a = wave_sum(INP(I_LQ1)[l * QKD + lane] * INP(I_LK1)[l * QKD + lane]);
            const float b = wave_sum(INP(I_LQ2)[l * QKD + lane] * INP(I_LK2)[l * QKD + lane]);
            if (lane == 0) LAMS[l] = expf(a) - expf(b) + ((l == 0) ? 0.2f : 0.35550906759f); }
        for (int i = gw * 64 + lane; i < NH * 512; i += NGW * 64) { const int h = i >> 9, rel = (i & 511) - 256;
            ((float*)(sm + SM_BTAB))[i] = INP(I_RELB)[t5_bucket(rel) * NH + h] * LOG2E; }
    }
    SEAM(0);

    for (int l = 0; l < NL; ++l) {
        const int pbase = 2 + l * 14;
        if (PON(2) && IN(pbase + 0)) _Pragma("nounroll") for (int rep_ = 0; rep_ < REPS(2); ++rep_) { PH_ENTER LAYER_ENTER
            pg::SchedGrid Sg; Sg.init(XB, D, w.WIN, D, S, INC, G, bx); Sg.mix32 = true;
            EpiInProj E{RINV, UA, Qb, Kb, Vb, Gb, INP(I_QG) + l * QKD, INP(I_KG) + l * QKD};
            pg::gemm_phase(lds, D, D, D, Sg, E);
        }
        SEAM(pbase + 0);
        if (PON(3) && IN(pbase + 1)) _Pragma("nounroll") for (int rep_ = 0; rep_ < REPS(3); ++rep_) { PH_ENTER LAYER_ENTER
            pg::SchedGroup Sg; Sg.init(UA, UAW, (size_t)NCH * UAW * 2, w.F, 512, (size_t)256 * 512 * 2, 1, 1, NGRP, G, vcu);
            EpiSsum E{SSUM};
            pg::gemm_phase(lds, 512, UAW, 512, Sg, E);
            if (vcu >= NGRP) for (long i = (long)((vcu - NGRP) * 8 + wave) * 64 + lane; i < (long)NGRP * 512 * 64; i += (long)(G - NGRP) * 8 * 64) {
            const int l2 = l, g = (int)(i / (512 * 64)) % NGRP, rr = (int)(i / 64) % 512, kc = (int)(i % 64);
            const int t = rr >> 4, p = rr & 15, tau = kc >> 1, q0 = (kc & 1) * 8;
            const LayerW w2 = layer_w(ws, l2);
            const float* kf = w2.KTAB + (((size_t)g * 2 + 0) * TC) * 256; const float* kb = w2.KTAB + (((size_t)g * 2 + 1) * TC) * 256;
            f32x4 a, b;
            if (tau < t) { const float* s = kf + ((t - tau) * GP + p) * GP + q0; a = *(const f32x4*)s; b = *(const f32x4*)(s + 4); }
            else if (tau > t) { const float* s = kb + ((tau - t) * GP + p) * GP + q0; a = *(const f32x4*)s; b = *(const f32x4*)(s + 4); }
            else { const float* s = kf + p * GP + q0; const float* s2 = kb + p * GP + q0; a = *(const f32x4*)s + *(const f32x4*)s2; b = *(const f32x4*)(s + 4) + *(const f32x4*)(s2 + 4);
                const float dd = INP(I_SD)[l2 * SSMW + g * GP + p];
#pragma unroll
                for (int j = 0; j < 4; ++j) { if (q0 + j == p) a[j] += dd; if (q0 + 4 + j == p) b[j] += dd; } }
            *(u32x4*)(w2.BO + ((size_t)g * 512 + rr) * UAW + tau * 16 + q0) = pack8(a, b);
        }
            if (vcu < NGRP && wave < 2) {
                const int g = vcu, dir = wave; const size_t pb = ((size_t)(l * 2 + dir) * NGRP + g);
                const float are = INP(I_ARE)[pb * NST + lane], aim = INP(I_AIM)[pb * NST + lane], dt = expf(INP(I_LDT)[pb]);
                const float mg = expf(are * dt * (float)TC), an = aim * dt * (float)TC, ar = mg * cosf(an), ai = mg * sinf(an);
                float sr = 0.f, si = 0.f;
                for (int cb = 0; cb < NCH; cb += 8) {
                    float xr[8], xi[8];
#pragma unroll
                    for (int k = 0; k < 8; ++k) { const int c = dir == 0 ? cb + k : NCH - 1 - cb - k; const float* s = SSUM + ((size_t)g * NCH + c) * 256 + dir * 128 + lane; xr[k] = s[0]; xi[k] = s[64]; }
#pragma unroll
                    for (int k = 0; k < 8; ++k) { const int c = dir == 0 ? cb + k : NCH - 1 - cb - k;
                        bf16_t* o = UA + ((size_t)g * NCH + c) * UAW + 512 + dir * 128 + lane; o[0] = f2bf(sr); o[64] = f2bf(si);
                        const float nr = ar * sr - ai * si + xr[k], ni = ar * si + ai * sr + xi[k]; sr = nr; si = ni; }
                }
            }
            convert_items_dyn(DecDown{ap_, ws, l}, (unsigned*)ws + 16384 + (l * 3 + 0) * 64, 0, DEF_A, (LAS float*)(lds + wave * 16640), MISC + 12, wave, lane);
        }
        SEAM(pbase + 1);
        if (PON(5) && IN(pbase + 3)) _Pragma("nounroll") for (int rep_ = 0; rep_ < REPS(5); ++rep_) { PH_ENTER LAYER_ENTER
            pg::SchedGroup Sg; Sg.init(UA, UAW, (size_t)NCH * UAW * 2, w.BO, UAW, (size_t)512 * UAW * 2, 1, 2, NGRP, G, vcu);
            EpiSsmOut E{Yb};
            pg::gemm_phase(lds, UAW, UAW, UAW, Sg, E);
            convert_items_dyn(DecDown{ap_, ws, l}, (unsigned*)ws + 16384 + (l * 3 + 1) * 64, DEF_A, DEF_B, (LAS float*)(lds + wave * 16640), MISC + 12, wave, lane);
        }
        SEAM(pbase + 3);
        if (PON(6) && IN(pbase + 4)) _Pragma("nounroll") for (int rep_ = 0; rep_ < REPS(6); ++rep_) { PH_ENTER LAYER_ENTER
            pg::SchedGrid Sg; Sg.init(Yb, SSMW, w.WGLU, SSMW, S, SSMW, G, bx);
            EpiGlu E{Yb, YO};
            pg::gemm_phase(lds, SSMW, SSMW, SSMW, Sg, E);
            convert_items_dyn(DecDown{ap_, ws, l}, (unsigned*)ws + 16384 + (l * 3 + 2) * 64, DEF_B, DEF_C, (LAS float*)(lds + wave * 16640), MISC + 12, wave, lane);
        }
        SEAM(pbase + 4);
        if (PON(7) && IN(pbase + 5)) _Pragma("nounroll") for (int rep_ = 0; rep_ < REPS(7); ++rep_) { PH_ENTER LAYER_ENTER
            for (int un = vcu; un < NH * (S / 256); un += G) {
                const int h = un / (S / 256), qb = un % (S / 256);
                __syncthreads();
                { int tb = threadIdx.x; asm volatile("" : "+v"(tb)); ((LAS float*)(lds + att::OFF_BT))[tb] = ((const float*)(sm + SM_BTAB))[h * 512 + tb]; }
                const int q0w = qb * 256 + wave * 32;
                f32x16 o[4];
                { f32x16 o2[4];
                  att::attn_dual(o, o2, Qb + (size_t)q0w * 1024 + h * 128, Kb + h * 128, Vb + h * 128, (LAS char*)lds, q0w);
                  const float lam = LAMS[l];
#pragma unroll
                  for (int d = 0; d < 4; ++d) o[d] = o[d] - o2[d] * lam; }
                { int tz = threadIdx.x; asm volatile("" : "+v"(tz)); const int r32 = tz & 31, hi2 = (tz >> 5) & 1;
                  float ssq[16];
#pragma unroll
                  for (int r = 0; r < 16; ++r) { float s = 0.f;
#pragma unroll
                    for (int d = 0; d < 4; ++d) s += o[d][r] * o[d][r];
                    s += swz_xor<1>(s); s += swz_xor<2>(s); s += swz_xor<4>(s); s += swz_xor<8>(s); s += swz_xor<16>(s);
                    ssq[r] = __builtin_amdgcn_rsqf(s * (1.f / VD) + EPS) * (1.f - lam_init); }
                  bf16_t* yo = YO + (size_t)(q0w + 4 * hi2) * 2048 + 1024 + h * 128 + r32;
#pragma unroll
                  for (int d = 0; d < 4; ++d) { const float gn = INP(I_SUBLN)[l * VD + d * 32 + r32];
#pragma unroll
                    for (int r = 0; r < 16; ++r) yo[(size_t)((r & 3) + 8 * (r >> 2)) * 2048 + d * 32] = f2bf(o[d][r] * ssq[r] * gn); } }
            }
            __syncthreads();
        }
        SEAM(pbase + 5);
        if (PON(8) && IN(pbase + 6)) _Pragma("nounroll") for (int rep_ = 0; rep_ < REPS(8); ++rep_) { PH_ENTER LAYER_ENTER
            pg::SchedGrid Sg; Sg.init(YO, 2048, w.WBR, 2048, S, D, G, bx);
            EpiMerge E{Gb, MG};
            pg::gemm_phase(lds, 2048, 2048, 2048, Sg, E);
        }
        SEAM(pbase + 6);
        if (PON(9) && IN(pbase + 7)) _Pragma("nounroll") for (int rep_ = 0; rep_ < REPS(9); ++rep_) { PH_ENTER LAYER_ENTER
            pg::SchedGrid Sg; Sg.init(MG, D, w.WOUT, D, S, D, G, bx);
            EpiOutProj E{xres, xnew};
            pg::gemm_phase(lds, D, D, D, Sg, E);
        }
        SEAM(pbase + 7);
        if (PON(10) && IN(pbase + 8)) _Pragma("nounroll") for (int rep_ = 0; rep_ < REPS(10); ++rep_) { PH_ENTER LAYER_ENTER
            LAS float* WtL = (LAS float*)lds;
            for (int i = tid; i < NE * D / 4; i += 512) ((LAS f32x4*)WtL)[i] = ((const f32x4*)w.WRT)[i];
            __syncthreads();
            for (int m = gw; m < S; m += NGW) { int lz = lane; asm volatile("" : "+v"(lz));
                row_pass<true>(xnew + (size_t)m * D, XB1 + (size_t)m * D, RINV2 + m, WtL, AFFT, m, lz); }
            __syncthreads();
        }
        SEAM(pbase + 8);
        if (PON(11) && IN(pbase + 9)) _Pragma("nounroll") for (int rep_ = 0; rep_ < REPS(11); ++rep_) { PH_ENTER LAYER_ENTER
            const int nparts = G / NE > 0 ? G / NE : 1;
            if (vcu < nparts * NE) {
                const int e = vcu / nparts, part = vcu % nparts, per = (CAP + nparts - 1) / nparts, slo = part * per, shi = (slo + per < CAP) ? slo + per : CAP;
                LAS int* red = (LAS int*)lds; LAS int* list = (LAS int*)(lds + 1024);
                unsigned bits[16]; { const float* a = AFFT + (size_t)e * S + tid * 16;
#pragma unroll
                    for (int q = 0; q < 4; ++q) { const f32x4 v = *(const f32x4*)(a + 4 * q); bits[4 * q] = __float_as_uint(v[0]); bits[4 * q + 1] = __float_as_uint(v[1]); bits[4 * q + 2] = __float_as_uint(v[2]); bits[4 * q + 3] = __float_as_uint(v[3]); } }
                unsigned T = 0u;
                for (int bit = 30; bit >= 0; bit -= 2) {
                    if (bit == 0) { const unsigned cand = T | 1u; int c = 0;
#pragma unroll
                        for (int i = 0; i < 16; ++i) c += bits[i] >= cand ? 1 : 0;
                        if (block_sum_i(c, red, wave, lane) >= CAP) T = cand; break; }
                    const unsigned c1 = T | (1u << (bit - 1)), c2 = T | (2u << (bit - 1)), c3 = T | (3u << (bit - 1)); int n12 = 0, n3 = 0;
#pragma unroll
                    for (int i = 0; i < 16; ++i) { n12 += (bits[i] >= c1 ? 1 : 0) + (bits[i] >= c2 ? 0x10000 : 0); n3 += bits[i] >= c3 ? 1 : 0; }
                    int s12 = n12, s3 = n3; block_sum2_i(s12, s3, red, wave, lane);
                    if (s3 >= CAP) T = c3; else if ((s12 >> 16) >= CAP) T = c2; else if ((s12 & 0xFFFF) >= CAP) T = c1; }
                int cg = 0, ce = 0;
#pragma unroll
                for (int i = 0; i < 16; ++i) { cg += bits[i] > T ? 1 : 0; ce += bits[i] == T ? 1 : 0; }
                const int need_eq = CAP - block_sum_i(cg, red, wave, lane);
                int sg = cg, se = ce;
#pragma unroll
                for (int o = 1; o < 64; o <<= 1) { const int a = __shfl_up(sg, o), b = __shfl_up(se, o); if (lane >= o) { sg += a; se += b; } }
                __syncthreads();
                if (lane == 63) { red[16 + wave] = sg; red[32 + wave] = se; }
                __syncthreads();
                int og = 0, oe = 0;
#pragma unroll
                for (int wv = 0; wv < 8; ++wv) if (wv < wave) { og += red[16 + wv]; oe += red[32 + wv]; }
                int gbef = og + sg - cg, ebef = oe + se - ce;
                const bool inv_mine = (tid * nparts) / 512 == part;
#pragma unroll
                for (int i = 0; i < 16; ++i) { const int tok = tid * 16 + i; const bool isg = bits[i] > T, ise = bits[i] == T; const bool sel = isg || (ise && ebef < need_eq);
                    const int slot = gbef + (ebef < need_eq ? ebef : need_eq);
                    if (sel && slot >= slo && slot < shi) { IDX[e * CAP + slot] = tok; GATE[e * CAP + slot] = __uint_as_float(bits[i]); RSL[e * CAP + slot] = RINV2[tok]; list[slot - slo] = tok; }
                    if (inv_mine) INV[tok * NE + e] = sel ? slot : -1;
                    gbef += isg ? 1 : 0; ebef += ise ? 1 : 0; }
                __syncthreads();
                for (int r = wave; r < shi - slo; r += 8) { const int tok = list[r]; const u32x4* s = (const u32x4*)(XB1 + (size_t)tok * D) + lane; u32x2* d = (u32x2*)((unsigned char*)XG + (size_t)(e * CAP + slo + r) * D) + lane;
#pragma unroll
                    for (int j = 0; j < 4; ++j) { f32x4 a, b; unpack8(s[64 * j], a, b); d[64 * j] = pack8_fp8(a, b); } }
                __syncthreads();
            }
        }
        SEAM(pbase + 9);
        if (PON(13) && IN(pbase + 11)) _Pragma("nounroll") for (int rep_ = 0; rep_ < REPS(13); ++rep_) { PH_ENTER LAYER_ENTER
            pg::SchedGroup Sg; Sg.init(XG, D, (size_t)CAP * D, w.WGU, D, (size_t)4096 * D, 4, 16, NE, G, vcu, 1);
            EpiExp1 E{RSL, Hb};
            pg::gemm_phase<EpiExp1, pg::SchedGroup, true, E8_ONE, E8_W>(lds, D, D, D, Sg, E);
        }
        SEAM(pbase + 11);
        if (PON(14) && IN(pbase + 12)) _Pragma("nounroll") for (int rep_ = 0; rep_ < REPS(14); ++rep_) { PH_ENTER LAYER_ENTER
            pg::SchedGroup Sg; Sg.init(Hb, FF, (size_t)CAP * FF, w.WD, FF, (size_t)D * FF, 4, 8, NE, G, vcu, 1);
            EpiExp2 E{GATE, YX};
            pg::gemm_phase<EpiExp2, pg::SchedGroup, true, E8_H, E8_W>(lds, FF, FF, FF, Sg, E);
        }
        SEAM(pbase + 12);
        if (PON(15) && IN(pbase + 13)) _Pragma("nounroll") for (int rep_ = 0; rep_ < REPS(15); ++rep_) { PH_ENTER LAYER_ENTER
            for (int m = gw; m < S; m += NGW) {
                float* xr = xnew + (size_t)m * D;
                f32x4 v[8];
#pragma unroll
                for (int j = 0; j < 8; ++j) v[j] = *(const f32x4*)(xr + 4 * lane + 256 * j);
                const int myinv = INV[m * NE + (lane & 15)];
                unsigned msk = (unsigned)(__ballot(myinv >= 0) & 0xFFFFull);
                while (msk) { const int e0 = __builtin_ctz(msk); msk &= msk - 1; const bool two = msk != 0u; const int e1 = two ? __builtin_ctz(msk) : e0; if (two) msk &= msk - 1;
                    const bf16_t* y0 = YX + ((size_t)e0 * CAP + __shfl(myinv, e0)) * D; const bf16_t* y1 = YX + ((size_t)e1 * CAP + __shfl(myinv, e1)) * D;
                    u32x2 a[8], b[8];
#pragma unroll
                    for (int j = 0; j < 8; ++j) a[j] = *(const u32x2*)(y0 + 4 * lane + 256 * j);
#pragma unroll
                    for (int j = 0; j < 8; ++j) b[j] = *(const u32x2*)(y1 + 4 * lane + 256 * j);
#pragma unroll
                    for (int j = 0; j < 8; ++j) { v[j][0] += bf_lo(a[j].x); v[j][1] += bf_hi(a[j].x); v[j][2] += bf_lo(a[j].y); v[j][3] += bf_hi(a[j].y); }
                    if (two) {
#pragma unroll
                        for (int j = 0; j < 8; ++j) { v[j][0] += bf_lo(b[j].x); v[j][1] += bf_hi(b[j].x); v[j][2] += bf_lo(b[j].y); v[j][3] += bf_hi(b[j].y); } } }
                float ss = 0.f;
#pragma unroll
                for (int j = 0; j < 8; ++j) { *(f32x4*)(xr + 4 * lane + 256 * j) = v[j]; ss += v[j][0] * v[j][0] + v[j][1] * v[j][1] + v[j][2] * v[j][2] + v[j][3] * v[j][3]; }
                if (l + 1 < NL) { ss = wave_sum(ss);
#pragma unroll
                    for (int j = 0; j < 8; ++j) { u32x2 wv; wv.x = cvt_pk_bf16(v[j][0], v[j][1]); wv.y = cvt_pk_bf16(v[j][2], v[j][3]); *(u32x2*)(XB + (size_t)m * D + 4 * lane + 256 * j) = wv; }
                    if (lane == 0) RINV[m] = __builtin_amdgcn_rsqf(ss * (1.f / D) + EPS); }
            }
        }
        SEAM(pbase + 13);
    }
#undef IN
#undef SEAM
}

#if defined(DBG_STOP)
#ifndef DBG_OFF
#define DBG_OFF A_XA
#endif
#ifndef DBG_BF16
#define DBG_BF16 0
#endif
__global__ void dbg_dump(float* out, const unsigned char* ws) {
    const unsigned char* p = ws + WS_ACT + DBG_OFF;
    for (size_t i = (size_t)blockIdx.x * 256 + threadIdx.x; i < (size_t)S * D; i += (size_t)gridDim.x * 256)
#if defined(DBG_SUM2)
        out[i] = __uint_as_float(((unsigned)((const bf16_t*)p)[i]) << 16) + __uint_as_float(((unsigned)((const bf16_t*)p)[i + (size_t)S * D]) << 16);
#else
        out[i] = DBG_BF16 ? __uint_as_float(((unsigned)((const bf16_t*)p)[i]) << 16) : ((const float*)p)[i];
#endif
}
#endif
constexpr int N_PHASES = 2 + NL * 14;
extern "C" void kernel_launch(void* const* d_in, const int* in_sizes, int n_in, void* d_out, int out_size, void* d_ws, size_t ws_size, hipStream_t stream) {
    static int grid = 0;
    if (grid == 0) {
        if (n_in != 28 || in_sizes[0] != S * D || out_size != S * D || ws_size < WS_END) { fprintf(stderr, "kernel_launch: shape/workspace mismatch (n_in %d, ws %zu, need %zu)\n", n_in, ws_size, (size_t)WS_END); grid = -1; return; }
        int dev = 0, cus = 0, per_cu = 0;
        if (hipGetDevice(&dev) != hipSuccess || hipDeviceGetAttribute(&cus, hipDeviceAttributeMultiprocessorCount, dev) != hipSuccess) { grid = -1; return; }
        if (hipFuncSetAttribute((const void*)fwd, hipFuncAttributeMaxDynamicSharedMemorySize, LDS_BYTES) != hipSuccess) { fprintf(stderr, "kernel_launch: hipFuncSetAttribute failed\n"); grid = -1; return; }
        if (hipOccupancyMaxActiveBlocksPerMultiprocessor(&per_cu, (const void*)fwd, 512, LDS_BYTES) != hipSuccess || per_cu < 1) { fprintf(stderr, "kernel_launch: occupancy query says %d\n", per_cu); }
        (void)hipGetLastError();
        grid = cus;
    }
    if (grid < 0) return;
    (void)hipMemsetAsync((char*)d_ws + WS_CTL, 0, CTL_BYTES, stream);
    Args a{};
    for (int i = 0; i < 28; ++i) a.in[i] = (GAS const float*)d_in[i];
    a.out = (GAS float*)d_out; a.ws = (GAS unsigned char*)d_ws;
#if defined(DBG_STOP)
    for (int p = 0; p < DBG_STOP; ++p) { a.ph_lo = p; a.ph_hi = p + 1; hipLaunchKernelGGL(fwd, dim3(grid), dim3(512), LDS_BYTES, stream, a); }
#if !defined(DBG_NODUMP)
    hipLaunchKernelGGL(dbg_dump, dim3(2048), dim3(256), 0, stream, (float*)d_out, (const unsigned char*)d_ws);
#endif
#elif MK_PER_PHASE
    for (int p = 0; p < N_PHASES; ++p) { a.ph_lo = p; a.ph_hi = p + 1; hipLaunchKernelGGL(fwd, dim3(grid), dim3(512), LDS_BYTES, stream, a); }
#else
    a.ph_lo = 0; a.ph_hi = N_PHASES; hipLaunchKernelGGL(fwd, dim3(grid), dim3(512), LDS_BYTES, stream, a);
#endif
    const hipError_t le = hipPeekAtLastError();
    if (le != hipSuccess) fprintf(stderr, "kernel_launch: launch failed: %s\n", hipGetErrorName(le));
}
```

```cpp
#include <hip/hip_runtime.h>
#include <cstdio>
#include <cstdint>

#define REP_MASK 7168
#ifndef MK_PER_PHASE
#define MK_PER_PHASE 0
#endif

#define LAS __attribute__((address_space(3)))
#define GAS __attribute__((address_space(1)))
typedef unsigned short bf16_t;
typedef short bf16x8 __attribute__((ext_vector_type(8)));
typedef short s16x4 __attribute__((ext_vector_type(4)));
typedef float f32x4 __attribute__((ext_vector_type(4)));
typedef float f32x2 __attribute__((ext_vector_type(2)));
typedef float f32x16 __attribute__((ext_vector_type(16)));
typedef unsigned u32x4 __attribute__((ext_vector_type(4)));
typedef unsigned u32x2 __attribute__((ext_vector_type(2)));

constexpr int S = 8192, D = 2048, NL = 2;
constexpr int SSMW = 1024, NGRP = 64, GP = 16, NST = 64;
constexpr int NH = 8, QKD = 64, VD = 128;
constexpr int NE = 16, CAP = 1024, FF = 2048;
constexpr int INC = 8192;
constexpr float EPS = 1e-6f;
constexpr int TC = 32, NCH = S / TC;
constexpr int UAW = TC * GP + 256;
constexpr float LOG2E = 1.4426950408889634f;

constexpr size_t MiB = 1u << 20;
constexpr size_t WS_CTL = 0, CTL_BYTES = 1 * MiB;
constexpr size_t LW_WIN = 0, LW_WGLU = 32 * MiB, LW_WBR = 34 * MiB, LW_WOUT = 42 * MiB, LW_WGU = 50 * MiB, LW_WD = 306 * MiB,
                 LW_F = 434 * MiB, LW_BO = 450 * MiB, LW_KTAB = 498 * MiB, LW_WRT = 502 * MiB, LW_SIZE = 503 * MiB;
constexpr size_t WS_LW = 1 * MiB;
constexpr size_t WS_ACT = WS_LW + 2 * LW_SIZE;
constexpr size_t A_XB = 0, A_XB1 = 32 * MiB, A_UA = 64 * MiB, A_Q = 88 * MiB, A_K = 104 * MiB, A_V = 120 * MiB, A_G = 136 * MiB,
                 A_SSUM = 200 * MiB, A_Y = 216 * MiB, A_YO = 232 * MiB, A_O1 = 264 * MiB, A_MG = 296 * MiB, A_XA = 328 * MiB,
                 A_XG = 392 * MiB, A_H = 456 * MiB, A_YX = 520 * MiB, A_SMALL = 584 * MiB, A_END = 588 * MiB;
constexpr size_t SM_RINV = 0, SM_RINV2 = 64 * 1024, SM_AFFT = 128 * 1024, SM_IDX = 640 * 1024, SM_GATE = 704 * 1024, SM_RSL = 768 * 1024,
                 SM_INV = 1024 * 1024, SM_BTAB = 1536 * 1024, SM_LAM = 1600 * 1024;
constexpr size_t WS_END = WS_ACT + A_END;

constexpr int RING_BYTES = 131072;
constexpr int LDS_BYTES = 163840;
constexpr int MISC_OFF = 155648;

typedef __bf16 bf16v2_t __attribute__((ext_vector_type(2)));
__device__ __forceinline__ unsigned cvt_pk_bf16(float lo, float hi) { const f32x2 v = {lo, hi}; return __builtin_bit_cast(unsigned, __builtin_convertvector(v, bf16v2_t)); }
__device__ __forceinline__ float bf_lo(unsigned w) { return __uint_as_float(w << 16); }
__device__ __forceinline__ float bf_hi(unsigned w) { return __uint_as_float(w & 0xffff0000u); }
__device__ __forceinline__ unsigned short f2bf(float f) { return (unsigned short)(cvt_pk_bf16(f, 0.f) & 0xffffu); }
__device__ __forceinline__ float fast_sigmoid(float x) { return __builtin_amdgcn_rcpf(1.f + __builtin_amdgcn_exp2f(-x * LOG2E)); }
__device__ __forceinline__ float wave_sum(float v) {
#pragma unroll
    for (int o = 1; o < 64; o <<= 1) v += __shfl_xor(v, o);
    return v;
}
template <int X> __device__ __forceinline__ float swz_xor(float v) { return __int_as_float(__builtin_amdgcn_ds_swizzle(__float_as_int(v), (X << 10) | 0x1F)); }
__device__ __forceinline__ u32x2 pack8_fp8(const f32x4 a, const f32x4 b) { int w0 = 0, w1 = 0;
    w0 = __builtin_amdgcn_cvt_pk_fp8_f32(a[0], a[1], w0, false); w0 = __builtin_amdgcn_cvt_pk_fp8_f32(a[2], a[3], w0, true);
    w1 = __builtin_amdgcn_cvt_pk_fp8_f32(b[0], b[1], w1, false); w1 = __builtin_amdgcn_cvt_pk_fp8_f32(b[2], b[3], w1, true);
    u32x2 r; r.x = (unsigned)w0; r.y = (unsigned)w1; return r; }
constexpr float W8_SCALE = 64.f, H8_SCALE = 16.f;
constexpr int E8_ONE = 0x7F7F7F7F, E8_W = 0x79797979  , E8_H = 0x7B7B7B7B  ;
#define LDS_WAIT() asm volatile("s_waitcnt lgkmcnt(0)" ::: "memory")
#define VM_WAIT() asm volatile("s_waitcnt vmcnt(0)" ::: "memory")

#define XB_TMO      128
#define XB_XCNT(j)  (256  + 64 * (j))
#define XB_XSUB(j)  (1280 + 64 * (j))
#define XB_XGEN(j)  (2304 + 64 * (j))
#define XB_TOP      3328
#define XB_TOPGEN   3392
#define XCD_BAR_WORDS 3456
#define XB_SPIN_CAP (1u << 22)
__device__ __forceinline__ unsigned xb_ld(unsigned* p)              { return __hip_atomic_load(p, __ATOMIC_RELAXED, __HIP_MEMORY_SCOPE_AGENT); }
__device__ __forceinline__ unsigned xb_add(unsigned* p, unsigned v) { return __hip_atomic_fetch_add(p, v, __ATOMIC_RELAXED, __HIP_MEMORY_SCOPE_AGENT); }
__device__ __forceinline__ unsigned xb_xcc_id() { return (unsigned)__builtin_amdgcn_s_getreg((3 << 11) | 20) & 0xFu; }
#define XB_SPIN(cond, bar) do { unsigned _sp = 0; while (cond) { __builtin_amdgcn_s_sleep(1); \
    if ((++_sp & 255u) == 0u) { if (xb_ld(&(bar)[XB_TMO])) break; if (_sp > XB_SPIN_CAP) { atomicAdd(&(bar)[XB_TMO], 1u); break; } } } } while (0)
struct XcdBarrier { unsigned* bar; unsigned x; volatile LAS unsigned* st; };
__device__ __forceinline__ XcdBarrier xcd_barrier_post(unsigned* bar, volatile LAS unsigned* st) {
    XcdBarrier b; b.bar = bar; b.x = xb_xcc_id(); b.st = st;
    if (threadIdx.x == 0) (void)xb_add(&bar[XB_XCNT(b.x)], 1u);
    return b;
}
__device__ __forceinline__ void xcd_barrier_complete(unsigned* bar, unsigned x, unsigned& nloc, unsigned& nx) {
    const unsigned G = gridDim.x * gridDim.y * gridDim.z;
    unsigned sum, cnt, mine, sp = 0u;
    for (;;) {
        sum = 0u; cnt = 0u; mine = 0u;
#pragma unroll
        for (unsigned j = 0; j < 16; ++j) { const unsigned c = xb_ld(&bar[XB_XCNT(j)]); sum += c; cnt += (c > 0u) ? 1u : 0u; mine = (j == x) ? c : mine; }
        if (sum == G) break;
        __builtin_amdgcn_s_sleep(1);
        if ((++sp & 255u) == 0u) { if (xb_ld(&bar[XB_TMO])) break; if (sp > XB_SPIN_CAP) { atomicAdd(&bar[XB_TMO], 1u); break; } }
    }
    nloc = mine > 0u ? mine : 1u; nx = cnt > 0u ? cnt : 1u;
}
__device__ __forceinline__ void xcd_barrier(const XcdBarrier& b) {
    asm volatile("s_waitcnt vmcnt(0)" ::: "memory");
    __syncthreads();
    if (threadIdx.x == 0) {
        unsigned* bar = b.bar;
        __builtin_amdgcn_s_waitcnt(0);
        unsigned nloc = b.st[0], nx = b.st[1];
        if (nloc == 0u) { xcd_barrier_complete(bar, b.x, nloc, nx); b.st[0] = nloc; b.st[1] = nx; }
        const unsigned old = xb_add(&bar[XB_XSUB(b.x)], 1u);
        const unsigned gen = old / nloc;
        if (old + 1u == (gen + 1u) * nloc) {
            __builtin_amdgcn_fence(__ATOMIC_RELEASE, "agent");
            asm volatile("s_waitcnt vmcnt(0)" ::: "memory");
            const unsigned og = xb_add(&bar[XB_TOP], 1u);
            const unsigned tg = og / nx;
            if (og + 1u == (tg + 1u) * nx) xb_add(&bar[XB_TOPGEN], 1u);
            else XB_SPIN(xb_ld(&bar[XB_TOPGEN]) == tg, bar);
            __builtin_amdgcn_fence(__ATOMIC_ACQUIRE, "agent");
            xb_add(&bar[XB_XGEN(b.x)], 1u);
            asm volatile("s_waitcnt vmcnt(0)" ::: "memory");
        } else {
            XB_SPIN(xb_ld(&bar[XB_XGEN(b.x)]) == gen, bar);
            __builtin_amdgcn_fence(__ATOMIC_ACQUIRE, "agent");
            asm volatile("s_waitcnt vmcnt(0)" ::: "memory");
        }
    }
    __syncthreads();
}

namespace pg {
constexpr int BM = 256, BK = 64, HALF = 128, HTB = HALF * BK * 2, STAGE_BYTES = 8 * HTB;
__device__ __forceinline__ int lds_byte(int r, int c) { const int st = (r >> 4) * 2 + (c >> 5), rr = r & 15, cc = c & 31, ob = rr * 64 + cc * 2; return st * 1024 + (ob ^ (((ob >> 9) & 1) << 5)); }
__device__ __forceinline__ void stage_rc(int b, int& R, int& C) { const int st = b / 1024, sb = b % 1024, swz = sb ^ (((sb >> 9) & 1) << 5); R = (st >> 1) * 16 + swz / 64; C = (st & 1) * 32 + (swz % 64) / 2; }
__device__ __forceinline__ int perm32(int rho) { const int n = rho >> 4, i = rho & 15; return 8 * (i >> 2) + 4 * n + (i & 3); }
struct Unit { const char* a; const char* b; int pm, pn, grp; };
typedef f32x4 Acc[2][2][4][2];

typedef int v8i_t __attribute__((ext_vector_type(8)));
template <class Epi, class Sched, bool F8 = false, int SA_ = 0x7F7F7F7F, int SB_ = 0x7F7F7F7F>
__device__ __forceinline__ void gemm_phase(LAS unsigned char* lds, const int K, const int lda, const int ldb, const Sched& S, const Epi& E) {
    int tz_ = threadIdx.x; asm volatile("" : "+v"(tz_));
    const int tid = tz_, wid = __builtin_amdgcn_readfirstlane(tid >> 6), lane = tid & 63, wr = wid >> 2, wc = wid & 3, fr = lane & 15, fq = lane >> 4;
    constexpr int ESZ = F8 ? 1 : 2;
    const int nt = K * ESZ / (BK * 2);
    unsigned voffA[2], voffB[2];
#pragma unroll
    for (int i = 0; i < 2; ++i) { int R, C; stage_rc(tid * 16 + i * 8192, R, C);
        voffA[i] = (unsigned)(R * lda * ESZ + C * 2); voffB[i] = (unsigned)((64 * (R >> 5) + perm32(R & 31)) * ldb * ESZ + C * 2); }
    const size_t kstep = (size_t)(BK * 2);
    const size_t hstepA = (size_t)HALF * lda * ESZ;
    const size_t hstepB = (size_t)32 * ldb * ESZ;
    const unsigned ldsw = (unsigned)wid * 1024u;
    const int aoff = F8 ? lds_byte(wr * 64 + fr, fq * 16) : lds_byte(wr * 64 + fr, fq * 8), boff = F8 ? lds_byte(wc * 32 + fr, fq * 16) : lds_byte(wc * 32 + fr, fq * 8);
#define PG8_SA(b, h) (((b) * 2 + (h)) * HTB)
#define PG8_SB(b, h) ((4 + (b) * 2 + (h)) * HTB)
#define PG8_STAGE(bufoff, gbase, voff) do { _Pragma("unroll") for (int _i = 0; _i < 2; ++_i) \
        __builtin_amdgcn_global_load_lds((const unsigned*)((const char*)(gbase) + (voff)[_i]), (LAS unsigned*)(lds + (bufoff) + ldsw + _i * 8192), 16, 0, 0); } while (0)
    typedef v8i_t v8i_a16 __attribute__((aligned(16)));
#define PG8_LD32(p) __builtin_bit_cast(v8i_t, __builtin_shufflevector(*(const LAS u32x4*)(p), *(const LAS u32x4*)((p) + 16), 0, 1, 2, 3, 4, 5, 6, 7))
#define PG8_LDA(dst, b, h) do { if constexpr (F8) { _Pragma("unroll") for (int m = 0; m < 4; ++m) dst##8[m] = PG8_LD32(lds + PG8_SA(b, h) + aoff + m * 2048); } \
        else { _Pragma("unroll") for (int m = 0; m < 4; ++m) _Pragma("unroll") for (int k = 0; k < 2; ++k) dst[m][k] = *(const LAS bf16x8*)(lds + PG8_SA(b, h) + aoff + m * 2048 + k * 1024); } } while (0)
#define PG8_LDB(dst, b, h) do { if constexpr (F8) { _Pragma("unroll") for (int n = 0; n < 2; ++n) dst##8[n] = PG8_LD32(lds + PG8_SB(b, h) + boff + n * 2048); } \
        else { _Pragma("unroll") for (int n = 0; n < 2; ++n) _Pragma("unroll") for (int k = 0; k < 2; ++k) dst[n][k] = *(const LAS bf16x8*)(lds + PG8_SB(b, h) + boff + n * 2048 + k * 1024); } } while (0)
#define PG8_MMA(ai, bj, At, Bt) do { __builtin_amdgcn_s_setprio(1); \
        if constexpr (F8) { _Pragma("unroll") for (int m = 0; m < 4; ++m) _Pragma("unroll") for (int n = 0; n < 2; ++n) \
            asm volatile("v_mfma_scale_f32_16x16x128_f8f6f4 %0, %1, %2, %0, %3, %4 op_sel_hi:[0,0,0]" : "+v"(acc[ai][bj][m][n]) : "v"(Bt##8[n]), "v"(At##8[m]), "v"(sbv), "v"(sav)); } \
        else { _Pragma("unroll") for (int m = 0; m < 4; ++m) _Pragma("unroll") for (int n = 0; n < 2; ++n) _Pragma("unroll") for (int k = 0; k < 2; ++k) \
            acc[ai][bj][m][n] = __builtin_amdgcn_mfma_f32_16x16x32_bf16(Bt[n][k], At[m][k], acc[ai][bj][m][n], 0, 0, 0); } \
        __builtin_amdgcn_s_setprio(0); } while (0)
#define PG8_WAIT_V(n) asm volatile("s_waitcnt vmcnt(" #n ")" ::: "memory")
#define PG8_WAIT_L(n) asm volatile("s_waitcnt lgkmcnt(" #n ")" ::: "memory")
#define PG8_BAR __builtin_amdgcn_s_barrier()
#define PG8_SCHED __builtin_amdgcn_sched_barrier(0)
    Unit cur, nxt; int ui = 0;
    if (!S.next(0, cur)) return;
    Acc acc;
#pragma unroll
    for (int a = 0; a < 2; ++a)
#pragma unroll
        for (int b = 0; b < 2; ++b)
#pragma unroll
            for (int m = 0; m < 4; ++m)
#pragma unroll
                for (int n = 0; n < 2; ++n) acc[a][b][m][n] = (f32x4){0.f, 0.f, 0.f, 0.f};
    bf16x8 At[4][2], B0[2][2], B1[2][2]; v8i_t At8[4], B08[2], B18[2];
    const int sav = SA_, sbv = SB_;
    const char* cA = cur.a; const char* cB = cur.b;
    PG8_STAGE(PG8_SB(0, 0), cB, voffB); PG8_STAGE(PG8_SA(0, 0), cA, voffA); PG8_STAGE(PG8_SB(0, 1), cB + hstepB, voffB); PG8_STAGE(PG8_SA(0, 1), cA + hstepA, voffA);
    if (wr == 1) PG8_BAR;
    PG8_WAIT_V(4); PG8_BAR;
    PG8_STAGE(PG8_SB(1, 0), cB + kstep, voffB); PG8_STAGE(PG8_SA(1, 0), cA + kstep, voffA); PG8_STAGE(PG8_SB(1, 1), cB + hstepB + kstep, voffB);
    PG8_WAIT_V(6); PG8_BAR;
    for (;;) {
        const bool has_next = S.next(ui + 1, nxt);
        const char* nA = has_next ? nxt.a : cA; const char* nB = has_next ? nxt.b : cB;
        for (int t = 0; t < nt; t += 2) {
            const bool last = (t == nt - 2);
            const char* a1 = cA + (size_t)(t + 1) * kstep;
            const char* a2 = last ? nA : cA + (size_t)(t + 2) * kstep; const char* b2 = last ? nB : cB + (size_t)(t + 2) * kstep;
            const char* a3 = a2 + kstep; const char* b3 = b2 + kstep;
            if constexpr (Epi::HAS_MID) { if (t == nt / 2) E.mid(acc, cur, wr, wc, fr, fq); }
            PG8_LDB(B0, 0, 0); PG8_SCHED; PG8_LDA(At, 0, 0); PG8_STAGE(PG8_SA(1, 1), a1 + hstepA, voffA);
            PG8_WAIT_L(8); PG8_BAR; PG8_WAIT_L(0); PG8_MMA(0, 0, At, B0); PG8_BAR; PG8_SCHED;
            PG8_LDB(B1, 0, 1); PG8_STAGE(PG8_SB(0, 0), b2, voffB);
            PG8_BAR; PG8_WAIT_L(0); PG8_MMA(0, 1, At, B1); PG8_BAR;
            PG8_LDA(At, 0, 1); PG8_STAGE(PG8_SA(0, 0), a2, voffA);
            PG8_BAR; PG8_WAIT_L(0); PG8_MMA(1, 0, At, B0); PG8_BAR; PG8_SCHED;
            PG8_STAGE(PG8_SB(0, 1), b2 + hstepB, voffB);
            PG8_WAIT_V(6); PG8_BAR; PG8_MMA(1, 1, At, B1); PG8_BAR;
            PG8_LDB(B0, 1, 0); PG8_SCHED; PG8_LDA(At, 1, 0); PG8_STAGE(PG8_SA(0, 1), a2 + hstepA, voffA);
            PG8_WAIT_L(8); PG8_BAR; PG8_WAIT_L(0); PG8_MMA(0, 0, At, B0); PG8_BAR; PG8_SCHED;
            PG8_LDB(B1, 1, 1); PG8_STAGE(PG8_SB(1, 0), b3, voffB);
            PG8_BAR; PG8_WAIT_L(0); PG8_MMA(0, 1, At, B1); PG8_BAR;
            PG8_LDA(At, 1, 1); PG8_STAGE(PG8_SA(1, 0), a3, voffA);
            PG8_BAR; PG8_WAIT_L(0); PG8_MMA(1, 0, At, B0); PG8_BAR; PG8_SCHED;
            PG8_STAGE(PG8_SB(1, 1), b3 + hstepB, voffB);
            PG8_WAIT_V(6); PG8_BAR; PG8_MMA(1, 1, At, B1); PG8_BAR;
        }
        if constexpr (F8) asm volatile("s_nop 15\n\ts_nop 15" ::: "memory");
        E(acc, cur, wr, wc, fr, fq);
        if (!has_next) break;
#pragma unroll
        for (int a = 0; a < 2; ++a)
#pragma unroll
            for (int b = 0; b < 2; ++b)
#pragma unroll
                for (int m = 0; m < 4; ++m)
#pragma unroll
                    for (int n = 0; n < 2; ++n) acc[a][b][m][n] = (f32x4){0.f, 0.f, 0.f, 0.f};
        cur = nxt; cA = nA; cB = nB; ++ui;
    }
    PG8_WAIT_V(0);
    if (wr == 0) PG8_BAR;
    PG8_BAR;
#undef PG8_SA
#undef PG8_SB
#undef PG8_STAGE
#undef PG8_LDA
#undef PG8_LD32
#undef PG8_LDB
#undef PG8_MMA
#undef PG8_WAIT_V
#undef PG8_WAIT_L
#undef PG8_BAR
#undef PG8_SCHED
}

struct SchedGrid {
    const char* A; const char* B; size_t tstepA, tstepB; int nM, nN, nwg, G, c; bool mix32 = false;
    __device__ void init(const void* A_, int lda, const void* B_, int ldb, int M, int N, int G_, int c_, int esz = 2) {
        A = (const char*)A_; B = (const char*)B_; tstepA = (size_t)256 * lda * esz; tstepB = (size_t)256 * ldb * esz; nM = M / 256; nN = N / 256; nwg = nM * nN; G = G_; c = c_; }
    __device__ __forceinline__ bool next(int i, Unit& u) const {
        const long L = (long)i * G + c; if (L >= nwg) return false;
        int wgid = (int)L; { const int q = nwg / 8, r = nwg % 8, xcd = wgid % 8, off = wgid / 8; wgid = (xcd < r ? xcd * (q + 1) : r * (q + 1) + (xcd - r) * q) + off; }
        const int nig = 8 * nN, gid = wgid / nig, fm = gid * 8, gsz = (nM - fm) < 8 ? (nM - fm) : 8;
        u.pm = fm + ((wgid % nig) % gsz); u.pn = (wgid % nig) / gsz; u.grp = 0;
        if (mix32) { const int a = u.pn >> 4, r4 = (u.pn >> 2) & 3, r = u.pn & 3; u.pn = ((r4 & 1) << 4) | (a << 3) | ((r4 >> 1) << 2) | r; }
        u.a = A + (size_t)u.pm * tstepA; u.b = B + (size_t)u.pn * tstepB; return true;
    }
};
struct SchedGroup {
    const char* A; const char* B; size_t tstepA, tstepB, gstepA, gstepB; int nM, nN, total, G, c;
    __device__ void init(const void* A_, int lda, size_t gA, const void* B_, int ldb, size_t gB, int nM_, int nN_, int NG, int G_, int c_, int esz = 2) {
        A = (const char*)A_; B = (const char*)B_; tstepA = (size_t)256 * lda * esz; tstepB = (size_t)256 * ldb * esz; gstepA = gA; gstepB = gB; nM = nM_; nN = nN_; total = NG * nM_ * nN_; G = G_; c = c_; }
    __device__ __forceinline__ bool next(int i, Unit& u) const {
        const long L = (long)i * G + c; if (L >= total) return false;
        const int per = nM * nN, g = (int)L / per, r = (int)L % per;
        u.grp = g; u.pm = r % nM; u.pn = r / nM;
        u.a = A + (size_t)g * gstepA + (size_t)u.pm * tstepA; u.b = B + (size_t)g * gstepB + (size_t)u.pn * tstepB; return true;
    }
};
}

#define EPI_LANES int tz_ = threadIdx.x; asm volatile("" : "+v"(tz_)); const int wr = tz_ >> 8, wc = (tz_ >> 6) & 3, fr = tz_ & 15, fq = (tz_ >> 4) & 3;
#define EPI_FOR _Pragma("unroll") for (int ai = 0; ai < 2; ++ai) _Pragma("unroll") for (int m = 0; m < 4; ++m)
#define EPI_RL const int rl = ai * 128 + wr * 64 + m * 16 + fr;
__device__ __forceinline__ u32x4 pack8(const f32x4 a, const f32x4 b) { u32x4 w; w.x = cvt_pk_bf16(a[0], a[1]); w.y = cvt_pk_bf16(a[2], a[3]); w.z = cvt_pk_bf16(b[0], b[1]); w.w = cvt_pk_bf16(b[2], b[3]); return w; }
__device__ __forceinline__ void unpack8(const u32x4 w, f32x4& a, f32x4& b) { a = (f32x4){bf_lo(w.x), bf_hi(w.x), bf_lo(w.y), bf_hi(w.y)}; b = (f32x4){bf_lo(w.z), bf_hi(w.z), bf_lo(w.w), bf_hi(w.w)}; }

struct EpiInProj {
    static constexpr bool HAS_MID = false;
    const float* rinv; bf16_t *UA, *Q, *Kb, *V, *G; const float *qg, *kg;
    __device__ __forceinline__ void operator()(const pg::Acc& acc, const pg::Unit& u, int, int, int, int) const { EPI_LANES
        const int pn = u.pn, row0 = u.pm * 256;
        if (pn < 4) {
            EPI_FOR { EPI_RL const int tok = row0 + rl; const float rs = rinv[tok]; const int c = tok >> 5, tau = tok & 31;
#pragma unroll
                for (int bj = 0; bj < 2; ++bj) { const int ch = 256 * pn + 64 * wc + 32 * bj + 8 * fq, g = ch >> 4, p0 = ch & 15;
                    *(u32x4*)(UA + ((size_t)(g * NCH + c) * UAW + tau * 16 + p0)) = pack8(acc[ai][bj][m][0] * rs, acc[ai][bj][m][1] * rs); } }
        } else if (pn < 12) {
            const bool isq = pn < 8; const int col0 = 256 * (pn - (isq ? 4 : 8)) + 64 * wc; const float* gp = isq ? qg : kg; const float sc = isq ? 0.125f * LOG2E : 1.f;
            bf16_t* dst = isq ? Q : Kb;
            f32x4 gv[2][2];
#pragma unroll
            for (int bj = 0; bj < 2; ++bj)
#pragma unroll
                for (int n = 0; n < 2; ++n) gv[bj][n] = *(const f32x4*)(gp + 32 * bj + 8 * fq + 4 * n) * sc;
            EPI_FOR { EPI_RL const int tok = row0 + rl; const float rs = rinv[tok];
                f32x4 v[2][2]; float ss = 0.f;
#pragma unroll
                for (int bj = 0; bj < 2; ++bj)
#pragma unroll
                    for (int n = 0; n < 2; ++n) { v[bj][n] = acc[ai][bj][m][n] * rs; ss += v[bj][n][0] * v[bj][n][0] + v[bj][n][1] * v[bj][n][1] + v[bj][n][2] * v[bj][n][2] + v[bj][n][3] * v[bj][n][3]; }
                ss += __shfl_xor(ss, 16); ss += __shfl_xor(ss, 32);
                const float r = __builtin_amdgcn_rsqf(ss * (1.f / 64.f) + EPS);
#pragma unroll
                for (int bj = 0; bj < 2; ++bj)
                    *(u32x4*)(dst + (size_t)tok * 1024 + col0 + 32 * bj + 8 * fq) = pack8(v[bj][0] * r * gv[bj][0], v[bj][1] * r * gv[bj][1]); }
        } else if (pn < 16) {
            EPI_FOR { EPI_RL const int tok = row0 + rl; const float rs = rinv[tok];
#pragma unroll
                for (int bj = 0; bj < 2; ++bj)
                    *(u32x4*)(V + (size_t)tok * 1024 + 256 * (pn - 12) + 64 * wc + 32 * bj + 8 * fq) = pack8(acc[ai][bj][m][0] * rs, acc[ai][bj][m][1] * rs); }
        } else {
            EPI_FOR { EPI_RL const int tok = row0 + rl; const float rs = rinv[tok];
#pragma unroll
                for (int bj = 0; bj < 2; ++bj) { f32x4 a = acc[ai][bj][m][0] * rs, b = acc[ai][bj][m][1] * rs;
#pragma unroll
                    for (int j = 0; j < 4; ++j) { a[j] = fast_sigmoid(a[j]); b[j] = fast_sigmoid(b[j]); }
                    *(u32x4*)(G + (size_t)tok * 4096 + 256 * (pn - 16) + 64 * wc + 32 * bj + 8 * fq) = pack8(a, b); } }
        }
    }
};
struct EpiSsum {
    static constexpr bool HAS_MID = false;
    float* SS;
    __device__ __forceinline__ void operator()(const pg::Acc& acc, const pg::Unit& u, int, int, int, int) const { EPI_LANES
        EPI_FOR { EPI_RL float* rp = SS + ((size_t)u.grp * NCH + rl) * 256 + 64 * wc + 8 * fq;
#pragma unroll
            for (int bj = 0; bj < 2; ++bj) { *(f32x4*)(rp + 32 * bj) = acc[ai][bj][m][0]; *(f32x4*)(rp + 32 * bj + 4) = acc[ai][bj][m][1]; } }
    }
};
__device__ __forceinline__ float gelu_tanh(float x) {
    const float t = 1.5957691216057308f * (x + 0.044715f * x * x * x);
    return x * fast_sigmoid(t);
}
struct EpiSsmOut {
    static constexpr bool HAS_MID = false;
    bf16_t* Y;
    __device__ __forceinline__ void operator()(const pg::Acc& acc, const pg::Unit& u, int, int, int, int) const { EPI_LANES
        EPI_FOR { EPI_RL
#pragma unroll
            for (int bj = 0; bj < 2; ++bj) { const int col = 256 * u.pn + 64 * wc + 32 * bj + 8 * fq, t = col >> 4, p0 = col & 15;
                f32x4 a = acc[ai][bj][m][0], b = acc[ai][bj][m][1];
#pragma unroll
                for (int j = 0; j < 4; ++j) { a[j] = gelu_tanh(a[j]); b[j] = gelu_tanh(b[j]); }
                *(u32x4*)(Y + (size_t)(rl * TC + t) * SSMW + u.grp * GP + p0) = pack8(a, b); } }
    }
};
struct EpiGlu {
    static constexpr bool HAS_MID = false;
    const bf16_t* Y; bf16_t* YO;
    __device__ __forceinline__ void operator()(const pg::Acc& acc, const pg::Unit& u, int, int, int, int) const { EPI_LANES
        EPI_FOR { EPI_RL const int tok = u.pm * 256 + rl;
#pragma unroll
            for (int bj = 0; bj < 2; ++bj) { const int col = 256 * u.pn + 64 * wc + 32 * bj + 8 * fq;
                f32x4 ya, yb; unpack8(*(const u32x4*)(Y + (size_t)tok * SSMW + col), ya, yb);
                f32x4 a = acc[ai][bj][m][0], b = acc[ai][bj][m][1];
#pragma unroll
                for (int j = 0; j < 4; ++j) { a[j] = ya[j] * fast_sigmoid(a[j]); b[j] = yb[j] * fast_sigmoid(b[j]); }
                *(u32x4*)(YO + (size_t)tok * 2048 + col) = pack8(a, b); } }
    }
};
struct EpiMerge {
    static constexpr bool HAS_MID = true;
    const bf16_t* G; bf16_t* MG;
    __device__ __forceinline__ void mid(pg::Acc& acc, const pg::Unit& u, int, int, int, int) const { EPI_LANES
        EPI_FOR { EPI_RL const int tok = u.pm * 256 + rl;
#pragma unroll
            for (int bj = 0; bj < 2; ++bj) { const int col = 256 * u.pn + 64 * wc + 32 * bj + 8 * fq;
                f32x4 sa, sb, ga, gb; unpack8(*(const u32x4*)(G + (size_t)tok * 4096 + col), sa, sb); unpack8(*(const u32x4*)(G + (size_t)tok * 4096 + 2048 + col), ga, gb);
#pragma unroll
                for (int j = 0; j < 4; ++j) { acc[ai][bj][m][0][j] *= sa[j] * __builtin_amdgcn_rcpf(ga[j]); acc[ai][bj][m][1][j] *= sb[j] * __builtin_amdgcn_rcpf(gb[j]); } }
            __builtin_amdgcn_sched_barrier(0); }
    }
    __device__ __forceinline__ void operator()(const pg::Acc& acc, const pg::Unit& u, int, int, int, int) const { EPI_LANES
        EPI_FOR { EPI_RL const int tok = u.pm * 256 + rl;
#pragma unroll
            for (int bj = 0; bj < 2; ++bj) { const int col = 256 * u.pn + 64 * wc + 32 * bj + 8 * fq;
                f32x4 ga, gb; unpack8(*(const u32x4*)(G + (size_t)tok * 4096 + 2048 + col), ga, gb);
                *(u32x4*)(MG + (size_t)tok * 2048 + col) = pack8(acc[ai][bj][m][0] * ga, acc[ai][bj][m][1] * gb); } }
    }
};
struct EpiOutProj {
    static constexpr bool HAS_MID = false;
    const bf16_t* XR; bf16_t* XO;
    __device__ __forceinline__ void operator()(const pg::Acc& acc, const pg::Unit& u, int, int, int, int) const { EPI_LANES
        EPI_FOR { EPI_RL const int tok = u.pm * 256 + rl;
#pragma unroll
            for (int bj = 0; bj < 2; ++bj) { const size_t o = (size_t)tok * 2048 + 256 * u.pn + 64 * wc + 32 * bj + 8 * fq;
                f32x4 a, b; unpack8(*(const u32x4*)(XR + o), a, b);
                *(u32x4*)(XO + o) = pack8(a + acc[ai][bj][m][0], b + acc[ai][bj][m][1]); } }
    }
};
struct EpiExp1 {
    static constexpr bool HAS_MID = false;
    const float* RSL; bf16_t* H;
    __device__ __forceinline__ void operator()(const pg::Acc& acc, const pg::Unit& u, int, int, int, int) const { EPI_LANES
        EPI_FOR { EPI_RL const int row = u.grp * CAP + u.pm * 256 + rl; const float rs = RSL[row];
            f32x4 h[2];
#pragma unroll
            for (int n = 0; n < 2; ++n)
#pragma unroll
                for (int j = 0; j < 4; ++j) { const float g = acc[ai][0][m][n][j] * rs, up = acc[ai][1][m][n][j] * rs; h[n][j] = g * fast_sigmoid(g) * up; }
            *(u32x2*)((unsigned char*)H + (size_t)row * FF + 128 * u.pn + 32 * wc + 8 * fq) = pack8_fp8(h[0] * H8_SCALE, h[1] * H8_SCALE); }
    }
};
struct EpiExp2 {
    static constexpr bool HAS_MID = false;
    const float* GATE; bf16_t* YX;
    __device__ __forceinline__ void operator()(const pg::Acc& acc, const pg::Unit& u, int, int, int, int) const { EPI_LANES
        EPI_FOR { EPI_RL const int row = u.grp * CAP + u.pm * 256 + rl; const float gt = GATE[row];
#pragma unroll
            for (int bj = 0; bj < 2; ++bj)
                *(u32x4*)(YX + (size_t)row * D + 256 * u.pn + 64 * wc + 32 * bj + 8 * fq) = pack8(acc[ai][bj][m][0] * gt, acc[ai][bj][m][1] * gt); }
    }
};

namespace att {
constexpr int KVBLK = 64, QBLK = 32;
constexpr int SHM_T = KVBLK * 256;
constexpr int OFF_K = 0, OFF_V = 3 * SHM_T, OFF_Q = 5 * SHM_T, OFF_WS = OFF_Q + 8 * 8192, OFF_BT = OFF_WS + 8 * 64 * 4, ATT_LDS_END = OFF_BT + 2048;
#define KSWZ(row, colB) ((row) * 256 + ((colB) ^ (((row) & 7) << 4)))
#define SBAR() __builtin_amdgcn_sched_barrier(0)
__device__ __forceinline__ int crow(int r, int hi) { return (r & 3) + 8 * (r >> 2) + 4 * hi; }
__device__ __forceinline__ int v_rd_base(int lane) { return ((lane & 3) << 3) | (((lane >> 2) & 3) << 6) | (((lane >> 4) & 1) << 5) | (((lane >> 5) & 1) << 8); }
constexpr int v_rd_off(int d0, int ks, int half) { return d0 * 512 + ks * 4096 + half * 2048; }
template <int OFF> __device__ __forceinline__ s16x4 tr_read(int vb) { s16x4 r; asm volatile("ds_read_b64_tr_b16 %0, %1 offset:%2" : "=&v"(r) : "v"(vb), "i"(OFF) : "memory"); return r; }
template <int D0> __device__ __forceinline__ void pv_one(f32x16& od, int vb, bf16x8 pa0, bf16x8 pa1, bf16x8 pa2, bf16x8 pa3) {
    const s16x4 l0 = tr_read<v_rd_off(D0, 0, 0)>(vb), h0 = tr_read<v_rd_off(D0, 0, 1)>(vb), l1 = tr_read<v_rd_off(D0, 1, 0)>(vb), h1 = tr_read<v_rd_off(D0, 1, 1)>(vb);
    const s16x4 l2 = tr_read<v_rd_off(D0, 2, 0)>(vb), h2 = tr_read<v_rd_off(D0, 2, 1)>(vb), l3 = tr_read<v_rd_off(D0, 3, 0)>(vb), h3 = tr_read<v_rd_off(D0, 3, 1)>(vb);
    asm volatile("s_waitcnt lgkmcnt(0)" ::: "memory"); SBAR();
#define PK(L, H) (bf16x8){L[0], L[1], L[2], L[3], H[0], H[1], H[2], H[3]}
    od = __builtin_amdgcn_mfma_f32_32x32x16_bf16(pa0, PK(l0, h0), od, 0, 0, 0);
    od = __builtin_amdgcn_mfma_f32_32x32x16_bf16(pa1, PK(l1, h1), od, 0, 0, 0);
    od = __builtin_amdgcn_mfma_f32_32x32x16_bf16(pa2, PK(l2, h2), od, 0, 0, 0);
    od = __builtin_amdgcn_mfma_f32_32x32x16_bf16(pa3, PK(l3, h3), od, 0, 0, 0);
#undef PK
}
__device__ __forceinline__ void pv_d0(f32x16* o, int vb, bf16x8 pa0, bf16x8 pa1, bf16x8 pa2, bf16x8 pa3) {
    pv_one<0>(o[0], vb, pa0, pa1, pa2, pa3); pv_one<1>(o[1], vb, pa0, pa1, pa2, pa3); pv_one<2>(o[2], vb, pa0, pa1, pa2, pa3); pv_one<3>(o[3], vb, pa0, pa1, pa2, pa3);
}
__device__ __forceinline__ int kq_addr(int row, int c) { return (c >> 2) * 4096 + row * 64 + (((c & 3) ^ ((row >> 2) & 3)) << 4); }
template <int COMP> __device__ __forceinline__ void qkt(f32x16& p0, f32x16& p1, const LAS char* Ks, const LAS char* Qs, int kq0, int kq1) {
    p0 = (f32x16){}; p1 = (f32x16){};
#pragma unroll
    for (int d0 = 0; d0 < 4; ++d0) { const int chi = COMP * 2 + (d0 >> 1); const int a = (d0 & 1) ? kq1 : kq0;
        const bf16x8 b0 = *(const LAS bf16x8*)(Ks + a + chi * 4096);
        const bf16x8 b1 = *(const LAS bf16x8*)(Ks + a + chi * 4096 + 2048);
        const bf16x8 qf = *(const LAS bf16x8*)(Qs + a + chi * 2048);
        p0 = __builtin_amdgcn_mfma_f32_32x32x16_bf16(b0, qf, p0, 0, 0, 0);
        p1 = __builtin_amdgcn_mfma_f32_32x32x16_bf16(b1, qf, p1, 0, 0, 0); }
}
__device__ __forceinline__ void sm_exp(f32x16& p0, f32x16& p1, const LAS float* bt, int relb, int dq, int hi) {
    if (dq > -191 && dq < 158) {
        const LAS float* bp = bt + relb + 4 * hi;
#pragma unroll
        for (int a = 0; a < 4; ++a) {
            float t0[4], t1[4];
#pragma unroll
            for (int b = 0; b < 4; ++b) { t0[b] = bp[8 * a + b]; t1[b] = bp[32 + 8 * a + b]; }
#pragma unroll
            for (int b = 0; b < 4; ++b) { p0[4 * a + b] += t0[b]; p1[4 * a + b] += t1[b]; }
            SBAR();
        } }
#pragma unroll
    for (int r = 0; r < 16; ++r) p0[r] = __builtin_amdgcn_exp2f(p0[r]);
#pragma unroll
    for (int r = 0; r < 16; ++r) p1[r] = __builtin_amdgcn_exp2f(p1[r]);
}
__device__ __forceinline__ void sm_fin(f32x16& p0, f32x16& p1, float& l_reg, bf16x8& pa0, bf16x8& pa1, bf16x8& pa2, bf16x8& pa3) {
    float ps = 0;
#pragma unroll
    for (int r = 0; r < 16; ++r) ps += p0[r];
#pragma unroll
    for (int r = 0; r < 16; ++r) ps += p1[r];
    { auto rr = __builtin_amdgcn_permlane32_swap(__float_as_uint(ps), __float_as_uint(ps), false, false);
      ps = __uint_as_float(rr[0]) + __uint_as_float(rr[1]); }
    l_reg += ps;
#define PK4(P, BASE, OUT) do { unsigned a0 = cvt_pk_bf16(P[BASE + 0], P[BASE + 1]), a1 = cvt_pk_bf16(P[BASE + 2], P[BASE + 3]);   \
    unsigned b0 = cvt_pk_bf16(P[BASE + 4], P[BASE + 5]), b1 = cvt_pk_bf16(P[BASE + 6], P[BASE + 7]);                              \
    auto r0 = __builtin_amdgcn_permlane32_swap(a0, b0, false, false); auto r1 = __builtin_amdgcn_permlane32_swap(a1, b1, false, false); \
    u32x4 w = {r0[0], r1[0], r0[1], r1[1]}; OUT = *reinterpret_cast<bf16x8*>(&w); } while (0)
    PK4(p0, 0, pa0); PK4(p0, 8, pa1); PK4(p1, 0, pa2); PK4(p1, 8, pa3);
#undef PK4
}
__device__ __forceinline__ void attn_dual(f32x16 (&o1)[4], f32x16 (&o2)[4], const bf16_t* __restrict__ Qg, const bf16_t* __restrict__ Kh, const bf16_t* __restrict__ Vh, LAS char* lds, int q0w) {
    int tz_ = threadIdx.x; asm volatile("" : "+v"(tz_));
    const int tid = tz_, wid = __builtin_amdgcn_readfirstlane(tid >> 6), lane = tid & 63, r32 = lane & 31, hi = lane >> 5;
    LAS char* K_lds = lds + OFF_K; LAS char* V_lds = lds + OFF_V; LAS char* Qs = lds + OFF_Q + wid * 8192;
    LAS float* ws = (LAS float*)(lds + OFF_WS) + wid * 64; LAS float* li_l = ws;
    const LAS float* bt = (const LAS float*)(lds + OFF_BT);
    float l1 = 0.f, l2 = 0.f;
#pragma unroll
    for (int d = 0; d < 4; ++d) { o1[d] = (f32x16){}; o2[d] = (f32x16){}; }
#pragma unroll
    for (int i = 0; i < 8; ++i) { const int ci = i * 64 + lane, row = (ci >> 2) & 31, c = (ci >> 7) * 4 + ((ci & 3) ^ ((row >> 2) & 3));
        __builtin_amdgcn_global_load_lds((const unsigned*)(Qg + (size_t)row * 1024 + c * 8), (LAS unsigned*)(Qs + i * 1024), 16, 0, 0); }
    const int kq0 = r32 * 64 + ((hi ^ ((r32 >> 2) & 3)) << 4), kq1 = r32 * 64 + (((2 + hi) ^ ((r32 >> 2) & 3)) << 4);
    unsigned ko0, vo0;
    { const int p = wid * 2;
        { const int ci = p * 64 + lane, row = (ci >> 2) & 63, c = (ci >> 8) * 4 + ((ci & 3) ^ ((row >> 2) & 3)); ko0 = (unsigned)(row * 1024 + c * 8) * 2u; }
        { const int ci = p * 64 + lane, sub = ci >> 5, kk = (sub >> 2) * 8 + ((ci >> 2) & 7), c = (sub & 3) * 32 + (ci & 3) * 8;
          const int k = (kk & ~0xC) | ((kk & 4) << 1) | ((kk & 8) >> 1); vo0 = (unsigned)(k * 1024 + c) * 2u; } }
    const unsigned pw = (unsigned)wid * 2048u;
#define DMA_K(buf, k0) do { const char* g_ = (const char*)(Kh + (size_t)(k0) * 1024); \
    __builtin_amdgcn_global_load_lds((const unsigned*)(g_ + ko0), (LAS unsigned*)(K_lds + (buf) * SHM_T + pw), 16, 0, 0); \
    __builtin_amdgcn_global_load_lds((const unsigned*)(g_ + ko0 + 32768u), (LAS unsigned*)(K_lds + (buf) * SHM_T + pw + 1024), 16, 0, 0); } while (0)
#define DMA_V(buf, k0) do { const char* g_ = (const char*)(Vh + (size_t)(k0) * 1024); \
    __builtin_amdgcn_global_load_lds((const unsigned*)(g_ + vo0), (LAS unsigned*)(V_lds + (buf) * SHM_T + pw), 16, 0, 0); \
    __builtin_amdgcn_global_load_lds((const unsigned*)(g_ + vo0 + 128u), (LAS unsigned*)(V_lds + (buf) * SHM_T + pw + 1024), 16, 0, 0); } while (0)
    const int vbb = (int)(size_t)V_lds + v_rd_base(lane);
    const int relq = 256 - (q0w + r32);
    f32x16 pA0, pA1, pB0, pB1; bf16x8 pa0, pa1, pa2, pa3; constexpr int NT = S / KVBLK;
    DMA_K(0, 0); DMA_K(1, KVBLK); DMA_V(0, 0);
    asm volatile("s_waitcnt vmcnt(0) lgkmcnt(0)" ::: "memory"); __syncthreads();
    qkt<0>(pA0, pA1, K_lds, Qs, kq0, kq1); sm_exp(pA0, pA1, bt, relq, 0 - q0w, hi);
    int kb = 0, vb = 0;
    int ureg = (0 - q0w <= -191) ? 0 : ((0 - q0w >= 158) ? 2 : 1);
    for (int j = 0; j < NT; ++j) {
        asm volatile("s_waitcnt vmcnt(0)" ::: "memory"); __syncthreads();
        const int kb1 = kb == 2 ? 0 : kb + 1, kb2 = kb1 == 2 ? 0 : kb1 + 1;
        if (j + 2 < NT) DMA_K(kb2, (j + 2) * KVBLK);
        if (j + 1 < NT) DMA_V(vb ^ 1, (j + 1) * KVBLK);
        const int dq = j * KVBLK - q0w;
        { const int u = (dq <= -191) ? 0 : ((dq >= 158) ? 2 : 1);
          if (u != ureg) {
              const float cp = ureg == 0 ? bt[0] : (ureg == 2 ? bt[511] : 0.f), cn = u == 0 ? bt[0] : (u == 2 ? bt[511] : 0.f);
              const float f = __builtin_amdgcn_exp2f(cp - cn);
#pragma unroll
              for (int d = 0; d < 4; ++d) { o1[d] = o1[d] * f; o2[d] = o2[d] * f; }
              l1 *= f; l2 *= f; ureg = u; } }
        sm_fin(pA0, pA1, l1, pa0, pa1, pa2, pa3); SBAR();
        qkt<1>(pB0, pB1, K_lds + kb * SHM_T, Qs, kq0, kq1); SBAR();
        pv_d0(o1, vbb + vb * SHM_T, pa0, pa1, pa2, pa3);
        sm_exp(pB0, pB1, bt, relq + j * KVBLK, dq, hi);
        sm_fin(pB0, pB1, l2, pa0, pa1, pa2, pa3); SBAR();
        if (j + 1 < NT) { qkt<0>(pA0, pA1, K_lds + kb1 * SHM_T, Qs, kq0, kq1); SBAR(); }
        pv_d0(o2, vbb + vb * SHM_T, pa0, pa1, pa2, pa3);
        if (j + 1 < NT) sm_exp(pA0, pA1, bt, relq + (j + 1) * KVBLK, dq + KVBLK, hi);
        kb = kb1; vb ^= 1;
    }
    if (hi == 0) li_l[r32] = l1; asm volatile("s_waitcnt lgkmcnt(0)" ::: "memory");
#pragma unroll
    for (int r = 0; r < 16; ++r) { const float rl = __builtin_amdgcn_rcpf(li_l[crow(r, hi)]);
#pragma unroll
        for (int d = 0; d < 4; ++d) o1[d][r] *= rl; }
    asm volatile("s_waitcnt lgkmcnt(0)" ::: "memory");
    if (hi == 0) li_l[r32] = l2; asm volatile("s_waitcnt lgkmcnt(0)" ::: "memory");
#pragma unroll
    for (int r = 0; r < 16; ++r) { const float rl = __builtin_amdgcn_rcpf(li_l[crow(r, hi)]);
#pragma unroll
        for (int d = 0; d < 4; ++d) o2[d][r] *= rl; }
#undef DMA_K
#undef DMA_V
}
}

__device__ __forceinline__ int t5_bucket(int rel) {
    const int side = rel > 0 ? 16 : 0; const int n = rel < 0 ? -rel : rel;
    if (n < 8) return side + n;
    const float v = logf((float)n / 8.0f) / 2.7725887f * 8.0f;
    int large = 8 + (int)v; large = large < 15 ? large : 15;
    return side + large;
}

struct Args { GAS const float* in[28]; GAS float* out; GAS unsigned char* ws; int ph_lo, ph_hi; };
typedef const Args __attribute__((address_space(4))) CArgs;
struct LayerW { bf16_t *WIN, *WGLU, *WBR, *WOUT, *WGU, *WD, *F, *BO; float *KTAB, *WRT; };
__device__ __forceinline__ LayerW layer_w(unsigned char* ws, int l) {
    unsigned char* b = ws + WS_LW + (size_t)l * LW_SIZE; LayerW w;
    w.WIN = (bf16_t*)(b + LW_WIN); w.WGLU = (bf16_t*)(b + LW_WGLU); w.WBR = (bf16_t*)(b + LW_WBR); w.WOUT = (bf16_t*)(b + LW_WOUT); w.WGU = (bf16_t*)(b + LW_WGU);
    w.WD = (bf16_t*)(b + LW_WD); w.F = (bf16_t*)(b + LW_F); w.BO = (bf16_t*)(b + LW_BO); w.KTAB = (float*)(b + LW_KTAB); w.WRT = (float*)(b + LW_WRT); return w;
}
enum { I_X = 0, I_WIN, I_ARE, I_AIM, I_LDT, I_BRE, I_BIM, I_CRE, I_CIM, I_SD, I_WGLU, I_WSB, I_QG, I_KG, I_LQ1, I_LK1, I_LQ2, I_LK2, I_SUBLN, I_WAB, I_RELB, I_WOUT,
       I_NMIX, I_NFFN, I_WR, I_WEG, I_WEU, I_WED };

struct TItem { const float* src; bf16_t* dst; const float* gain; int N, ldd, rowmode, f8; };
__device__ __forceinline__ void t_load(const TItem& t, f32x4 (&v)[16], int lane) {
    const int r = lane >> 4, q = lane & 15;
#pragma unroll
    for (int j = 0; j < 16; ++j) v[j] = __builtin_nontemporal_load((const f32x4*)(t.src + (size_t)(4 * j + r) * t.N + 4 * q));
}
__device__ __forceinline__ void t_lds(const f32x4 (&v)[16], LAS float* scr, int lane) {
    const int r = lane >> 4, q = lane & 15;
#pragma unroll
    for (int j = 0; j < 16; ++j) { LAS float* s = scr + (4 * j + r) * 65 + 4 * q; s[0] = v[j][0]; s[1] = v[j][1]; s[2] = v[j][2]; s[3] = v[j][3]; }
}
__device__ __forceinline__ void t_store(const TItem& t, int n0, LAS float* scr, int lane) {
    const int c = lane & 7;
    float gn[8];
#pragma unroll
    for (int i = 0; i < 8; ++i) gn[i] = t.gain ? t.gain[8 * c + i] : 1.f;
#pragma unroll
    for (int j = 0; j < 8; ++j) { const int n = (lane >> 3) + 8 * j; const LAS float* s = scr + (8 * c) * 65 + n;
        u32x4 o; o.x = cvt_pk_bf16(s[0 * 65] * gn[0], s[1 * 65] * gn[1]); o.y = cvt_pk_bf16(s[2 * 65] * gn[2], s[3 * 65] * gn[3]);
        o.z = cvt_pk_bf16(s[4 * 65] * gn[4], s[5 * 65] * gn[5]); o.w = cvt_pk_bf16(s[6 * 65] * gn[6], s[7 * 65] * gn[7]);
        const int ng = n0 + n; const int drow = t.rowmode == 0 ? ng : ((ng >> 7) * 256 + ((ng >> 5) & 3) * 64 + (ng & 31) + (t.rowmode == 2 ? 32 : 0));
        if (t.f8) { const f32x4 a = (f32x4){s[0 * 65] * gn[0], s[1 * 65] * gn[1], s[2 * 65] * gn[2], s[3 * 65] * gn[3]} * W8_SCALE, b = (f32x4){s[4 * 65] * gn[4], s[5 * 65] * gn[5], s[6 * 65] * gn[6], s[7 * 65] * gn[7]} * W8_SCALE;
            *(u32x2*)((unsigned char*)t.dst + (size_t)drow * t.ldd + 8 * c) = pack8_fp8(a, b); }
        else *(u32x4*)(t.dst + (size_t)drow * t.ldd + 8 * c) = o; }
}

constexpr int IT_WIN = (D / 64) * (INC / 64), IT_GLU = 16 * 16, IT_BR = 16 * 32, IT_OUT = 32 * 32, IT_E = 32 * 32;
constexpr int IT_LAYER0 = IT_WIN + IT_GLU + 2 * IT_BR + IT_OUT + 2 * NE * IT_E;
constexpr int IT_DOWN = NE * IT_E;
__device__ __forceinline__ TItem make_item(const float* src, bf16_t* dst, const float* gain, int N, int ldd, int rowmode, int f8, int r, int& n0) {
    const int nblk = N / 64, k0 = 64 * (r / nblk); n0 = 64 * (r % nblk);
    TItem t; t.src = src + (size_t)k0 * N + n0; t.dst = f8 ? (bf16_t*)((unsigned char*)dst + k0) : dst + k0; t.gain = gain ? gain + k0 : nullptr; t.N = N; t.ldd = ldd; t.rowmode = rowmode; t.f8 = f8; return t; }
struct DecMain { CArgs* ap; unsigned char* ws;
    __device__ __forceinline__ TItem operator()(int it, int& n0) const { CArgs& args = *ap;
        const int l = it / IT_LAYER0; int r = it % IT_LAYER0; const LayerW w = layer_w(ws, l);
        if (r < IT_WIN) return make_item((const float*)args.in[I_WIN] + (size_t)l * D * INC, w.WIN, (const float*)args.in[I_NMIX] + l * D, INC, D, 0, 0, r, n0);
        if ((r -= IT_WIN) < IT_GLU) return make_item((const float*)args.in[I_WGLU] + (size_t)l * SSMW * SSMW, w.WGLU, nullptr, SSMW, SSMW, 0, 0, r, n0);
        if ((r -= IT_GLU) < IT_BR) return make_item((const float*)args.in[I_WSB] + (size_t)l * SSMW * D, w.WBR, nullptr, D, 2048, 0, 0, r, n0);
        if ((r -= IT_BR) < IT_BR) return make_item((const float*)args.in[I_WAB] + (size_t)l * 1024 * D, w.WBR + 1024, nullptr, D, 2048, 0, 0, r, n0);
        if ((r -= IT_BR) < IT_OUT) return make_item((const float*)args.in[I_WOUT] + (size_t)l * D * D, w.WOUT, nullptr, D, D, 0, 0, r, n0);
        r -= IT_OUT; const int which = r / (NE * IT_E), e = (r / IT_E) % NE; r = r % IT_E; const size_t eo = ((size_t)l * NE + e) * D * FF;
        return make_item((const float*)args.in[which == 0 ? I_WEG : I_WEU] + eo, (bf16_t*)((unsigned char*)w.WGU + (size_t)e * 4096 * D), (const float*)args.in[I_NFFN] + l * D, FF, D, which == 0 ? 1 : 2, 1, r, n0); } };
struct DecDown { CArgs* ap; unsigned char* ws; int l;
    __device__ __forceinline__ TItem operator()(int it, int& n0) const { CArgs& args = *ap; const LayerW w = layer_w(ws, l);
        const int e = it / IT_E, r = it % IT_E; const size_t eo = ((size_t)l * NE + e) * D * FF;
        return make_item((const float*)args.in[I_WED] + eo, (bf16_t*)((unsigned char*)w.WD + (size_t)e * D * FF), nullptr, D, FF, 0, 1, r, n0); } };
template <class Dec> __device__ __forceinline__ void convert_items(const Dec& dec, int first, int end, int step, LAS float* scr, int lane) {
    f32x4 tv[16]; int n0c = 0, n0n = 0; TItem cur, nxt; cur.src = nullptr; cur.dst = nullptr; cur.gain = nullptr; cur.N = 0; cur.ldd = 0; cur.rowmode = 0; cur.f8 = 0; nxt = cur;
    int it = first;
    if (it < end) { cur = dec(it, n0c); t_load(cur, tv, lane); }
    for (; it < end; it += step) {
        t_lds(tv, scr, lane);
        if (it + step < end) { nxt = dec(it + step, n0n); t_load(nxt, tv, lane); }
        LDS_WAIT(); asm volatile("" ::: "memory");
        t_store(cur, n0c, scr, lane);
        LDS_WAIT(); asm volatile("" ::: "memory");
        cur = nxt; n0c = n0n; }
}

template <bool ROUTER>
__device__ __forceinline__ void row_pass(const float* xrow, bf16_t* xb, float* rinv_out, const LAS float* WtL, float* afft, int row, int lane) {
    f32x4 v[8]; float ss = 0.f;
#pragma unroll
    for (int j = 0; j < 8; ++j) { v[j] = *(const f32x4*)(xrow + 4 * lane + 256 * j); ss += v[j][0] * v[j][0] + v[j][1] * v[j][1] + v[j][2] * v[j][2] + v[j][3] * v[j][3]; }
    ss = wave_sum(ss);
    const float rinv = __builtin_amdgcn_rsqf(ss * (1.f / D) + EPS);
#pragma unroll
    for (int j = 0; j < 8; ++j) { u32x2 w; w.x = cvt_pk_bf16(v[j][0], v[j][1]); w.y = cvt_pk_bf16(v[j][2], v[j][3]); *(u32x2*)(xb + 4 * lane + 256 * j) = w; }
    if (lane == 0) *rinv_out = rinv;
    if constexpr (ROUTER) {
        float lg[16];
#pragma unroll
        for (int e = 0; e < 16; ++e) { float a = 0.f;
#pragma unroll
            for (int j = 0; j < 8; ++j) { const f32x4 w = *(const LAS f32x4*)(WtL + e * 2048 + 4 * lane + 256 * j); a += v[j][0] * w[0] + v[j][1] * w[1] + v[j][2] * w[2] + v[j][3] * w[3]; }
            lg[e] = wave_sum(a) * rinv; }
        float mx = lg[0];
#pragma unroll
        for (int e = 1; e < 16; ++e) mx = fmaxf(mx, lg[e]);
        float sum = 0.f;
#pragma unroll
        for (int e = 0; e < 16; ++e) { lg[e] = __expf(lg[e] - mx); sum += lg[e]; }
        const float inv = 1.f / sum;
        float mine = 0.f;
#pragma unroll
        for (int e = 0; e < 16; ++e) mine = (lane == e) ? lg[e] * inv : mine;
        if (lane < 16) afft[(size_t)lane * S + row] = mine;
    }
}

__device__ __forceinline__ void router_row(const bf16_t* xrow, float* rinv_out, const LAS float* WtL, float* afft, int row, int lane) {
    f32x4 v[8]; float ss = 0.f;
#pragma unroll
    for (int j = 0; j < 8; ++j) { const u32x2 w = *(const u32x2*)(xrow + 4 * lane + 256 * j); v[j] = (f32x4){bf_lo(w.x), bf_hi(w.x), bf_lo(w.y), bf_hi(w.y)}; ss += v[j][0] * v[j][0] + v[j][1] * v[j][1] + v[j][2] * v[j][2] + v[j][3] * v[j][3]; }
    ss = wave_sum(ss);
    const float rinv = __builtin_amdgcn_rsqf(ss * (1.f / D) + EPS);
    if (lane == 0) *rinv_out = rinv;
    float lg[16];
#pragma unroll
    for (int e = 0; e < 16; ++e) { float a = 0.f;
#pragma unroll
        for (int j = 0; j < 8; ++j) { const f32x4 w = *(const LAS f32x4*)(WtL + e * 2048 + 4 * lane + 256 * j); a += v[j][0] * w[0] + v[j][1] * w[1] + v[j][2] * w[2] + v[j][3] * w[3]; }
        lg[e] = wave_sum(a) * rinv; }
    float mx = lg[0];
#pragma unroll
    for (int e = 1; e < 16; ++e) mx = fmaxf(mx, lg[e]);
    float sum = 0.f;
#pragma unroll
    for (int e = 0; e < 16; ++e) { lg[e] = __expf(lg[e] - mx); sum += lg[e]; }
    const float inv = 1.f / sum;
    float mine = 0.f;
#pragma unroll
    for (int e = 0; e < 16; ++e) mine = (lane == e) ? lg[e] * inv : mine;
    if (lane < 16) afft[(size_t)lane * S + row] = mine;
}
__device__ __forceinline__ int block_sum_i(int v, LAS int* red, int wave, int lane) {
#pragma unroll
    for (int o = 1; o < 64; o <<= 1) v += __shfl_xor(v, o);
    __syncthreads();
    if (lane == 0) red[wave] = v;
    __syncthreads();
    int t = 0;
#pragma unroll
    for (int w = 0; w < 8; ++w) t += red[w];
    return t;
}

__global__ void __launch_bounds__(512, 2) fwd(Args kargs) {
    extern __shared__ __attribute__((aligned(16))) unsigned char lds_raw[];
    LAS unsigned char* lds = (LAS unsigned char*)lds_raw;
    volatile LAS unsigned* MISC = (volatile LAS unsigned*)(lds + MISC_OFF);
    const int G = gridDim.x;
    unsigned* ctl = (unsigned*)((unsigned char*)kargs.ws + WS_CTL);
    if (threadIdx.x < 64) MISC[threadIdx.x] = 0u;
    __syncthreads();
    XcdBarrier bar; bar.bar = ctl + 1024; bar.x = 0; bar.st = nullptr;
    if (!MK_PER_PHASE) bar = xcd_barrier_post(ctl + 1024, MISC + 8);
    const int lo = kargs.ph_lo, hi = kargs.ph_hi;
#ifndef PH_MASK
#define PH_MASK 0xFFFF
#endif
#define PON(b) ((PH_MASK >> (b)) & 1)
#ifndef REP_MASK
#define REP_MASK 0
#endif
#define REPS(b) (((REP_MASK >> (b)) & 1) ? 2 : 1)
#define IN(k) (lo <= (k) && (k) < hi)
#define PH_ENTER int tz0_ = threadIdx.x; asm volatile("" : "+v"(tz0_)); int bz0_ = blockIdx.x; asm volatile("" : "+s"(bz0_)); \
    const int tid = tz0_, lane = tid & 63, wave = __builtin_amdgcn_readfirstlane(tid >> 6), bx = bz0_, vcu = (G % 8 == 0) ? (bx % 8) * (G / 8) + bx / 8 : bx, gw = vcu * 8 + wave, NGW = G * 8; \
    (void)lane; (void)wave; (void)bx; (void)vcu; (void)gw; (void)NGW; \
      \
    CArgs* ap_ = (CArgs*)__builtin_amdgcn_kernarg_segment_ptr(); asm volatile("" : "+s"(ap_)); CArgs& args = *ap_; \
    unsigned char* const ws = (unsigned char*)args.ws; unsigned char* const act = ws + WS_ACT; unsigned char* const sm = act + A_SMALL; (void)sm; \
    bf16_t* const XB = (bf16_t*)(act + A_XB); bf16_t* const XB1 = (bf16_t*)(act + A_XB1); bf16_t* const UA = (bf16_t*)(act + A_UA); \
    bf16_t* const Qb = (bf16_t*)(act + A_Q); bf16_t* const Kb = (bf16_t*)(act + A_K); bf16_t* const Vb = (bf16_t*)(act + A_V); bf16_t* const Gb = (bf16_t*)(act + A_G); \
    float* const SSUM = (float*)(act + A_SSUM); bf16_t* const Yb = (bf16_t*)(act + A_Y); bf16_t* const YO = (bf16_t*)(act + A_YO); \
    bf16_t* const MG = (bf16_t*)(act + A_MG); float* const XA = (float*)(act + A_XA); bf16_t* const XG = (bf16_t*)(act + A_XG); bf16_t* const Hb = (bf16_t*)(act + A_H); bf16_t* const YX = (bf16_t*)(act + A_YX); \
    float* const RINV = (float*)(sm + SM_RINV); float* const RINV2 = (float*)(sm + SM_RINV2); float* const AFFT = (float*)(sm + SM_AFFT); int* const IDX = (int*)(sm + SM_IDX); \
    float* const GATE = (float*)(sm + SM_GATE); float* const RSL = (float*)(sm + SM_RSL); int* const INV = (int*)(sm + SM_INV); float* const LAMS = (float*)(sm + SM_LAM); \
    (void)XB; (void)XB1; (void)UA; (void)Qb; (void)Kb; (void)Vb; (void)Gb; (void)SSUM; (void)Yb; (void)YO; (void)MG; (void)XA; (void)XG; (void)Hb; (void)YX; \
    (void)RINV; (void)RINV2; (void)AFFT; (void)IDX; (void)GATE; (void)RSL; (void)INV; (void)LAMS;
#define INP(i) ((const float*)args.in[i])
#define OUTP ((float*)args.out)
#define LAYER_ENTER const LayerW w = layer_w(ws, l); const float lam_init = (l == 0) ? 0.2f : 0.35550906759f;   \
    (void)w; (void)lam_init;
#define SEAM(k) do { if (IN(k) && IN((k) + 1)) { if (!MK_PER_PHASE) xcd_barrier(bar); } } while (0)

    if (PON(0) && IN(0)) _Pragma("nounroll") for (int rep_ = 0; rep_ < REPS(0); ++rep_) { PH_ENTER
        LAS float* scr = (LAS float*)(lds + wave * 16640);
        convert_items(DecMain{ap_, ws}, gw, NL * IT_LAYER0, NGW, scr, lane);
        for (int i = gw * 64 + lane; i < NL * NE * D; i += NGW * 64) { const int l = i / (NE * D), e = (i / D) % NE, k = i % D;
            layer_w(ws, l).WRT[e * D + k] = INP(I_NFFN)[l * D + k] * INP(I_WR)[((size_t)l * D + k) * NE + e]; }
        for (int it = gw; it < NL * NGRP * 2 * TC; it += NGW) {
            const int l = it / (NGRP * 2 * TC), g = (it / (2 * TC)) % NGRP, dir = (it / TC) % 2, dl = it % TC;
            const size_t pb = ((size_t)(l * 2 + dir) * NGRP + g);
            const float are = INP(I_ARE)[pb * NST + lane], aim = INP(I_AIM)[pb * NST + lane], dt = expf(INP(I_LDT)[pb]);
            const float mag1 = expf(are * dt), ang1 = aim * dt, b1r = mag1 * cosf(ang1), b1i = mag1 * sinf(ang1);
            const float nr = b1r - 1.f, ni = b1i, den = are * are + aim * aim;
            const float cr = (nr * are + ni * aim) / den, ci = (ni * are - nr * aim) / den;
            const float magd = expf(are * dt * (float)dl), angd = aim * dt * (float)dl, pr = magd * cosf(angd), pi = magd * sinf(angd);
            const float wre = pr * cr - pi * ci, wim = pr * ci + pi * cr;
            const int p = lane >> 2, q0 = (lane & 3) * 4;
            const float* cre = INP(I_CRE) + (pb * GP + p) * NST; const float* cim = INP(I_CIM) + (pb * GP + p) * NST;
            const float* bre = INP(I_BRE) + pb * NST * GP + q0; const float* bim = INP(I_BIM) + pb * NST * GP + q0;
            f32x4 out = {0.f, 0.f, 0.f, 0.f};
            for (int n = 0; n < NST; ++n) {
                const float wr_ = __shfl(wre, n), wi_ = __shfl(wim, n);
                const float c_r = cre[n], c_i = cim[n];
                const float er = c_r * wr_ - c_i * wi_, ei = c_r * wi_ + c_i * wr_;
                const f32x4 br = *(const f32x4*)(bre + n * GP), bi = *(const f32x4*)(bim + n * GP);
                out += br * er - bi * ei;
            }
            *(f32x4*)(layer_w(ws, l).KTAB + ((((size_t)g * 2 + dir) * TC + dl) * GP + p) * GP + q0) = out;
        }
        for (int it = gw; it < NL * NGRP * 2 * TC; it += NGW) {
            const int l = it / (NGRP * 2 * TC), g = (it / (2 * TC)) % NGRP, dir = (it / TC) % 2, t = it % TC;
            const LayerW w = layer_w(ws, l);
            const size_t pb = ((size_t)(l * 2 + dir) * NGRP + g);
            const float are = INP(I_ARE)[pb * NST + lane], aim = INP(I_AIM)[pb * NST + lane], dt = expf(INP(I_LDT)[pb]);
            { const float e = dir == 0 ? (float)(t + 1) : (float)(TC - t); const float mg = expf(are * dt * e), an = aim * dt * e, pr = mg * cosf(an), pi = mg * sinf(an);
              float crv[GP], civ[GP];
#pragma unroll
              for (int p = 0; p < GP; ++p) { crv[p] = INP(I_CRE)[(pb * GP + p) * NST + lane]; civ[p] = INP(I_CIM)[(pb * GP + p) * NST + lane]; }
#pragma unroll
              for (int p = 0; p < GP; ++p) { bf16_t* o = w.BO + ((size_t)g * 512 + t * 16 + p) * UAW + 512 + dir * 128 + lane;
                  o[0] = f2bf(crv[p] * pr - civ[p] * pi); o[64] = f2bf(-(crv[p] * pi + civ[p] * pr)); } }
            { const float mag1 = expf(are * dt), ang1 = aim * dt, b1r = mag1 * cosf(ang1), b1i = mag1 * sinf(ang1);
              const float nr = b1r - 1.f, ni = b1i, den = are * are + aim * aim;
              const float cr = (nr * are + ni * aim) / den, ci = (ni * are - nr * aim) / den;
              const float e = dir == 0 ? (float)(TC - 1 - t) : (float)t; const float mg = expf(are * dt * e), an = aim * dt * e, pr = mg * cosf(an), pi = mg * sinf(an);
              const float wre = pr * cr - pi * ci, wim = pr * ci + pi * cr;
              const float* bre = INP(I_BRE) + (pb * NST + lane) * GP; const float* bim = INP(I_BIM) + (pb * NST + lane) * GP;
              f32x4 re[4], im[4];
#pragma unroll
              for (int q = 0; q < 4; ++q) { const f32x4 br = *(const f32x4*)(bre + 4 * q), bi = *(const f32x4*)(bim + 4 * q); re[q] = br * wre - bi * wim; im[q] = bi * wre + br * wim; }
              bf16_t* o = w.F + ((size_t)g * 256 + dir * 128 + lane) * 512 + t * 16;
              *(u32x4*)o = pack8(re[0], re[1]); *(u32x4*)(o + 8) = pack8(re[2], re[3]);
              *(u32x4*)(o + 64 * 512) = pack8(im[0], im[1]); *(u32x4*)(o + 64 * 512 + 8) = pack8(im[2], im[3]); }
        }
        for (int m = gw; m < S; m += NGW) row_pass<false>(INP(I_X) + (size_t)m * D, XB + (size_t)m * D, RINV + m, nullptr, nullptr, m, lane);
        if (gw < NL) { const int l = gw; const float a = wave_sum(INP(I_LQ1)[l * QKD + lane] * INP(I_LK1)[l * QKD + lane]);
            const float b = wave_sum(INP(I_LQ2)[l * QKD + lane] * INP(I_LK2)[l * QKD + lane]);
            if (lane == 0) LAMS[l] = expf(a) - expf(b) + ((l == 0) ? 0.2f : 0.35550906759f); }
        for (int i = gw * 64 + lane; i < NH * 512; i += NGW * 64) { const int h = i >> 9, rel = (i & 511) - 256;
            ((float*)(sm + SM_BTAB))[i] = INP(I_RELB)[t5_bucket(rel) * NH + h] * LOG2E; }
    }
    SEAM(0);

    for (int l = 0; l < NL; ++l) {
        const int pbase = 2 + l * 14;
        if (PON(2) && IN(pbase + 0)) _Pragma("nounroll") for (int rep_ = 0; rep_ < REPS(2); ++rep_) { PH_ENTER LAYER_ENTER
            pg::SchedGrid Sg; Sg.init(XB, D, w.WIN, D, S, INC, G, bx); Sg.mix32 = true;
            EpiInProj E{RINV, UA, Qb, Kb, Vb, Gb, INP(I_QG) + l * QKD, INP(I_KG) + l * QKD};
            pg::gemm_phase(lds, D, D, D, Sg, E);
        }
        SEAM(pbase + 0);
        if (PON(3) && IN(pbase + 1)) _Pragma("nounroll") for (int rep_ = 0; rep_ < REPS(3); ++rep_) { PH_ENTER LAYER_ENTER
            pg::SchedGroup Sg; Sg.init(UA, UAW, (size_t)NCH * UAW * 2, w.F, 512, (size_t)256 * 512 * 2, 1, 1, NGRP, G, vcu);
            EpiSsum E{SSUM};
            pg::gemm_phase(lds, 512, UAW, 512, Sg, E);
            if (vcu >= NGRP) convert_items(DecDown{ap_, ws, l}, (vcu - NGRP) * 8 + wave, 4096, (G - NGRP) * 8, (LAS float*)(lds + wave * 16640), lane);
            if (vcu >= NGRP) for (long i = (long)((vcu - NGRP) * 8 + wave) * 64 + lane; i < (long)NGRP * 512 * 64; i += (long)(G - NGRP) * 8 * 64) {
            const int l2 = l, g = (int)(i / (512 * 64)) % NGRP, rr = (int)(i / 64) % 512, kc = (int)(i % 64);
            const int t = rr >> 4, p = rr & 15, tau = kc >> 1, q0 = (kc & 1) * 8;
            const LayerW w2 = layer_w(ws, l2);
            const float* kf = w2.KTAB + (((size_t)g * 2 + 0) * TC) * 256; const float* kb = w2.KTAB + (((size_t)g * 2 + 1) * TC) * 256;
            f32x4 a, b;
            if (tau < t) { const float* s = kf + ((t - tau) * GP + p) * GP + q0; a = *(const f32x4*)s; b = *(const f32x4*)(s + 4); }
            else if (tau > t) { const float* s = kb + ((tau - t) * GP + p) * GP + q0; a = *(const f32x4*)s; b = *(const f32x4*)(s + 4); }
            else { const float* s = kf + p * GP + q0; const float* s2 = kb + p * GP + q0; a = *(const f32x4*)s + *(const f32x4*)s2; b = *(const f32x4*)(s + 4) + *(const f32x4*)(s2 + 4);
                const float dd = INP(I_SD)[l2 * SSMW + g * GP + p];
#pragma unroll
                for (int j = 0; j < 4; ++j) { if (q0 + j == p) a[j] += dd; if (q0 + 4 + j == p) b[j] += dd; } }
            *(u32x4*)(w2.BO + ((size_t)g * 512 + rr) * UAW + tau * 16 + q0) = pack8(a, b);
        }
            if (vcu < NGRP && wave < 2) {
                const int g = vcu, dir = wave; const size_t pb = ((size_t)(l * 2 + dir) * NGRP + g);
                const float are = INP(I_ARE)[pb * NST + lane], aim = INP(I_AIM)[pb * NST + lane], dt = expf(INP(I_LDT)[pb]);
                const float mg = expf(are * dt * (float)TC), an = aim * dt * (float)TC, ar = mg * cosf(an), ai = mg * sinf(an);
                float sr = 0.f, si = 0.f;
                for (int cb = 0; cb < NCH; cb += 8) {
                    float xr[8], xi[8];
#pragma unroll
                    for (int k = 0; k < 8; ++k) { const int c = dir == 0 ? cb + k : NCH - 1 - cb - k; const float* s = SSUM + ((size_t)g * NCH + c) * 256 + dir * 128 + lane; xr[k] = s[0]; xi[k] = s[64]; }
#pragma unroll
                    for (int k = 0; k < 8; ++k) { const int c = dir == 0 ? cb + k : NCH - 1 - cb - k;
                        bf16_t* o = UA + ((size_t)g * NCH + c) * UAW + 512 + dir * 128 + lane; o[0] = f2bf(sr); o[64] = f2bf(si);
                        const float nr = ar * sr - ai * si + xr[k], ni = ar * si + ai * sr + xi[k]; sr = nr; si = ni; }
                }
            }
        }
        SEAM(pbase + 1);
        if (PON(5) && IN(pbase + 3)) _Pragma("nounroll") for (int rep_ = 0; rep_ < REPS(5); ++rep_) { PH_ENTER LAYER_ENTER
            pg::SchedGroup Sg; Sg.init(UA, UAW, (size_t)NCH * UAW * 2, w.BO, UAW, (size_t)512 * UAW * 2, 1, 2, NGRP, G, vcu);
            EpiSsmOut E{Yb};
            pg::gemm_phase(lds, UAW, UAW, UAW, Sg, E);
            if (vcu >= 2 * NGRP) convert_items(DecDown{ap_, ws, l}, 4096 + (vcu - 2 * NGRP) * 8 + wave, 10240, (G - 2 * NGRP) * 8, (LAS float*)(lds + wave * 16640), lane);
        }
        SEAM(pbase + 3);
        if (PON(6) && IN(pbase + 4)) _Pragma("nounroll") for (int rep_ = 0; rep_ < REPS(6); ++rep_) { PH_ENTER LAYER_ENTER
            pg::SchedGrid Sg; Sg.init(Yb, SSMW, w.WGLU, SSMW, S, SSMW, G, bx);
            EpiGlu E{Yb, YO};
            pg::gemm_phase(lds, SSMW, SSMW, SSMW, Sg, E);
            if (bx >= 128) convert_items(DecDown{ap_, ws, l}, 10240 + (bx - 128) * 8 + wave, IT_DOWN, (G - 128) * 8, (LAS float*)(lds + wave * 16640), lane);
        }
        SEAM(pbase + 4);
        if (PON(7) && IN(pbase + 5)) _Pragma("nounroll") for (int rep_ = 0; rep_ < REPS(7); ++rep_) { PH_ENTER LAYER_ENTER
            for (int un = vcu; un < NH * (S / 256); un += G) {
                const int h = un / (S / 256), qb = un % (S / 256);
                __syncthreads();
                { int tb = threadIdx.x; asm volatile("" : "+v"(tb)); ((LAS float*)(lds + att::OFF_BT))[tb] = ((const float*)(sm + SM_BTAB))[h * 512 + tb]; }
                const int q0w = qb * 256 + wave * 32;
                f32x16 o[4];
                { f32x16 o2[4];
                  att::attn_dual(o, o2, Qb + (size_t)q0w * 1024 + h * 128, Kb + h * 128, Vb + h * 128, (LAS char*)lds, q0w);
                  const float lam = LAMS[l];
#pragma unroll
                  for (int d = 0; d < 4; ++d) o[d] = o[d] - o2[d] * lam; }
                { int tz = threadIdx.x; asm volatile("" : "+v"(tz)); const int r32 = tz & 31, hi2 = (tz >> 5) & 1;
                  float ssq[16];
#pragma unroll
                  for (int r = 0; r < 16; ++r) { float s = 0.f;
#pragma unroll
                    for (int d = 0; d < 4; ++d) s += o[d][r] * o[d][r];
                    s += swz_xor<1>(s); s += swz_xor<2>(s); s += swz_xor<4>(s); s += swz_xor<8>(s); s += swz_xor<16>(s);
                    ssq[r] = __builtin_amdgcn_rsqf(s * (1.f / VD) + EPS) * (1.f - lam_init); }
                  bf16_t* yo = YO + (size_t)(q0w + 4 * hi2) * 2048 + 1024 + h * 128 + r32;
#pragma unroll
                  for (int d = 0; d < 4; ++d) { const float gn = INP(I_SUBLN)[l * VD + d * 32 + r32];
#pragma unroll
                    for (int r = 0; r < 16; ++r) yo[(size_t)((r & 3) + 8 * (r >> 2)) * 2048 + d * 32] = f2bf(o[d][r] * ssq[r] * gn); } }
            }
            __syncthreads();
        }
        SEAM(pbase + 5);
        if (PON(8) && IN(pbase + 6)) _Pragma("nounroll") for (int rep_ = 0; rep_ < REPS(8); ++rep_) { PH_ENTER LAYER_ENTER
            pg::SchedGrid Sg; Sg.init(YO, 2048, w.WBR, 2048, S, D, G, bx);
            EpiMerge E{Gb, MG};
            pg::gemm_phase(lds, 2048, 2048, 2048, Sg, E);
        }
        SEAM(pbase + 6);
        if (PON(9) && IN(pbase + 7)) _Pragma("nounroll") for (int rep_ = 0; rep_ < REPS(9); ++rep_) { PH_ENTER LAYER_ENTER
            pg::SchedGrid Sg; Sg.init(MG, D, w.WOUT, D, S, D, G, bx);
            EpiOutProj E{XB, XB1};
            pg::gemm_phase(lds, D, D, D, Sg, E);
        }
        SEAM(pbase + 7);
        if (PON(10) && IN(pbase + 8)) _Pragma("nounroll") for (int rep_ = 0; rep_ < REPS(10); ++rep_) { PH_ENTER LAYER_ENTER
            LAS float* WtL = (LAS float*)lds;
            for (int i = tid; i < NE * D / 4; i += 512) ((LAS f32x4*)WtL)[i] = ((const f32x4*)w.WRT)[i];
            __syncthreads();
            for (int m = gw; m < S; m += NGW) { int lz = lane; asm volatile("" : "+v"(lz));
                router_row(XB1 + (size_t)m * D, RINV2 + m, WtL, AFFT, m, lz); }
            __syncthreads();
        }
        SEAM(pbase + 8);
        if (PON(11) && IN(pbase + 9)) _Pragma("nounroll") for (int rep_ = 0; rep_ < REPS(11); ++rep_) { PH_ENTER LAYER_ENTER
            const int nparts = G / NE > 0 ? G / NE : 1;
            if (vcu < nparts * NE) {
                const int e = vcu / nparts, part = vcu % nparts, per = (CAP + nparts - 1) / nparts, slo = part * per, shi = (slo + per < CAP) ? slo + per : CAP;
                LAS int* red = (LAS int*)lds; LAS int* list = (LAS int*)(lds + 1024);
                unsigned bits[16]; { const float* a = AFFT + (size_t)e * S + tid * 16;
#pragma unroll
                    for (int q = 0; q < 4; ++q) { const f32x4 v = *(const f32x4*)(a + 4 * q); bits[4 * q] = __float_as_uint(v[0]); bits[4 * q + 1] = __float_as_uint(v[1]); bits[4 * q + 2] = __float_as_uint(v[2]); bits[4 * q + 3] = __float_as_uint(v[3]); } }
                unsigned T = 0u;
                for (int bit = 30; bit >= 0; --bit) { const unsigned cand = T | (1u << bit); int c = 0;
#pragma unroll
                    for (int i = 0; i < 16; ++i) c += bits[i] >= cand ? 1 : 0;
                    if (block_sum_i(c, red, wave, lane) >= CAP) T = cand; }
                int cg = 0, ce = 0;
#pragma unroll
                for (int i = 0; i < 16; ++i) { cg += bits[i] > T ? 1 : 0; ce += bits[i] == T ? 1 : 0; }
                const int need_eq = CAP - block_sum_i(cg, red, wave, lane);
                int sg = cg, se = ce;
#pragma unroll
                for (int o = 1; o < 64; o <<= 1) { const int a = __shfl_up(sg, o), b = __shfl_up(se, o); if (lane >= o) { sg += a; se += b; } }
                __syncthreads();
                if (lane == 63) { red[16 + wave] = sg; red[32 + wave] = se; }
                __syncthreads();
                int og = 0, oe = 0;
#pragma unroll
                for (int wv = 0; wv < 8; ++wv) if (wv < wave) { og += red[16 + wv]; oe += red[32 + wv]; }
                int gbef = og + sg - cg, ebef = oe + se - ce;
                const bool inv_mine = (tid * nparts) / 512 == part;
#pragma unroll
                for (int i = 0; i < 16; ++i) { const int tok = tid * 16 + i; const bool isg = bits[i] > T, ise = bits[i] == T; const bool sel = isg || (ise && ebef < need_eq);
                    const int slot = gbef + (ebef < need_eq ? ebef : need_eq);
                    if (sel && slot >= slo && slot < shi) { IDX[e * CAP + slot] = tok; GATE[e * CAP + slot] = __uint_as_float(bits[i]); RSL[e * CAP + slot] = RINV2[tok]; list[slot - slo] = tok; }
                    if (inv_mine) INV[tok * NE + e] = sel ? slot : -1;
                    gbef += isg ? 1 : 0; ebef += ise ? 1 : 0; }
                __syncthreads();
                for (int r = wave; r < shi - slo; r += 8) { const int tok = list[r]; const u32x4* s = (const u32x4*)(XB1 + (size_t)tok * D) + lane; u32x2* d = (u32x2*)((unsigned char*)XG + (size_t)(e * CAP + slo + r) * D) + lane;
#pragma unroll
                    for (int j = 0; j < 4; ++j) { f32x4 a, b; unpack8(s[64 * j], a, b); d[64 * j] = pack8_fp8(a, b); } }
                __syncthreads();
            }
        }
        SEAM(pbase + 9);
        if (PON(13) && IN(pbase + 11)) _Pragma("nounroll") for (int rep_ = 0; rep_ < REPS(13); ++rep_) { PH_ENTER LAYER_ENTER
            pg::SchedGroup Sg; Sg.init(XG, D, (size_t)CAP * D, w.WGU, D, (size_t)4096 * D, 4, 16, NE, G, vcu, 1);
            EpiExp1 E{RSL, Hb};
            pg::gemm_phase<EpiExp1, pg::SchedGroup, true, E8_ONE, E8_W>(lds, D, D, D, Sg, E);
        }
        SEAM(pbase + 11);
        if (PON(14) && IN(pbase + 12)) _Pragma("nounroll") for (int rep_ = 0; rep_ < REPS(14); ++rep_) { PH_ENTER LAYER_ENTER
            pg::SchedGroup Sg; Sg.init(Hb, FF, (size_t)CAP * FF, w.WD, FF, (size_t)D * FF, 4, 8, NE, G, vcu, 1);
            EpiExp2 E{GATE, YX};
            pg::gemm_phase<EpiExp2, pg::SchedGroup, true, E8_H, E8_W>(lds, FF, FF, FF, Sg, E);
        }
        SEAM(pbase + 12);
        if (PON(15) && IN(pbase + 13)) _Pragma("nounroll") for (int rep_ = 0; rep_ < REPS(15); ++rep_) { PH_ENTER LAYER_ENTER
            for (int m = gw; m < S; m += NGW) {
                const bf16_t* xr = XB1 + (size_t)m * D;
                f32x4 v[8];
#pragma unroll
                for (int j = 0; j < 8; ++j) { const u32x2 w0 = *(const u32x2*)(xr + 4 * lane + 256 * j); v[j] = (f32x4){bf_lo(w0.x), bf_hi(w0.x), bf_lo(w0.y), bf_hi(w0.y)}; }
                const int myinv = INV[m * NE + (lane & 15)];
                unsigned msk = (unsigned)(__ballot(myinv >= 0) & 0xFFFFull);
                while (msk) { const int e0 = __builtin_ctz(msk); msk &= msk - 1; const bool two = msk != 0u; const int e1 = two ? __builtin_ctz(msk) : e0; if (two) msk &= msk - 1;
                    const bf16_t* y0 = YX + ((size_t)e0 * CAP + __shfl(myinv, e0)) * D; const bf16_t* y1 = YX + ((size_t)e1 * CAP + __shfl(myinv, e1)) * D;
                    u32x2 a[8], b[8];
#pragma unroll
                    for (int j = 0; j < 8; ++j) a[j] = *(const u32x2*)(y0 + 4 * lane + 256 * j);
#pragma unroll
                    for (int j = 0; j < 8; ++j) b[j] = *(const u32x2*)(y1 + 4 * lane + 256 * j);
#pragma unroll
                    for (int j = 0; j < 8; ++j) { v[j][0] += bf_lo(a[j].x); v[j][1] += bf_hi(a[j].x); v[j][2] += bf_lo(a[j].y); v[j][3] += bf_hi(a[j].y); }
                    if (two) {
#pragma unroll
                        for (int j = 0; j < 8; ++j) { v[j][0] += bf_lo(b[j].x); v[j][1] += bf_hi(b[j].x); v[j][2] += bf_lo(b[j].y); v[j][3] += bf_hi(b[j].y); } } }
                if (l + 1 < NL) {
                    float ss = 0.f;
#pragma unroll
                    for (int j = 0; j < 8; ++j) ss += v[j][0] * v[j][0] + v[j][1] * v[j][1] + v[j][2] * v[j][2] + v[j][3] * v[j][3];
                    ss = wave_sum(ss);
#pragma unroll
                    for (int j = 0; j < 8; ++j) { u32x2 wv; wv.x = cvt_pk_bf16(v[j][0], v[j][1]); wv.y = cvt_pk_bf16(v[j][2], v[j][3]); *(u32x2*)(XB + (size_t)m * D + 4 * lane + 256 * j) = wv; }
                    if (lane == 0) RINV[m] = __builtin_amdgcn_rsqf(ss * (1.f / D) + EPS);
                } else { float* orow = OUTP + (size_t)m * D;
#pragma unroll
                    for (int j = 0; j < 8; ++j) *(f32x4*)(orow + 4 * lane + 256 * j) = v[j]; }
            }
        }
        SEAM(pbase + 13);
    }
#undef IN
#undef SEAM
}

#if defined(DBG_STOP)
#ifndef DBG_OFF
#define DBG_OFF A_XA
#endif
#ifndef DBG_BF16
#define DBG_BF16 0
#endif
__global__ void dbg_dump(float* out, const unsigned char* ws) {
    const unsigned char* p = ws + WS_ACT + DBG_OFF;
    for (size_t i = (size_t)blockIdx.x * 256 + threadIdx.x; i < (size_t)S * D; i += (size_t)gridDim.x * 256)
#if defined(DBG_SUM2)
        out[i] = __uint_as_float(((unsigned)((const bf16_t*)p)[i]) << 16) + __uint_as_float(((unsigned)((const bf16_t*)p)[i + (size_t)S * D]) << 16);
#else
        out[i] = DBG_BF16 ? __uint_as_float(((unsigned)((const bf16_t*)p)[i]) << 16) : ((const float*)p)[i];
#endif
}
#endif
constexpr int N_PHASES = 2 + NL * 14;
extern "C" void kernel_launch(void* const* d_in, const int* in_sizes, int n_in, void* d_out, int out_size, void* d_ws, size_t ws_size, hipStream_t stream) {
    static int grid = 0;
    if (grid == 0) {
        if (n_in != 28 || in_sizes[0] != S * D || out_size != S * D || ws_size < WS_END) { fprintf(stderr, "kernel_launch: shape/workspace mismatch (n_in %d, ws %zu, need %zu)\n", n_in, ws_size, (size_t)WS_END); grid = -1; return; }
        int dev = 0, cus = 0, per_cu = 0;
        if (hipGetDevice(&dev) != hipSuccess || hipDeviceGetAttribute(&cus, hipDeviceAttributeMultiprocessorCount, dev) != hipSuccess) { grid = -1; return; }
        if (hipFuncSetAttribute((const void*)fwd, hipFuncAttributeMaxDynamicSharedMemorySize, LDS_BYTES) != hipSuccess) { fprintf(stderr, "kernel_launch: hipFuncSetAttribute failed\n"); grid = -1; return; }
        if (hipOccupancyMaxActiveBlocksPerMultiprocessor(&per_cu, (const void*)fwd, 512, LDS_BYTES) != hipSuccess || per_cu < 1) { fprintf(stderr, "kernel_launch: occupancy query says %d\n", per_cu); }
        (void)hipGetLastError();
        grid = cus;
    }
    if (grid < 0) return;
    (void)hipMemsetAsync((char*)d_ws + WS_CTL, 0, CTL_BYTES, stream);
    Args a{};
    for (int i = 0; i < 28; ++i) a.in[i] = (GAS const float*)d_in[i];
    a.out = (GAS float*)d_out; a.ws = (GAS unsigned char*)d_ws;
#if defined(DBG_STOP)
    for (int p = 0; p < DBG_STOP; ++p) { a.ph_lo = p; a.ph_hi = p + 1; hipLaunchKernelGGL(fwd, dim3(grid), dim3(512), LDS_BYTES, stream, a); }
#if !defined(DBG_NODUMP)
    hipLaunchKernelGGL(dbg_dump, dim3(2048), dim3(256), 0, stream, (float*)d_out, (const unsigned char*)d_ws);
#endif
#elif MK_PER_PHASE
    for (int p = 0; p < N_PHASES; ++p) { a.ph_lo = p; a.ph_hi = p + 1; hipLaunchKernelGGL(fwd, dim3(grid), dim3(512), LDS_BYTES, stream, a); }
#else
    a.ph_lo = 0; a.ph_hi = N_PHASES; hipLaunchKernelGGL(fwd, dim3(grid), dim3(512), LDS_BYTES, stream, a);
#endif
    const hipError_t le = hipPeekAtLastError();
    if (le != hipSuccess) fprintf(stderr, "kernel_launch: launch failed: %s\n", hipGetErrorName(le));
}
```

```cpp
#include <hip/hip_runtime.h>
#include <cstdio>
#include <cstdint>

#define REP_MASK 7168
#ifndef MK_PER_PHASE
#define MK_PER_PHASE 0
#endif

#define LAS __attribute__((address_space(3)))
#define GAS __attribute__((address_space(1)))
typedef unsigned short bf16_t;
typedef short bf16x8 __attribute__((ext_vector_type(8)));
typedef short s16x4 __attribute__((ext_vector_type(4)));
typedef float f32x4 __attribute__((ext_vector_type(4)));
typedef float f32x2 __attribute__((ext_vector_type(2)));
typedef float f32x16 __attribute__((ext_vector_type(16)));
typedef unsigned u32x4 __attribute__((ext_vector_type(4)));
typedef unsigned u32x2 __attribute__((ext_vector_type(2)));

constexpr int S = 8192, D = 2048, NL = 2;
constexpr int SSMW = 1024, NGRP = 64, GP = 16, NST = 64;
constexpr int NH = 8, QKD = 64, VD = 128;
constexpr int NE = 16, CAP = 1024, FF = 2048;
constexpr int INC = 8192;
constexpr float EPS = 1e-6f;
constexpr int TC = 32, NCH = S / TC;
constexpr int UAW = TC * GP + 256;
constexpr float LOG2E = 1.4426950408889634f;

constexpr size_t MiB = 1u << 20;
constexpr size_t WS_CTL = 0, CTL_BYTES = 1 * MiB;
constexpr size_t LW_WIN = 0, LW_WGLU = 32 * MiB, LW_WBR = 34 * MiB, LW_WOUT = 42 * MiB, LW_WGU = 50 * MiB, LW_WD = 306 * MiB,
                 LW_F = 434 * MiB, LW_BO = 450 * MiB, LW_KTAB = 498 * MiB, LW_WRT = 502 * MiB, LW_SIZE = 503 * MiB;
constexpr size_t WS_LW = 1 * MiB;
constexpr size_t WS_ACT = WS_LW + 2 * LW_SIZE;
constexpr size_t A_XB = 0, A_XB1 = 32 * MiB, A_UA = 64 * MiB, A_Q = 88 * MiB, A_K = 104 * MiB, A_V = 120 * MiB, A_G = 136 * MiB,
                 A_SSUM = 200 * MiB, A_Y = 216 * MiB, A_YO = 232 * MiB, A_O1 = 264 * MiB, A_MG = 296 * MiB, A_XA = 328 * MiB,
                 A_XG = 392 * MiB, A_H = 456 * MiB, A_YX = 520 * MiB, A_SMALL = 584 * MiB, A_END = 588 * MiB;
constexpr size_t SM_RINV = 0, SM_RINV2 = 64 * 1024, SM_AFFT = 128 * 1024, SM_IDX = 640 * 1024, SM_GATE = 704 * 1024, SM_RSL = 768 * 1024,
                 SM_INV = 1024 * 1024, SM_BTAB = 1536 * 1024, SM_LAM = 1600 * 1024;
constexpr size_t WS_END = WS_ACT + A_END;

constexpr int RING_BYTES = 131072;
constexpr int LDS_BYTES = 163840;
constexpr int MISC_OFF = 155648;

typedef __bf16 bf16v2_t __attribute__((ext_vector_type(2)));
__device__ __forceinline__ unsigned cvt_pk_bf16(float lo, float hi) { const f32x2 v = {lo, hi}; return __builtin_bit_cast(unsigned, __builtin_convertvector(v, bf16v2_t)); }
__device__ __forceinline__ float bf_lo(unsigned w) { return __uint_as_float(w << 16); }
__device__ __forceinline__ float bf_hi(unsigned w) { return __uint_as_float(w & 0xffff0000u); }
__device__ __forceinline__ unsigned short f2bf(float f) { return (unsigned short)(cvt_pk_bf16(f, 0.f) & 0xffffu); }
__device__ __forceinline__ float fast_sigmoid(float x) { return __builtin_amdgcn_rcpf(1.f + __builtin_amdgcn_exp2f(-x * LOG2E)); }
__device__ __forceinline__ float wave_sum(float v) {
#pragma unroll
    for (int o = 1; o < 64; o <<= 1) v += __shfl_xor(v, o);
    return v;
}
template <int X> __device__ __forceinline__ float swz_xor(float v) { return __int_as_float(__builtin_amdgcn_ds_swizzle(__float_as_int(v), (X << 10) | 0x1F)); }
__device__ __forceinline__ u32x2 pack8_fp8(const f32x4 a, const f32x4 b) { int w0 = 0, w1 = 0;
    w0 = __builtin_amdgcn_cvt_pk_fp8_f32(a[0], a[1], w0, false); w0 = __builtin_amdgcn_cvt_pk_fp8_f32(a[2], a[3], w0, true);
    w1 = __builtin_amdgcn_cvt_pk_fp8_f32(b[0], b[1], w1, false); w1 = __builtin_amdgcn_cvt_pk_fp8_f32(b[2], b[3], w1, true);
    u32x2 r; r.x = (unsigned)w0; r.y = (unsigned)w1; return r; }
constexpr float W8_SCALE = 64.f, H8_SCALE = 16.f;
constexpr int E8_ONE = 0x7F7F7F7F, E8_W = 0x79797979  , E8_H = 0x7B7B7B7B  ;
#define LDS_WAIT() asm volatile("s_waitcnt lgkmcnt(0)" ::: "memory")
#define VM_WAIT() asm volatile("s_waitcnt vmcnt(0)" ::: "memory")

#define XB_TMO      128
#define XB_XCNT(j)  (256  + 64 * (j))
#define XB_XSUB(j)  (1280 + 64 * (j))
#define XB_XGEN(j)  (2304 + 64 * (j))
#define XB_TOP      3328
#define XB_TOPGEN   3392
#define XCD_BAR_WORDS 3456
#define XB_SPIN_CAP (1u << 22)
__device__ __forceinline__ unsigned xb_ld(unsigned* p)              { return __hip_atomic_load(p, __ATOMIC_RELAXED, __HIP_MEMORY_SCOPE_AGENT); }
__device__ __forceinline__ unsigned xb_add(unsigned* p, unsigned v) { return __hip_atomic_fetch_add(p, v, __ATOMIC_RELAXED, __HIP_MEMORY_SCOPE_AGENT); }
__device__ __forceinline__ unsigned xb_xcc_id() { return (unsigned)__builtin_amdgcn_s_getreg((3 << 11) | 20) & 0xFu; }
#define XB_SPIN(cond, bar) do { unsigned _sp = 0; while (cond) { __builtin_amdgcn_s_sleep(1); \
    if ((++_sp & 255u) == 0u) { if (xb_ld(&(bar)[XB_TMO])) break; if (_sp > XB_SPIN_CAP) { atomicAdd(&(bar)[XB_TMO], 1u); break; } } } } while (0)
struct XcdBarrier { unsigned* bar; unsigned x; volatile LAS unsigned* st; };
__device__ __forceinline__ XcdBarrier xcd_barrier_post(unsigned* bar, volatile LAS unsigned* st) {
    XcdBarrier b; b.bar = bar; b.x = xb_xcc_id(); b.st = st;
    if (threadIdx.x == 0) (void)xb_add(&bar[XB_XCNT(b.x)], 1u);
    return b;
}
__device__ __forceinline__ void xcd_barrier_complete(unsigned* bar, unsigned x, unsigned& nloc, unsigned& nx) {
    const unsigned G = gridDim.x * gridDim.y * gridDim.z;
    unsigned sum, cnt, mine, sp = 0u;
    for (;;) {
        sum = 0u; cnt = 0u; mine = 0u;
#pragma nounroll
        for (unsigned j = 0; j < 16; ++j) { const unsigned c = xb_ld(&bar[XB_XCNT(j)]); sum += c; cnt += (c > 0u) ? 1u : 0u; mine = (j == x) ? c : mine; }
        if (sum == G) break;
        __builtin_amdgcn_s_sleep(1);
        if ((++sp & 255u) == 0u) { if (xb_ld(&bar[XB_TMO])) break; if (sp > XB_SPIN_CAP) { atomicAdd(&bar[XB_TMO], 1u); break; } }
    }
    nloc = mine > 0u ? mine : 1u; nx = cnt > 0u ? cnt : 1u;
}
__device__ __forceinline__ void xcd_barrier(const XcdBarrier& b) {
    asm volatile("s_waitcnt vmcnt(0)" ::: "memory");
    __syncthreads();
    if (threadIdx.x == 0) {
        unsigned* bar = b.bar;
        __builtin_amdgcn_s_waitcnt(0);
        unsigned nloc = b.st[0], nx = b.st[1];
        if (nloc == 0u) { xcd_barrier_complete(bar, b.x, nloc, nx); b.st[0] = nloc; b.st[1] = nx; }
        const unsigned old = xb_add(&bar[XB_XSUB(b.x)], 1u);
        const unsigned gen = old / nloc;
        if (old + 1u == (gen + 1u) * nloc) {
            __builtin_amdgcn_fence(__ATOMIC_RELEASE, "agent");
            asm volatile("s_waitcnt vmcnt(0)" ::: "memory");
            const unsigned og = xb_add(&bar[XB_TOP], 1u);
            const unsigned tg = og / nx;
            if (og + 1u == (tg + 1u) * nx) xb_add(&bar[XB_TOPGEN], 1u);
            else XB_SPIN(xb_ld(&bar[XB_TOPGEN]) == tg, bar);
            __builtin_amdgcn_fence(__ATOMIC_ACQUIRE, "agent");
            xb_add(&bar[XB_XGEN(b.x)], 1u);
            asm volatile("s_waitcnt vmcnt(0)" ::: "memory");
        } else {
            XB_SPIN(xb_ld(&bar[XB_XGEN(b.x)]) == gen, bar);
            __builtin_amdgcn_fence(__ATOMIC_ACQUIRE, "agent");
            asm volatile("s_waitcnt vmcnt(0)" ::: "memory");
        }
    }
    __syncthreads();
}

namespace pg {
constexpr int BM = 256, BK = 64, HALF = 128, HTB = HALF * BK * 2, STAGE_BYTES = 8 * HTB;
__device__ __forceinline__ int lds_byte(int r, int c) { const int st = (r >> 4) * 2 + (c >> 5), rr = r & 15, cc = c & 31, ob = rr * 64 + cc * 2; return st * 1024 + (ob ^ (((ob >> 9) & 1) << 5)); }
__device__ __forceinline__ void stage_rc(int b, int& R, int& C) { const int st = b / 1024, sb = b % 1024, swz = sb ^ (((sb >> 9) & 1) << 5); R = (st >> 1) * 16 + swz / 64; C = (st & 1) * 32 + (swz % 64) / 2; }
__device__ __forceinline__ int perm32(int rho) { const int n = rho >> 4, i = rho & 15; return 8 * (i >> 2) + 4 * n + (i & 3); }
struct Unit { const char* a; const char* b; int pm, pn, grp; };
typedef f32x4 Acc[2][2][4][2];

typedef int v8i_t __attribute__((ext_vector_type(8)));
template <class Epi, class Sched, bool F8 = false, int SA_ = 0x7F7F7F7F, int SB_ = 0x7F7F7F7F>
__device__ __forceinline__ void gemm_phase(LAS unsigned char* lds, const int K, const int lda, const int ldb, const Sched& S, const Epi& E) {
    int tz_ = threadIdx.x; asm volatile("" : "+v"(tz_));
    const int tid = tz_, wid = __builtin_amdgcn_readfirstlane(tid >> 6), lane = tid & 63, wr = wid >> 2, wc = wid & 3, fr = lane & 15, fq = lane >> 4;
    constexpr int ESZ = F8 ? 1 : 2;
    const int nt = K * ESZ / (BK * 2);
    unsigned voffA[2], voffB[2];
#pragma unroll
    for (int i = 0; i < 2; ++i) { int R, C; stage_rc(tid * 16 + i * 8192, R, C);
        voffA[i] = (unsigned)(R * lda * ESZ + C * 2); voffB[i] = (unsigned)((64 * (R >> 5) + perm32(R & 31)) * ldb * ESZ + C * 2); }
    const size_t kstep = (size_t)(BK * 2);
    const size_t hstepA = (size_t)HALF * lda * ESZ;
    const size_t hstepB = (size_t)32 * ldb * ESZ;
    const unsigned ldsw = (unsigned)wid * 1024u;
    const int aoff = F8 ? lds_byte(wr * 64 + fr, fq * 16) : lds_byte(wr * 64 + fr, fq * 8), boff = F8 ? lds_byte(wc * 32 + fr, fq * 16) : lds_byte(wc * 32 + fr, fq * 8);
#define PG8_SA(b, h) (((b) * 2 + (h)) * HTB)
#define PG8_SB(b, h) ((4 + (b) * 2 + (h)) * HTB)
#define PG8_STAGE(bufoff, gbase, voff) do { _Pragma("unroll") for (int _i = 0; _i < 2; ++_i) \
        __builtin_amdgcn_global_load_lds((const unsigned*)((const char*)(gbase) + (voff)[_i]), (LAS unsigned*)(lds + (bufoff) + ldsw + _i * 8192), 16, 0, 0); } while (0)
    typedef v8i_t v8i_a16 __attribute__((aligned(16)));
#define PG8_LD32(p) __builtin_bit_cast(v8i_t, __builtin_shufflevector(*(const LAS u32x4*)(p), *(const LAS u32x4*)((p) + 16), 0, 1, 2, 3, 4, 5, 6, 7))
#define PG8_LDA(dst, b, h) do { if constexpr (F8) { _Pragma("unroll") for (int m = 0; m < 4; ++m) dst##8[m] = PG8_LD32(lds + PG8_SA(b, h) + aoff + m * 2048); } \
        else { _Pragma("unroll") for (int m = 0; m < 4; ++m) _Pragma("unroll") for (int k = 0; k < 2; ++k) dst[m][k] = *(const LAS bf16x8*)(lds + PG8_SA(b, h) + aoff + m * 2048 + k * 1024); } } while (0)
#define PG8_LDB(dst, b, h) do { if constexpr (F8) { _Pragma("unroll") for (int n = 0; n < 2; ++n) dst##8[n] = PG8_LD32(lds + PG8_SB(b, h) + boff + n * 2048); } \
        else { _Pragma("unroll") for (int n = 0; n < 2; ++n) _Pragma("unroll") for (int k = 0; k < 2; ++k) dst[n][k] = *(const LAS bf16x8*)(lds + PG8_SB(b, h) + boff + n * 2048 + k * 1024); } } while (0)
#define PG8_MMA(ai, bj, At, Bt) do { __builtin_amdgcn_s_setprio(1); \
        if constexpr (F8) { _Pragma("unroll") for (int m = 0; m < 4; ++m) _Pragma("unroll") for (int n = 0; n < 2; ++n) \
            asm volatile("v_mfma_scale_f32_16x16x128_f8f6f4 %0, %1, %2, %0, %3, %4 op_sel_hi:[0,0,0]" : "+v"(acc[ai][bj][m][n]) : "v"(Bt##8[n]), "v"(At##8[m]), "v"(sbv), "v"(sav)); } \
        else { _Pragma("unroll") for (int m = 0; m < 4; ++m) _Pragma("unroll") for (int n = 0; n < 2; ++n) _Pragma("unroll") for (int k = 0; k < 2; ++k) \
            acc[ai][bj][m][n] = __builtin_amdgcn_mfma_f32_16x16x32_bf16(Bt[n][k], At[m][k], acc[ai][bj][m][n], 0, 0, 0); } \
        __builtin_amdgcn_s_setprio(0); } while (0)
#define PG8_WAIT_V(n) asm volatile("s_waitcnt vmcnt(" #n ")" ::: "memory")
#define PG8_WAIT_L(n) asm volatile("s_waitcnt lgkmcnt(" #n ")" ::: "memory")
#define PG8_BAR __builtin_amdgcn_s_barrier()
#define PG8_SCHED __builtin_amdgcn_sched_barrier(0)
    Unit cur, nxt; int ui = 0;
    if (!S.next(0, cur)) return;
    Acc acc;
#pragma unroll
    for (int a = 0; a < 2; ++a)
#pragma unroll
        for (int b = 0; b < 2; ++b)
#pragma unroll
            for (int m = 0; m < 4; ++m)
#pragma unroll
                for (int n = 0; n < 2; ++n) acc[a][b][m][n] = (f32x4){0.f, 0.f, 0.f, 0.f};
    bf16x8 At[4][2], B0[2][2], B1[2][2]; v8i_t At8[4], B08[2], B18[2];
    const int sav = SA_, sbv = SB_;
    const char* cA = cur.a; const char* cB = cur.b;
    PG8_STAGE(PG8_SB(0, 0), cB, voffB); PG8_STAGE(PG8_SA(0, 0), cA, voffA); PG8_STAGE(PG8_SB(0, 1), cB + hstepB, voffB); PG8_STAGE(PG8_SA(0, 1), cA + hstepA, voffA);
    if (wr == 1) PG8_BAR;
    PG8_WAIT_V(4); PG8_BAR;
    PG8_STAGE(PG8_SB(1, 0), cB + kstep, voffB); PG8_STAGE(PG8_SA(1, 0), cA + kstep, voffA); PG8_STAGE(PG8_SB(1, 1), cB + hstepB + kstep, voffB);
    PG8_WAIT_V(6); PG8_BAR;
    for (;;) {
        const bool has_next = S.next(ui + 1, nxt);
        const char* nA = has_next ? nxt.a : cA; const char* nB = has_next ? nxt.b : cB;
        for (int t = 0; t < nt; t += 2) {
            const bool last = (t == nt - 2);
            const char* a1 = cA + (size_t)(t + 1) * kstep;
            const char* a2 = last ? nA : cA + (size_t)(t + 2) * kstep; const char* b2 = last ? nB : cB + (size_t)(t + 2) * kstep;
            const char* a3 = a2 + kstep; const char* b3 = b2 + kstep;
            if constexpr (Epi::HAS_MID) { if (t == nt / 2) E.mid(acc, cur, wr, wc, fr, fq); }
            PG8_LDB(B0, 0, 0); PG8_SCHED; PG8_LDA(At, 0, 0); PG8_STAGE(PG8_SA(1, 1), a1 + hstepA, voffA);
            PG8_WAIT_L(8); PG8_BAR; PG8_WAIT_L(0); PG8_MMA(0, 0, At, B0); PG8_BAR; PG8_SCHED;
            PG8_LDB(B1, 0, 1); PG8_STAGE(PG8_SB(0, 0), b2, voffB);
            PG8_BAR; PG8_WAIT_L(0); PG8_MMA(0, 1, At, B1); PG8_BAR;
            PG8_LDA(At, 0, 1); PG8_STAGE(PG8_SA(0, 0), a2, voffA);
            PG8_BAR; PG8_WAIT_L(0); PG8_MMA(1, 0, At, B0); PG8_BAR; PG8_SCHED;
            PG8_STAGE(PG8_SB(0, 1), b2 + hstepB, voffB);
            PG8_WAIT_V(6); PG8_BAR; PG8_MMA(1, 1, At, B1); PG8_BAR;
            PG8_LDB(B0, 1, 0); PG8_SCHED; PG8_LDA(At, 1, 0); PG8_STAGE(PG8_SA(0, 1), a2 + hstepA, voffA);
            PG8_WAIT_L(8); PG8_BAR; PG8_WAIT_L(0); PG8_MMA(0, 0, At, B0); PG8_BAR; PG8_SCHED;
            PG8_LDB(B1, 1, 1); PG8_STAGE(PG8_SB(1, 0), b3, voffB);
            PG8_BAR; PG8_WAIT_L(0); PG8_MMA(0, 1, At, B1); PG8_BAR;
            PG8_LDA(At, 1, 1); PG8_STAGE(PG8_SA(1, 0), a3, voffA);
            PG8_BAR; PG8_WAIT_L(0); PG8_MMA(1, 0, At, B0); PG8_BAR; PG8_SCHED;
            PG8_STAGE(PG8_SB(1, 1), b3 + hstepB, voffB);
            PG8_WAIT_V(6); PG8_BAR; PG8_MMA(1, 1, At, B1); PG8_BAR;
        }
        if constexpr (F8) asm volatile("s_nop 15\n\ts_nop 15" ::: "memory");
        E(acc, cur, wr, wc, fr, fq);
        if (!has_next) break;
#pragma unroll
        for (int a = 0; a < 2; ++a)
#pragma unroll
            for (int b = 0; b < 2; ++b)
#pragma unroll
                for (int m = 0; m < 4; ++m)
#pragma unroll
                    for (int n = 0; n < 2; ++n) acc[a][b][m][n] = (f32x4){0.f, 0.f, 0.f, 0.f};
        cur = nxt; cA = nA; cB = nB; ++ui;
    }
    PG8_WAIT_V(0);
    if (wr == 0) PG8_BAR;
    PG8_BAR;
#undef PG8_SA
#undef PG8_SB
#undef PG8_STAGE
#undef PG8_LDA
#undef PG8_LD32
#undef PG8_LDB
#undef PG8_MMA
#undef PG8_WAIT_V
#undef PG8_WAIT_L
#undef PG8_BAR
#undef PG8_SCHED
}

struct SchedGrid {
    const char* A; const char* B; size_t tstepA, tstepB; int nM, nN, nwg, G, c; bool mix32 = false;
    __device__ void init(const void* A_, int lda, const void* B_, int ldb, int M, int N, int G_, int c_, int esz = 2) {
        A = (const char*)A_; B = (const char*)B_; tstepA = (size_t)256 * lda * esz; tstepB = (size_t)256 * ldb * esz; nM = M / 256; nN = N / 256; nwg = nM * nN; G = G_; c = c_; }
    __device__ __forceinline__ bool next(int i, Unit& u) const {
        const long L = (long)i * G + c; if (L >= nwg) return false;
        int wgid = (int)L; { const int q = nwg / 8, r = nwg % 8, xcd = wgid % 8, off = wgid / 8; wgid = (xcd < r ? xcd * (q + 1) : r * (q + 1) + (xcd - r) * q) + off; }
        const int nig = 8 * nN, gid = wgid / nig, fm = gid * 8, gsz = (nM - fm) < 8 ? (nM - fm) : 8;
        u.pm = fm + ((wgid % nig) % gsz); u.pn = (wgid % nig) / gsz; u.grp = 0;
        if (mix32) { const int a = u.pn >> 4, r4 = (u.pn >> 2) & 3, r = u.pn & 3; u.pn = ((r4 & 1) << 4) | (a << 3) | ((r4 >> 1) << 2) | r; }
        u.a = A + (size_t)u.pm * tstepA; u.b = B + (size_t)u.pn * tstepB; return true;
    }
};
struct SchedGroup {
    const char* A; const char* B; size_t tstepA, tstepB, gstepA, gstepB; int nM, nN, total, G, c;
    __device__ void init(const void* A_, int lda, size_t gA, const void* B_, int ldb, size_t gB, int nM_, int nN_, int NG, int G_, int c_, int esz = 2) {
        A = (const char*)A_; B = (const char*)B_; tstepA = (size_t)256 * lda * esz; tstepB = (size_t)256 * ldb * esz; gstepA = gA; gstepB = gB; nM = nM_; nN = nN_; total = NG * nM_ * nN_; G = G_; c = c_; }
    __device__ __forceinline__ bool next(int i, Unit& u) const {
        const long L = (long)i * G + c; if (L >= total) return false;
        const int per = nM * nN, g = (int)L / per, r = (int)L % per;
        u.grp = g; u.pm = r % nM; u.pn = r / nM;
        u.a = A + (size_t)g * gstepA + (size_t)u.pm * tstepA; u.b = B + (size_t)g * gstepB + (size_t)u.pn * tstepB; return true;
    }
};
}

#define EPI_LANES int tz_ = threadIdx.x; asm volatile("" : "+v"(tz_)); const int wr = tz_ >> 8, wc = (tz_ >> 6) & 3, fr = tz_ & 15, fq = (tz_ >> 4) & 3;
#define EPI_FOR _Pragma("unroll") for (int ai = 0; ai < 2; ++ai) _Pragma("unroll") for (int m = 0; m < 4; ++m)
#define EPI_RL const int rl = ai * 128 + wr * 64 + m * 16 + fr;
__device__ __forceinline__ u32x4 pack8(const f32x4 a, const f32x4 b) { u32x4 w; w.x = cvt_pk_bf16(a[0], a[1]); w.y = cvt_pk_bf16(a[2], a[3]); w.z = cvt_pk_bf16(b[0], b[1]); w.w = cvt_pk_bf16(b[2], b[3]); return w; }
__device__ __forceinline__ void unpack8(const u32x4 w, f32x4& a, f32x4& b) { a = (f32x4){bf_lo(w.x), bf_hi(w.x), bf_lo(w.y), bf_hi(w.y)}; b = (f32x4){bf_lo(w.z), bf_hi(w.z), bf_lo(w.w), bf_hi(w.w)}; }

struct EpiInProj {
    static constexpr bool HAS_MID = false;
    const float* rinv; bf16_t *UA, *Q, *Kb, *V, *G; const float *qg, *kg;
    __device__ __forceinline__ void operator()(const pg::Acc& acc, const pg::Unit& u, int, int, int, int) const { EPI_LANES
        const int pn = u.pn, row0 = u.pm * 256;
        if (pn < 4) {
            EPI_FOR { EPI_RL const int tok = row0 + rl; const float rs = rinv[tok]; const int c = tok >> 5, tau = tok & 31;
#pragma unroll
                for (int bj = 0; bj < 2; ++bj) { const int ch = 256 * pn + 64 * wc + 32 * bj + 8 * fq, g = ch >> 4, p0 = ch & 15;
                    *(u32x4*)(UA + ((size_t)(g * NCH + c) * UAW + tau * 16 + p0)) = pack8(acc[ai][bj][m][0] * rs, acc[ai][bj][m][1] * rs); } }
        } else if (pn < 12) {
            const bool isq = pn < 8; const int col0 = 256 * (pn - (isq ? 4 : 8)) + 64 * wc; const float* gp = isq ? qg : kg; const float sc = isq ? 0.125f * LOG2E : 1.f;
            bf16_t* dst = isq ? Q : Kb;
            f32x4 gv[2][2];
#pragma unroll
            for (int bj = 0; bj < 2; ++bj)
#pragma unroll
                for (int n = 0; n < 2; ++n) gv[bj][n] = *(const f32x4*)(gp + 32 * bj + 8 * fq + 4 * n) * sc;
            EPI_FOR { EPI_RL const int tok = row0 + rl; const float rs = rinv[tok];
                f32x4 v[2][2]; float ss = 0.f;
#pragma unroll
                for (int bj = 0; bj < 2; ++bj)
#pragma unroll
                    for (int n = 0; n < 2; ++n) { v[bj][n] = acc[ai][bj][m][n] * rs; ss += v[bj][n][0] * v[bj][n][0] + v[bj][n][1] * v[bj][n][1] + v[bj][n][2] * v[bj][n][2] + v[bj][n][3] * v[bj][n][3]; }
                ss += __shfl_xor(ss, 16); ss += __shfl_xor(ss, 32);
                const float r = __builtin_amdgcn_rsqf(ss * (1.f / 64.f) + EPS);
#pragma unroll
                for (int bj = 0; bj < 2; ++bj)
                    *(u32x4*)(dst + (size_t)tok * 1024 + col0 + 32 * bj + 8 * fq) = pack8(v[bj][0] * r * gv[bj][0], v[bj][1] * r * gv[bj][1]); }
        } else {
            EPI_FOR { EPI_RL const int tok = row0 + rl; const float rs = rinv[tok];
#pragma unroll
                for (int bj = 0; bj < 2; ++bj)
                    *(u32x4*)(V + (size_t)tok * 1024 + 256 * (pn - 12) + 64 * wc + 32 * bj + 8 * fq) = pack8(acc[ai][bj][m][0] * rs, acc[ai][bj][m][1] * rs); }
        }
    }
};
struct EpiGates {
    static constexpr bool HAS_MID = false;
    const float* rinv; bf16_t* G;
    __device__ __forceinline__ void operator()(const pg::Acc& acc, const pg::Unit& u, int, int, int, int) const { EPI_LANES
        EPI_FOR { EPI_RL const int tok = u.pm * 256 + rl; const float rs = rinv[tok];
#pragma unroll
            for (int bj = 0; bj < 2; ++bj) { f32x4 a = acc[ai][bj][m][0] * rs, b = acc[ai][bj][m][1] * rs;
#pragma unroll
                for (int j = 0; j < 4; ++j) { a[j] = fast_sigmoid(a[j]); b[j] = fast_sigmoid(b[j]); }
                *(u32x4*)(G + (size_t)tok * 4096 + 256 * u.pn + 64 * wc + 32 * bj + 8 * fq) = pack8(a, b); } }
    }
};
struct EpiSsum {
    static constexpr bool HAS_MID = false;
    float* SS;
    __device__ __forceinline__ void operator()(const pg::Acc& acc, const pg::Unit& u, int, int, int, int) const { EPI_LANES
        EPI_FOR { EPI_RL float* rp = SS + ((size_t)u.grp * NCH + rl) * 256 + 64 * wc + 8 * fq;
#pragma unroll
            for (int bj = 0; bj < 2; ++bj) { *(f32x4*)(rp + 32 * bj) = acc[ai][bj][m][0]; *(f32x4*)(rp + 32 * bj + 4) = acc[ai][bj][m][1]; } }
    }
};
__device__ __forceinline__ float gelu_tanh(float x) {
    const float t = 1.5957691216057308f * (x + 0.044715f * x * x * x);
    return x * fast_sigmoid(t);
}
struct EpiSsmOut {
    static constexpr bool HAS_MID = false;
    bf16_t* Y;
    __device__ __forceinline__ void operator()(const pg::Acc& acc, const pg::Unit& u, int, int, int, int) const { EPI_LANES
        EPI_FOR { EPI_RL
#pragma unroll
            for (int bj = 0; bj < 2; ++bj) { const int col = 256 * u.pn + 64 * wc + 32 * bj + 8 * fq, t = col >> 4, p0 = col & 15;
                f32x4 a = acc[ai][bj][m][0], b = acc[ai][bj][m][1];
#pragma unroll
                for (int j = 0; j < 4; ++j) { a[j] = gelu_tanh(a[j]); b[j] = gelu_tanh(b[j]); }
                *(u32x4*)(Y + (size_t)(rl * TC + t) * SSMW + u.grp * GP + p0) = pack8(a, b); } }
    }
};
struct EpiGlu {
    static constexpr bool HAS_MID = false;
    const bf16_t* Y; bf16_t* YO;
    __device__ __forceinline__ void operator()(const pg::Acc& acc, const pg::Unit& u, int, int, int, int) const { EPI_LANES
        EPI_FOR { EPI_RL const int tok = u.pm * 256 + rl;
#pragma unroll
            for (int bj = 0; bj < 2; ++bj) { const int col = 256 * u.pn + 64 * wc + 32 * bj + 8 * fq;
                f32x4 ya, yb; unpack8(*(const u32x4*)(Y + (size_t)tok * SSMW + col), ya, yb);
                f32x4 a = acc[ai][bj][m][0], b = acc[ai][bj][m][1];
#pragma unroll
                for (int j = 0; j < 4; ++j) { a[j] = ya[j] * fast_sigmoid(a[j]); b[j] = yb[j] * fast_sigmoid(b[j]); }
                *(u32x4*)(YO + (size_t)tok * 2048 + col) = pack8(a, b); } }
    }
};
struct EpiMerge {
    static constexpr bool HAS_MID = true;
    const bf16_t* G; bf16_t* MG;
    __device__ __forceinline__ void mid(pg::Acc& acc, const pg::Unit& u, int, int, int, int) const { EPI_LANES
        EPI_FOR { EPI_RL const int tok = u.pm * 256 + rl;
#pragma unroll
            for (int bj = 0; bj < 2; ++bj) { const int col = 256 * u.pn + 64 * wc + 32 * bj + 8 * fq;
                f32x4 sa, sb, ga, gb; unpack8(*(const u32x4*)(G + (size_t)tok * 4096 + col), sa, sb); unpack8(*(const u32x4*)(G + (size_t)tok * 4096 + 2048 + col), ga, gb);
#pragma unroll
                for (int j = 0; j < 4; ++j) { acc[ai][bj][m][0][j] *= sa[j] * __builtin_amdgcn_rcpf(ga[j]); acc[ai][bj][m][1][j] *= sb[j] * __builtin_amdgcn_rcpf(gb[j]); } }
            __builtin_amdgcn_sched_barrier(0); }
    }
    __device__ __forceinline__ void operator()(const pg::Acc& acc, const pg::Unit& u, int, int, int, int) const { EPI_LANES
        EPI_FOR { EPI_RL const int tok = u.pm * 256 + rl;
#pragma unroll
            for (int bj = 0; bj < 2; ++bj) { const int col = 256 * u.pn + 64 * wc + 32 * bj + 8 * fq;
                f32x4 ga, gb; unpack8(*(const u32x4*)(G + (size_t)tok * 4096 + 2048 + col), ga, gb);
                *(u32x4*)(MG + (size_t)tok * 2048 + col) = pack8(acc[ai][bj][m][0] * ga, acc[ai][bj][m][1] * gb); } }
    }
};
struct EpiOutProj {
    static constexpr bool HAS_MID = false;
    const bf16_t* XR; bf16_t* XO;
    __device__ __forceinline__ void operator()(const pg::Acc& acc, const pg::Unit& u, int, int, int, int) const { EPI_LANES
        EPI_FOR { EPI_RL const int tok = u.pm * 256 + rl;
#pragma unroll
            for (int bj = 0; bj < 2; ++bj) { const size_t o = (size_t)tok * 2048 + 256 * u.pn + 64 * wc + 32 * bj + 8 * fq;
                f32x4 a, b; unpack8(*(const u32x4*)(XR + o), a, b);
                *(u32x4*)(XO + o) = pack8(a + acc[ai][bj][m][0], b + acc[ai][bj][m][1]); } }
    }
};
struct EpiExp1 {
    static constexpr bool HAS_MID = false;
    const float* RSL; bf16_t* H;
    __device__ __forceinline__ void operator()(const pg::Acc& acc, const pg::Unit& u, int, int, int, int) const { EPI_LANES
        EPI_FOR { EPI_RL const int row = u.grp * CAP + u.pm * 256 + rl; const float rs = RSL[row];
            f32x4 h[2];
#pragma unroll
            for (int n = 0; n < 2; ++n)
#pragma unroll
                for (int j = 0; j < 4; ++j) { const float g = acc[ai][0][m][n][j] * rs, up = acc[ai][1][m][n][j] * rs; h[n][j] = g * fast_sigmoid(g) * up; }
            *(u32x2*)((unsigned char*)H + (size_t)row * FF + 128 * u.pn + 32 * wc + 8 * fq) = pack8_fp8(h[0] * H8_SCALE, h[1] * H8_SCALE); }
    }
};
struct EpiExp2 {
    static constexpr bool HAS_MID = false;
    const float* GATE; bf16_t* YX;
    __device__ __forceinline__ void operator()(const pg::Acc& acc, const pg::Unit& u, int, int, int, int) const { EPI_LANES
        EPI_FOR { EPI_RL const int row = u.grp * CAP + u.pm * 256 + rl; const float gt = GATE[row];
#pragma unroll
            for (int bj = 0; bj < 2; ++bj)
                *(u32x4*)(YX + (size_t)row * D + 256 * u.pn + 64 * wc + 32 * bj + 8 * fq) = pack8(acc[ai][bj][m][0] * gt, acc[ai][bj][m][1] * gt); }
    }
};

namespace att {
constexpr int KVBLK = 64, QBLK = 32;
constexpr int SHM_T = KVBLK * 256;
constexpr int OFF_K = 0, OFF_V = 3 * SHM_T, OFF_Q = 5 * SHM_T, OFF_WS = OFF_Q + 8 * 8192, OFF_BT = OFF_WS + 8 * 64 * 4, ATT_LDS_END = OFF_BT + 2048;
#define KSWZ(row, colB) ((row) * 256 + ((colB) ^ (((row) & 7) << 4)))
#define SBAR() __builtin_amdgcn_sched_barrier(0)
__device__ __forceinline__ int crow(int r, int hi) { return (r & 3) + 8 * (r >> 2) + 4 * hi; }
__device__ __forceinline__ int v_rd_base(int lane) { return ((lane & 3) << 3) | (((lane >> 2) & 3) << 6) | (((lane >> 4) & 1) << 5) | (((lane >> 5) & 1) << 8); }
constexpr int v_rd_off(int d0, int ks, int half) { return d0 * 512 + ks * 4096 + half * 2048; }
template <int OFF> __device__ __forceinline__ s16x4 tr_read(int vb) { s16x4 r; asm volatile("ds_read_b64_tr_b16 %0, %1 offset:%2" : "=&v"(r) : "v"(vb), "i"(OFF) : "memory"); return r; }
template <int D0> __device__ __forceinline__ void pv_one(f32x16& od, int vb, bf16x8 pa0, bf16x8 pa1, bf16x8 pa2, bf16x8 pa3) {
    const s16x4 l0 = tr_read<v_rd_off(D0, 0, 0)>(vb), h0 = tr_read<v_rd_off(D0, 0, 1)>(vb), l1 = tr_read<v_rd_off(D0, 1, 0)>(vb), h1 = tr_read<v_rd_off(D0, 1, 1)>(vb);
    const s16x4 l2 = tr_read<v_rd_off(D0, 2, 0)>(vb), h2 = tr_read<v_rd_off(D0, 2, 1)>(vb), l3 = tr_read<v_rd_off(D0, 3, 0)>(vb), h3 = tr_read<v_rd_off(D0, 3, 1)>(vb);
    asm volatile("s_waitcnt lgkmcnt(0)" ::: "memory"); SBAR();
#define PK(L, H) (bf16x8){L[0], L[1], L[2], L[3], H[0], H[1], H[2], H[3]}
    od = __builtin_amdgcn_mfma_f32_32x32x16_bf16(pa0, PK(l0, h0), od, 0, 0, 0);
    od = __builtin_amdgcn_mfma_f32_32x32x16_bf16(pa1, PK(l1, h1), od, 0, 0, 0);
    od = __builtin_amdgcn_mfma_f32_32x32x16_bf16(pa2, PK(l2, h2), od, 0, 0, 0);
    od = __builtin_amdgcn_mfma_f32_32x32x16_bf16(pa3, PK(l3, h3), od, 0, 0, 0);
#undef PK
}
__device__ __forceinline__ void pv_d0(f32x16* o, int vb, bf16x8 pa0, bf16x8 pa1, bf16x8 pa2, bf16x8 pa3) {
    pv_one<0>(o[0], vb, pa0, pa1, pa2, pa3); pv_one<1>(o[1], vb, pa0, pa1, pa2, pa3); pv_one<2>(o[2], vb, pa0, pa1, pa2, pa3); pv_one<3>(o[3], vb, pa0, pa1, pa2, pa3);
}
__device__ __forceinline__ int kq_addr(int row, int c) { return (c >> 2) * 4096 + row * 64 + (((c & 3) ^ ((row >> 2) & 3)) << 4); }
template <int COMP> __device__ __forceinline__ void qkt(f32x16& p0, f32x16& p1, const LAS char* Ks, const LAS char* Qs, int kq0, int kq1) {
    p0 = (f32x16){}; p1 = (f32x16){};
#pragma unroll
    for (int d0 = 0; d0 < 4; ++d0) { const int chi = COMP * 2 + (d0 >> 1); const int a = (d0 & 1) ? kq1 : kq0;
        const bf16x8 b0 = *(const LAS bf16x8*)(Ks + a + chi * 4096);
        const bf16x8 b1 = *(const LAS bf16x8*)(Ks + a + chi * 4096 + 2048);
        const bf16x8 qf = *(const LAS bf16x8*)(Qs + a + chi * 2048);
        p0 = __builtin_amdgcn_mfma_f32_32x32x16_bf16(b0, qf, p0, 0, 0, 0);
        p1 = __builtin_amdgcn_mfma_f32_32x32x16_bf16(b1, qf, p1, 0, 0, 0); }
}
__device__ __forceinline__ void sm_exp(f32x16& p0, f32x16& p1, const LAS float* bt, int relb, int dq, int hi) {
    if (dq > -191 && dq < 158) {
        const LAS float* bp = bt + relb + 4 * hi;
#pragma unroll
        for (int a = 0; a < 4; ++a) {
            float t0[4], t1[4];
#pragma unroll
            for (int b = 0; b < 4; ++b) { t0[b] = bp[8 * a + b]; t1[b] = bp[32 + 8 * a + b]; }
#pragma unroll
            for (int b = 0; b < 4; ++b) { p0[4 * a + b] += t0[b]; p1[4 * a + b] += t1[b]; }
            SBAR();
        } }
#pragma unroll
    for (int r = 0; r < 16; ++r) p0[r] = __builtin_amdgcn_exp2f(p0[r]);
#pragma unroll
    for (int r = 0; r < 16; ++r) p1[r] = __builtin_amdgcn_exp2f(p1[r]);
}
__device__ __forceinline__ void sm_fin(f32x16& p0, f32x16& p1, float& l_reg, bf16x8& pa0, bf16x8& pa1, bf16x8& pa2, bf16x8& pa3) {
    float ps = 0;
#pragma unroll
    for (int r = 0; r < 16; ++r) ps += p0[r];
#pragma unroll
    for (int r = 0; r < 16; ++r) ps += p1[r];
    { auto rr = __builtin_amdgcn_permlane32_swap(__float_as_uint(ps), __float_as_uint(ps), false, false);
      ps = __uint_as_float(rr[0]) + __uint_as_float(rr[1]); }
    l_reg += ps;
#define PK4(P, BASE, OUT) do { unsigned a0 = cvt_pk_bf16(P[BASE + 0], P[BASE + 1]), a1 = cvt_pk_bf16(P[BASE + 2], P[BASE + 3]);   \
    unsigned b0 = cvt_pk_bf16(P[BASE + 4], P[BASE + 5]), b1 = cvt_pk_bf16(P[BASE + 6], P[BASE + 7]);                              \
    auto r0 = __builtin_amdgcn_permlane32_swap(a0, b0, false, false); auto r1 = __builtin_amdgcn_permlane32_swap(a1, b1, false, false); \
    u32x4 w = {r0[0], r1[0], r0[1], r1[1]}; OUT = *reinterpret_cast<bf16x8*>(&w); } while (0)
    PK4(p0, 0, pa0); PK4(p0, 8, pa1); PK4(p1, 0, pa2); PK4(p1, 8, pa3);
#undef PK4
}
__device__ __forceinline__ void attn_dual(f32x16 (&o1)[4], f32x16 (&o2)[4], const bf16_t* __restrict__ Qg, const bf16_t* __restrict__ Kh, const bf16_t* __restrict__ Vh, LAS char* lds, int q0w) {
    int tz_ = threadIdx.x; asm volatile("" : "+v"(tz_));
    const int tid = tz_, wid = __builtin_amdgcn_readfirstlane(tid >> 6), lane = tid & 63, r32 = lane & 31, hi = lane >> 5;
    LAS char* K_lds = lds + OFF_K; LAS char* V_lds = lds + OFF_V; LAS char* Qs = lds + OFF_Q + wid * 8192;
    LAS float* ws = (LAS float*)(lds + OFF_WS) + wid * 64; LAS float* li_l = ws;
    const LAS float* bt = (const LAS float*)(lds + OFF_BT);
    float l1 = 0.f, l2 = 0.f;
#pragma unroll
    for (int d = 0; d < 4; ++d) { o1[d] = (f32x16){}; o2[d] = (f32x16){}; }
#pragma unroll
    for (int i = 0; i < 8; ++i) { const int ci = i * 64 + lane, row = (ci >> 2) & 31, c = (ci >> 7) * 4 + ((ci & 3) ^ ((row >> 2) & 3));
        __builtin_amdgcn_global_load_lds((const unsigned*)(Qg + (size_t)row * 1024 + c * 8), (LAS unsigned*)(Qs + i * 1024), 16, 0, 0); }
    const int kq0 = r32 * 64 + ((hi ^ ((r32 >> 2) & 3)) << 4), kq1 = r32 * 64 + (((2 + hi) ^ ((r32 >> 2) & 3)) << 4);
    unsigned ko0, vo0;
    { const int p = wid * 2;
        { const int ci = p * 64 + lane, row = (ci >> 2) & 63, c = (ci >> 8) * 4 + ((ci & 3) ^ ((row >> 2) & 3)); ko0 = (unsigned)(row * 1024 + c * 8) * 2u; }
        { const int ci = p * 64 + lane, sub = ci >> 5, kk = (sub >> 2) * 8 + ((ci >> 2) & 7), c = (sub & 3) * 32 + (ci & 3) * 8;
          const int k = (kk & ~0xC) | ((kk & 4) << 1) | ((kk & 8) >> 1); vo0 = (unsigned)(k * 1024 + c) * 2u; } }
    const unsigned pw = (unsigned)wid * 2048u;
#define DMA_K(buf, k0) do { const char* g_ = (const char*)(Kh + (size_t)(k0) * 1024); \
    __builtin_amdgcn_global_load_lds((const unsigned*)(g_ + ko0), (LAS unsigned*)(K_lds + (buf) * SHM_T + pw), 16, 0, 0); \
    __builtin_amdgcn_global_load_lds((const unsigned*)(g_ + ko0 + 32768u), (LAS unsigned*)(K_lds + (buf) * SHM_T + pw + 1024), 16, 0, 0); } while (0)
#define DMA_V(buf, k0) do { const char* g_ = (const char*)(Vh + (size_t)(k0) * 1024); \
    __builtin_amdgcn_global_load_lds((const unsigned*)(g_ + vo0), (LAS unsigned*)(V_lds + (buf) * SHM_T + pw), 16, 0, 0); \
    __builtin_amdgcn_global_load_lds((const unsigned*)(g_ + vo0 + 128u), (LAS unsigned*)(V_lds + (buf) * SHM_T + pw + 1024), 16, 0, 0); } while (0)
    const int vbb = (int)(size_t)V_lds + v_rd_base(lane);
    const int relq = 256 - (q0w + r32);
    f32x16 pA0, pA1, pB0, pB1; bf16x8 pa0, pa1, pa2, pa3; constexpr int NT = S / KVBLK;
    DMA_K(0, 0); DMA_K(1, KVBLK); DMA_V(0, 0);
    asm volatile("s_waitcnt vmcnt(0) lgkmcnt(0)" ::: "memory"); __syncthreads();
    qkt<0>(pA0, pA1, K_lds, Qs, kq0, kq1); sm_exp(pA0, pA1, bt, relq, 0 - q0w, hi);
    int kb = 0, vb = 0;
    int ureg = (0 - q0w <= -191) ? 0 : ((0 - q0w >= 158) ? 2 : 1);
    for (int j = 0; j < NT; ++j) {
        asm volatile("s_waitcnt vmcnt(0)" ::: "memory"); __syncthreads();
        const int kb1 = kb == 2 ? 0 : kb + 1, kb2 = kb1 == 2 ? 0 : kb1 + 1;
        if (j + 2 < NT) DMA_K(kb2, (j + 2) * KVBLK);
        if (j + 1 < NT) DMA_V(vb ^ 1, (j + 1) * KVBLK);
        const int dq = j * KVBLK - q0w;
        { const int u = (dq <= -191) ? 0 : ((dq >= 158) ? 2 : 1);
          if (u != ureg) {
              const float cp = ureg == 0 ? bt[0] : (ureg == 2 ? bt[511] : 0.f), cn = u == 0 ? bt[0] : (u == 2 ? bt[511] : 0.f);
              const float f = __builtin_amdgcn_exp2f(cp - cn);
#pragma unroll
              for (int d = 0; d < 4; ++d) { o1[d] = o1[d] * f; o2[d] = o2[d] * f; }
              l1 *= f; l2 *= f; ureg = u; } }
        sm_fin(pA0, pA1, l1, pa0, pa1, pa2, pa3); SBAR();
        qkt<1>(pB0, pB1, K_lds + kb * SHM_T, Qs, kq0, kq1); SBAR();
        pv_d0(o1, vbb + vb * SHM_T, pa0, pa1, pa2, pa3);
        sm_exp(pB0, pB1, bt, relq + j * KVBLK, dq, hi);
        sm_fin(pB0, pB1, l2, pa0, pa1, pa2, pa3); SBAR();
        if (j + 1 < NT) { qkt<0>(pA0, pA1, K_lds + kb1 * SHM_T, Qs, kq0, kq1); SBAR(); }
        pv_d0(o2, vbb + vb * SHM_T, pa0, pa1, pa2, pa3);
        if (j + 1 < NT) sm_exp(pA0, pA1, bt, relq + (j + 1) * KVBLK, dq + KVBLK, hi);
        kb = kb1; vb ^= 1;
    }
    if (hi == 0) li_l[r32] = l1; asm volatile("s_waitcnt lgkmcnt(0)" ::: "memory");
#pragma unroll
    for (int r = 0; r < 16; ++r) { const float rl = __builtin_amdgcn_rcpf(li_l[crow(r, hi)]);
#pragma unroll
        for (int d = 0; d < 4; ++d) o1[d][r] *= rl; }
    asm volatile("s_waitcnt lgkmcnt(0)" ::: "memory");
    if (hi == 0) li_l[r32] = l2; asm volatile("s_waitcnt lgkmcnt(0)" ::: "memory");
#pragma unroll
    for (int r = 0; r < 16; ++r) { const float rl = __builtin_amdgcn_rcpf(li_l[crow(r, hi)]);
#pragma unroll
        for (int d = 0; d < 4; ++d) o2[d][r] *= rl; }
#undef DMA_K
#undef DMA_V
}
}

__device__ __forceinline__ int t5_bucket(int rel) {
    const int side = rel > 0 ? 16 : 0; const int n = rel < 0 ? -rel : rel;
    if (n < 8) return side + n;
    const float v = logf((float)n / 8.0f) / 2.7725887f * 8.0f;
    int large = 8 + (int)v; large = large < 15 ? large : 15;
    return side + large;
}

struct Args { GAS const float* in[28]; GAS float* out; GAS unsigned char* ws; int ph_lo, ph_hi; };
typedef const Args __attribute__((address_space(4))) CArgs;
struct LayerW { bf16_t *WIN, *WGLU, *WBR, *WOUT, *WGU, *WD, *F, *BO; float *KTAB, *WRT; };
__device__ __forceinline__ LayerW layer_w(unsigned char* ws, int l) {
    unsigned char* b = ws + WS_LW + (size_t)l * LW_SIZE; LayerW w;
    w.WIN = (bf16_t*)(b + LW_WIN); w.WGLU = (bf16_t*)(b + LW_WGLU); w.WBR = (bf16_t*)(b + LW_WBR); w.WOUT = (bf16_t*)(b + LW_WOUT); w.WGU = (bf16_t*)(b + LW_WGU);
    w.WD = (bf16_t*)(b + LW_WD); w.F = (bf16_t*)(b + LW_F); w.BO = (bf16_t*)(b + LW_BO); w.KTAB = (float*)(b + LW_KTAB); w.WRT = (float*)(b + LW_WRT); return w;
}
enum { I_X = 0, I_WIN, I_ARE, I_AIM, I_LDT, I_BRE, I_BIM, I_CRE, I_CIM, I_SD, I_WGLU, I_WSB, I_QG, I_KG, I_LQ1, I_LK1, I_LQ2, I_LK2, I_SUBLN, I_WAB, I_RELB, I_WOUT,
       I_NMIX, I_NFFN, I_WR, I_WEG, I_WEU, I_WED };

struct TItem { const float* src; bf16_t* dst; const float* gain; int N, ldd, rowmode, f8; };
__device__ __forceinline__ void t_load(const TItem& t, f32x4 (&v)[16], int lane) {
    const int r = lane >> 4, q = lane & 15;
#pragma unroll
    for (int j = 0; j < 16; ++j) v[j] = __builtin_nontemporal_load((const f32x4*)(t.src + (size_t)(4 * j + r) * t.N + 4 * q));
}
__device__ __forceinline__ void t_lds(const f32x4 (&v)[16], LAS float* scr, int lane) {
    const int r = lane >> 4, q = lane & 15;
#pragma unroll
    for (int j = 0; j < 16; ++j) { LAS float* s = scr + (4 * j + r) * 65 + 4 * q; s[0] = v[j][0]; s[1] = v[j][1]; s[2] = v[j][2]; s[3] = v[j][3]; }
}
__device__ __forceinline__ void t_store(const TItem& t, int n0, LAS float* scr, int lane) {
    const int c = lane & 7;
    float gn[8];
#pragma unroll
    for (int i = 0; i < 8; ++i) gn[i] = t.gain ? t.gain[8 * c + i] : 1.f;
#pragma unroll
    for (int j = 0; j < 8; ++j) { const int n = (lane >> 3) + 8 * j; const LAS float* s = scr + (8 * c) * 65 + n;
        u32x4 o; o.x = cvt_pk_bf16(s[0 * 65] * gn[0], s[1 * 65] * gn[1]); o.y = cvt_pk_bf16(s[2 * 65] * gn[2], s[3 * 65] * gn[3]);
        o.z = cvt_pk_bf16(s[4 * 65] * gn[4], s[5 * 65] * gn[5]); o.w = cvt_pk_bf16(s[6 * 65] * gn[6], s[7 * 65] * gn[7]);
        const int ng = n0 + n; const int drow = t.rowmode == 0 ? ng : ((ng >> 7) * 256 + ((ng >> 5) & 3) * 64 + (ng & 31) + (t.rowmode == 2 ? 32 : 0));
        if (t.f8) { const f32x4 a = (f32x4){s[0 * 65] * gn[0], s[1 * 65] * gn[1], s[2 * 65] * gn[2], s[3 * 65] * gn[3]} * W8_SCALE, b = (f32x4){s[4 * 65] * gn[4], s[5 * 65] * gn[5], s[6 * 65] * gn[6], s[7 * 65] * gn[7]} * W8_SCALE;
            *(u32x2*)((unsigned char*)t.dst + (size_t)drow * t.ldd + 8 * c) = pack8_fp8(a, b); }
        else *(u32x4*)(t.dst + (size_t)drow * t.ldd + 8 * c) = o; }
}

constexpr int IT_WIN = (D / 64) * (INC / 64), IT_GLU = 16 * 16, IT_BR = 16 * 32, IT_OUT = 32 * 32, IT_E = 32 * 32;
constexpr int IT_LAYER0 = IT_WIN + IT_GLU + 2 * IT_BR + IT_OUT + 2 * NE * IT_E;
constexpr int IT_DOWN = NE * IT_E;
__device__ __forceinline__ TItem make_item(const float* src, bf16_t* dst, const float* gain, int N, int ldd, int rowmode, int f8, int r, int& n0) {
    const int nblk = N / 64, k0 = 64 * (r / nblk); n0 = 64 * (r % nblk);
    TItem t; t.src = src + (size_t)k0 * N + n0; t.dst = f8 ? (bf16_t*)((unsigned char*)dst + k0) : dst + k0; t.gain = gain ? gain + k0 : nullptr; t.N = N; t.ldd = ldd; t.rowmode = rowmode; t.f8 = f8; return t; }
struct DecMain { CArgs* ap; unsigned char* ws;
    __device__ __forceinline__ TItem operator()(int it, int& n0) const { CArgs& args = *ap;
        const int l = it / IT_LAYER0; int r = it % IT_LAYER0; const LayerW w = layer_w(ws, l);
        if (r < IT_WIN) { const bool gate = (r % (INC / 64)) >= 64;
            return gate ? make_item((const float*)args.in[I_WIN] + (size_t)l * D * INC, (bf16_t*)((unsigned char*)w.WIN + (size_t)16 * MiB - (size_t)4096 * D), (const float*)args.in[I_NMIX] + l * D, INC, D, 0, 1, r, n0)
                        : make_item((const float*)args.in[I_WIN] + (size_t)l * D * INC, w.WIN, (const float*)args.in[I_NMIX] + l * D, INC, D, 0, 0, r, n0); }
        if ((r -= IT_WIN) < IT_GLU) return make_item((const float*)args.in[I_WGLU] + (size_t)l * SSMW * SSMW, w.WGLU, nullptr, SSMW, SSMW, 0, 0, r, n0);
        if ((r -= IT_GLU) < IT_BR) return make_item((const float*)args.in[I_WSB] + (size_t)l * SSMW * D, w.WBR, nullptr, D, 2048, 0, 0, r, n0);
        if ((r -= IT_BR) < IT_BR) return make_item((const float*)args.in[I_WAB] + (size_t)l * 1024 * D, w.WBR + 1024, nullptr, D, 2048, 0, 0, r, n0);
        if ((r -= IT_BR) < IT_OUT) return make_item((const float*)args.in[I_WOUT] + (size_t)l * D * D, w.WOUT, nullptr, D, D, 0, 0, r, n0);
        r -= IT_OUT; const int which = r / (NE * IT_E), e = (r / IT_E) % NE; r = r % IT_E; const size_t eo = ((size_t)l * NE + e) * D * FF;
        return make_item((const float*)args.in[which == 0 ? I_WEG : I_WEU] + eo, (bf16_t*)((unsigned char*)w.WGU + (size_t)e * 4096 * D), (const float*)args.in[I_NFFN] + l * D, FF, D, which == 0 ? 1 : 2, 1, r, n0); } };
struct DecDown { CArgs* ap; unsigned char* ws; int l;
    __device__ __forceinline__ TItem operator()(int it, int& n0) const { CArgs& args = *ap; const LayerW w = layer_w(ws, l);
        const int e = it / IT_E, r = it % IT_E; const size_t eo = ((size_t)l * NE + e) * D * FF;
        return make_item((const float*)args.in[I_WED] + eo, (bf16_t*)((unsigned char*)w.WD + (size_t)e * D * FF), nullptr, D, FF, 0, 1, r, n0); } };
template <class Dec> __device__ __forceinline__ void convert_items(const Dec& dec, int first, int end, int step, LAS float* scr, int lane) {
    f32x4 tv[16]; int n0c = 0, n0n = 0; TItem cur, nxt; cur.src = nullptr; cur.dst = nullptr; cur.gain = nullptr; cur.N = 0; cur.ldd = 0; cur.rowmode = 0; cur.f8 = 0; nxt = cur;
    int it = first;
    if (it < end) { cur = dec(it, n0c); t_load(cur, tv, lane); }
    for (; it < end; it += step) {
        t_lds(tv, scr, lane);
        if (it + step < end) { nxt = dec(it + step, n0n); t_load(nxt, tv, lane); }
        LDS_WAIT(); asm volatile("" ::: "memory");
        t_store(cur, n0c, scr, lane);
        LDS_WAIT(); asm volatile("" ::: "memory");
        cur = nxt; n0c = n0n; }
}

template <bool ROUTER>
__device__ __forceinline__ void row_pass(const float* xrow, bf16_t* xb, float* rinv_out, const LAS float* WtL, float* afft, int row, int lane, unsigned char* xb8 = nullptr) {
    f32x4 v[8]; float ss = 0.f;
#pragma unroll
    for (int j = 0; j < 8; ++j) { v[j] = *(const f32x4*)(xrow + 4 * lane + 256 * j); ss += v[j][0] * v[j][0] + v[j][1] * v[j][1] + v[j][2] * v[j][2] + v[j][3] * v[j][3]; }
    ss = wave_sum(ss);
    const float rinv = __builtin_amdgcn_rsqf(ss * (1.f / D) + EPS);
#pragma unroll
    for (int j = 0; j < 8; ++j) { u32x2 w; w.x = cvt_pk_bf16(v[j][0], v[j][1]); w.y = cvt_pk_bf16(v[j][2], v[j][3]); *(u32x2*)(xb + 4 * lane + 256 * j) = w; }
    if (xb8) {
#pragma unroll
        for (int j = 0; j < 8; ++j) { int w8 = 0; w8 = __builtin_amdgcn_cvt_pk_fp8_f32(v[j][0], v[j][1], w8, false); w8 = __builtin_amdgcn_cvt_pk_fp8_f32(v[j][2], v[j][3], w8, true); *(int*)(xb8 + 4 * lane + 256 * j) = w8; } }
    if (lane == 0) *rinv_out = rinv;
    if constexpr (ROUTER) {
        float lg[16];
#pragma unroll
        for (int e = 0; e < 16; ++e) { float a = 0.f;
#pragma unroll
            for (int j = 0; j < 8; ++j) { const f32x4 w = *(const LAS f32x4*)(WtL + e * 2048 + 4 * lane + 256 * j); a += v[j][0] * w[0] + v[j][1] * w[1] + v[j][2] * w[2] + v[j][3] * w[3]; }
            lg[e] = wave_sum(a) * rinv; }
        float mx = lg[0];
#pragma unroll
        for (int e = 1; e < 16; ++e) mx = fmaxf(mx, lg[e]);
        float sum = 0.f;
#pragma unroll
        for (int e = 0; e < 16; ++e) { lg[e] = __expf(lg[e] - mx); sum += lg[e]; }
        const float inv = 1.f / sum;
        float mine = 0.f;
#pragma unroll
        for (int e = 0; e < 16; ++e) mine = (lane == e) ? lg[e] * inv : mine;
        if (lane < 16) afft[(size_t)lane * S + row] = mine;
    }
}

__device__ __forceinline__ void router_row(const bf16_t* xrow, float* rinv_out, const LAS float* WtL, float* afft, int row, int lane) {
    f32x4 v[8]; float ss = 0.f;
#pragma unroll
    for (int j = 0; j < 8; ++j) { const u32x2 w = *(const u32x2*)(xrow + 4 * lane + 256 * j); v[j] = (f32x4){bf_lo(w.x), bf_hi(w.x), bf_lo(w.y), bf_hi(w.y)}; ss += v[j][0] * v[j][0] + v[j][1] * v[j][1] + v[j][2] * v[j][2] + v[j][3] * v[j][3]; }
    ss = wave_sum(ss);
    const float rinv = __builtin_amdgcn_rsqf(ss * (1.f / D) + EPS);
    if (lane == 0) *rinv_out = rinv;
    float lg[16];
#pragma unroll
    for (int e = 0; e < 16; ++e) { float a = 0.f;
#pragma unroll
        for (int j = 0; j < 8; ++j) { const f32x4 w = *(const LAS f32x4*)(WtL + e * 2048 + 4 * lane + 256 * j); a += v[j][0] * w[0] + v[j][1] * w[1] + v[j][2] * w[2] + v[j][3] * w[3]; }
        lg[e] = wave_sum(a) * rinv; }
    float mx = lg[0];
#pragma unroll
    for (int e = 1; e < 16; ++e) mx = fmaxf(mx, lg[e]);
    float sum = 0.f;
#pragma unroll
    for (int e = 0; e < 16; ++e) { lg[e] = __expf(lg[e] - mx); sum += lg[e]; }
    const float inv = 1.f / sum;
    float mine = 0.f;
#pragma unroll
    for (int e = 0; e < 16; ++e) mine = (lane == e) ? lg[e] * inv : mine;
    if (lane < 16) afft[(size_t)lane * S + row] = mine;
}
__device__ __forceinline__ int block_sum_i(int v, LAS int* red, int wave, int lane) {
#pragma unroll
    for (int o = 1; o < 64; o <<= 1) v += __shfl_xor(v, o);
    __syncthreads();
    if (lane == 0) red[wave] = v;
    __syncthreads();
    int t = 0;
#pragma unroll
    for (int w = 0; w < 8; ++w) t += red[w];
    return t;
}

__global__ void __launch_bounds__(512, 2) fwd(Args kargs) {
    extern __shared__ __attribute__((aligned(16))) unsigned char lds_raw[];
    LAS unsigned char* lds = (LAS unsigned char*)lds_raw;
    volatile LAS unsigned* MISC = (volatile LAS unsigned*)(lds + MISC_OFF);
    const int G = gridDim.x;
    unsigned* ctl = (unsigned*)((unsigned char*)kargs.ws + WS_CTL);
    if (threadIdx.x < 64) MISC[threadIdx.x] = 0u;
    __syncthreads();
    XcdBarrier bar; bar.bar = ctl + 1024; bar.x = 0; bar.st = nullptr;
    if (!MK_PER_PHASE) bar = xcd_barrier_post(ctl + 1024, MISC + 8);
    const int lo = kargs.ph_lo, hi = kargs.ph_hi;
#ifndef PH_MASK
#define PH_MASK 0xFFFF
#endif
#define PON(b) ((PH_MASK >> (b)) & 1)
#ifndef REP_MASK
#define REP_MASK 0
#endif
#define REPS(b) (((REP_MASK >> (b)) & 1) ? 2 : 1)
#define IN(k) (lo <= (k) && (k) < hi)
#define PH_ENTER int tz0_ = threadIdx.x; asm volatile("" : "+v"(tz0_)); int bz0_ = blockIdx.x; asm volatile("" : "+s"(bz0_)); \
    const int tid = tz0_, lane = tid & 63, wave = __builtin_amdgcn_readfirstlane(tid >> 6), bx = bz0_, vcu = (G % 8 == 0) ? (bx % 8) * (G / 8) + bx / 8 : bx, gw = vcu * 8 + wave, NGW = G * 8; \
    (void)lane; (void)wave; (void)bx; (void)vcu; (void)gw; (void)NGW; \
      \
    CArgs* ap_ = (CArgs*)__builtin_amdgcn_kernarg_segment_ptr(); asm volatile("" : "+s"(ap_)); CArgs& args = *ap_; \
    unsigned char* const ws = (unsigned char*)args.ws; unsigned char* const act = ws + WS_ACT; unsigned char* const sm = act + A_SMALL; (void)sm; \
    bf16_t* const XB = (bf16_t*)(act + A_XB); unsigned char* const XB8 = act + A_O1; (void)XB8; bf16_t* const XB1 = (bf16_t*)(act + A_XB1); bf16_t* const UA = (bf16_t*)(act + A_UA); \
    bf16_t* const Qb = (bf16_t*)(act + A_Q); bf16_t* const Kb = (bf16_t*)(act + A_K); bf16_t* const Vb = (bf16_t*)(act + A_V); bf16_t* const Gb = (bf16_t*)(act + A_G); \
    float* const SSUM = (float*)(act + A_SSUM); bf16_t* const Yb = (bf16_t*)(act + A_Y); bf16_t* const YO = (bf16_t*)(act + A_YO); \
    bf16_t* const MG = (bf16_t*)(act + A_MG); float* const XA = (float*)(act + A_XA); bf16_t* const XG = (bf16_t*)(act + A_XG); bf16_t* const Hb = (bf16_t*)(act + A_H); bf16_t* const YX = (bf16_t*)(act + A_YX); \
    float* const RINV = (float*)(sm + SM_RINV); float* const RINV2 = (float*)(sm + SM_RINV2); float* const AFFT = (float*)(sm + SM_AFFT); int* const IDX = (int*)(sm + SM_IDX); \
    float* const GATE = (float*)(sm + SM_GATE); float* const RSL = (float*)(sm + SM_RSL); int* const INV = (int*)(sm + SM_INV); float* const LAMS = (float*)(sm + SM_LAM); \
    (void)XB; (void)XB1; (void)UA; (void)Qb; (void)Kb; (void)Vb; (void)Gb; (void)SSUM; (void)Yb; (void)YO; (void)MG; (void)XA; (void)XG; (void)Hb; (void)YX; \
    (void)RINV; (void)RINV2; (void)AFFT; (void)IDX; (void)GATE; (void)RSL; (void)INV; (void)LAMS;
#define INP(i) ((const float*)args.in[i])
#define OUTP ((float*)args.out)
#define LAYER_ENTER const LayerW w = layer_w(ws, l); const float lam_init = (l == 0) ? 0.2f : 0.35550906759f;   \
    (void)w; (void)lam_init;
#define SEAM(k) do { if (IN(k) && IN((k) + 1)) { if (!MK_PER_PHASE) xcd_barrier(bar); } } while (0)

    if (PON(0) && IN(0)) _Pragma("nounroll") for (int rep_ = 0; rep_ < REPS(0); ++rep_) { PH_ENTER
        LAS float* scr = (LAS float*)(lds + wave * 16640);
        convert_items(DecMain{ap_, ws}, gw, NL * IT_LAYER0, NGW, scr, lane);
        for (int i = gw * 64 + lane; i < NL * NE * D; i += NGW * 64) { const int l = i / (NE * D), e = (i / D) % NE, k = i % D;
            layer_w(ws, l).WRT[e * D + k] = INP(I_NFFN)[l * D + k] * INP(I_WR)[((size_t)l * D + k) * NE + e]; }
        for (int it = gw; it < NL * NGRP * 2 * TC; it += NGW) {
            const int l = it / (NGRP * 2 * TC), g = (it / (2 * TC)) % NGRP, dir = (it / TC) % 2, dl = it % TC;
            const size_t pb = ((size_t)(l * 2 + dir) * NGRP + g);
            const float are = INP(I_ARE)[pb * NST + lane], aim = INP(I_AIM)[pb * NST + lane], dt = expf(INP(I_LDT)[pb]);
            const float mag1 = expf(are * dt), ang1 = aim * dt, b1r = mag1 * cosf(ang1), b1i = mag1 * sinf(ang1);
            const float nr = b1r - 1.f, ni = b1i, den = are * are + aim * aim;
            const float cr = (nr * are + ni * aim) / den, ci = (ni * are - nr * aim) / den;
            const float magd = expf(are * dt * (float)dl), angd = aim * dt * (float)dl, pr = magd * cosf(angd), pi = magd * sinf(angd);
            const float wre = pr * cr - pi * ci, wim = pr * ci + pi * cr;
            const int p = lane >> 2, q0 = (lane & 3) * 4;
            const float* cre = INP(I_CRE) + (pb * GP + p) * NST; const float* cim = INP(I_CIM) + (pb * GP + p) * NST;
            const float* bre = INP(I_BRE) + pb * NST * GP + q0; const float* bim = INP(I_BIM) + pb * NST * GP + q0;
            f32x4 out = {0.f, 0.f, 0.f, 0.f};
            for (int n = 0; n < NST; ++n) {
                const float wr_ = __shfl(wre, n), wi_ = __shfl(wim, n);
                const float c_r = cre[n], c_i = cim[n];
                const float er = c_r * wr_ - c_i * wi_, ei = c_r * wi_ + c_i * wr_;
                const f32x4 br = *(const f32x4*)(bre + n * GP), bi = *(const f32x4*)(bim + n * GP);
                out += br * er - bi * ei;
            }
            *(f32x4*)(layer_w(ws, l).KTAB + ((((size_t)g * 2 + dir) * TC + dl) * GP + p) * GP + q0) = out;
        }
        for (int it = gw; it < NL * NGRP * 2 * TC; it += NGW) {
            const int l = it / (NGRP * 2 * TC), g = (it / (2 * TC)) % NGRP, dir = (it / TC) % 2, t = it % TC;
            const LayerW w = layer_w(ws, l);
            const size_t pb = ((size_t)(l * 2 + dir) * NGRP + g);
            const float are = INP(I_ARE)[pb * NST + lane], aim = INP(I_AIM)[pb * NST + lane], dt = expf(INP(I_LDT)[pb]);
            { const float e = dir == 0 ? (float)(t + 1) : (float)(TC - t); const float mg = expf(are * dt * e), an = aim * dt * e, pr = mg * cosf(an), pi = mg * sinf(an);
              float crv[GP], civ[GP];
#pragma unroll
              for (int p = 0; p < GP; ++p) { crv[p] = INP(I_CRE)[(pb * GP + p) * NST + lane]; civ[p] = INP(I_CIM)[(pb * GP + p) * NST + lane]; }
#pragma unroll
              for (int p = 0; p < GP; ++p) { bf16_t* o = w.BO + ((size_t)g * 512 + t * 16 + p) * UAW + 512 + dir * 128 + lane;
                  o[0] = f2bf(crv[p] * pr - civ[p] * pi); o[64] = f2bf(-(crv[p] * pi + civ[p] * pr)); } }
            { const float mag1 = expf(are * dt), ang1 = aim * dt, b1r = mag1 * cosf(ang1), b1i = mag1 * sinf(ang1);
              const float nr = b1r - 1.f, ni = b1i, den = are * are + aim * aim;
              const float cr = (nr * are + ni * aim) / den, ci = (ni * are - nr * aim) / den;
              const float e = dir == 0 ? (float)(TC - 1 - t) : (float)t; const float mg = expf(are * dt * e), an = aim * dt * e, pr = mg * cosf(an), pi = mg * sinf(an);
              const float wre = pr * cr - pi * ci, wim = pr * ci + pi * cr;
              const float* bre = INP(I_BRE) + (pb * NST + lane) * GP; const float* bim = INP(I_BIM) + (pb * NST + lane) * GP;
              f32x4 re[4], im[4];
#pragma unroll
              for (int q = 0; q < 4; ++q) { const f32x4 br = *(const f32x4*)(bre + 4 * q), bi = *(const f32x4*)(bim + 4 * q); re[q] = br * wre - bi * wim; im[q] = bi * wre + br * wim; }
              bf16_t* o = w.F + ((size_t)g * 256 + dir * 128 + lane) * 512 + t * 16;
              *(u32x4*)o = pack8(re[0], re[1]); *(u32x4*)(o + 8) = pack8(re[2], re[3]);
              *(u32x4*)(o + 64 * 512) = pack8(im[0], im[1]); *(u32x4*)(o + 64 * 512 + 8) = pack8(im[2], im[3]); }
        }
        for (int m = gw; m < S; m += NGW) row_pass<false>(INP(I_X) + (size_t)m * D, XB + (size_t)m * D, RINV + m, nullptr, nullptr, m, lane, XB8 + (size_t)m * D);
        if (gw < NL) { const int l = gw; const float a = wave_sum(INP(I_LQ1)[l * QKD + lane] * INP(I_LK1)[l * QKD + lane]);
            const float b = wave_sum(INP(I_LQ2)[l * QKD + lane] * INP(I_LK2)[l * QKD + lane]);
            if (lane == 0) LAMS[l] = expf(a) - expf(b) + ((l == 0) ? 0.2f : 0.35550906759f); }
        for (int i = gw * 64 + lane; i < NH * 512; i += NGW * 64) { const int h = i >> 9, rel = (i & 511) - 256;
            ((float*)(sm + SM_BTAB))[i] = INP(I_RELB)[t5_bucket(rel) * NH + h] * LOG2E; }
    }
    SEAM(0);

    for (int l = 0; l < NL; ++l) {
        const int pbase = 2 + l * 14;
        if (PON(2) && IN(pbase + 0)) _Pragma("nounroll") for (int rep_ = 0; rep_ < REPS(2); ++rep_) { PH_ENTER LAYER_ENTER
            { pg::SchedGrid Sg; Sg.init(XB, D, w.WIN, D, S, 4096, G, bx);
              EpiInProj E{RINV, UA, Qb, Kb, Vb, Gb, INP(I_QG) + l * QKD, INP(I_KG) + l * QKD};
              pg::gemm_phase(lds, D, D, D, Sg, E); }
            { pg::SchedGrid Sg; Sg.init(XB8, D, (unsigned char*)w.WIN + (size_t)16 * MiB, D, S, 4096, G, bx, 1);
              EpiGates E{RINV, Gb};
              pg::gemm_phase<EpiGates, pg::SchedGrid, true, E8_ONE, E8_W>(lds, D, D, D, Sg, E); }
        }
        SEAM(pbase + 0);
        if (PON(3) && IN(pbase + 1)) _Pragma("nounroll") for (int rep_ = 0; rep_ < REPS(3); ++rep_) { PH_ENTER LAYER_ENTER
            pg::SchedGroup Sg; Sg.init(UA, UAW, (size_t)NCH * UAW * 2, w.F, 512, (size_t)256 * 512 * 2, 1, 1, NGRP, G, vcu);
            EpiSsum E{SSUM};
            pg::gemm_phase(lds, 512, UAW, 512, Sg, E);
            if (vcu >= NGRP) convert_items(DecDown{ap_, ws, l}, (vcu - NGRP) * 8 + wave, 4096, (G - NGRP) * 8, (LAS float*)(lds + wave * 16640), lane);
            if (vcu >= NGRP) for (long i = (long)((vcu - NGRP) * 8 + wave) * 64 + lane; i < (long)NGRP * 512 * 64; i += (long)(G - NGRP) * 8 * 64) {
            const int l2 = l, g = (int)(i / (512 * 64)) % NGRP, rr = (int)(i / 64) % 512, kc = (int)(i % 64);
            const int t = rr >> 4, p = rr & 15, tau = kc >> 1, q0 = (kc & 1) * 8;
            const LayerW w2 = layer_w(ws, l2);
            const float* kf = w2.KTAB + (((size_t)g * 2 + 0) * TC) * 256; const float* kb = w2.KTAB + (((size_t)g * 2 + 1) * TC) * 256;
            f32x4 a, b;
            if (tau < t) { const float* s = kf + ((t - tau) * GP + p) * GP + q0; a = *(const f32x4*)s; b = *(const f32x4*)(s + 4); }
            else if (tau > t) { const float* s = kb + ((tau - t) * GP + p) * GP + q0; a = *(const f32x4*)s; b = *(const f32x4*)(s + 4); }
            else { const float* s = kf + p * GP + q0; const float* s2 = kb + p * GP + q0; a = *(const f32x4*)s + *(const f32x4*)s2; b = *(const f32x4*)(s + 4) + *(const f32x4*)(s2 + 4);
                const float dd = INP(I_SD)[l2 * SSMW + g * GP + p];
#pragma unroll
                for (int j = 0; j < 4; ++j) { if (q0 + j == p) a[j] += dd; if (q0 + 4 + j == p) b[j] += dd; } }
            *(u32x4*)(w2.BO + ((size_t)g * 512 + rr) * UAW + tau * 16 + q0) = pack8(a, b);
        }
            if (vcu < NGRP && wave < 2) {
                const int g = vcu, dir = wave; const size_t pb = ((size_t)(l * 2 + dir) * NGRP + g);
                const float are = INP(I_ARE)[pb * NST + lane], aim = INP(I_AIM)[pb * NST + lane], dt = expf(INP(I_LDT)[pb]);
                const float mg = expf(are * dt * (float)TC), an = aim * dt * (float)TC, ar = mg * cosf(an), ai = mg * sinf(an);
                float sr = 0.f, si = 0.f;
                for (int cb = 0; cb < NCH; cb += 8) {
                    float xr[8], xi[8];
#pragma unroll
                    for (int k = 0; k < 8; ++k) { const int c = dir == 0 ? cb + k : NCH - 1 - cb - k; const float* s = SSUM + ((size_t)g * NCH + c) * 256 + dir * 128 + lane; xr[k] = s[0]; xi[k] = s[64]; }
#pragma unroll
                    for (int k = 0; k < 8; ++k) { const int c = dir == 0 ? cb + k : NCH - 1 - cb - k;
                        bf16_t* o = UA + ((size_t)g * NCH + c) * UAW + 512 + dir * 128 + lane; o[0] = f2bf(sr); o[64] = f2bf(si);
                        const float nr = ar * sr - ai * si + xr[k], ni = ar * si + ai * sr + xi[k]; sr = nr; si = ni; }
                }
            }
        }
        SEAM(pbase + 1);
        if (PON(5) && IN(pbase + 3)) _Pragma("nounroll") for (int rep_ = 0; rep_ < REPS(5); ++rep_) { PH_ENTER LAYER_ENTER
            pg::SchedGroup Sg; Sg.init(UA, UAW, (size_t)NCH * UAW * 2, w.BO, UAW, (size_t)512 * UAW * 2, 1, 2, NGRP, G, vcu);
            EpiSsmOut E{Yb};
            pg::gemm_phase(lds, UAW, UAW, UAW, Sg, E);
            if (vcu >= 2 * NGRP) convert_items(DecDown{ap_, ws, l}, 4096 + (vcu - 2 * NGRP) * 8 + wave, 10240, (G - 2 * NGRP) * 8, (LAS float*)(lds + wave * 16640), lane);
        }
        SEAM(pbase + 3);
        if (PON(6) && IN(pbase + 4)) _Pragma("nounroll") for (int rep_ = 0; rep_ < REPS(6); ++rep_) { PH_ENTER LAYER_ENTER
            pg::SchedGrid Sg; Sg.init(Yb, SSMW, w.WGLU, SSMW, S, SSMW, G, bx);
            EpiGlu E{Yb, YO};
            pg::gemm_phase(lds, SSMW, SSMW, SSMW, Sg, E);
            if (bx >= 128) convert_items(DecDown{ap_, ws, l}, 10240 + (bx - 128) * 8 + wave, IT_DOWN, (G - 128) * 8, (LAS float*)(lds + wave * 16640), lane);
        }
        SEAM(pbase + 4);
        if (PON(7) && IN(pbase + 5)) _Pragma("nounroll") for (int rep_ = 0; rep_ < REPS(7); ++rep_) { PH_ENTER LAYER_ENTER
            for (int un = vcu; un < NH * (S / 256); un += G) {
                const int h = un / (S / 256), qb = un % (S / 256);
                __syncthreads();
                { int tb = threadIdx.x; asm volatile("" : "+v"(tb)); ((LAS float*)(lds + att::OFF_BT))[tb] = ((const float*)(sm + SM_BTAB))[h * 512 + tb]; }
                const int q0w = qb * 256 + wave * 32;
                f32x16 o[4];
                { f32x16 o2[4];
                  att::attn_dual(o, o2, Qb + (size_t)q0w * 1024 + h * 128, Kb + h * 128, Vb + h * 128, (LAS char*)lds, q0w);
                  const float lam = LAMS[l];
#pragma unroll
                  for (int d = 0; d < 4; ++d) o[d] = o[d] - o2[d] * lam; }
                { int tz = threadIdx.x; asm volatile("" : "+v"(tz)); const int r32 = tz & 31, hi2 = (tz >> 5) & 1;
                  float ssq[16];
#pragma unroll
                  for (int r = 0; r < 16; ++r) { float s = 0.f;
#pragma unroll
                    for (int d = 0; d < 4; ++d) s += o[d][r] * o[d][r];
                    s += swz_xor<1>(s); s += swz_xor<2>(s); s += swz_xor<4>(s); s += swz_xor<8>(s); s += swz_xor<16>(s);
                    ssq[r] = __builtin_amdgcn_rsqf(s * (1.f / VD) + EPS) * (1.f - lam_init); }
                  bf16_t* yo = YO + (size_t)(q0w + 4 * hi2) * 2048 + 1024 + h * 128 + r32;
#pragma unroll
                  for (int d = 0; d < 4; ++d) { const float gn = INP(I_SUBLN)[l * VD + d * 32 + r32];
#pragma unroll
                    for (int r = 0; r < 16; ++r) yo[(size_t)((r & 3) + 8 * (r >> 2)) * 2048 + d * 32] = f2bf(o[d][r] * ssq[r] * gn); } }
            }
            __syncthreads();
        }
        SEAM(pbase + 5);
        if (PON(8) && IN(pbase + 6)) _Pragma("nounroll") for (int rep_ = 0; rep_ < REPS(8); ++rep_) { PH_ENTER LAYER_ENTER
            pg::SchedGrid Sg; Sg.init(YO, 2048, w.WBR, 2048, S, D, G, bx);
            EpiMerge E{Gb, MG};
            pg::gemm_phase(lds, 2048, 2048, 2048, Sg, E);
        }
        SEAM(pbase + 6);
        if (PON(9) && IN(pbase + 7)) _Pragma("nounroll") for (int rep_ = 0; rep_ < REPS(9); ++rep_) { PH_ENTER LAYER_ENTER
            pg::SchedGrid Sg; Sg.init(MG, D, w.WOUT, D, S, D, G, bx);
            EpiOutProj E{XB, XB1};
            pg::gemm_phase(lds, D, D, D, Sg, E);
        }
        SEAM(pbase + 7);
        if (PON(10) && IN(pbase + 8)) _Pragma("nounroll") for (int rep_ = 0; rep_ < REPS(10); ++rep_) { PH_ENTER LAYER_ENTER
            LAS float* WtL = (LAS float*)lds;
            for (int i = tid; i < NE * D / 4; i += 512) ((LAS f32x4*)WtL)[i] = ((const f32x4*)w.WRT)[i];
            __syncthreads();
            for (int m = gw; m < S; m += NGW) { int lz = lane; asm volatile("" : "+v"(lz));
                router_row(XB1 + (size_t)m * D, RINV2 + m, WtL, AFFT, m, lz); }
            __syncthreads();
        }
        SEAM(pbase + 8);
        if (PON(11) && IN(pbase + 9)) _Pragma("nounroll") for (int rep_ = 0; rep_ < REPS(11); ++rep_) { PH_ENTER LAYER_ENTER
            const int nparts = G / NE > 0 ? G / NE : 1;
            if (vcu < nparts * NE) {
                const int e = vcu / nparts, part = vcu % nparts, per = (CAP + nparts - 1) / nparts, slo = part * per, shi = (slo + per < CAP) ? slo + per : CAP;
                LAS int* red = (LAS int*)lds; LAS int* list = (LAS int*)(lds + 1024);
                unsigned bits[16]; { const float* a = AFFT + (size_t)e * S + tid * 16;
#pragma unroll
                    for (int q = 0; q < 4; ++q) { const f32x4 v = *(const f32x4*)(a + 4 * q); bits[4 * q] = __float_as_uint(v[0]); bits[4 * q + 1] = __float_as_uint(v[1]); bits[4 * q + 2] = __float_as_uint(v[2]); bits[4 * q + 3] = __float_as_uint(v[3]); } }
                unsigned T = 0u;
                for (int bit = 30; bit >= 0; --bit) { const unsigned cand = T | (1u << bit); int c = 0;
#pragma unroll
                    for (int i = 0; i < 16; ++i) c += bits[i] >= cand ? 1 : 0;
                    if (block_sum_i(c, red, wave, lane) >= CAP) T = cand; }
                int cg = 0, ce = 0;
#pragma unroll
                for (int i = 0; i < 16; ++i) { cg += bits[i] > T ? 1 : 0; ce += bits[i] == T ? 1 : 0; }
                const int need_eq = CAP - block_sum_i(cg, red, wave, lane);
                int sg = cg, se = ce;
#pragma unroll
                for (int o = 1; o < 64; o <<= 1) { const int a = __shfl_up(sg, o), b = __shfl_up(se, o); if (lane >= o) { sg += a; se += b; } }
                __syncthreads();
                if (lane == 63) { red[16 + wave] = sg; red[32 + wave] = se; }
                __syncthreads();
                int og = 0, oe = 0;
#pragma unroll
                for (int wv = 0; wv < 8; ++wv) if (wv < wave) { og += red[16 + wv]; oe += red[32 + wv]; }
                int gbef = og + sg - cg, ebef = oe + se - ce;
                const bool inv_mine = (tid * nparts) / 512 == part;
#pragma unroll
                for (int i = 0; i < 16; ++i) { const int tok = tid * 16 + i; const bool isg = bits[i] > T, ise = bits[i] == T; const bool sel = isg || (ise && ebef < need_eq);
                    const int slot = gbef + (ebef < need_eq ? ebef : need_eq);
                    if (sel && slot >= slo && slot < shi) { IDX[e * CAP + slot] = tok; GATE[e * CAP + slot] = __uint_as_float(bits[i]); RSL[e * CAP + slot] = RINV2[tok]; list[slot - slo] = tok; }
                    if (inv_mine) INV[tok * NE + e] = sel ? slot : -1;
                    gbef += isg ? 1 : 0; ebef += ise ? 1 : 0; }
                __syncthreads();
                for (int r = wave; r < shi - slo; r += 8) { const int tok = list[r]; const u32x4* s = (const u32x4*)(XB1 + (size_t)tok * D) + lane; u32x2* d = (u32x2*)((unsigned char*)XG + (size_t)(e * CAP + slo + r) * D) + lane;
#pragma unroll
                    for (int j = 0; j < 4; ++j) { f32x4 a, b; unpack8(s[64 * j], a, b); d[64 * j] = pack8_fp8(a, b); } }
                __syncthreads();
            }
        }
        SEAM(pbase + 9);
        if (PON(13) && IN(pbase + 11)) _Pragma("nounroll") for (int rep_ = 0; rep_ < REPS(13); ++rep_) { PH_ENTER LAYER_ENTER
            pg::SchedGroup Sg; Sg.init(XG, D, (size_t)CAP * D, w.WGU, D, (size_t)4096 * D, 4, 16, NE, G, vcu, 1);
            EpiExp1 E{RSL, Hb};
            pg::gemm_phase<EpiExp1, pg::SchedGroup, true, E8_ONE, E8_W>(lds, D, D, D, Sg, E);
        }
        SEAM(pbase + 11);
        if (PON(14) && IN(pbase + 12)) _Pragma("nounroll") for (int rep_ = 0; rep_ < REPS(14); ++rep_) { PH_ENTER LAYER_ENTER
            pg::SchedGroup Sg; Sg.init(Hb, FF, (size_t)CAP * FF, w.WD, FF, (size_t)D * FF, 4, 8, NE, G, vcu, 1);
            EpiExp2 E{GATE, YX};
            pg::gemm_phase<EpiExp2, pg::SchedGroup, true, E8_H, E8_W>(lds, FF, FF, FF, Sg, E);
        }
        SEAM(pbase + 12);
        if (PON(15) && IN(pbase + 13)) _Pragma("nounroll") for (int rep_ = 0; rep_ < REPS(15); ++rep_) { PH_ENTER LAYER_ENTER
            for (int m = gw; m < S; m += NGW) {
                const bf16_t* xr = XB1 + (size_t)m * D;
                f32x4 v[8];
#pragma unroll
                for (int j = 0; j < 8; ++j) { const u32x2 w0 = *(const u32x2*)(xr + 4 * lane + 256 * j); v[j] = (f32x4){bf_lo(w0.x), bf_hi(w0.x), bf_lo(w0.y), bf_hi(w0.y)}; }
                const int myinv = INV[m * NE + (lane & 15)];
                unsigned msk = (unsigned)(__ballot(myinv >= 0) & 0xFFFFull);
                while (msk) { const int e0 = __builtin_ctz(msk); msk &= msk - 1; const bool two = msk != 0u; const int e1 = two ? __builtin_ctz(msk) : e0; if (two) msk &= msk - 1;
                    const bf16_t* y0 = YX + ((size_t)e0 * CAP + __shfl(myinv, e0)) * D; const bf16_t* y1 = YX + ((size_t)e1 * CAP + __shfl(myinv, e1)) * D;
                    u32x2 a[8], b[8];
#pragma unroll
                    for (int j = 0; j < 8; ++j) a[j] = *(const u32x2*)(y0 + 4 * lane + 256 * j);
#pragma unroll
                    for (int j = 0; j < 8; ++j) b[j] = *(const u32x2*)(y1 + 4 * lane + 256 * j);
#pragma unroll
                    for (int j = 0; j < 8; ++j) { v[j][0] += bf_lo(a[j].x); v[j][1] += bf_hi(a[j].x); v[j][2] += bf_lo(a[j].y); v[j][3] += bf_hi(a[j].y); }
                    if (two) {
#pragma unroll
                        for (int j = 0; j < 8; ++j) { v[j][0] += bf_lo(b[j].x); v[j][1] += bf_hi(b[j].x); v[j][2] += bf_lo(b[j].y); v[j][3] += bf_hi(b[j].y); } } }
                if (l + 1 < NL) {
                    float ss = 0.f;
#pragma unroll
                    for (int j = 0; j < 8; ++j) ss += v[j][0] * v[j][0] + v[j][1] * v[j][1] + v[j][2] * v[j][2] + v[j][3] * v[j][3];
                    ss = wave_sum(ss);
#pragma unroll
                    for (int j = 0; j < 8; ++j) { u32x2 wv; wv.x = cvt_pk_bf16(v[j][0], v[j][1]); wv.y = cvt_pk_bf16(v[j][2], v[j][3]); *(u32x2*)(XB + (size_t)m * D + 4 * lane + 256 * j) = wv;
                        int w8 = 0; w8 = __builtin_amdgcn_cvt_pk_fp8_f32(v[j][0], v[j][1], w8, false); w8 = __builtin_amdgcn_cvt_pk_fp8_f32(v[j][2], v[j][3], w8, true); *(int*)(XB8 + (size_t)m * D + 4 * lane + 256 * j) = w8; }
                    if (lane == 0) RINV[m] = __builtin_amdgcn_rsqf(ss * (1.f / D) + EPS);
                } else { float* orow = OUTP + (size_t)m * D;
#pragma unroll
                    for (int j = 0; j < 8; ++j) *(f32x4*)(orow + 4 * lane + 256 * j) = v[j]; }
            }
        }
        SEAM(pbase + 13);
    }
#undef IN
#undef SEAM
}

#if defined(DBG_STOP)
#ifndef DBG_OFF
#define DBG_OFF A_XA
#endif
#ifndef DBG_BF16
#define DBG_BF16 0
#endif
__global__ void dbg_dump(float* out, const unsigned char* ws) {
    const unsigned char* p = ws + WS_ACT + DBG_OFF;
    for (size_t i = (size_t)blockIdx.x * 256 + threadIdx.x; i < (size_t)S * D; i += (size_t)gridDim.x * 256)
#if defined(DBG_SUM2)
        out[i] = __uint_as_float(((unsigned)((const bf16_t*)p)[i]) << 16) + __uint_as_float(((unsigned)((const bf16_t*)p)[i + (size_t)S * D]) << 16);
#else
        out[i] = DBG_BF16 ? __uint_as_float(((unsigned)((const bf16_t*)p)[i]) << 16) : ((const float*)p)[i];
#endif
}
#endif
constexpr int N_PHASES = 2 + NL * 14;
extern "C" void kernel_launch(void* const* d_in, const int* in_sizes, int n_in, void* d_out, int out_size, void* d_ws, size_t ws_size, hipStream_t stream) {
    static int grid = 0;
    if (grid == 0) {
        if (n_in != 28 || in_sizes[0] != S * D || out_size != S * D || ws_size < WS_END) { fprintf(stderr, "kernel_launch: shape/workspace mismatch (n_in %d, ws %zu, need %zu)\n", n_in, ws_size, (size_t)WS_END); grid = -1; return; }
        int dev = 0, cus = 0, per_cu = 0;
        if (hipGetDevice(&dev) != hipSuccess || hipDeviceGetAttribute(&cus, hipDeviceAttributeMultiprocessorCount, dev) != hipSuccess) { grid = -1; return; }
        if (hipFuncSetAttribute((const void*)fwd, hipFuncAttributeMaxDynamicSharedMemorySize, LDS_BYTES) != hipSuccess) { fprintf(stderr, "kernel_launch: hipFuncSetAttribute failed\n"); grid = -1; return; }
        if (hipOccupancyMaxActiveBlocksPerMultiprocessor(&per_cu, (const void*)fwd, 512, LDS_BYTES) != hipSuccess || per_cu < 1) { fprintf(stderr, "kernel_launch: occupancy query says %d\n", per_cu); }
        (void)hipGetLastError();
        grid = cus;
    }
    if (grid < 0) return;
    (void)hipMemsetAsync((char*)d_ws + WS_CTL, 0, CTL_BYTES, stream);
    Args a{};
    for (int i = 0; i < 28; ++i) a.in[i] = (GAS const float*)d_in[i];
    a.out = (GAS float*)d_out; a.ws = (GAS unsigned char*)d_ws;
#if defined(DBG_STOP)
    for (int p = 0; p < DBG_STOP; ++p) { a.ph_lo = p; a.ph_hi = p + 1; hipLaunchKernelGGL(fwd, dim3(grid), dim3(512), LDS_BYTES, stream, a); }
#if !defined(DBG_NODUMP)
    hipLaunchKernelGGL(dbg_dump, dim3(2048), dim3(256), 0, stream, (float*)d_out, (const unsigned char*)d_ws);
#endif
#elif MK_PER_PHASE
    for (int p = 0; p < N_PHASES; ++p) { a.ph_lo = p; a.ph_hi = p + 1; hipLaunchKernelGGL(fwd, dim3(grid), dim3(512), LDS_BYTES, stream, a); }
#else
    a.ph_lo = 0; a.ph_hi = N_PHASES; hipLaunchKernelGGL(fwd, dim3(grid), dim3(512), LDS_BYTES, stream, a);
#endif
    const hipError_t le = hipPeekAtLastError();
    if (le != hipSuccess) fprintf(stderr, "kernel_launch: launch failed: %s\n", hipGetErrorName(le));
}
```

```cpp
#include <hip/hip_runtime.h>
#include <cstdio>
#include <cstdint>

#define REP_MASK 7168
#ifndef MK_PER_PHASE
#define MK_PER_PHASE 0
#endif

#define LAS __attribute__((address_space(3)))
#define GAS __attribute__((address_space(1)))
typedef unsigned short bf16_t;
typedef short bf16x8 __attribute__((ext_vector_type(8)));
typedef short s16x4 __attribute__((ext_vector_type(4)));
typedef float f32x4 __attribute__((ext_vector_type(4)));
typedef float f32x2 __attribute__((ext_vector_type(2)));
typedef float f32x16 __attribute__((ext_vector_type(16)));
typedef unsigned u32x4 __attribute__((ext_vector_type(4)));
typedef unsigned u32x2 __attribute__((ext_vector_type(2)));

constexpr int S = 8192, D = 2048, NL = 2;
constexpr int SSMW = 1024, NGRP = 64, GP = 16, NST = 64;
constexpr int NH = 8, QKD = 64, VD = 128;
constexpr int NE = 16, CAP = 1024, FF = 2048;
constexpr int INC = 8192;
constexpr float EPS = 1e-6f;
constexpr int TC = 32, NCH = S / TC;
constexpr int UAW = TC * GP + 256;
constexpr float LOG2E = 1.4426950408889634f;

constexpr size_t MiB = 1u << 20;
constexpr size_t WS_CTL = 0, CTL_BYTES = 1 * MiB;
constexpr size_t LW_WIN = 0, LW_WGLU = 32 * MiB, LW_WBR = 34 * MiB, LW_WOUT = 42 * MiB, LW_WGU = 50 * MiB, LW_WD = 306 * MiB,
                 LW_F = 434 * MiB, LW_BO = 450 * MiB, LW_KTAB = 498 * MiB, LW_WRT = 502 * MiB, LW_SIZE = 503 * MiB;
constexpr size_t WS_LW = 1 * MiB;
constexpr size_t WS_ACT = WS_LW + 2 * LW_SIZE;
constexpr size_t A_XB = 0, A_XB1 = 32 * MiB, A_UA = 64 * MiB, A_Q = 88 * MiB, A_K = 104 * MiB, A_V = 120 * MiB, A_G = 136 * MiB,
                 A_SSUM = 200 * MiB, A_Y = 216 * MiB, A_YO = 232 * MiB, A_O1 = 264 * MiB, A_MG = 296 * MiB, A_XA = 328 * MiB,
                 A_XG = 392 * MiB, A_H = 456 * MiB, A_YX = 520 * MiB, A_SMALL = 584 * MiB, A_END = 588 * MiB;
constexpr size_t SM_RINV = 0, SM_RINV2 = 64 * 1024, SM_AFFT = 128 * 1024, SM_IDX = 640 * 1024, SM_GATE = 704 * 1024, SM_RSL = 768 * 1024,
                 SM_INV = 1024 * 1024, SM_BTAB = 1536 * 1024, SM_LAM = 1600 * 1024;
constexpr size_t WS_END = WS_ACT + A_END;

constexpr int RING_BYTES = 131072;
constexpr int LDS_BYTES = 163840;
constexpr int MISC_OFF = 155648;

typedef __bf16 bf16v2_t __attribute__((ext_vector_type(2)));
__device__ __forceinline__ unsigned cvt_pk_bf16(float lo, float hi) { const f32x2 v = {lo, hi}; return __builtin_bit_cast(unsigned, __builtin_convertvector(v, bf16v2_t)); }
__device__ __forceinline__ float bf_lo(unsigned w) { return __uint_as_float(w << 16); }
__device__ __forceinline__ float bf_hi(unsigned w) { return __uint_as_float(w & 0xffff0000u); }
__device__ __forceinline__ unsigned short f2bf(float f) { return (unsigned short)(cvt_pk_bf16(f, 0.f) & 0xffffu); }
__device__ __forceinline__ float fast_sigmoid(float x) { return __builtin_amdgcn_rcpf(1.f + __builtin_amdgcn_exp2f(-x * LOG2E)); }
__device__ __forceinline__ float wave_sum(float v) {
#pragma unroll
    for (int o = 1; o < 64; o <<= 1) v += __shfl_xor(v, o);
    return v;
}
template <int X> __device__ __forceinline__ float swz_xor(float v) { return __int_as_float(__builtin_amdgcn_ds_swizzle(__float_as_int(v), (X << 10) | 0x1F)); }
__device__ __forceinline__ u32x2 pack8_fp8(const f32x4 a, const f32x4 b) { int w0 = 0, w1 = 0;
    w0 = __builtin_amdgcn_cvt_pk_fp8_f32(a[0], a[1], w0, false); w0 = __builtin_amdgcn_cvt_pk_fp8_f32(a[2], a[3], w0, true);
    w1 = __builtin_amdgcn_cvt_pk_fp8_f32(b[0], b[1], w1, false); w1 = __builtin_amdgcn_cvt_pk_fp8_f32(b[2], b[3], w1, true);
    u32x2 r; r.x = (unsigned)w0; r.y = (unsigned)w1; return r; }
constexpr float W8_SCALE = 64.f, H8_SCALE = 16.f;
constexpr int E8_ONE = 0x7F7F7F7F, E8_W = 0x79797979  , E8_H = 0x7B7B7B7B  ;
#define LDS_WAIT() asm volatile("s_waitcnt lgkmcnt(0)" ::: "memory")
#define VM_WAIT() asm volatile("s_waitcnt vmcnt(0)" ::: "memory")

#define XB_TMO      128
#define XB_XCNT(j)  (256  + 64 * (j))
#define XB_XSUB(j)  (1280 + 64 * (j))
#define XB_XGEN(j)  (2304 + 64 * (j))
#define XB_TOP      3328
#define XB_TOPGEN   3392
#define XCD_BAR_WORDS 3456
#define XB_SPIN_CAP (1u << 22)
__device__ __forceinline__ unsigned xb_ld(unsigned* p)              { return __hip_atomic_load(p, __ATOMIC_RELAXED, __HIP_MEMORY_SCOPE_AGENT); }
__device__ __forceinline__ unsigned xb_add(unsigned* p, unsigned v) { return __hip_atomic_fetch_add(p, v, __ATOMIC_RELAXED, __HIP_MEMORY_SCOPE_AGENT); }
__device__ __forceinline__ unsigned xb_xcc_id() { return (unsigned)__builtin_amdgcn_s_getreg((3 << 11) | 20) & 0xFu; }
#define XB_SPIN(cond, bar) do { unsigned _sp = 0; while (cond) { __builtin_amdgcn_s_sleep(1); \
    if ((++_sp & 255u) == 0u) { if (xb_ld(&(bar)[XB_TMO])) break; if (_sp > XB_SPIN_CAP) { atomicAdd(&(bar)[XB_TMO], 1u); break; } } } } while (0)
struct XcdBarrier { unsigned* bar; unsigned x; volatile LAS unsigned* st; };
__device__ __forceinline__ XcdBarrier xcd_barrier_post(unsigned* bar, volatile LAS unsigned* st) {
    XcdBarrier b; b.bar = bar; b.x = xb_xcc_id(); b.st = st;
    if (threadIdx.x == 0) (void)xb_add(&bar[XB_XCNT(b.x)], 1u);
    return b;
}
__device__ __forceinline__ void xcd_barrier_complete(unsigned* bar, unsigned x, unsigned& nloc, unsigned& nx) {
    const unsigned G = gridDim.x * gridDim.y * gridDim.z;
    unsigned sum, cnt, mine, sp = 0u;
    for (;;) {
        sum = 0u; cnt = 0u; mine = 0u;
#pragma nounroll
        for (unsigned j = 0; j < 16; ++j) { const unsigned c = xb_ld(&bar[XB_XCNT(j)]); sum += c; cnt += (c > 0u) ? 1u : 0u; mine = (j == x) ? c : mine; }
        if (sum == G) break;
        __builtin_amdgcn_s_sleep(1);
        if ((++sp & 255u) == 0u) { if (xb_ld(&bar[XB_TMO])) break; if (sp > XB_SPIN_CAP) { atomicAdd(&bar[XB_TMO], 1u); break; } }
    }
    nloc = mine > 0u ? mine : 1u; nx = cnt > 0u ? cnt : 1u;
}
__device__ __forceinline__ void xcd_barrier(const XcdBarrier& b) {
    asm volatile("s_waitcnt vmcnt(0)" ::: "memory");
    __syncthreads();
    if (threadIdx.x == 0) {
        unsigned* bar = b.bar;
        __builtin_amdgcn_s_waitcnt(0);
        unsigned nloc = b.st[0], nx = b.st[1];
        if (nloc == 0u) { xcd_barrier_complete(bar, b.x, nloc, nx); b.st[0] = nloc; b.st[1] = nx; }
        const unsigned old = xb_add(&bar[XB_XSUB(b.x)], 1u);
        const unsigned gen = old / nloc;
        if (old + 1u == (gen + 1u) * nloc) {
            __builtin_amdgcn_fence(__ATOMIC_RELEASE, "agent");
            asm volatile("s_waitcnt vmcnt(0)" ::: "memory");
            const unsigned og = xb_add(&bar[XB_TOP], 1u);
            const unsigned tg = og / nx;
            if (og + 1u == (tg + 1u) * nx) xb_add(&bar[XB_TOPGEN], 1u);
            else XB_SPIN(xb_ld(&bar[XB_TOPGEN]) == tg, bar);
            __builtin_amdgcn_fence(__ATOMIC_ACQUIRE, "agent");
            xb_add(&bar[XB_XGEN(b.x)], 1u);
            asm volatile("s_waitcnt vmcnt(0)" ::: "memory");
        } else {
            XB_SPIN(xb_ld(&bar[XB_XGEN(b.x)]) == gen, bar);
            __builtin_amdgcn_fence(__ATOMIC_ACQUIRE, "agent");
            asm volatile("s_waitcnt vmcnt(0)" ::: "memory");
        }
    }
    __syncthreads();
}

namespace pg {
constexpr int BM = 256, BK = 64, HALF = 128, HTB = HALF * BK * 2, STAGE_BYTES = 8 * HTB;
__device__ __forceinline__ int lds_byte(int r, int c) { const int st = (r >> 4) * 2 + (c >> 5), rr = r & 15, cc = c & 31, ob = rr * 64 + cc * 2; return st * 1024 + (ob ^ (((ob >> 9) & 1) << 5)); }
__device__ __forceinline__ void stage_rc(int b, int& R, int& C) { const int st = b / 1024, sb = b % 1024, swz = sb ^ (((sb >> 9) & 1) << 5); R = (st >> 1) * 16 + swz / 64; C = (st & 1) * 32 + (swz % 64) / 2; }
__device__ __forceinline__ int perm32(int rho) { const int n = rho >> 4, i = rho & 15; return 8 * (i >> 2) + 4 * n + (i & 3); }
struct Unit { const char* a; const char* b; int pm, pn, grp; };
typedef f32x4 Acc[2][2][4][2];

typedef int v8i_t __attribute__((ext_vector_type(8)));
template <class Epi, class Sched, bool F8 = false, int SA_ = 0x7F7F7F7F, int SB_ = 0x7F7F7F7F>
__device__ __forceinline__ void gemm_phase(LAS unsigned char* lds, const int K, const int lda, const int ldb, const Sched& S, const Epi& E) {
    int tz_ = threadIdx.x; asm volatile("" : "+v"(tz_));
    const int tid = tz_, wid = __builtin_amdgcn_readfirstlane(tid >> 6), lane = tid & 63, wr = wid >> 2, wc = wid & 3, fr = lane & 15, fq = lane >> 4;
    constexpr int ESZ = F8 ? 1 : 2;
    const int nt = K * ESZ / (BK * 2);
    unsigned voffA[2], voffB[2];
#pragma unroll
    for (int i = 0; i < 2; ++i) { int R, C; stage_rc(tid * 16 + i * 8192, R, C);
        voffA[i] = (unsigned)(R * lda * ESZ + C * 2); voffB[i] = (unsigned)((64 * (R >> 5) + perm32(R & 31)) * ldb * ESZ + C * 2); }
    const size_t kstep = (size_t)(BK * 2);
    const size_t hstepA = (size_t)HALF * lda * ESZ;
    const size_t hstepB = (size_t)32 * ldb * ESZ;
    const unsigned ldsw = (unsigned)wid * 1024u;
    const int aoff = F8 ? lds_byte(wr * 64 + fr, fq * 16) : lds_byte(wr * 64 + fr, fq * 8), boff = F8 ? lds_byte(wc * 32 + fr, fq * 16) : lds_byte(wc * 32 + fr, fq * 8);
#define PG8_SA(b, h) (((b) * 2 + (h)) * HTB)
#define PG8_SB(b, h) ((4 + (b) * 2 + (h)) * HTB)
#define PG8_STAGE(bufoff, gbase, voff) do { _Pragma("unroll") for (int _i = 0; _i < 2; ++_i) \
        __builtin_amdgcn_global_load_lds((const unsigned*)((const char*)(gbase) + (voff)[_i]), (LAS unsigned*)(lds + (bufoff) + ldsw + _i * 8192), 16, 0, 0); } while (0)
    typedef v8i_t v8i_a16 __attribute__((aligned(16)));
#define PG8_LD32(p) __builtin_bit_cast(v8i_t, __builtin_shufflevector(*(const LAS u32x4*)(p), *(const LAS u32x4*)((p) + 16), 0, 1, 2, 3, 4, 5, 6, 7))
#define PG8_LDA(dst, b, h) do { if constexpr (F8) { _Pragma("unroll") for (int m = 0; m < 4; ++m) dst##8[m] = PG8_LD32(lds + PG8_SA(b, h) + aoff + m * 2048); } \
        else { _Pragma("unroll") for (int m = 0; m < 4; ++m) _Pragma("unroll") for (int k = 0; k < 2; ++k) dst[m][k] = *(const LAS bf16x8*)(lds + PG8_SA(b, h) + aoff + m * 2048 + k * 1024); } } while (0)
#define PG8_LDB(dst, b, h) do { if constexpr (F8) { _Pragma("unroll") for (int n = 0; n < 2; ++n) dst##8[n] = PG8_LD32(lds + PG8_SB(b, h) + boff + n * 2048); } \
        else { _Pragma("unroll") for (int n = 0; n < 2; ++n) _Pragma("unroll") for (int k = 0; k < 2; ++k) dst[n][k] = *(const LAS bf16x8*)(lds + PG8_SB(b, h) + boff + n * 2048 + k * 1024); } } while (0)
#define PG8_MMA(ai, bj, At, Bt) do { __builtin_amdgcn_s_setprio(1); \
        if constexpr (F8) { _Pragma("unroll") for (int m = 0; m < 4; ++m) _Pragma("unroll") for (int n = 0; n < 2; ++n) \
            asm volatile("v_mfma_scale_f32_16x16x128_f8f6f4 %0, %1, %2, %0, %3, %4 op_sel_hi:[0,0,0]" : "+v"(acc[ai][bj][m][n]) : "v"(Bt##8[n]), "v"(At##8[m]), "v"(sbv), "v"(sav)); } \
        else { _Pragma("unroll") for (int m = 0; m < 4; ++m) _Pragma("unroll") for (int n = 0; n < 2; ++n) _Pragma("unroll") for (int k = 0; k < 2; ++k) \
            acc[ai][bj][m][n] = __builtin_amdgcn_mfma_f32_16x16x32_bf16(Bt[n][k], At[m][k], acc[ai][bj][m][n], 0, 0, 0); } \
        __builtin_amdgcn_s_setprio(0); } while (0)
#define PG8_WAIT_V(n) asm volatile("s_waitcnt vmcnt(" #n ")" ::: "memory")
#define PG8_WAIT_L(n) asm volatile("s_waitcnt lgkmcnt(" #n ")" ::: "memory")
#define PG8_BAR __builtin_amdgcn_s_barrier()
#define PG8_SCHED __builtin_amdgcn_sched_barrier(0)
    Unit cur, nxt; int ui = 0;
    if (!S.next(0, cur)) return;
    Acc acc;
#pragma unroll
    for (int a = 0; a < 2; ++a)
#pragma unroll
        for (int b = 0; b < 2; ++b)
#pragma unroll
            for (int m = 0; m < 4; ++m)
#pragma unroll
                for (int n = 0; n < 2; ++n) acc[a][b][m][n] = (f32x4){0.f, 0.f, 0.f, 0.f};
    bf16x8 At[4][2], B0[2][2], B1[2][2]; v8i_t At8[4], B08[2], B18[2];
    const int sav = SA_, sbv = SB_;
    const char* cA = cur.a; const char* cB = cur.b;
    PG8_STAGE(PG8_SB(0, 0), cB, voffB); PG8_STAGE(PG8_SA(0, 0), cA, voffA); PG8_STAGE(PG8_SB(0, 1), cB + hstepB, voffB); PG8_STAGE(PG8_SA(0, 1), cA + hstepA, voffA);
    if (wr == 1) PG8_BAR;
    PG8_WAIT_V(4); PG8_BAR;
    PG8_STAGE(PG8_SB(1, 0), cB + kstep, voffB); PG8_STAGE(PG8_SA(1, 0), cA + kstep, voffA); PG8_STAGE(PG8_SB(1, 1), cB + hstepB + kstep, voffB);
    PG8_WAIT_V(6); PG8_BAR;
    for (;;) {
        const bool has_next = S.next(ui + 1, nxt);
        const char* nA = has_next ? nxt.a : cA; const char* nB = has_next ? nxt.b : cB;
        for (int t = 0; t < nt; t += 2) {
            const bool last = (t == nt - 2);
            const char* a1 = cA + (size_t)(t + 1) * kstep;
            const char* a2 = last ? nA : cA + (size_t)(t + 2) * kstep; const char* b2 = last ? nB : cB + (size_t)(t + 2) * kstep;
            const char* a3 = a2 + kstep; const char* b3 = b2 + kstep;
            if constexpr (Epi::HAS_MID) { if (t == nt / 2) E.mid(acc, cur, wr, wc, fr, fq); }
            PG8_LDB(B0, 0, 0); PG8_SCHED; PG8_LDA(At, 0, 0); PG8_STAGE(PG8_SA(1, 1), a1 + hstepA, voffA);
            PG8_WAIT_L(8); PG8_BAR; PG8_WAIT_L(0); PG8_MMA(0, 0, At, B0); PG8_BAR; PG8_SCHED;
            PG8_LDB(B1, 0, 1); PG8_STAGE(PG8_SB(0, 0), b2, voffB);
            PG8_BAR; PG8_WAIT_L(0); PG8_MMA(0, 1, At, B1); PG8_BAR;
            PG8_LDA(At, 0, 1); PG8_STAGE(PG8_SA(0, 0), a2, voffA);
            PG8_BAR; PG8_WAIT_L(0); PG8_MMA(1, 0, At, B0); PG8_BAR; PG8_SCHED;
            PG8_STAGE(PG8_SB(0, 1), b2 + hstepB, voffB);
            PG8_WAIT_V(6); PG8_BAR; PG8_MMA(1, 1, At, B1); PG8_BAR;
            PG8_LDB(B0, 1, 0); PG8_SCHED; PG8_LDA(At, 1, 0); PG8_STAGE(PG8_SA(0, 1), a2 + hstepA, voffA);
            PG8_WAIT_L(8); PG8_BAR; PG8_WAIT_L(0); PG8_MMA(0, 0, At, B0); PG8_BAR; PG8_SCHED;
            PG8_LDB(B1, 1, 1); PG8_STAGE(PG8_SB(1, 0), b3, voffB);
            PG8_BAR; PG8_WAIT_L(0); PG8_MMA(0, 1, At, B1); PG8_BAR;
            PG8_LDA(At, 1, 1); PG8_STAGE(PG8_SA(1, 0), a3, voffA);
            PG8_BAR; PG8_WAIT_L(0); PG8_MMA(1, 0, At, B0); PG8_BAR; PG8_SCHED;
            PG8_STAGE(PG8_SB(1, 1), b3 + hstepB, voffB);
            PG8_WAIT_V(6); PG8_BAR; PG8_MMA(1, 1, At, B1); PG8_BAR;
        }
        if constexpr (F8) asm volatile("s_nop 15\n\ts_nop 15" ::: "memory");
        E(acc, cur, wr, wc, fr, fq);
        if (!has_next) break;
#pragma unroll
        for (int a = 0; a < 2; ++a)
#pragma unroll
            for (int b = 0; b < 2; ++b)
#pragma unroll
                for (int m = 0; m < 4; ++m)
#pragma unroll
                    for (int n = 0; n < 2; ++n) acc[a][b][m][n] = (f32x4){0.f, 0.f, 0.f, 0.f};
        cur = nxt; cA = nA; cB = nB; ++ui;
    }
    PG8_WAIT_V(0);
    if (wr == 0) PG8_BAR;
    PG8_BAR;
#undef PG8_SA
#undef PG8_SB
#undef PG8_STAGE
#undef PG8_LDA
#undef PG8_LD32
#undef PG8_LDB
#undef PG8_MMA
#undef PG8_WAIT_V
#undef PG8_WAIT_L
#undef PG8_BAR
#undef PG8_SCHED
}

struct SchedGrid {
    const char* A; const char* B; size_t tstepA, tstepB; int nM, nN, nwg, G, c; bool mix32 = false;
    __device__ void init(const void* A_, int lda, const void* B_, int ldb, int M, int N, int G_, int c_, int esz = 2) {
        A = (const char*)A_; B = (const char*)B_; tstepA = (size_t)256 * lda * esz; tstepB = (size_t)256 * ldb * esz; nM = M / 256; nN = N / 256; nwg = nM * nN; G = G_; c = c_; }
    __device__ __forceinline__ bool next(int i, Unit& u) const {
        const long L = (long)i * G + c; if (L >= nwg) return false;
        int wgid = (int)L; { const int q = nwg / 8, r = nwg % 8, xcd = wgid % 8, off = wgid / 8; wgid = (xcd < r ? xcd * (q + 1) : r * (q + 1) + (xcd - r) * q) + off; }
        const int nig = 8 * nN, gid = wgid / nig, fm = gid * 8, gsz = (nM - fm) < 8 ? (nM - fm) : 8;
        u.pm = fm + ((wgid % nig) % gsz); u.pn = (wgid % nig) / gsz; u.grp = 0;
        if (mix32) { const int a = u.pn >> 4, r4 = (u.pn >> 2) & 3, r = u.pn & 3; u.pn = ((r4 & 1) << 4) | (a << 3) | ((r4 >> 1) << 2) | r; }
        u.a = A + (size_t)u.pm * tstepA; u.b = B + (size_t)u.pn * tstepB; return true;
    }
};
struct SchedGroup {
    const char* A; const char* B; size_t tstepA, tstepB, gstepA, gstepB; int nM, nN, total, G, c;
    __device__ void init(const void* A_, int lda, size_t gA, const void* B_, int ldb, size_t gB, int nM_, int nN_, int NG, int G_, int c_, int esz = 2) {
        A = (const char*)A_; B = (const char*)B_; tstepA = (size_t)256 * lda * esz; tstepB = (size_t)256 * ldb * esz; gstepA = gA; gstepB = gB; nM = nM_; nN = nN_; total = NG * nM_ * nN_; G = G_; c = c_; }
    __device__ __forceinline__ bool next(int i, Unit& u) const {
        const long L = (long)i * G + c; if (L >= total) return false;
        const int per = nM * nN, g = (int)L / per, r = (int)L % per;
        u.grp = g; u.pm = r % nM; u.pn = r / nM;
        u.a = A + (size_t)g * gstepA + (size_t)u.pm * tstepA; u.b = B + (size_t)g * gstepB + (size_t)u.pn * tstepB; return true;
    }
};
}

#define EPI_LANES int tz_ = threadIdx.x; asm volatile("" : "+v"(tz_)); const int wr = tz_ >> 8, wc = (tz_ >> 6) & 3, fr = tz_ & 15, fq = (tz_ >> 4) & 3;
#define EPI_ROWVALS(name, ptr, base) float name[2][4]; _Pragma("unroll") for (int ai = 0; ai < 2; ++ai) _Pragma("unroll") for (int m = 0; m < 4; ++m) name[ai][m] = (ptr)[(base) + ai * 128 + wr * 64 + m * 16 + fr];
#define EPI_FOR _Pragma("unroll") for (int ai = 0; ai < 2; ++ai) _Pragma("unroll") for (int m = 0; m < 4; ++m)
#define EPI_RL const int rl = ai * 128 + wr * 64 + m * 16 + fr;
__device__ __forceinline__ u32x4 pack8(const f32x4 a, const f32x4 b) { u32x4 w; w.x = cvt_pk_bf16(a[0], a[1]); w.y = cvt_pk_bf16(a[2], a[3]); w.z = cvt_pk_bf16(b[0], b[1]); w.w = cvt_pk_bf16(b[2], b[3]); return w; }
__device__ __forceinline__ void unpack8(const u32x4 w, f32x4& a, f32x4& b) { a = (f32x4){bf_lo(w.x), bf_hi(w.x), bf_lo(w.y), bf_hi(w.y)}; b = (f32x4){bf_lo(w.z), bf_hi(w.z), bf_lo(w.w), bf_hi(w.w)}; }

struct EpiInProj {
    static constexpr bool HAS_MID = false;
    const float* rinv; bf16_t *UA, *Q, *Kb, *V, *G; const float *qg, *kg;
    __device__ __forceinline__ void operator()(const pg::Acc& acc, const pg::Unit& u, int, int, int, int) const { EPI_LANES
        const int pn = u.pn, row0 = u.pm * 256;
        EPI_ROWVALS(rsv, rinv, row0)
        if (pn < 4) {
            EPI_FOR { EPI_RL const int tok = row0 + rl; const float rs = rsv[ai][m]; const int c = tok >> 5, tau = tok & 31;
#pragma unroll
                for (int bj = 0; bj < 2; ++bj) { const int ch = 256 * pn + 64 * wc + 32 * bj + 8 * fq, g = ch >> 4, p0 = ch & 15;
                    *(u32x4*)(UA + ((size_t)(g * NCH + c) * UAW + tau * 16 + p0)) = pack8(acc[ai][bj][m][0] * rs, acc[ai][bj][m][1] * rs); } }
        } else if (pn < 12) {
            const bool isq = pn < 8; const int col0 = 256 * (pn - (isq ? 4 : 8)) + 64 * wc; const float* gp = isq ? qg : kg; const float sc = isq ? 0.125f * LOG2E : 1.f;
            bf16_t* dst = isq ? Q : Kb;
            f32x4 gv[2][2];
#pragma unroll
            for (int bj = 0; bj < 2; ++bj)
#pragma unroll
                for (int n = 0; n < 2; ++n) gv[bj][n] = *(const f32x4*)(gp + 32 * bj + 8 * fq + 4 * n) * sc;
            EPI_FOR { EPI_RL const int tok = row0 + rl; const float rs = rsv[ai][m];
                f32x4 v[2][2]; float ss = 0.f;
#pragma unroll
                for (int bj = 0; bj < 2; ++bj)
#pragma unroll
                    for (int n = 0; n < 2; ++n) { v[bj][n] = acc[ai][bj][m][n] * rs; ss += v[bj][n][0] * v[bj][n][0] + v[bj][n][1] * v[bj][n][1] + v[bj][n][2] * v[bj][n][2] + v[bj][n][3] * v[bj][n][3]; }
                ss += __shfl_xor(ss, 16); ss += __shfl_xor(ss, 32);
                const float r = __builtin_amdgcn_rsqf(ss * (1.f / 64.f) + EPS);
#pragma unroll
                for (int bj = 0; bj < 2; ++bj)
                    *(u32x4*)(dst + (size_t)tok * 1024 + col0 + 32 * bj + 8 * fq) = pack8(v[bj][0] * r * gv[bj][0], v[bj][1] * r * gv[bj][1]); }
        } else {
            EPI_FOR { EPI_RL const int tok = row0 + rl; const float rs = rsv[ai][m];
#pragma unroll
                for (int bj = 0; bj < 2; ++bj)
                    *(u32x4*)(V + (size_t)tok * 1024 + 256 * (pn - 12) + 64 * wc + 32 * bj + 8 * fq) = pack8(acc[ai][bj][m][0] * rs, acc[ai][bj][m][1] * rs); }
        }
    }
};
struct EpiGates {
    static constexpr bool HAS_MID = false;
    const float* rinv; bf16_t* G;
    __device__ __forceinline__ void operator()(const pg::Acc& acc, const pg::Unit& u, int, int, int, int) const { EPI_LANES
        EPI_ROWVALS(rsv, rinv, u.pm * 256)
        EPI_FOR { EPI_RL const int tok = u.pm * 256 + rl; const float rs = rsv[ai][m];
#pragma unroll
            for (int bj = 0; bj < 2; ++bj) { f32x4 a = acc[ai][bj][m][0] * rs, b = acc[ai][bj][m][1] * rs;
#pragma unroll
                for (int j = 0; j < 4; ++j) { a[j] = fast_sigmoid(a[j]); b[j] = fast_sigmoid(b[j]); }
                *(u32x4*)(G + (size_t)tok * 4096 + 256 * u.pn + 64 * wc + 32 * bj + 8 * fq) = pack8(a, b); } }
    }
};
struct EpiSsum {
    static constexpr bool HAS_MID = false;
    float* SS;
    __device__ __forceinline__ void operator()(const pg::Acc& acc, const pg::Unit& u, int, int, int, int) const { EPI_LANES
        EPI_FOR { EPI_RL float* rp = SS + ((size_t)u.grp * NCH + rl) * 256 + 64 * wc + 8 * fq;
#pragma unroll
            for (int bj = 0; bj < 2; ++bj) { *(f32x4*)(rp + 32 * bj) = acc[ai][bj][m][0]; *(f32x4*)(rp + 32 * bj + 4) = acc[ai][bj][m][1]; } }
    }
};
__device__ __forceinline__ float gelu_tanh(float x) {
    const float t = 1.5957691216057308f * (x + 0.044715f * x * x * x);
    return x * fast_sigmoid(t);
}
struct EpiSsmOut {
    static constexpr bool HAS_MID = false;
    bf16_t* Y;
    __device__ __forceinline__ void operator()(const pg::Acc& acc, const pg::Unit& u, int, int, int, int) const { EPI_LANES
        EPI_FOR { EPI_RL
#pragma unroll
            for (int bj = 0; bj < 2; ++bj) { const int col = 256 * u.pn + 64 * wc + 32 * bj + 8 * fq, t = col >> 4, p0 = col & 15;
                f32x4 a = acc[ai][bj][m][0], b = acc[ai][bj][m][1];
#pragma unroll
                for (int j = 0; j < 4; ++j) { a[j] = gelu_tanh(a[j]); b[j] = gelu_tanh(b[j]); }
                *(u32x4*)(Y + (size_t)(rl * TC + t) * SSMW + u.grp * GP + p0) = pack8(a, b); } }
    }
};
struct EpiGlu {
    static constexpr bool HAS_MID = false;
    const bf16_t* Y; bf16_t* YO;
    __device__ __forceinline__ void operator()(const pg::Acc& acc, const pg::Unit& u, int, int, int, int) const { EPI_LANES
        const int colb = 256 * u.pn + 64 * wc + 8 * fq; const size_t rb = (size_t)(u.pm * 256 + wr * 64 + fr);
        u32x4 cur[2], nxt[2];
        cur[0] = *(const u32x4*)(Y + rb * SSMW + colb); cur[1] = *(const u32x4*)(Y + rb * SSMW + colb + 32);
#pragma unroll
        for (int r_ = 0; r_ < 8; ++r_) { const int ai = r_ >> 2, m = r_ & 3; const size_t tok = rb + ai * 128 + m * 16;
            if (r_ < 7) { const size_t tn = rb + ((r_ + 1) >> 2) * 128 + ((r_ + 1) & 3) * 16; nxt[0] = *(const u32x4*)(Y + tn * SSMW + colb); nxt[1] = *(const u32x4*)(Y + tn * SSMW + colb + 32); }
#pragma unroll
            for (int bj = 0; bj < 2; ++bj) { f32x4 ya, yb; unpack8(cur[bj], ya, yb);
                f32x4 a = acc[ai][bj][m][0], b = acc[ai][bj][m][1];
#pragma unroll
                for (int j = 0; j < 4; ++j) { a[j] = ya[j] * fast_sigmoid(a[j]); b[j] = yb[j] * fast_sigmoid(b[j]); }
                *(u32x4*)(YO + tok * 2048 + colb + 32 * bj) = pack8(a, b); }
            cur[0] = nxt[0]; cur[1] = nxt[1]; }
    }
};
struct EpiMerge {
    static constexpr bool HAS_MID = true;
    const bf16_t* G; bf16_t* MG;
    __device__ __forceinline__ void mid(pg::Acc& acc, const pg::Unit& u, int, int, int, int) const { EPI_LANES
        const int colb = 256 * u.pn + 64 * wc + 8 * fq; const size_t rb = (size_t)(u.pm * 256 + wr * 64 + fr);
        u32x4 cur[4], nxt[4];
#pragma unroll
        for (int q = 0; q < 4; ++q) cur[q] = *(const u32x4*)(G + rb * 4096 + (q >> 1) * 2048 + colb + 32 * (q & 1));
#pragma unroll
        for (int r_ = 0; r_ < 8; ++r_) { const int ai = r_ >> 2, m = r_ & 3;
            if (r_ < 7) { const size_t tn = rb + ((r_ + 1) >> 2) * 128 + ((r_ + 1) & 3) * 16;
#pragma unroll
                for (int q = 0; q < 4; ++q) nxt[q] = *(const u32x4*)(G + tn * 4096 + (q >> 1) * 2048 + colb + 32 * (q & 1)); }
#pragma unroll
            for (int bj = 0; bj < 2; ++bj) { f32x4 sa, sb, ga, gb; unpack8(cur[bj], sa, sb); unpack8(cur[2 + bj], ga, gb);
#pragma unroll
                for (int j = 0; j < 4; ++j) { acc[ai][bj][m][0][j] *= sa[j] * __builtin_amdgcn_rcpf(ga[j]); acc[ai][bj][m][1][j] *= sb[j] * __builtin_amdgcn_rcpf(gb[j]); } }
#pragma unroll
            for (int q = 0; q < 4; ++q) cur[q] = nxt[q];
            __builtin_amdgcn_sched_barrier(0); }
    }
    __device__ __forceinline__ void operator()(const pg::Acc& acc, const pg::Unit& u, int, int, int, int) const { EPI_LANES
        const int colb = 256 * u.pn + 64 * wc + 8 * fq; const size_t rb = (size_t)(u.pm * 256 + wr * 64 + fr);
        u32x4 cur[2], nxt[2];
        cur[0] = *(const u32x4*)(G + rb * 4096 + 2048 + colb); cur[1] = *(const u32x4*)(G + rb * 4096 + 2048 + colb + 32);
#pragma unroll
        for (int r_ = 0; r_ < 8; ++r_) { const int ai = r_ >> 2, m = r_ & 3; const size_t tok = rb + ai * 128 + m * 16;
            if (r_ < 7) { const size_t tn = rb + ((r_ + 1) >> 2) * 128 + ((r_ + 1) & 3) * 16; nxt[0] = *(const u32x4*)(G + tn * 4096 + 2048 + colb); nxt[1] = *(const u32x4*)(G + tn * 4096 + 2048 + colb + 32); }
#pragma unroll
            for (int bj = 0; bj < 2; ++bj) { f32x4 ga, gb; unpack8(cur[bj], ga, gb);
                *(u32x4*)(MG + tok * 2048 + colb + 32 * bj) = pack8(acc[ai][bj][m][0] * ga, acc[ai][bj][m][1] * gb); }
            cur[0] = nxt[0]; cur[1] = nxt[1]; }
    }
};
struct EpiOutProj {
    static constexpr bool HAS_MID = false;
    const bf16_t* XR; bf16_t* XO;
    __device__ __forceinline__ void operator()(const pg::Acc& acc, const pg::Unit& u, int, int, int, int) const { EPI_LANES
        const int colb = 256 * u.pn + 64 * wc + 8 * fq; const size_t rb = (size_t)(u.pm * 256 + wr * 64 + fr);
        u32x4 cur[2], nxt[2];
        cur[0] = *(const u32x4*)(XR + rb * 2048 + colb); cur[1] = *(const u32x4*)(XR + rb * 2048 + colb + 32);
#pragma unroll
        for (int r_ = 0; r_ < 8; ++r_) { const int ai = r_ >> 2, m = r_ & 3; const size_t tok = rb + ai * 128 + m * 16;
            if (r_ < 7) { const size_t tn = rb + ((r_ + 1) >> 2) * 128 + ((r_ + 1) & 3) * 16; nxt[0] = *(const u32x4*)(XR + tn * 2048 + colb); nxt[1] = *(const u32x4*)(XR + tn * 2048 + colb + 32); }
#pragma unroll
            for (int bj = 0; bj < 2; ++bj) { f32x4 a, b; unpack8(cur[bj], a, b);
                *(u32x4*)(XO + tok * 2048 + colb + 32 * bj) = pack8(a + acc[ai][bj][m][0], b + acc[ai][bj][m][1]); }
            cur[0] = nxt[0]; cur[1] = nxt[1]; }
    }
};
struct EpiExp1 {
    static constexpr bool HAS_MID = false;
    const float* RSL; bf16_t* H;
    __device__ __forceinline__ void operator()(const pg::Acc& acc, const pg::Unit& u, int, int, int, int) const { EPI_LANES
        EPI_ROWVALS(rsv, RSL, u.grp * CAP + u.pm * 256)
        EPI_FOR { EPI_RL const int row = u.grp * CAP + u.pm * 256 + rl; const float rs = rsv[ai][m];
            f32x4 h[2];
#pragma unroll
            for (int n = 0; n < 2; ++n)
#pragma unroll
                for (int j = 0; j < 4; ++j) { const float g = acc[ai][0][m][n][j] * rs, up = acc[ai][1][m][n][j] * rs; h[n][j] = g * fast_sigmoid(g) * up; }
            *(u32x2*)((unsigned char*)H + (size_t)row * FF + 128 * u.pn + 32 * wc + 8 * fq) = pack8_fp8(h[0] * H8_SCALE, h[1] * H8_SCALE); }
    }
};
struct EpiExp2 {
    static constexpr bool HAS_MID = false;
    const float* GATE; bf16_t* YX;
    __device__ __forceinline__ void operator()(const pg::Acc& acc, const pg::Unit& u, int, int, int, int) const { EPI_LANES
        EPI_ROWVALS(gtv, GATE, u.grp * CAP + u.pm * 256)
        EPI_FOR { EPI_RL const int row = u.grp * CAP + u.pm * 256 + rl; const float gt = gtv[ai][m];
#pragma unroll
            for (int bj = 0; bj < 2; ++bj)
                *(u32x4*)(YX + (size_t)row * D + 256 * u.pn + 64 * wc + 32 * bj + 8 * fq) = pack8(acc[ai][bj][m][0] * gt, acc[ai][bj][m][1] * gt); }
    }
};

namespace att {
constexpr int KVBLK = 64, QBLK = 32;
constexpr int SHM_T = KVBLK * 256;
constexpr int OFF_K = 0, OFF_V = 3 * SHM_T, OFF_Q = 5 * SHM_T, OFF_WS = OFF_Q + 8 * 8192, OFF_BT = OFF_WS + 8 * 64 * 4, ATT_LDS_END = OFF_BT + 2048;
#define KSWZ(row, colB) ((row) * 256 + ((colB) ^ (((row) & 7) << 4)))
#define SBAR() __builtin_amdgcn_sched_barrier(0)
__device__ __forceinline__ int crow(int r, int hi) { return (r & 3) + 8 * (r >> 2) + 4 * hi; }
__device__ __forceinline__ int v_rd_base(int lane) { return ((lane & 3) << 3) | (((lane >> 2) & 3) << 6) | (((lane >> 4) & 1) << 5) | (((lane >> 5) & 1) << 8); }
constexpr int v_rd_off(int d0, int ks, int half) { return d0 * 512 + ks * 4096 + half * 2048; }
template <int OFF> __device__ __forceinline__ s16x4 tr_read(int vb) { s16x4 r; asm volatile("ds_read_b64_tr_b16 %0, %1 offset:%2" : "=&v"(r) : "v"(vb), "i"(OFF) : "memory"); return r; }
template <int D0> __device__ __forceinline__ void pv_one(f32x16& od, int vb, bf16x8 pa0, bf16x8 pa1, bf16x8 pa2, bf16x8 pa3) {
    const s16x4 l0 = tr_read<v_rd_off(D0, 0, 0)>(vb), h0 = tr_read<v_rd_off(D0, 0, 1)>(vb), l1 = tr_read<v_rd_off(D0, 1, 0)>(vb), h1 = tr_read<v_rd_off(D0, 1, 1)>(vb);
    const s16x4 l2 = tr_read<v_rd_off(D0, 2, 0)>(vb), h2 = tr_read<v_rd_off(D0, 2, 1)>(vb), l3 = tr_read<v_rd_off(D0, 3, 0)>(vb), h3 = tr_read<v_rd_off(D0, 3, 1)>(vb);
    asm volatile("s_waitcnt lgkmcnt(0)" ::: "memory"); SBAR();
#define PK(L, H) (bf16x8){L[0], L[1], L[2], L[3], H[0], H[1], H[2], H[3]}
    od = __builtin_amdgcn_mfma_f32_32x32x16_bf16(pa0, PK(l0, h0), od, 0, 0, 0);
    od = __builtin_amdgcn_mfma_f32_32x32x16_bf16(pa1, PK(l1, h1), od, 0, 0, 0);
    od = __builtin_amdgcn_mfma_f32_32x32x16_bf16(pa2, PK(l2, h2), od, 0, 0, 0);
    od = __builtin_amdgcn_mfma_f32_32x32x16_bf16(pa3, PK(l3, h3), od, 0, 0, 0);
#undef PK
}
__device__ __forceinline__ void pv_d0(f32x16* o, int vb, bf16x8 pa0, bf16x8 pa1, bf16x8 pa2, bf16x8 pa3) {
    pv_one<0>(o[0], vb, pa0, pa1, pa2, pa3); pv_one<1>(o[1], vb, pa0, pa1, pa2, pa3); pv_one<2>(o[2], vb, pa0, pa1, pa2, pa3); pv_one<3>(o[3], vb, pa0, pa1, pa2, pa3);
}
__device__ __forceinline__ int kq_addr(int row, int c) { return (c >> 2) * 4096 + row * 64 + (((c & 3) ^ ((row >> 2) & 3)) << 4); }
template <int COMP> __device__ __forceinline__ void qkt(f32x16& p0, f32x16& p1, const LAS char* Ks, const LAS char* Qs, int kq0, int kq1) {
    p0 = (f32x16){}; p1 = (f32x16){};
#pragma unroll
    for (int d0 = 0; d0 < 4; ++d0) { const int chi = COMP * 2 + (d0 >> 1); const int a = (d0 & 1) ? kq1 : kq0;
        const bf16x8 b0 = *(const LAS bf16x8*)(Ks + a + chi * 4096);
        const bf16x8 b1 = *(const LAS bf16x8*)(Ks + a + chi * 4096 + 2048);
        const bf16x8 qf = *(const LAS bf16x8*)(Qs + a + chi * 2048);
        p0 = __builtin_amdgcn_mfma_f32_32x32x16_bf16(b0, qf, p0, 0, 0, 0);
        p1 = __builtin_amdgcn_mfma_f32_32x32x16_bf16(b1, qf, p1, 0, 0, 0); }
}
__device__ __forceinline__ void sm_exp(f32x16& p0, f32x16& p1, const LAS float* bt, int relb, int dq, int hi) {
    if (dq > -191 && dq < 158) {
        const LAS float* bp = bt + relb + 4 * hi;
#pragma unroll
        for (int a = 0; a < 4; ++a) {
            float t0[4], t1[4];
#pragma unroll
            for (int b = 0; b < 4; ++b) { t0[b] = bp[8 * a + b]; t1[b] = bp[32 + 8 * a + b]; }
#pragma unroll
            for (int b = 0; b < 4; ++b) { p0[4 * a + b] += t0[b]; p1[4 * a + b] += t1[b]; }
            SBAR();
        } }
#pragma unroll
    for (int r = 0; r < 16; ++r) p0[r] = __builtin_amdgcn_exp2f(p0[r]);
#pragma unroll
    for (int r = 0; r < 16; ++r) p1[r] = __builtin_amdgcn_exp2f(p1[r]);
}
__device__ __forceinline__ void sm_fin(f32x16& p0, f32x16& p1, float& l_reg, bf16x8& pa0, bf16x8& pa1, bf16x8& pa2, bf16x8& pa3) {
    float ps = 0;
#pragma unroll
    for (int r = 0; r < 16; ++r) ps += p0[r];
#pragma unroll
    for (int r = 0; r < 16; ++r) ps += p1[r];
    { auto rr = __builtin_amdgcn_permlane32_swap(__float_as_uint(ps), __float_as_uint(ps), false, false);
      ps = __uint_as_float(rr[0]) + __uint_as_float(rr[1]); }
    l_reg += ps;
#define PK4(P, BASE, OUT) do { unsigned a0 = cvt_pk_bf16(P[BASE + 0], P[BASE + 1]), a1 = cvt_pk_bf16(P[BASE + 2], P[BASE + 3]);   \
    unsigned b0 = cvt_pk_bf16(P[BASE + 4], P[BASE + 5]), b1 = cvt_pk_bf16(P[BASE + 6], P[BASE + 7]);                              \
    auto r0 = __builtin_amdgcn_permlane32_swap(a0, b0, false, false); auto r1 = __builtin_amdgcn_permlane32_swap(a1, b1, false, false); \
    u32x4 w = {r0[0], r1[0], r0[1], r1[1]}; OUT = *reinterpret_cast<bf16x8*>(&w); } while (0)
    PK4(p0, 0, pa0); PK4(p0, 8, pa1); PK4(p1, 0, pa2); PK4(p1, 8, pa3);
#undef PK4
}
__device__ __forceinline__ void attn_dual(f32x16 (&o1)[4], f32x16 (&o2)[4], const bf16_t* __restrict__ Qg, const bf16_t* __restrict__ Kh, const bf16_t* __restrict__ Vh, LAS char* lds, int q0w) {
    int tz_ = threadIdx.x; asm volatile("" : "+v"(tz_));
    const int tid = tz_, wid = __builtin_amdgcn_readfirstlane(tid >> 6), lane = tid & 63, r32 = lane & 31, hi = lane >> 5;
    LAS char* K_lds = lds + OFF_K; LAS char* V_lds = lds + OFF_V; LAS char* Qs = lds + OFF_Q + wid * 8192;
    LAS float* ws = (LAS float*)(lds + OFF_WS) + wid * 64; LAS float* li_l = ws;
    const LAS float* bt = (const LAS float*)(lds + OFF_BT);
    float l1 = 0.f, l2 = 0.f;
#pragma unroll
    for (int d = 0; d < 4; ++d) { o1[d] = (f32x16){}; o2[d] = (f32x16){}; }
#pragma unroll
    for (int i = 0; i < 8; ++i) { const int ci = i * 64 + lane, row = (ci >> 2) & 31, c = (ci >> 7) * 4 + ((ci & 3) ^ ((row >> 2) & 3));
        __builtin_amdgcn_global_load_lds((const unsigned*)(Qg + (size_t)row * 1024 + c * 8), (LAS unsigned*)(Qs + i * 1024), 16, 0, 0); }
    const int kq0 = r32 * 64 + ((hi ^ ((r32 >> 2) & 3)) << 4), kq1 = r32 * 64 + (((2 + hi) ^ ((r32 >> 2) & 3)) << 4);
    unsigned ko0, vo0;
    { const int p = wid * 2;
        { const int ci = p * 64 + lane, row = (ci >> 2) & 63, c = (ci >> 8) * 4 + ((ci & 3) ^ ((row >> 2) & 3)); ko0 = (unsigned)(row * 1024 + c * 8) * 2u; }
        { const int ci = p * 64 + lane, sub = ci >> 5, kk = (sub >> 2) * 8 + ((ci >> 2) & 7), c = (sub & 3) * 32 + (ci & 3) * 8;
          const int k = (kk & ~0xC) | ((kk & 4) << 1) | ((kk & 8) >> 1); vo0 = (unsigned)(k * 1024 + c) * 2u; } }
    const unsigned pw = (unsigned)wid * 2048u;
#define DMA_K(buf, k0) do { const char* g_ = (const char*)(Kh + (size_t)(k0) * 1024); \
    __builtin_amdgcn_global_load_lds((const unsigned*)(g_ + ko0), (LAS unsigned*)(K_lds + (buf) * SHM_T + pw), 16, 0, 0); \
    __builtin_amdgcn_global_load_lds((const unsigned*)(g_ + ko0 + 32768u), (LAS unsigned*)(K_lds + (buf) * SHM_T + pw + 1024), 16, 0, 0); } while (0)
#define DMA_V(buf, k0) do { const char* g_ = (const char*)(Vh + (size_t)(k0) * 1024); \
    __builtin_amdgcn_global_load_lds((const unsigned*)(g_ + vo0), (LAS unsigned*)(V_lds + (buf) * SHM_T + pw), 16, 0, 0); \
    __builtin_amdgcn_global_load_lds((const unsigned*)(g_ + vo0 + 128u), (LAS unsigned*)(V_lds + (buf) * SHM_T + pw + 1024), 16, 0, 0); } while (0)
    const int vbb = (int)(size_t)V_lds + v_rd_base(lane);
    const int relq = 256 - (q0w + r32);
    f32x16 pA0, pA1, pB0, pB1; bf16x8 pa0, pa1, pa2, pa3; constexpr int NT = S / KVBLK;
    DMA_K(0, 0); DMA_K(1, KVBLK); DMA_V(0, 0);
    asm volatile("s_waitcnt vmcnt(0) lgkmcnt(0)" ::: "memory"); __syncthreads();
    qkt<0>(pA0, pA1, K_lds, Qs, kq0, kq1); sm_exp(pA0, pA1, bt, relq, 0 - q0w, hi);
    int kb = 0, vb = 0;
    int ureg = (0 - q0w <= -191) ? 0 : ((0 - q0w >= 158) ? 2 : 1);
    for (int j = 0; j < NT; ++j) {
        asm volatile("s_waitcnt vmcnt(0)" ::: "memory"); __syncthreads();
        const int kb1 = kb == 2 ? 0 : kb + 1, kb2 = kb1 == 2 ? 0 : kb1 + 1;
        if (j + 2 < NT) DMA_K(kb2, (j + 2) * KVBLK);
        if (j + 1 < NT) DMA_V(vb ^ 1, (j + 1) * KVBLK);
        const int dq = j * KVBLK - q0w;
        { const int u = (dq <= -191) ? 0 : ((dq >= 158) ? 2 : 1);
          if (u != ureg) {
              const float cp = ureg == 0 ? bt[0] : (ureg == 2 ? bt[511] : 0.f), cn = u == 0 ? bt[0] : (u == 2 ? bt[511] : 0.f);
              const float f = __builtin_amdgcn_exp2f(cp - cn);
#pragma unroll
              for (int d = 0; d < 4; ++d) { o1[d] = o1[d] * f; o2[d] = o2[d] * f; }
              l1 *= f; l2 *= f; ureg = u; } }
        sm_fin(pA0, pA1, l1, pa0, pa1, pa2, pa3); SBAR();
        qkt<1>(pB0, pB1, K_lds + kb * SHM_T, Qs, kq0, kq1); SBAR();
        pv_d0(o1, vbb + vb * SHM_T, pa0, pa1, pa2, pa3);
        sm_exp(pB0, pB1, bt, relq + j * KVBLK, dq, hi);
        sm_fin(pB0, pB1, l2, pa0, pa1, pa2, pa3); SBAR();
        if (j + 1 < NT) { qkt<0>(pA0, pA1, K_lds + kb1 * SHM_T, Qs, kq0, kq1); SBAR(); }
        pv_d0(o2, vbb + vb * SHM_T, pa0, pa1, pa2, pa3);
        if (j + 1 < NT) sm_exp(pA0, pA1, bt, relq + (j + 1) * KVBLK, dq + KVBLK, hi);
        kb = kb1; vb ^= 1;
    }
    if (hi == 0) li_l[r32] = l1; asm volatile("s_waitcnt lgkmcnt(0)" ::: "memory");
#pragma unroll
    for (int r = 0; r < 16; ++r) { const float rl = __builtin_amdgcn_rcpf(li_l[crow(r, hi)]);
#pragma unroll
        for (int d = 0; d < 4; ++d) o1[d][r] *= rl; }
    asm volatile("s_waitcnt lgkmcnt(0)" ::: "memory");
    if (hi == 0) li_l[r32] = l2; asm volatile("s_waitcnt lgkmcnt(0)" ::: "memory");
#pragma unroll
    for (int r = 0; r < 16; ++r) { const float rl = __builtin_amdgcn_rcpf(li_l[crow(r, hi)]);
#pragma unroll
        for (int d = 0; d < 4; ++d) o2[d][r] *= rl; }
#undef DMA_K
#undef DMA_V
}
}

__device__ __forceinline__ int t5_bucket(int rel) {
    const int side = rel > 0 ? 16 : 0; const int n = rel < 0 ? -rel : rel;
    if (n < 8) return side + n;
    const float v = logf((float)n / 8.0f) / 2.7725887f * 8.0f;
    int large = 8 + (int)v; large = large < 15 ? large : 15;
    return side + large;
}

struct Args { GAS const float* in[28]; GAS float* out; GAS unsigned char* ws; int ph_lo, ph_hi; };
typedef const Args __attribute__((address_space(4))) CArgs;
struct LayerW { bf16_t *WIN, *WGLU, *WBR, *WOUT, *WGU, *WD, *F, *BO; float *KTAB, *WRT; };
__device__ __forceinline__ LayerW layer_w(unsigned char* ws, int l) {
    unsigned char* b = ws + WS_LW + (size_t)l * LW_SIZE; LayerW w;
    w.WIN = (bf16_t*)(b + LW_WIN); w.WGLU = (bf16_t*)(b + LW_WGLU); w.WBR = (bf16_t*)(b + LW_WBR); w.WOUT = (bf16_t*)(b + LW_WOUT); w.WGU = (bf16_t*)(b + LW_WGU);
    w.WD = (bf16_t*)(b + LW_WD); w.F = (bf16_t*)(b + LW_F); w.BO = (bf16_t*)(b + LW_BO); w.KTAB = (float*)(b + LW_KTAB); w.WRT = (float*)(b + LW_WRT); return w;
}
enum { I_X = 0, I_WIN, I_ARE, I_AIM, I_LDT, I_BRE, I_BIM, I_CRE, I_CIM, I_SD, I_WGLU, I_WSB, I_QG, I_KG, I_LQ1, I_LK1, I_LQ2, I_LK2, I_SUBLN, I_WAB, I_RELB, I_WOUT,
       I_NMIX, I_NFFN, I_WR, I_WEG, I_WEU, I_WED };

struct TItem { const float* src; bf16_t* dst; const float* gain; int N, ldd, rowmode, f8; };
__device__ __forceinline__ void t_load(const TItem& t, f32x4 (&v)[16], int lane) {
    const int r = lane >> 4, q = lane & 15;
#pragma unroll
    for (int j = 0; j < 16; ++j) v[j] = __builtin_nontemporal_load((const f32x4*)(t.src + (size_t)(4 * j + r) * t.N + 4 * q));
}
__device__ __forceinline__ void t_lds(const f32x4 (&v)[16], LAS float* scr, int lane) {
    const int r = lane >> 4, q = lane & 15;
#pragma unroll
    for (int j = 0; j < 16; ++j) { LAS float* s = scr + (4 * j + r) * 65 + 4 * q; s[0] = v[j][0]; s[1] = v[j][1]; s[2] = v[j][2]; s[3] = v[j][3]; }
}
__device__ __forceinline__ void t_store(const TItem& t, int n0, LAS float* scr, int lane) {
    const int c = lane & 7;
    float gn[8];
#pragma unroll
    for (int i = 0; i < 8; ++i) gn[i] = t.gain ? t.gain[8 * c + i] : 1.f;
#pragma unroll
    for (int j = 0; j < 8; ++j) { const int n = (lane >> 3) + 8 * j; const LAS float* s = scr + (8 * c) * 65 + n;
        u32x4 o; o.x = cvt_pk_bf16(s[0 * 65] * gn[0], s[1 * 65] * gn[1]); o.y = cvt_pk_bf16(s[2 * 65] * gn[2], s[3 * 65] * gn[3]);
        o.z = cvt_pk_bf16(s[4 * 65] * gn[4], s[5 * 65] * gn[5]); o.w = cvt_pk_bf16(s[6 * 65] * gn[6], s[7 * 65] * gn[7]);
        const int ng = n0 + n; const int drow = t.rowmode == 0 ? ng : ((ng >> 7) * 256 + ((ng >> 5) & 3) * 64 + (ng & 31) + (t.rowmode == 2 ? 32 : 0));
        if (t.f8) { const f32x4 a = (f32x4){s[0 * 65] * gn[0], s[1 * 65] * gn[1], s[2 * 65] * gn[2], s[3 * 65] * gn[3]} * W8_SCALE, b = (f32x4){s[4 * 65] * gn[4], s[5 * 65] * gn[5], s[6 * 65] * gn[6], s[7 * 65] * gn[7]} * W8_SCALE;
            *(u32x2*)((unsigned char*)t.dst + (size_t)drow * t.ldd + 8 * c) = pack8_fp8(a, b); }
        else *(u32x4*)(t.dst + (size_t)drow * t.ldd + 8 * c) = o; }
}

constexpr int IT_WIN = (D / 64) * (INC / 64), IT_GLU = 16 * 16, IT_BR = 16 * 32, IT_OUT = 32 * 32, IT_E = 32 * 32;
constexpr int IT_LAYER0 = IT_WIN + IT_GLU + 2 * IT_BR + IT_OUT + 2 * NE * IT_E;
constexpr int IT_DOWN = NE * IT_E;
__device__ __forceinline__ TItem make_item(const float* src, bf16_t* dst, const float* gain, int N, int ldd, int rowmode, int f8, int r, int& n0) {
    const int nblk = N / 64, k0 = 64 * (r / nblk); n0 = 64 * (r % nblk);
    TItem t; t.src = src + (size_t)k0 * N + n0; t.dst = f8 ? (bf16_t*)((unsigned char*)dst + k0) : dst + k0; t.gain = gain ? gain + k0 : nullptr; t.N = N; t.ldd = ldd; t.rowmode = rowmode; t.f8 = f8; return t; }
struct DecMain { CArgs* ap; unsigned char* ws;
    __device__ __forceinline__ TItem operator()(int it, int& n0) const { CArgs& args = *ap;
        const int l = it / IT_LAYER0; int r = it % IT_LAYER0; const LayerW w = layer_w(ws, l);
        if (r < IT_WIN) { const bool gate = (r % (INC / 64)) >= 64;
            return gate ? make_item((const float*)args.in[I_WIN] + (size_t)l * D * INC, (bf16_t*)((unsigned char*)w.WIN + (size_t)16 * MiB - (size_t)4096 * D), (const float*)args.in[I_NMIX] + l * D, INC, D, 0, 1, r, n0)
                        : make_item((const float*)args.in[I_WIN] + (size_t)l * D * INC, w.WIN, (const float*)args.in[I_NMIX] + l * D, INC, D, 0, 0, r, n0); }
        if ((r -= IT_WIN) < IT_GLU) return make_item((const float*)args.in[I_WGLU] + (size_t)l * SSMW * SSMW, w.WGLU, nullptr, SSMW, SSMW, 0, 0, r, n0);
        if ((r -= IT_GLU) < IT_BR) return make_item((const float*)args.in[I_WSB] + (size_t)l * SSMW * D, w.WBR, nullptr, D, 2048, 0, 0, r, n0);
        if ((r -= IT_BR) < IT_BR) return make_item((const float*)args.in[I_WAB] + (size_t)l * 1024 * D, w.WBR + 1024, nullptr, D, 2048, 0, 0, r, n0);
        if ((r -= IT_BR) < IT_OUT) return make_item((const float*)args.in[I_WOUT] + (size_t)l * D * D, w.WOUT, nullptr, D, D, 0, 0, r, n0);
        r -= IT_OUT; const int which = r / (NE * IT_E), e = (r / IT_E) % NE; r = r % IT_E; const size_t eo = ((size_t)l * NE + e) * D * FF;
        return make_item((const float*)args.in[which == 0 ? I_WEG : I_WEU] + eo, (bf16_t*)((unsigned char*)w.WGU + (size_t)e * 4096 * D), (const float*)args.in[I_NFFN] + l * D, FF, D, which == 0 ? 1 : 2, 1, r, n0); } };
struct DecDown { CArgs* ap; unsigned char* ws; int l;
    __device__ __forceinline__ TItem operator()(int it, int& n0) const { CArgs& args = *ap; const LayerW w = layer_w(ws, l);
        const int e = it / IT_E, r = it % IT_E; const size_t eo = ((size_t)l * NE + e) * D * FF;
        return make_item((const float*)args.in[I_WED] + eo, (bf16_t*)((unsigned char*)w.WD + (size_t)e * D * FF), nullptr, D, FF, 0, 1, r, n0); } };
template <class Dec> __device__ __forceinline__ void convert_items(const Dec& dec, int first, int end, int step, LAS float* scr, int lane) {
    f32x4 tv[16]; int n0c = 0, n0n = 0; TItem cur, nxt; cur.src = nullptr; cur.dst = nullptr; cur.gain = nullptr; cur.N = 0; cur.ldd = 0; cur.rowmode = 0; cur.f8 = 0; nxt = cur;
    int it = first;
    if (it < end) { cur = dec(it, n0c); t_load(cur, tv, lane); }
    for (; it < end; it += step) {
        t_lds(tv, scr, lane);
        if (it + step < end) { nxt = dec(it + step, n0n); t_load(nxt, tv, lane); }
        LDS_WAIT(); asm volatile("" ::: "memory");
        t_store(cur, n0c, scr, lane);
        LDS_WAIT(); asm volatile("" ::: "memory");
        cur = nxt; n0c = n0n; }
}

template <bool ROUTER>
__device__ __forceinline__ void row_pass(const float* xrow, bf16_t* xb, float* rinv_out, const LAS float* WtL, float* afft, int row, int lane, unsigned char* xb8 = nullptr) {
    f32x4 v[8]; float ss = 0.f;
#pragma unroll
    for (int j = 0; j < 8; ++j) { v[j] = *(const f32x4*)(xrow + 4 * lane + 256 * j); ss += v[j][0] * v[j][0] + v[j][1] * v[j][1] + v[j][2] * v[j][2] + v[j][3] * v[j][3]; }
    ss = wave_sum(ss);
    const float rinv = __builtin_amdgcn_rsqf(ss * (1.f / D) + EPS);
#pragma unroll
    for (int j = 0; j < 8; ++j) { u32x2 w; w.x = cvt_pk_bf16(v[j][0], v[j][1]); w.y = cvt_pk_bf16(v[j][2], v[j][3]); *(u32x2*)(xb + 4 * lane + 256 * j) = w; }
    if (xb8) {
#pragma unroll
        for (int j = 0; j < 8; ++j) { int w8 = 0; w8 = __builtin_amdgcn_cvt_pk_fp8_f32(v[j][0], v[j][1], w8, false); w8 = __builtin_amdgcn_cvt_pk_fp8_f32(v[j][2], v[j][3], w8, true); *(int*)(xb8 + 4 * lane + 256 * j) = w8; } }
    if (lane == 0) *rinv_out = rinv;
    if constexpr (ROUTER) {
        float lg[16];
#pragma unroll
        for (int e = 0; e < 16; ++e) { float a = 0.f;
#pragma unroll
            for (int j = 0; j < 8; ++j) { const f32x4 w = *(const LAS f32x4*)(WtL + e * 2048 + 4 * lane + 256 * j); a += v[j][0] * w[0] + v[j][1] * w[1] + v[j][2] * w[2] + v[j][3] * w[3]; }
            lg[e] = wave_sum(a) * rinv; }
        float mx = lg[0];
#pragma unroll
        for (int e = 1; e < 16; ++e) mx = fmaxf(mx, lg[e]);
        float sum = 0.f;
#pragma unroll
        for (int e = 0; e < 16; ++e) { lg[e] = __expf(lg[e] - mx); sum += lg[e]; }
        const float inv = 1.f / sum;
        float mine = 0.f;
#pragma unroll
        for (int e = 0; e < 16; ++e) mine = (lane == e) ? lg[e] * inv : mine;
        if (lane < 16) afft[(size_t)lane * S + row] = mine;
    }
}

__device__ __forceinline__ void router_row(const u32x2 (&xw)[8], float* rinv_out, const LAS float* WtL, float* afft, int row, int lane) {
    f32x4 v[8]; float ss = 0.f;
#pragma unroll
    for (int j = 0; j < 8; ++j) { const u32x2 w = xw[j]; v[j] = (f32x4){bf_lo(w.x), bf_hi(w.x), bf_lo(w.y), bf_hi(w.y)}; ss += v[j][0] * v[j][0] + v[j][1] * v[j][1] + v[j][2] * v[j][2] + v[j][3] * v[j][3]; }
    ss = wave_sum(ss);
    const float rinv = __builtin_amdgcn_rsqf(ss * (1.f / D) + EPS);
    if (lane == 0) *rinv_out = rinv;
    float lg[16];
#pragma unroll
    for (int e = 0; e < 16; ++e) { float a = 0.f;
#pragma unroll
        for (int j = 0; j < 8; ++j) { const f32x4 w = *(const LAS f32x4*)(WtL + e * 2048 + 4 * lane + 256 * j); a += v[j][0] * w[0] + v[j][1] * w[1] + v[j][2] * w[2] + v[j][3] * w[3]; }
        lg[e] = wave_sum(a) * rinv; }
    float mx = lg[0];
#pragma unroll
    for (int e = 1; e < 16; ++e) mx = fmaxf(mx, lg[e]);
    float sum = 0.f;
#pragma unroll
    for (int e = 0; e < 16; ++e) { lg[e] = __expf(lg[e] - mx); sum += lg[e]; }
    const float inv = 1.f / sum;
    float mine = 0.f;
#pragma unroll
    for (int e = 0; e < 16; ++e) mine = (lane == e) ? lg[e] * inv : mine;
    if (lane < 16) afft[(size_t)lane * S + row] = mine;
}
__device__ __forceinline__ int block_sum_i(int v, LAS int* red, int wave, int lane) {
#pragma unroll
    for (int o = 1; o < 64; o <<= 1) v += __shfl_xor(v, o);
    __syncthreads();
    if (lane == 0) red[wave] = v;
    __syncthreads();
    int t = 0;
#pragma unroll
    for (int w = 0; w < 8; ++w) t += red[w];
    return t;
}

__global__ void __launch_bounds__(512, 2) fwd(Args kargs) {
    extern __shared__ __attribute__((aligned(16))) unsigned char lds_raw[];
    LAS unsigned char* lds = (LAS unsigned char*)lds_raw;
    volatile LAS unsigned* MISC = (volatile LAS unsigned*)(lds + MISC_OFF);
    const int G = gridDim.x;
    unsigned* ctl = (unsigned*)((unsigned char*)kargs.ws + WS_CTL);
    if (threadIdx.x < 64) MISC[threadIdx.x] = 0u;
    __syncthreads();
    XcdBarrier bar; bar.bar = ctl + 1024; bar.x = 0; bar.st = nullptr;
    if (!MK_PER_PHASE) bar = xcd_barrier_post(ctl + 1024, MISC + 8);
    const int lo = kargs.ph_lo, hi = kargs.ph_hi;
#ifndef PH_MASK
#define PH_MASK 0xFFFF
#endif
#define PON(b) ((PH_MASK >> (b)) & 1)
#ifndef REP_MASK
#define REP_MASK 0
#endif
#define REPS(b) (((REP_MASK >> (b)) & 1) ? 2 : 1)
#define IN(k) (lo <= (k) && (k) < hi)
#define PH_ENTER int tz0_ = threadIdx.x; asm volatile("" : "+v"(tz0_)); int bz0_ = blockIdx.x; asm volatile("" : "+s"(bz0_)); \
    const int tid = tz0_, lane = tid & 63, wave = __builtin_amdgcn_readfirstlane(tid >> 6), bx = bz0_, vcu = (G % 8 == 0) ? (bx % 8) * (G / 8) + bx / 8 : bx, gw = vcu * 8 + wave, NGW = G * 8; \
    (void)lane; (void)wave; (void)bx; (void)vcu; (void)gw; (void)NGW; \
      \
    CArgs* ap_ = (CArgs*)__builtin_amdgcn_kernarg_segment_ptr(); asm volatile("" : "+s"(ap_)); CArgs& args = *ap_; \
    unsigned char* const ws = (unsigned char*)args.ws; unsigned char* const act = ws + WS_ACT; unsigned char* const sm = act + A_SMALL; (void)sm; \
    bf16_t* const XB = (bf16_t*)(act + A_XB); unsigned char* const XB8 = act + A_O1; (void)XB8; bf16_t* const XB1 = (bf16_t*)(act + A_XB1); bf16_t* const UA = (bf16_t*)(act + A_UA); \
    bf16_t* const Qb = (bf16_t*)(act + A_Q); bf16_t* const Kb = (bf16_t*)(act + A_K); bf16_t* const Vb = (bf16_t*)(act + A_V); bf16_t* const Gb = (bf16_t*)(act + A_G); \
    float* const SSUM = (float*)(act + A_SSUM); bf16_t* const Yb = (bf16_t*)(act + A_Y); bf16_t* const YO = (bf16_t*)(act + A_YO); \
    bf16_t* const MG = (bf16_t*)(act + A_MG); float* const XA = (float*)(act + A_XA); bf16_t* const XG = (bf16_t*)(act + A_XG); bf16_t* const Hb = (bf16_t*)(act + A_H); bf16_t* const YX = (bf16_t*)(act + A_YX); \
    float* const RINV = (float*)(sm + SM_RINV); float* const RINV2 = (float*)(sm + SM_RINV2); float* const AFFT = (float*)(sm + SM_AFFT); int* const IDX = (int*)(sm + SM_IDX); \
    float* const GATE = (float*)(sm + SM_GATE); float* const RSL = (float*)(sm + SM_RSL); int* const INV = (int*)(sm + SM_INV); float* const LAMS = (float*)(sm + SM_LAM); \
    (void)XB; (void)XB1; (void)UA; (void)Qb; (void)Kb; (void)Vb; (void)Gb; (void)SSUM; (void)Yb; (void)YO; (void)MG; (void)XA; (void)XG; (void)Hb; (void)YX; \
    (void)RINV; (void)RINV2; (void)AFFT; (void)IDX; (void)GATE; (void)RSL; (void)INV; (void)LAMS;
#define INP(i) ((const float*)args.in[i])
#define OUTP ((float*)args.out)
#define LAYER_ENTER const LayerW w = layer_w(ws, l); const float lam_init = (l == 0) ? 0.2f : 0.35550906759f;   \
    (void)w; (void)lam_init;
#define SEAM(k) do { if (IN(k) && IN((k) + 1)) { if (!MK_PER_PHASE) xcd_barrier(bar); } } while (0)

    if (PON(0) && IN(0)) _Pragma("nounroll") for (int rep_ = 0; rep_ < REPS(0); ++rep_) { PH_ENTER
        LAS float* scr = (LAS float*)(lds + wave * 16640);
        convert_items(DecMain{ap_, ws}, gw, NL * IT_LAYER0, NGW, scr, lane);
        for (int i = gw * 64 + lane; i < NL * NE * D; i += NGW * 64) { const int l = i / (NE * D), e = (i / D) % NE, k = i % D;
            layer_w(ws, l).WRT[e * D + k] = INP(I_NFFN)[l * D + k] * INP(I_WR)[((size_t)l * D + k) * NE + e]; }
        for (int it = gw; it < NL * NGRP * 2 * TC; it += NGW) {
            const int l = it / (NGRP * 2 * TC), g = (it / (2 * TC)) % NGRP, dir = (it / TC) % 2, dl = it % TC;
            const size_t pb = ((size_t)(l * 2 + dir) * NGRP + g);
            const float are = INP(I_ARE)[pb * NST + lane], aim = INP(I_AIM)[pb * NST + lane], dt = expf(INP(I_LDT)[pb]);
            const float mag1 = expf(are * dt), ang1 = aim * dt, b1r = mag1 * cosf(ang1), b1i = mag1 * sinf(ang1);
            const float nr = b1r - 1.f, ni = b1i, den = are * are + aim * aim;
            const float cr = (nr * are + ni * aim) / den, ci = (ni * are - nr * aim) / den;
            const float magd = expf(are * dt * (float)dl), angd = aim * dt * (float)dl, pr = magd * cosf(angd), pi = magd * sinf(angd);
            const float wre = pr * cr - pi * ci, wim = pr * ci + pi * cr;
            const int p = lane >> 2, q0 = (lane & 3) * 4;
            const float* cre = INP(I_CRE) + (pb * GP + p) * NST; const float* cim = INP(I_CIM) + (pb * GP + p) * NST;
            const float* bre = INP(I_BRE) + pb * NST * GP + q0; const float* bim = INP(I_BIM) + pb * NST * GP + q0;
            f32x4 out = {0.f, 0.f, 0.f, 0.f};
            for (int n = 0; n < NST; ++n) {
                const float wr_ = __shfl(wre, n), wi_ = __shfl(wim, n);
                const float c_r = cre[n], c_i = cim[n];
                const float er = c_r * wr_ - c_i * wi_, ei = c_r * wi_ + c_i * wr_;
                const f32x4 br = *(const f32x4*)(bre + n * GP), bi = *(const f32x4*)(bim + n * GP);
                out += br * er - bi * ei;
            }
            *(f32x4*)(layer_w(ws, l).KTAB + ((((size_t)g * 2 + dir) * TC + dl) * GP + p) * GP + q0) = out;
        }
        for (int it = gw; it < NL * NGRP * 2 * TC; it += NGW) {
            const int l = it / (NGRP * 2 * TC), g = (it / (2 * TC)) % NGRP, dir = (it / TC) % 2, t = it % TC;
            const LayerW w = layer_w(ws, l);
            const size_t pb = ((size_t)(l * 2 + dir) * NGRP + g);
            const float are = INP(I_ARE)[pb * NST + lane], aim = INP(I_AIM)[pb * NST + lane], dt = expf(INP(I_LDT)[pb]);
            { const float e = dir == 0 ? (float)(t + 1) : (float)(TC - t); const float mg = expf(are * dt * e), an = aim * dt * e, pr = mg * cosf(an), pi = mg * sinf(an);
              float crv[GP], civ[GP];
#pragma unroll
              for (int p = 0; p < GP; ++p) { crv[p] = INP(I_CRE)[(pb * GP + p) * NST + lane]; civ[p] = INP(I_CIM)[(pb * GP + p) * NST + lane]; }
#pragma unroll
              for (int p = 0; p < GP; ++p) { bf16_t* o = w.BO + ((size_t)g * 512 + t * 16 + p) * UAW + 512 + dir * 128 + lane;
                  o[0] = f2bf(crv[p] * pr - civ[p] * pi); o[64] = f2bf(-(crv[p] * pi + civ[p] * pr)); } }
            { const float mag1 = expf(are * dt), ang1 = aim * dt, b1r = mag1 * cosf(ang1), b1i = mag1 * sinf(ang1);
              const float nr = b1r - 1.f, ni = b1i, den = are * are + aim * aim;
              const float cr = (nr * are + ni * aim) / den, ci = (ni * are - nr * aim) / den;
              const float e = dir == 0 ? (float)(TC - 1 - t) : (float)t; const float mg = expf(are * dt * e), an = aim * dt * e, pr = mg * cosf(an), pi = mg * sinf(an);
              const float wre = pr * cr - pi * ci, wim = pr * ci + pi * cr;
              const float* bre = INP(I_BRE) + (pb * NST + lane) * GP; const float* bim = INP(I_BIM) + (pb * NST + lane) * GP;
              f32x4 re[4], im[4];
#pragma unroll
              for (int q = 0; q < 4; ++q) { const f32x4 br = *(const f32x4*)(bre + 4 * q), bi = *(const f32x4*)(bim + 4 * q); re[q] = br * wre - bi * wim; im[q] = bi * wre + br * wim; }
              bf16_t* o = w.F + ((size_t)g * 256 + dir * 128 + lane) * 512 + t * 16;
              *(u32x4*)o = pack8(re[0], re[1]); *(u32x4*)(o + 8) = pack8(re[2], re[3]);
              *(u32x4*)(o + 64 * 512) = pack8(im[0], im[1]); *(u32x4*)(o + 64 * 512 + 8) = pack8(im[2], im[3]); }
        }
        for (int m = gw; m < S; m += NGW) row_pass<false>(INP(I_X) + (size_t)m * D, XB + (size_t)m * D, RINV + m, nullptr, nullptr, m, lane, XB8 + (size_t)m * D);
        if (gw < NL) { const int l = gw; const float a = wave_sum(INP(I_LQ1)[l * QKD + lane] * INP(I_LK1)[l * QKD + lane]);
            const float b = wave_sum(INP(I_LQ2)[l * QKD + lane] * INP(I_LK2)[l * QKD + lane]);
            if (lane == 0) LAMS[l] = expf(a) - expf(b) + ((l == 0) ? 0.2f : 0.35550906759f); }
        for (int i = gw * 64 + lane; i < NH * 512; i += NGW * 64) { const int h = i >> 9, rel = (i & 511) - 256;
            ((float*)(sm + SM_BTAB))[i] = INP(I_RELB)[t5_bucket(rel) * NH + h] * LOG2E; }
    }
    SEAM(0);

    for (int l = 0; l < NL; ++l) {
        const int pbase = 2 + l * 14;
        if (PON(2) && IN(pbase + 0)) _Pragma("nounroll") for (int rep_ = 0; rep_ < REPS(2); ++rep_) { PH_ENTER LAYER_ENTER
            { pg::SchedGrid Sg; Sg.init(XB, D, w.WIN, D, S, 4096, G, bx);
              EpiInProj E{RINV, UA, Qb, Kb, Vb, Gb, INP(I_QG) + l * QKD, INP(I_KG) + l * QKD};
              pg::gemm_phase(lds, D, D, D, Sg, E); }
            { pg::SchedGrid Sg; Sg.init(XB8, D, (unsigned char*)w.WIN + (size_t)16 * MiB, D, S, 4096, G, bx, 1);
              EpiGates E{RINV, Gb};
              pg::gemm_phase<EpiGates, pg::SchedGrid, true, E8_ONE, E8_W>(lds, D, D, D, Sg, E); }
        }
        SEAM(pbase + 0);
        if (PON(3) && IN(pbase + 1)) _Pragma("nounroll") for (int rep_ = 0; rep_ < REPS(3); ++rep_) { PH_ENTER LAYER_ENTER
            pg::SchedGroup Sg; Sg.init(UA, UAW, (size_t)NCH * UAW * 2, w.F, 512, (size_t)256 * 512 * 2, 1, 1, NGRP, G, vcu);
            EpiSsum E{SSUM};
            pg::gemm_phase(lds, 512, UAW, 512, Sg, E);
            if (vcu >= NGRP) convert_items(DecDown{ap_, ws, l}, (vcu - NGRP) * 8 + wave, 4096, (G - NGRP) * 8, (LAS float*)(lds + wave * 16640), lane);
            if (vcu >= NGRP) for (long i = (long)((vcu - NGRP) * 8 + wave) * 64 + lane; i < (long)NGRP * 512 * 64; i += (long)(G - NGRP) * 8 * 64) {
            const int l2 = l, g = (int)(i / (512 * 64)) % NGRP, rr = (int)(i / 64) % 512, kc = (int)(i % 64);
            const int t = rr >> 4, p = rr & 15, tau = kc >> 1, q0 = (kc & 1) * 8;
            const LayerW w2 = layer_w(ws, l2);
            const float* kf = w2.KTAB + (((size_t)g * 2 + 0) * TC) * 256; const float* kb = w2.KTAB + (((size_t)g * 2 + 1) * TC) * 256;
            f32x4 a, b;
            if (tau < t) { const float* s = kf + ((t - tau) * GP + p) * GP + q0; a = *(const f32x4*)s; b = *(const f32x4*)(s + 4); }
            else if (tau > t) { const float* s = kb + ((tau - t) * GP + p) * GP + q0; a = *(const f32x4*)s; b = *(const f32x4*)(s + 4); }
            else { const float* s = kf + p * GP + q0; const float* s2 = kb + p * GP + q0; a = *(const f32x4*)s + *(const f32x4*)s2; b = *(const f32x4*)(s + 4) + *(const f32x4*)(s2 + 4);
                const float dd = INP(I_SD)[l2 * SSMW + g * GP + p];
#pragma unroll
                for (int j = 0; j < 4; ++j) { if (q0 + j == p) a[j] += dd; if (q0 + 4 + j == p) b[j] += dd; } }
            *(u32x4*)(w2.BO + ((size_t)g * 512 + rr) * UAW + tau * 16 + q0) = pack8(a, b);
        }
            if (vcu < NGRP && wave < 2) {
                const int g = vcu, dir = wave; const size_t pb = ((size_t)(l * 2 + dir) * NGRP + g);
                const float are = INP(I_ARE)[pb * NST + lane], aim = INP(I_AIM)[pb * NST + lane], dt = expf(INP(I_LDT)[pb]);
                const float mg = expf(are * dt * (float)TC), an = aim * dt * (float)TC, ar = mg * cosf(an), ai = mg * sinf(an);
                float sr = 0.f, si = 0.f;
                for (int cb = 0; cb < NCH; cb += 8) {
                    float xr[8], xi[8];
#pragma unroll
                    for (int k = 0; k < 8; ++k) { const int c = dir == 0 ? cb + k : NCH - 1 - cb - k; const float* s = SSUM + ((size_t)g * NCH + c) * 256 + dir * 128 + lane; xr[k] = s[0]; xi[k] = s[64]; }
#pragma unroll
                    for (int k = 0; k < 8; ++k) { const int c = dir == 0 ? cb + k : NCH - 1 - cb - k;
                        bf16_t* o = UA + ((size_t)g * NCH + c) * UAW + 512 + dir * 128 + lane; o[0] = f2bf(sr); o[64] = f2bf(si);
                        const float nr = ar * sr - ai * si + xr[k], ni = ar * si + ai * sr + xi[k]; sr = nr; si = ni; }
                }
            }
        }
        SEAM(pbase + 1);
        if (PON(5) && IN(pbase + 3)) _Pragma("nounroll") for (int rep_ = 0; rep_ < REPS(5); ++rep_) { PH_ENTER LAYER_ENTER
            pg::SchedGroup Sg; Sg.init(UA, UAW, (size_t)NCH * UAW * 2, w.BO, UAW, (size_t)512 * UAW * 2, 1, 2, NGRP, G, vcu);
            EpiSsmOut E{Yb};
            pg::gemm_phase(lds, UAW, UAW, UAW, Sg, E);
            if (vcu >= 2 * NGRP) convert_items(DecDown{ap_, ws, l}, 4096 + (vcu - 2 * NGRP) * 8 + wave, 10240, (G - 2 * NGRP) * 8, (LAS float*)(lds + wave * 16640), lane);
        }
        SEAM(pbase + 3);
        if (PON(6) && IN(pbase + 4)) _Pragma("nounroll") for (int rep_ = 0; rep_ < REPS(6); ++rep_) { PH_ENTER LAYER_ENTER
            pg::SchedGrid Sg; Sg.init(Yb, SSMW, w.WGLU, SSMW, S, SSMW, G, bx);
            EpiGlu E{Yb, YO};
            pg::gemm_phase(lds, SSMW, SSMW, SSMW, Sg, E);
            if (bx >= 128) convert_items(DecDown{ap_, ws, l}, 10240 + (bx - 128) * 8 + wave, IT_DOWN, (G - 128) * 8, (LAS float*)(lds + wave * 16640), lane);
        }
        SEAM(pbase + 4);
        if (PON(7) && IN(pbase + 5)) _Pragma("nounroll") for (int rep_ = 0; rep_ < REPS(7); ++rep_) { PH_ENTER LAYER_ENTER
            for (int un = vcu; un < NH * (S / 256); un += G) {
                const int h = un / (S / 256), qb = un % (S / 256);
                __syncthreads();
                { int tb = threadIdx.x; asm volatile("" : "+v"(tb)); ((LAS float*)(lds + att::OFF_BT))[tb] = ((const float*)(sm + SM_BTAB))[h * 512 + tb]; }
                const int q0w = qb * 256 + wave * 32;
                f32x16 o[4];
                { f32x16 o2[4];
                  att::attn_dual(o, o2, Qb + (size_t)q0w * 1024 + h * 128, Kb + h * 128, Vb + h * 128, (LAS char*)lds, q0w);
                  const float lam = LAMS[l];
#pragma unroll
                  for (int d = 0; d < 4; ++d) o[d] = o[d] - o2[d] * lam; }
                { int tz = threadIdx.x; asm volatile("" : "+v"(tz)); const int r32 = tz & 31, hi2 = (tz >> 5) & 1;
                  float ssq[16];
#pragma unroll
                  for (int r = 0; r < 16; ++r) { float s = 0.f;
#pragma unroll
                    for (int d = 0; d < 4; ++d) s += o[d][r] * o[d][r];
                    s += swz_xor<1>(s); s += swz_xor<2>(s); s += swz_xor<4>(s); s += swz_xor<8>(s); s += swz_xor<16>(s);
                    ssq[r] = __builtin_amdgcn_rsqf(s * (1.f / VD) + EPS) * (1.f - lam_init); }
                  bf16_t* yo = YO + (size_t)(q0w + 4 * hi2) * 2048 + 1024 + h * 128 + r32;
#pragma unroll
                  for (int d = 0; d < 4; ++d) { const float gn = INP(I_SUBLN)[l * VD + d * 32 + r32];
#pragma unroll
                    for (int r = 0; r < 16; ++r) yo[(size_t)((r & 3) + 8 * (r >> 2)) * 2048 + d * 32] = f2bf(o[d][r] * ssq[r] * gn); } }
            }
            __syncthreads();
        }
        SEAM(pbase + 5);
        if (PON(8) && IN(pbase + 6)) _Pragma("nounroll") for (int rep_ = 0; rep_ < REPS(8); ++rep_) { PH_ENTER LAYER_ENTER
            pg::SchedGrid Sg; Sg.init(YO, 2048, w.WBR, 2048, S, D, G, bx);
            EpiMerge E{Gb, MG};
            pg::gemm_phase(lds, 2048, 2048, 2048, Sg, E);
        }
        SEAM(pbase + 6);
        if (PON(9) && IN(pbase + 7)) _Pragma("nounroll") for (int rep_ = 0; rep_ < REPS(9); ++rep_) { PH_ENTER LAYER_ENTER
            pg::SchedGrid Sg; Sg.init(MG, D, w.WOUT, D, S, D, G, bx);
            EpiOutProj E{XB, XB1};
            pg::gemm_phase(lds, D, D, D, Sg, E);
        }
        SEAM(pbase + 7);
        if (PON(10) && IN(pbase + 8)) _Pragma("nounroll") for (int rep_ = 0; rep_ < REPS(10); ++rep_) { PH_ENTER LAYER_ENTER
            LAS float* WtL = (LAS float*)lds;
            for (int i = tid; i < NE * D / 4; i += 512) ((LAS f32x4*)WtL)[i] = ((const f32x4*)w.WRT)[i];
            __syncthreads();
            { u32x2 xc[8], xn[8];
#pragma unroll
              for (int j = 0; j < 8; ++j) { xc[j] = (u32x2){0u, 0u}; xn[j] = xc[j]; }
              if (gw < S) {
#pragma unroll
                  for (int j = 0; j < 8; ++j) xc[j] = *(const u32x2*)(XB1 + (size_t)gw * D + 4 * lane + 256 * j); }
              for (int m = gw; m < S; m += NGW) { int lz = lane; asm volatile("" : "+v"(lz));
                  if (m + NGW < S) {
#pragma unroll
                      for (int j = 0; j < 8; ++j) xn[j] = *(const u32x2*)(XB1 + (size_t)(m + NGW) * D + 4 * lz + 256 * j); }
                  router_row(xc, RINV2 + m, WtL, AFFT, m, lz);
#pragma unroll
                  for (int j = 0; j < 8; ++j) xc[j] = xn[j]; } }
            __syncthreads();
        }
        SEAM(pbase + 8);
        if (PON(11) && IN(pbase + 9)) _Pragma("nounroll") for (int rep_ = 0; rep_ < REPS(11); ++rep_) { PH_ENTER LAYER_ENTER
            const int nparts = G / NE > 0 ? G / NE : 1;
            if (vcu < nparts * NE) {
                const int e = vcu / nparts, part = vcu % nparts, per = (CAP + nparts - 1) / nparts, slo = part * per, shi = (slo + per < CAP) ? slo + per : CAP;
                LAS int* red = (LAS int*)lds; LAS int* list = (LAS int*)(lds + 1024);
                unsigned bits[16]; { const float* a = AFFT + (size_t)e * S + tid * 16;
#pragma unroll
                    for (int q = 0; q < 4; ++q) { const f32x4 v = *(const f32x4*)(a + 4 * q); bits[4 * q] = __float_as_uint(v[0]); bits[4 * q + 1] = __float_as_uint(v[1]); bits[4 * q + 2] = __float_as_uint(v[2]); bits[4 * q + 3] = __float_as_uint(v[3]); } }
                unsigned T = 0u;
                for (int bit = 30; bit >= 0; --bit) { const unsigned cand = T | (1u << bit); int c = 0;
#pragma unroll
                    for (int i = 0; i < 16; ++i) c += bits[i] >= cand ? 1 : 0;
                    if (block_sum_i(c, red, wave, lane) >= CAP) T = cand; }
                int cg = 0, ce = 0;
#pragma unroll
                for (int i = 0; i < 16; ++i) { cg += bits[i] > T ? 1 : 0; ce += bits[i] == T ? 1 : 0; }
                const int need_eq = CAP - block_sum_i(cg, red, wave, lane);
                int sg = cg, se = ce;
#pragma unroll
                for (int o = 1; o < 64; o <<= 1) { const int a = __shfl_up(sg, o), b = __shfl_up(se, o); if (lane >= o) { sg += a; se += b; } }
                __syncthreads();
                if (lane == 63) { red[16 + wave] = sg; red[32 + wave] = se; }
                __syncthreads();
                int og = 0, oe = 0;
#pragma unroll
                for (int wv = 0; wv < 8; ++wv) if (wv < wave) { og += red[16 + wv]; oe += red[32 + wv]; }
                int gbef = og + sg - cg, ebef = oe + se - ce;
                const bool inv_mine = (tid * nparts) / 512 == part;
#pragma unroll
                for (int i = 0; i < 16; ++i) { const int tok = tid * 16 + i; const bool isg = bits[i] > T, ise = bits[i] == T; const bool sel = isg || (ise && ebef < need_eq);
                    const int slot = gbef + (ebef < need_eq ? ebef : need_eq);
                    if (sel && slot >= slo && slot < shi) { IDX[e * CAP + slot] = tok; GATE[e * CAP + slot] = __uint_as_float(bits[i]); RSL[e * CAP + slot] = RINV2[tok]; list[slot - slo] = tok; }
                    if (inv_mine) INV[tok * NE + e] = sel ? slot : -1;
                    gbef += isg ? 1 : 0; ebef += ise ? 1 : 0; }
                __syncthreads();
                for (int r = wave; r < shi - slo; r += 32) {
                    u32x4 t[4][4];
#pragma unroll
                    for (int q = 0; q < 4; ++q) { const int rr = (r + 8 * q < shi - slo) ? r + 8 * q : r; const u32x4* s = (const u32x4*)(XB1 + (size_t)list[rr] * D) + lane;
#pragma unroll
                        for (int j = 0; j < 4; ++j) t[q][j] = s[64 * j]; }
#pragma unroll
                    for (int q = 0; q < 4; ++q) if (r + 8 * q < shi - slo) { u32x2* d = (u32x2*)((unsigned char*)XG + (size_t)(e * CAP + slo + r + 8 * q) * D) + lane;
#pragma unroll
                        for (int j = 0; j < 4; ++j) { f32x4 a, b; unpack8(t[q][j], a, b); d[64 * j] = pack8_fp8(a, b); } } }
                __syncthreads();
            }
        }
        SEAM(pbase + 9);
        if (PON(13) && IN(pbase + 11)) _Pragma("nounroll") for (int rep_ = 0; rep_ < REPS(13); ++rep_) { PH_ENTER LAYER_ENTER
            pg::SchedGroup Sg; Sg.init(XG, D, (size_t)CAP * D, w.WGU, D, (size_t)4096 * D, 4, 16, NE, G, vcu, 1);
            EpiExp1 E{RSL, Hb};
            pg::gemm_phase<EpiExp1, pg::SchedGroup, true, E8_ONE, E8_W>(lds, D, D, D, Sg, E);
        }
        SEAM(pbase + 11);
        if (PON(14) && IN(pbase + 12)) _Pragma("nounroll") for (int rep_ = 0; rep_ < REPS(14); ++rep_) { PH_ENTER LAYER_ENTER
            pg::SchedGroup Sg; Sg.init(Hb, FF, (size_t)CAP * FF, w.WD, FF, (size_t)D * FF, 4, 8, NE, G, vcu, 1);
            EpiExp2 E{GATE, YX};
            pg::gemm_phase<EpiExp2, pg::SchedGroup, true, E8_H, E8_W>(lds, FF, FF, FF, Sg, E);
        }
        SEAM(pbase + 12);
        if (PON(15) && IN(pbase + 13)) _Pragma("nounroll") for (int rep_ = 0; rep_ < REPS(15); ++rep_) { PH_ENTER LAYER_ENTER
            { u32x2 xc[8], xn[8]; int invc = -1, invn = -1;
#pragma unroll
              for (int j = 0; j < 8; ++j) { xc[j] = (u32x2){0u, 0u}; xn[j] = xc[j]; }
              if (gw < S) { invc = INV[gw * NE + (lane & 15)];
#pragma unroll
                  for (int j = 0; j < 8; ++j) xc[j] = *(const u32x2*)(XB1 + (size_t)gw * D + 4 * lane + 256 * j); }
              for (int m = gw; m < S; m += NGW) {
                if (m + NGW < S) { invn = INV[(m + NGW) * NE + (lane & 15)];
#pragma unroll
                    for (int j = 0; j < 8; ++j) xn[j] = *(const u32x2*)(XB1 + (size_t)(m + NGW) * D + 4 * lane + 256 * j); }
                f32x4 v[8];
#pragma unroll
                for (int j = 0; j < 8; ++j) v[j] = (f32x4){bf_lo(xc[j].x), bf_hi(xc[j].x), bf_lo(xc[j].y), bf_hi(xc[j].y)};
                const int myinv = invc;
                unsigned msk = (unsigned)(__ballot(myinv >= 0) & 0xFFFFull);
                while (msk) { const int e0 = __builtin_ctz(msk); msk &= msk - 1; const bool two = msk != 0u; const int e1 = two ? __builtin_ctz(msk) : e0; if (two) msk &= msk - 1;
                    const bf16_t* y0 = YX + ((size_t)e0 * CAP + __shfl(myinv, e0)) * D; const bf16_t* y1 = YX + ((size_t)e1 * CAP + __shfl(myinv, e1)) * D;
                    u32x2 a[8], b[8];
#pragma unroll
                    for (int j = 0; j < 8; ++j) a[j] = *(const u32x2*)(y0 + 4 * lane + 256 * j);
#pragma unroll
                    for (int j = 0; j < 8; ++j) b[j] = *(const u32x2*)(y1 + 4 * lane + 256 * j);
#pragma unroll
                    for (int j = 0; j < 8; ++j) { v[j][0] += bf_lo(a[j].x); v[j][1] += bf_hi(a[j].x); v[j][2] += bf_lo(a[j].y); v[j][3] += bf_hi(a[j].y); }
                    if (two) {
#pragma unroll
                        for (int j = 0; j < 8; ++j) { v[j][0] += bf_lo(b[j].x); v[j][1] += bf_hi(b[j].x); v[j][2] += bf_lo(b[j].y); v[j][3] += bf_hi(b[j].y); } } }
                if (l + 1 < NL) {
                    float ss = 0.f;
#pragma unroll
                    for (int j = 0; j < 8; ++j) ss += v[j][0] * v[j][0] + v[j][1] * v[j][1] + v[j][2] * v[j][2] + v[j][3] * v[j][3];
                    ss = wave_sum(ss);
#pragma unroll
                    for (int j = 0; j < 8; ++j) { u32x2 wv; wv.x = cvt_pk_bf16(v[j][0], v[j][1]); wv.y = cvt_pk_bf16(v[j][2], v[j][3]); *(u32x2*)(XB + (size_t)m * D + 4 * lane + 256 * j) = wv;
                        int w8 = 0; w8 = __builtin_amdgcn_cvt_pk_fp8_f32(v[j][0], v[j][1], w8, false); w8 = __builtin_amdgcn_cvt_pk_fp8_f32(v[j][2], v[j][3], w8, true); *(int*)(XB8 + (size_t)m * D + 4 * lane + 256 * j) = w8; }
                    if (lane == 0) RINV[m] = __builtin_amdgcn_rsqf(ss * (1.f / D) + EPS);
                } else { float* orow = OUTP + (size_t)m * D;
#pragma unroll
                    for (int j = 0; j < 8; ++j) *(f32x4*)(orow + 4 * lane + 256 * j) = v[j]; }
#pragma unroll
                for (int j = 0; j < 8; ++j) xc[j] = xn[j];
                invc = invn;
              } }
        }
        SEAM(pbase + 13);
    }
#undef IN
#undef SEAM
}

#if defined(DBG_STOP)
#ifndef DBG_OFF
#define DBG_OFF A_XA
#endif
#ifndef DBG_BF16
#define DBG_BF16 0
#endif
__global__ void dbg_dump(float* out, const unsigned char* ws) {
    const unsigned char* p = ws + WS_ACT + DBG_OFF;
    for (size_t i = (size_t)blockIdx.x * 256 + threadIdx.x; i < (size_t)S * D; i += (size_t)gridDim.x * 256)
#if defined(DBG_SUM2)
        out[i] = __uint_as_float(((unsigned)((const bf16_t*)p)[i]) << 16) + __uint_as_float(((unsigned)((const bf16_t*)p)[i + (size_t)S * D]) << 16);
#else
        out[i] = DBG_BF16 ? __uint_as_float(((unsigned)((const bf16_t*)p)[i]) << 16) : ((const float*)p)[i];
#endif
}
#endif
constexpr int N_PHASES = 2 + NL * 14;
extern "C" void kernel_launch(void* const* d_in, const int* in_sizes, int n_in, void* d_out, int out_size, void* d_ws, size_t ws_size, hipStream_t stream) {
    static int grid = 0;
    if (grid == 0) {
        if (n_in != 28 || in_sizes[0] != S * D || out_size != S * D || ws_size < WS_END) { fprintf(stderr, "kernel_launch: shape/workspace mismatch (n_in %d, ws %zu, need %zu)\n", n_in, ws_size, (size_t)WS_END); grid = -1; return; }
        int dev = 0, cus = 0, per_cu = 0;
        if (hipGetDevice(&dev) != hipSuccess || hipDeviceGetAttribute(&cus, hipDeviceAttributeMultiprocessorCount, dev) != hipSuccess) { grid = -1; return; }
        if (hipFuncSetAttribute((const void*)fwd, hipFuncAttributeMaxDynamicSharedMemorySize, LDS_BYTES) != hipSuccess) { fprintf(stderr, "kernel_launch: hipFuncSetAttribute failed\n"); grid = -1; return; }
        if (hipOccupancyMaxActiveBlocksPerMultiprocessor(&per_cu, (const void*)fwd, 512, LDS_BYTES) != hipSuccess || per_cu < 1) { fprintf(stderr, "kernel_launch: occupancy query says %d\n", per_cu); }
        (void)hipGetLastError();
        grid = cus;
    }
    if (grid < 0) return;
    (void)hipMemsetAsync((char*)d_ws + WS_CTL, 0, CTL_BYTES, stream);
    Args a{};
    for (int i = 0; i < 28; ++i) a.in[i] = (GAS const float*)d_in[i];
    a.out = (GAS float*)d_out; a.ws = (GAS unsigned char*)d_ws;
#if defined(DBG_STOP)
    for (int p = 0; p < DBG_STOP; ++p) { a.ph_lo = p; a.ph_hi = p + 1; hipLaunchKernelGGL(fwd, dim3(grid), dim3(512), LDS_BYTES, stream, a); }
#if !defined(DBG_NODUMP)
    hipLaunchKernelGGL(dbg_dump, dim3(2048), dim3(256), 0, stream, (float*)d_out, (const unsigned char*)d_ws);
#endif
#elif MK_PER_PHASE
    for (int p = 0; p < N_PHASES; ++p) { a.ph_lo = p; a.ph_hi = p + 1; hipLaunchKernelGGL(fwd, dim3(grid), dim3(512), LDS_BYTES, stream, a); }
#else
    a.ph_lo = 0; a.ph_hi = N_PHASES; hipLaunchKernelGGL(fwd, dim3(grid), dim3(512), LDS_BYTES, stream, a);
#endif
    const hipError_t le = hipPeekAtLastError();
    if (le != hipSuccess) fprintf(stderr, "kernel_launch: launch failed: %s\n", hipGetErrorName(le));
}
```

```cpp
#include <hip/hip_runtime.h>
#include <cstdio>
#include <cstdint>

#define REP_MASK 7168
#ifndef MK_PER_PHASE
#define MK_PER_PHASE 0
#endif

#define LAS __attribute__((address_space(3)))
#define GAS __attribute__((address_space(1)))
typedef unsigned short bf16_t;
typedef short bf16x8 __attribute__((ext_vector_type(8)));
typedef short s16x4 __attribute__((ext_vector_type(4)));
typedef float f32x4 __attribute__((ext_vector_type(4)));
typedef float f32x2 __attribute__((ext_vector_type(2)));
typedef float f32x16 __attribute__((ext_vector_type(16)));
typedef unsigned u32x4 __attribute__((ext_vector_type(4)));
typedef unsigned u32x2 __attribute__((ext_vector_type(2)));

constexpr int S = 8192, D = 2048, NL = 2;
constexpr int SSMW = 1024, NGRP = 64, GP = 16, NST = 64;
constexpr int NH = 8, QKD = 64, VD = 128;
constexpr int NE = 16, CAP = 1024, FF = 2048;
constexpr int INC = 8192;
constexpr float EPS = 1e-6f;
constexpr int TC = 32, NCH = S / TC;
constexpr int UAW = TC * GP + 256;
constexpr float LOG2E = 1.4426950408889634f;

constexpr size_t MiB = 1u << 20;
constexpr size_t WS_CTL = 0, CTL_BYTES = 1 * MiB;
constexpr size_t LW_WIN = 0, LW_WGLU = 32 * MiB, LW_WBR = 34 * MiB, LW_WOUT = 42 * MiB, LW_WGU = 50 * MiB, LW_WD = 306 * MiB,
                 LW_F = 434 * MiB, LW_BO = 450 * MiB, LW_KTAB = 498 * MiB, LW_WRT = 502 * MiB, LW_SIZE = 503 * MiB;
constexpr size_t WS_LW = 1 * MiB;
constexpr size_t WS_ACT = WS_LW + 2 * LW_SIZE;
constexpr size_t A_XB = 0, A_XB1 = 32 * MiB, A_UA = 64 * MiB, A_Q = 88 * MiB, A_K = 104 * MiB, A_V = 120 * MiB, A_G = 136 * MiB,
                 A_SSUM = 200 * MiB, A_Y = 216 * MiB, A_YO = 232 * MiB, A_O1 = 264 * MiB, A_MG = 296 * MiB, A_XA = 328 * MiB,
                 A_XG = 392 * MiB, A_H = 456 * MiB, A_YX = 520 * MiB, A_SMALL = 584 * MiB, A_END = 588 * MiB;
constexpr size_t SM_RINV = 0, SM_RINV2 = 64 * 1024, SM_AFFT = 128 * 1024, SM_IDX = 640 * 1024, SM_GATE = 704 * 1024, SM_RSL = 768 * 1024,
                 SM_INV = 1024 * 1024, SM_BTAB = 1536 * 1024, SM_LAM = 1600 * 1024;
constexpr size_t WS_END = WS_ACT + A_END;

constexpr int RING_BYTES = 131072;
constexpr int LDS_BYTES = 163840;
constexpr int MISC_OFF = 155648;

typedef __bf16 bf16v2_t __attribute__((ext_vector_type(2)));
__device__ __forceinline__ unsigned cvt_pk_bf16(float lo, float hi) { const f32x2 v = {lo, hi}; return __builtin_bit_cast(unsigned, __builtin_convertvector(v, bf16v2_t)); }
__device__ __forceinline__ float bf_lo(unsigned w) { return __uint_as_float(w << 16); }
__device__ __forceinline__ float bf_hi(unsigned w) { return __uint_as_float(w & 0xffff0000u); }
__device__ __forceinline__ unsigned short f2bf(float f) { return (unsigned short)(cvt_pk_bf16(f, 0.f) & 0xffffu); }
__device__ __forceinline__ float fast_sigmoid(float x) { return __builtin_amdgcn_rcpf(1.f + __builtin_amdgcn_exp2f(-x * LOG2E)); }
__device__ __forceinline__ float wave_sum(float v) {
#pragma unroll
    for (int o = 1; o < 64; o <<= 1) v += __shfl_xor(v, o);
    return v;
}
template <int X> __device__ __forceinline__ float swz_xor(float v) { return __int_as_float(__builtin_amdgcn_ds_swizzle(__float_as_int(v), (X << 10) | 0x1F)); }
__device__ __forceinline__ u32x2 pack8_fp8(const f32x4 a, const f32x4 b) { int w0 = 0, w1 = 0;
    w0 = __builtin_amdgcn_cvt_pk_fp8_f32(a[0], a[1], w0, false); w0 = __builtin_amdgcn_cvt_pk_fp8_f32(a[2], a[3], w0, true);
    w1 = __builtin_amdgcn_cvt_pk_fp8_f32(b[0], b[1], w1, false); w1 = __builtin_amdgcn_cvt_pk_fp8_f32(b[2], b[3], w1, true);
    u32x2 r; r.x = (unsigned)w0; r.y = (unsigned)w1; return r; }
constexpr float W8_SCALE = 64.f, H8_SCALE = 16.f;
constexpr int E8_ONE = 0x7F7F7F7F, E8_W = 0x79797979  , E8_H = 0x7B7B7B7B  ;
#define LDS_WAIT() asm volatile("s_waitcnt lgkmcnt(0)" ::: "memory")
#define VM_WAIT() asm volatile("s_waitcnt vmcnt(0)" ::: "memory")

#define XB_TMO      128
#define XB_XCNT(j)  (256  + 64 * (j))
#define XB_XSUB(j)  (1280 + 64 * (j))
#define XB_XGEN(j)  (2304 + 64 * (j))
#define XB_TOP      3328
#define XB_TOPGEN   3392
#define XCD_BAR_WORDS 3456
#define XB_SPIN_CAP (1u << 22)
__device__ __forceinline__ unsigned xb_ld(unsigned* p)              { return __hip_atomic_load(p, __ATOMIC_RELAXED, __HIP_MEMORY_SCOPE_AGENT); }
__device__ __forceinline__ unsigned xb_add(unsigned* p, unsigned v) { return __hip_atomic_fetch_add(p, v, __ATOMIC_RELAXED, __HIP_MEMORY_SCOPE_AGENT); }
__device__ __forceinline__ unsigned xb_xcc_id() { return (unsigned)__builtin_amdgcn_s_getreg((3 << 11) | 20) & 0xFu; }
#define XB_SPIN(cond, bar) do { unsigned _sp = 0; while (cond) { __builtin_amdgcn_s_sleep(1); \
    if ((++_sp & 255u) == 0u) { if (xb_ld(&(bar)[XB_TMO])) break; if (_sp > XB_SPIN_CAP) { atomicAdd(&(bar)[XB_TMO], 1u); break; } } } } while (0)
struct XcdBarrier { unsigned* bar; unsigned x; volatile LAS unsigned* st; };
__device__ __forceinline__ XcdBarrier xcd_barrier_post(unsigned* bar, volatile LAS unsigned* st) {
    XcdBarrier b; b.bar = bar; b.x = xb_xcc_id(); b.st = st;
    if (threadIdx.x == 0) (void)xb_add(&bar[XB_XCNT(b.x)], 1u);
    return b;
}
__device__ __forceinline__ void xcd_barrier_complete(unsigned* bar, unsigned x, unsigned& nloc, unsigned& nx) {
    const unsigned G = gridDim.x * gridDim.y * gridDim.z;
    unsigned sum, cnt, mine, sp = 0u;
    for (;;) {
        sum = 0u; cnt = 0u; mine = 0u;
#pragma nounroll
        for (unsigned j = 0; j < 16; ++j) { const unsigned c = xb_ld(&bar[XB_XCNT(j)]); sum += c; cnt += (c > 0u) ? 1u : 0u; mine = (j == x) ? c : mine; }
        if (sum == G) break;
        __builtin_amdgcn_s_sleep(1);
        if ((++sp & 255u) == 0u) { if (xb_ld(&bar[XB_TMO])) break; if (sp > XB_SPIN_CAP) { atomicAdd(&bar[XB_TMO], 1u); break; } }
    }
    nloc = mine > 0u ? mine : 1u; nx = cnt > 0u ? cnt : 1u;
}
__device__ __forceinline__ void xcd_barrier(const XcdBarrier& b) {
    asm volatile("s_waitcnt vmcnt(0)" ::: "memory");
    __syncthreads();
    if (threadIdx.x == 0) {
        unsigned* bar = b.bar;
        __builtin_amdgcn_s_waitcnt(0);
        unsigned nloc = b.st[0], nx = b.st[1];
        if (nloc == 0u) { xcd_barrier_complete(bar, b.x, nloc, nx); b.st[0] = nloc; b.st[1] = nx; }
        const unsigned old = xb_add(&bar[XB_XSUB(b.x)], 1u);
        const unsigned gen = old / nloc;
        if (old + 1u == (gen + 1u) * nloc) {
            __builtin_amdgcn_fence(__ATOMIC_RELEASE, "agent");
            asm volatile("s_waitcnt vmcnt(0)" ::: "memory");
            const unsigned og = xb_add(&bar[XB_TOP], 1u);
            const unsigned tg = og / nx;
            if (og + 1u == (tg + 1u) * nx) xb_add(&bar[XB_TOPGEN], 1u);
            else XB_SPIN(xb_ld(&bar[XB_TOPGEN]) == tg, bar);
            __builtin_amdgcn_fence(__ATOMIC_ACQUIRE, "agent");
            xb_add(&bar[XB_XGEN(b.x)], 1u);
            asm volatile("s_waitcnt vmcnt(0)" ::: "memory");
        } else {
            XB_SPIN(xb_ld(&bar[XB_XGEN(b.x)]) == gen, bar);
            __builtin_amdgcn_fence(__ATOMIC_ACQUIRE, "agent");
            asm volatile("s_waitcnt vmcnt(0)" ::: "memory");
        }
    }
    __syncthreads();
}

namespace pg {
constexpr int BM = 256, BK = 64, HALF = 128, HTB = HALF * BK * 2, STAGE_BYTES = 8 * HTB;
__device__ __forceinline__ int lds_byte(int r, int c) { const int st = (r >> 4) * 2 + (c >> 5), rr = r & 15, cc = c & 31, ob = rr * 64 + cc * 2; return st * 1024 + (ob ^ (((ob >> 9) & 1) << 5)); }
__device__ __forceinline__ void stage_rc(int b, int& R, int& C) { const int st = b / 1024, sb = b % 1024, swz = sb ^ (((sb >> 9) & 1) << 5); R = (st >> 1) * 16 + swz / 64; C = (st & 1) * 32 + (swz % 64) / 2; }
__device__ __forceinline__ int perm32(int rho) { const int n = rho >> 4, i = rho & 15; return 8 * (i >> 2) + 4 * n + (i & 3); }
struct Unit { const char* a; const char* b; int pm, pn, grp; };
typedef f32x4 Acc[2][2][4][2];

typedef int v8i_t __attribute__((ext_vector_type(8)));
template <class Epi, class Sched, bool F8 = false, int SA_ = 0x7F7F7F7F, int SB_ = 0x7F7F7F7F>
__device__ __forceinline__ void gemm_phase(LAS unsigned char* lds, const int K, const int lda, const int ldb, const Sched& S, const Epi& E) {
    int tz_ = threadIdx.x; asm volatile("" : "+v"(tz_));
    const int tid = tz_, wid = __builtin_amdgcn_readfirstlane(tid >> 6), lane = tid & 63, wr = wid >> 2, wc = wid & 3, fr = lane & 15, fq = lane >> 4;
    constexpr int ESZ = F8 ? 1 : 2;
    const int nt = K * ESZ / (BK * 2);
    unsigned voffA[2], voffB[2];
#pragma unroll
    for (int i = 0; i < 2; ++i) { int R, C; stage_rc(tid * 16 + i * 8192, R, C);
        voffA[i] = (unsigned)(R * lda * ESZ + C * 2); voffB[i] = (unsigned)((64 * (R >> 5) + perm32(R & 31)) * ldb * ESZ + C * 2); }
    const size_t kstep = (size_t)(BK * 2);
    const size_t hstepA = (size_t)HALF * lda * ESZ;
    const size_t hstepB = (size_t)32 * ldb * ESZ;
    const unsigned ldsw = (unsigned)wid * 1024u;
    const int aoff = F8 ? lds_byte(wr * 64 + fr, fq * 16) : lds_byte(wr * 64 + fr, fq * 8), boff = F8 ? lds_byte(wc * 32 + fr, fq * 16) : lds_byte(wc * 32 + fr, fq * 8);
#define PG8_SA(b, h) (((b) * 2 + (h)) * HTB)
#define PG8_SB(b, h) ((4 + (b) * 2 + (h)) * HTB)
#define PG8_STAGE(bufoff, gbase, voff) do { _Pragma("unroll") for (int _i = 0; _i < 2; ++_i) \
        __builtin_amdgcn_global_load_lds((const unsigned*)((const char*)(gbase) + (voff)[_i]), (LAS unsigned*)(lds + (bufoff) + ldsw + _i * 8192), 16, 0, 0); } while (0)
    typedef v8i_t v8i_a16 __attribute__((aligned(16)));
#define PG8_LD32(p) __builtin_bit_cast(v8i_t, __builtin_shufflevector(*(const LAS u32x4*)(p), *(const LAS u32x4*)((p) + 16), 0, 1, 2, 3, 4, 5, 6, 7))
#define PG8_LDA(dst, b, h) do { if constexpr (F8) { _Pragma("unroll") for (int m = 0; m < 4; ++m) dst##8[m] = PG8_LD32(lds + PG8_SA(b, h) + aoff + m * 2048); } \
        else { _Pragma("unroll") for (int m = 0; m < 4; ++m) _Pragma("unroll") for (int k = 0; k < 2; ++k) dst[m][k] = *(const LAS bf16x8*)(lds + PG8_SA(b, h) + aoff + m * 2048 + k * 1024); } } while (0)
#define PG8_LDB(dst, b, h) do { if constexpr (F8) { _Pragma("unroll") for (int n = 0; n < 2; ++n) dst##8[n] = PG8_LD32(lds + PG8_SB(b, h) + boff + n * 2048); } \
        else { _Pragma("unroll") for (int n = 0; n < 2; ++n) _Pragma("unroll") for (int k = 0; k < 2; ++k) dst[n][k] = *(const LAS bf16x8*)(lds + PG8_SB(b, h) + boff + n * 2048 + k * 1024); } } while (0)
#define PG8_MMA(ai, bj, At, Bt) do { __builtin_amdgcn_s_setprio(1); \
        if constexpr (F8) { _Pragma("unroll") for (int m = 0; m < 4; ++m) _Pragma("unroll") for (int n = 0; n < 2; ++n) \
            asm volatile("v_mfma_scale_f32_16x16x128_f8f6f4 %0, %1, %2, %0, %3, %4 op_sel_hi:[0,0,0]" : "+v"(acc[ai][bj][m][n]) : "v"(Bt##8[n]), "v"(At##8[m]), "v"(sbv), "v"(sav)); } \
        else { _Pragma("unroll") for (int m = 0; m < 4; ++m) _Pragma("unroll") for (int n = 0; n < 2; ++n) _Pragma("unroll") for (int k = 0; k < 2; ++k) \
            acc[ai][bj][m][n] = __builtin_amdgcn_mfma_f32_16x16x32_bf16(Bt[n][k], At[m][k], acc[ai][bj][m][n], 0, 0, 0); } \
        __builtin_amdgcn_s_setprio(0); } while (0)
#define PG8_WAIT_V(n) asm volatile("s_waitcnt vmcnt(" #n ")" ::: "memory")
#define PG8_WAIT_L(n) asm volatile("s_waitcnt lgkmcnt(" #n ")" ::: "memory")
#define PG8_BAR __builtin_amdgcn_s_barrier()
#define PG8_SCHED __builtin_amdgcn_sched_barrier(0)
    Unit cur, nxt; int ui = 0;
    if (!S.next(0, cur)) return;
    Acc acc;
#pragma unroll
    for (int a = 0; a < 2; ++a)
#pragma unroll
        for (int b = 0; b < 2; ++b)
#pragma unroll
            for (int m = 0; m < 4; ++m)
#pragma unroll
                for (int n = 0; n < 2; ++n) acc[a][b][m][n] = (f32x4){0.f, 0.f, 0.f, 0.f};
    bf16x8 At[4][2], B0[2][2], B1[2][2]; v8i_t At8[4], B08[2], B18[2];
    const int sav = SA_, sbv = SB_;
    const char* cA = cur.a; const char* cB = cur.b;
    PG8_STAGE(PG8_SB(0, 0), cB, voffB); PG8_STAGE(PG8_SA(0, 0), cA, voffA); PG8_STAGE(PG8_SB(0, 1), cB + hstepB, voffB); PG8_STAGE(PG8_SA(0, 1), cA + hstepA, voffA);
    if (wr == 1) PG8_BAR;
    PG8_WAIT_V(4); PG8_BAR;
    PG8_STAGE(PG8_SB(1, 0), cB + kstep, voffB); PG8_STAGE(PG8_SA(1, 0), cA + kstep, voffA); PG8_STAGE(PG8_SB(1, 1), cB + hstepB + kstep, voffB);
    PG8_WAIT_V(6); PG8_BAR;
    for (;;) {
        const bool has_next = S.next(ui + 1, nxt);
        const char* nA = has_next ? nxt.a : cA; const char* nB = has_next ? nxt.b : cB;
        for (int t = 0; t < nt; t += 2) {
            const bool last = (t == nt - 2);
            const char* a1 = cA + (size_t)(t + 1) * kstep;
            const char* a2 = last ? nA : cA + (size_t)(t + 2) * kstep; const char* b2 = last ? nB : cB + (size_t)(t + 2) * kstep;
            const char* a3 = a2 + kstep; const char* b3 = b2 + kstep;
            if constexpr (Epi::HAS_MID) { if (t == nt / 2) E.mid(acc, cur, wr, wc, fr, fq); }
            PG8_LDB(B0, 0, 0); PG8_SCHED; PG8_LDA(At, 0, 0); PG8_STAGE(PG8_SA(1, 1), a1 + hstepA, voffA);
            PG8_WAIT_L(8); PG8_BAR; PG8_WAIT_L(0); PG8_MMA(0, 0, At, B0); PG8_BAR; PG8_SCHED;
            PG8_LDB(B1, 0, 1); PG8_STAGE(PG8_SB(0, 0), b2, voffB);
            PG8_BAR; PG8_WAIT_L(0); PG8_MMA(0, 1, At, B1); PG8_BAR;
            PG8_LDA(At, 0, 1); PG8_STAGE(PG8_SA(0, 0), a2, voffA);
            PG8_BAR; PG8_WAIT_L(0); PG8_MMA(1, 0, At, B0); PG8_BAR; PG8_SCHED;
            PG8_STAGE(PG8_SB(0, 1), b2 + hstepB, voffB);
            PG8_WAIT_V(6); PG8_BAR; PG8_MMA(1, 1, At, B1); PG8_BAR;
            PG8_LDB(B0, 1, 0); PG8_SCHED; PG8_LDA(At, 1, 0); PG8_STAGE(PG8_SA(0, 1), a2 + hstepA, voffA);
            PG8_WAIT_L(8); PG8_BAR; PG8_WAIT_L(0); PG8_MMA(0, 0, At, B0); PG8_BAR; PG8_SCHED;
            PG8_LDB(B1, 1, 1); PG8_STAGE(PG8_SB(1, 0), b3, voffB);
            PG8_BAR; PG8_WAIT_L(0); PG8_MMA(0, 1, At, B1); PG8_BAR;
            PG8_LDA(At, 1, 1); PG8_STAGE(PG8_SA(1, 0), a3, voffA);
            PG8_BAR; PG8_WAIT_L(0); PG8_MMA(1, 0, At, B0); PG8_BAR; PG8_SCHED;
            PG8_STAGE(PG8_SB(1, 1), b3 + hstepB, voffB);
            PG8_WAIT_V(6); PG8_BAR; PG8_MMA(1, 1, At, B1); PG8_BAR;
        }
        if constexpr (F8) asm volatile("s_nop 15\n\ts_nop 15" ::: "memory");
        E(acc, cur, wr, wc, fr, fq);
        if (!has_next) break;
#pragma unroll
        for (int a = 0; a < 2; ++a)
#pragma unroll
            for (int b = 0; b < 2; ++b)
#pragma unroll
                for (int m = 0; m < 4; ++m)
#pragma unroll
                    for (int n = 0; n < 2; ++n) acc[a][b][m][n] = (f32x4){0.f, 0.f, 0.f, 0.f};
        cur = nxt; cA = nA; cB = nB; ++ui;
    }
    PG8_WAIT_V(0);
    if (wr == 0) PG8_BAR;
    PG8_BAR;
#undef PG8_SA
#undef PG8_SB
#undef PG8_STAGE
#undef PG8_LDA
#undef PG8_LD32
#undef PG8_LDB
#undef PG8_MMA
#undef PG8_WAIT_V
#undef PG8_WAIT_L
#undef PG8_BAR
#undef PG8_SCHED
}

struct SchedGrid {
    const char* A; const char* B; size_t tstepA, tstepB; int nM, nN, nwg, G, c; bool mix32 = false;
    __device__ void init(const void* A_, int lda, const void* B_, int ldb, int M, int N, int G_, int c_, int esz = 2) {
        A = (const char*)A_; B = (const char*)B_; tstepA = (size_t)256 * lda * esz; tstepB = (size_t)256 * ldb * esz; nM = M / 256; nN = N / 256; nwg = nM * nN; G = G_; c = c_; }
    __device__ __forceinline__ bool next(int i, Unit& u) const {
        const long L = (long)i * G + c; if (L >= nwg) return false;
        int wgid = (int)L; { const int q = nwg / 8, r = nwg % 8, xcd = wgid % 8, off = wgid / 8; wgid = (xcd < r ? xcd * (q + 1) : r * (q + 1) + (xcd - r) * q) + off; }
        const int nig = 8 * nN, gid = wgid / nig, fm = gid * 8, gsz = (nM - fm) < 8 ? (nM - fm) : 8;
        u.pm = fm + ((wgid % nig) % gsz); u.pn = (wgid % nig) / gsz; u.grp = 0;
        if (mix32) { const int a = u.pn >> 4, r4 = (u.pn >> 2) & 3, r = u.pn & 3; u.pn = ((r4 & 1) << 4) | (a << 3) | ((r4 >> 1) << 2) | r; }
        u.a = A + (size_t)u.pm * tstepA; u.b = B + (size_t)u.pn * tstepB; return true;
    }
};
struct SchedGroup {
    const char* A; const char* B; size_t tstepA, tstepB, gstepA, gstepB; int nM, nN, total, G, c;
    __device__ void init(const void* A_, int lda, size_t gA, const void* B_, int ldb, size_t gB, int nM_, int nN_, int NG, int G_, int c_, int esz = 2) {
        A = (const char*)A_; B = (const char*)B_; tstepA = (size_t)256 * lda * esz; tstepB = (size_t)256 * ldb * esz; gstepA = gA; gstepB = gB; nM = nM_; nN = nN_; total = NG * nM_ * nN_; G = G_; c = c_; }
    __device__ __forceinline__ bool next(int i, Unit& u) const {
        const long L = (long)i * G + c; if (L >= total) return false;
        const int per = nM * nN, g = (int)L / per, r = (int)L % per;
        u.grp = g; u.pm = r % nM; u.pn = r / nM;
        u.a = A + (size_t)g * gstepA + (size_t)u.pm * tstepA; u.b = B + (size_t)g * gstepB + (size_t)u.pn * tstepB; return true;
    }
};
}

#define EPI_LANES int tz_ = threadIdx.x; asm volatile("" : "+v"(tz_)); const int wr = tz_ >> 8, wc = (tz_ >> 6) & 3, fr = tz_ & 15, fq = (tz_ >> 4) & 3;
#define EPI_ROWVALS(name, ptr, base) float name[2][4]; _Pragma("unroll") for (int ai = 0; ai < 2; ++ai) _Pragma("unroll") for (int m = 0; m < 4; ++m) name[ai][m] = (ptr)[(base) + ai * 128 + wr * 64 + m * 16 + fr];
#define EPI_FOR _Pragma("unroll") for (int ai = 0; ai < 2; ++ai) _Pragma("unroll") for (int m = 0; m < 4; ++m)
#define EPI_RL const int rl = ai * 128 + wr * 64 + m * 16 + fr;
__device__ __forceinline__ u32x4 pack8(const f32x4 a, const f32x4 b) { u32x4 w; w.x = cvt_pk_bf16(a[0], a[1]); w.y = cvt_pk_bf16(a[2], a[3]); w.z = cvt_pk_bf16(b[0], b[1]); w.w = cvt_pk_bf16(b[2], b[3]); return w; }
__device__ __forceinline__ void unpack8(const u32x4 w, f32x4& a, f32x4& b) { a = (f32x4){bf_lo(w.x), bf_hi(w.x), bf_lo(w.y), bf_hi(w.y)}; b = (f32x4){bf_lo(w.z), bf_hi(w.z), bf_lo(w.w), bf_hi(w.w)}; }

struct EpiInProj {
    static constexpr bool HAS_MID = false;
    const float* rinv; bf16_t *UA, *Q, *Kb, *V, *G; const float *qg, *kg;
    __device__ __forceinline__ void operator()(const pg::Acc& acc, const pg::Unit& u, int, int, int, int) const { EPI_LANES
        const int pn = u.pn, row0 = u.pm * 256;
        EPI_ROWVALS(rsv, rinv, row0)
        if (pn < 4) {
            EPI_FOR { EPI_RL const int tok = row0 + rl; const float rs = rsv[ai][m]; const int c = tok >> 5, tau = tok & 31;
#pragma unroll
                for (int bj = 0; bj < 2; ++bj) { const int ch = 256 * pn + 64 * wc + 32 * bj + 8 * fq, g = ch >> 4, p0 = ch & 15;
                    *(u32x4*)(UA + ((size_t)(g * NCH + c) * UAW + tau * 16 + p0)) = pack8(acc[ai][bj][m][0] * rs, acc[ai][bj][m][1] * rs); } }
        } else if (pn < 12) {
            const bool isq = pn < 8; const int col0 = 256 * (pn - (isq ? 4 : 8)) + 64 * wc; const float* gp = isq ? qg : kg; const float sc = isq ? 0.125f * LOG2E : 1.f;
            bf16_t* dst = isq ? Q : Kb;
            f32x4 gv[2][2];
#pragma unroll
            for (int bj = 0; bj < 2; ++bj)
#pragma unroll
                for (int n = 0; n < 2; ++n) gv[bj][n] = *(const f32x4*)(gp + 32 * bj + 8 * fq + 4 * n) * sc;
            EPI_FOR { EPI_RL const int tok = row0 + rl; const float rs = rsv[ai][m];
                f32x4 v[2][2]; float ss = 0.f;
#pragma unroll
                for (int bj = 0; bj < 2; ++bj)
#pragma unroll
                    for (int n = 0; n < 2; ++n) { v[bj][n] = acc[ai][bj][m][n] * rs; ss += v[bj][n][0] * v[bj][n][0] + v[bj][n][1] * v[bj][n][1] + v[bj][n][2] * v[bj][n][2] + v[bj][n][3] * v[bj][n][3]; }
                ss += __shfl_xor(ss, 16); ss += __shfl_xor(ss, 32);
                const float r = __builtin_amdgcn_rsqf(ss * (1.f / 64.f) + EPS);
#pragma unroll
                for (int bj = 0; bj < 2; ++bj)
                    *(u32x4*)(dst + (size_t)tok * 1024 + col0 + 32 * bj + 8 * fq) = pack8(v[bj][0] * r * gv[bj][0], v[bj][1] * r * gv[bj][1]); }
        } else {
            EPI_FOR { EPI_RL const int tok = row0 + rl; const float rs = rsv[ai][m];
#pragma unroll
                for (int bj = 0; bj < 2; ++bj)
                    *(u32x4*)(V + (size_t)tok * 1024 + 256 * (pn - 12) + 64 * wc + 32 * bj + 8 * fq) = pack8(acc[ai][bj][m][0] * rs, acc[ai][bj][m][1] * rs); }
        }
    }
};
struct EpiGates {
    static constexpr bool HAS_MID = false;
    const float* rinv; bf16_t* G;
    __device__ __forceinline__ void operator()(const pg::Acc& acc, const pg::Unit& u, int, int, int, int) const { EPI_LANES
        EPI_ROWVALS(rsv, rinv, u.pm * 256)
        EPI_FOR { EPI_RL const int tok = u.pm * 256 + rl; const float rs = rsv[ai][m];
#pragma unroll
            for (int bj = 0; bj < 2; ++bj) { f32x4 a = acc[ai][bj][m][0] * rs, b = acc[ai][bj][m][1] * rs;
#pragma unroll
                for (int j = 0; j < 4; ++j) { a[j] = fast_sigmoid(a[j]); b[j] = fast_sigmoid(b[j]); }
                *(u32x4*)(G + (size_t)tok * 4096 + 256 * u.pn + 64 * wc + 32 * bj + 8 * fq) = pack8(a, b); } }
    }
};
struct EpiSsum {
    static constexpr bool HAS_MID = false;
    float* SS;
    __device__ __forceinline__ void operator()(const pg::Acc& acc, const pg::Unit& u, int, int, int, int) const { EPI_LANES
        EPI_FOR { EPI_RL float* rp = SS + ((size_t)u.grp * NCH + rl) * 256 + 64 * wc + 8 * fq;
#pragma unroll
            for (int bj = 0; bj < 2; ++bj) { *(f32x4*)(rp + 32 * bj) = acc[ai][bj][m][0]; *(f32x4*)(rp + 32 * bj + 4) = acc[ai][bj][m][1]; } }
    }
};
__device__ __forceinline__ float gelu_tanh(float x) {
    const float t = 1.5957691216057308f * (x + 0.044715f * x * x * x);
    return x * fast_sigmoid(t);
}
struct EpiSsmOut {
    static constexpr bool HAS_MID = false;
    bf16_t* Y;
    __device__ __forceinline__ void operator()(const pg::Acc& acc, const pg::Unit& u, int, int, int, int) const { EPI_LANES
        EPI_FOR { EPI_RL
#pragma unroll
            for (int bj = 0; bj < 2; ++bj) { const int col = 256 * u.pn + 64 * wc + 32 * bj + 8 * fq, t = col >> 4, p0 = col & 15;
                f32x4 a = acc[ai][bj][m][0], b = acc[ai][bj][m][1];
#pragma unroll
                for (int j = 0; j < 4; ++j) { a[j] = gelu_tanh(a[j]); b[j] = gelu_tanh(b[j]); }
                *(u32x4*)(Y + (size_t)(rl * TC + t) * SSMW + u.grp * GP + p0) = pack8(a, b); } }
    }
};
struct EpiGlu {
    static constexpr bool HAS_MID = false;
    const bf16_t* Y; bf16_t* YO;
    __device__ __forceinline__ void operator()(const pg::Acc& acc, const pg::Unit& u, int, int, int, int) const { EPI_LANES
        const int colb = 256 * u.pn + 64 * wc + 8 * fq; const size_t rb = (size_t)(u.pm * 256 + wr * 64 + fr);
        u32x4 cur[2], nxt[2];
        cur[0] = *(const u32x4*)(Y + rb * SSMW + colb); cur[1] = *(const u32x4*)(Y + rb * SSMW + colb + 32);
#pragma unroll
        for (int r_ = 0; r_ < 8; ++r_) { const int ai = r_ >> 2, m = r_ & 3; const size_t tok = rb + ai * 128 + m * 16;
            if (r_ < 7) { const size_t tn = rb + ((r_ + 1) >> 2) * 128 + ((r_ + 1) & 3) * 16; nxt[0] = *(const u32x4*)(Y + tn * SSMW + colb); nxt[1] = *(const u32x4*)(Y + tn * SSMW + colb + 32); }
#pragma unroll
            for (int bj = 0; bj < 2; ++bj) { f32x4 ya, yb; unpack8(cur[bj], ya, yb);
                f32x4 a = acc[ai][bj][m][0], b = acc[ai][bj][m][1];
#pragma unroll
                for (int j = 0; j < 4; ++j) { a[j] = ya[j] * fast_sigmoid(a[j]); b[j] = yb[j] * fast_sigmoid(b[j]); }
                *(u32x4*)(YO + tok * 2048 + colb + 32 * bj) = pack8(a, b); }
            cur[0] = nxt[0]; cur[1] = nxt[1]; }
    }
};
struct EpiMerge {
    static constexpr bool HAS_MID = true;
    const bf16_t* G; bf16_t* MG;
    __device__ __forceinline__ void mid(pg::Acc& acc, const pg::Unit& u, int, int, int, int) const { EPI_LANES
        const int colb = 256 * u.pn + 64 * wc + 8 * fq; const size_t rb = (size_t)(u.pm * 256 + wr * 64 + fr);
        u32x4 cur[4], nxt[4];
#pragma unroll
        for (int q = 0; q < 4; ++q) cur[q] = *(const u32x4*)(G + rb * 4096 + (q >> 1) * 2048 + colb + 32 * (q & 1));
#pragma unroll
        for (int r_ = 0; r_ < 8; ++r_) { const int ai = r_ >> 2, m = r_ & 3;
            if (r_ < 7) { const size_t tn = rb + ((r_ + 1) >> 2) * 128 + ((r_ + 1) & 3) * 16;
#pragma unroll
                for (int q = 0; q < 4; ++q) nxt[q] = *(const u32x4*)(G + tn * 4096 + (q >> 1) * 2048 + colb + 32 * (q & 1)); }
#pragma unroll
            for (int bj = 0; bj < 2; ++bj) { f32x4 sa, sb, ga, gb; unpack8(cur[bj], sa, sb); unpack8(cur[2 + bj], ga, gb);
#pragma unroll
                for (int j = 0; j < 4; ++j) { acc[ai][bj][m][0][j] *= sa[j] * __builtin_amdgcn_rcpf(ga[j]); acc[ai][bj][m][1][j] *= sb[j] * __builtin_amdgcn_rcpf(gb[j]); } }
#pragma unroll
            for (int q = 0; q < 4; ++q) cur[q] = nxt[q];
            __builtin_amdgcn_sched_barrier(0); }
    }
    __device__ __forceinline__ void operator()(const pg::Acc& acc, const pg::Unit& u, int, int, int, int) const { EPI_LANES
        const int colb = 256 * u.pn + 64 * wc + 8 * fq; const size_t rb = (size_t)(u.pm * 256 + wr * 64 + fr);
        u32x4 cur[2], nxt[2];
        cur[0] = *(const u32x4*)(G + rb * 4096 + 2048 + colb); cur[1] = *(const u32x4*)(G + rb * 4096 + 2048 + colb + 32);
#pragma unroll
        for (int r_ = 0; r_ < 8; ++r_) { const int ai = r_ >> 2, m = r_ & 3; const size_t tok = rb + ai * 128 + m * 16;
            if (r_ < 7) { const size_t tn = rb + ((r_ + 1) >> 2) * 128 + ((r_ + 1) & 3) * 16; nxt[0] = *(const u32x4*)(G + tn * 4096 + 2048 + colb); nxt[1] = *(const u32x4*)(G + tn * 4096 + 2048 + colb + 32); }
#pragma unroll
            for (int bj = 0; bj < 2; ++bj) { f32x4 ga, gb; unpack8(cur[bj], ga, gb);
                *(u32x4*)(MG + tok * 2048 + colb + 32 * bj) = pack8(acc[ai][bj][m][0] * ga, acc[ai][bj][m][1] * gb); }
            cur[0] = nxt[0]; cur[1] = nxt[1]; }
    }
};
struct EpiOutProj {
    static constexpr bool HAS_MID = false;
    const bf16_t* XR; bf16_t* XO;
    __device__ __forceinline__ void operator()(const pg::Acc& acc, const pg::Unit& u, int, int, int, int) const { EPI_LANES
        const int colb = 256 * u.pn + 64 * wc + 8 * fq; const size_t rb = (size_t)(u.pm * 256 + wr * 64 + fr);
        u32x4 cur[2], nxt[2];
        cur[0] = *(const u32x4*)(XR + rb * 2048 + colb); cur[1] = *(const u32x4*)(XR + rb * 2048 + colb + 32);
#pragma unroll
        for (int r_ = 0; r_ < 8; ++r_) { const int ai = r_ >> 2, m = r_ & 3; const size_t tok = rb + ai * 128 + m * 16;
            if (r_ < 7) { const size_t tn = rb + ((r_ + 1) >> 2) * 128 + ((r_ + 1) & 3) * 16; nxt[0] = *(const u32x4*)(XR + tn * 2048 + colb); nxt[1] = *(const u32x4*)(XR + tn * 2048 + colb + 32); }
#pragma unroll
            for (int bj = 0; bj < 2; ++bj) { f32x4 a, b; unpack8(cur[bj], a, b);
                *(u32x4*)(XO + tok * 2048 + colb + 32 * bj) = pack8(a + acc[ai][bj][m][0], b + acc[ai][bj][m][1]); }
            cur[0] = nxt[0]; cur[1] = nxt[1]; }
    }
};
struct EpiExp1 {
    static constexpr bool HAS_MID = false;
    const float* RSL; bf16_t* H;
    __device__ __forceinline__ void operator()(const pg::Acc& acc, const pg::Unit& u, int, int, int, int) const { EPI_LANES
        EPI_ROWVALS(rsv, RSL, u.grp * CAP + u.pm * 256)
        EPI_FOR { EPI_RL const int row = u.grp * CAP + u.pm * 256 + rl; const float rs = rsv[ai][m];
            f32x4 h[2];
#pragma unroll
            for (int n = 0; n < 2; ++n)
#pragma unroll
                for (int j = 0; j < 4; ++j) { const float g = acc[ai][0][m][n][j] * rs, up = acc[ai][1][m][n][j] * rs; h[n][j] = g * fast_sigmoid(g) * up; }
            *(u32x2*)((unsigned char*)H + (size_t)row * FF + 128 * u.pn + 32 * wc + 8 * fq) = pack8_fp8(h[0] * H8_SCALE, h[1] * H8_SCALE); }
    }
};
struct EpiExp2 {
    static constexpr bool HAS_MID = false;
    const float* GATE; bf16_t* YX;
    __device__ __forceinline__ void operator()(const pg::Acc& acc, const pg::Unit& u, int, int, int, int) const { EPI_LANES
        EPI_ROWVALS(gtv, GATE, u.grp * CAP + u.pm * 256)
        EPI_FOR { EPI_RL const int row = u.grp * CAP + u.pm * 256 + rl; const float gt = gtv[ai][m];
#pragma unroll
            for (int bj = 0; bj < 2; ++bj)
                *(u32x4*)(YX + (size_t)row * D + 256 * u.pn + 64 * wc + 32 * bj + 8 * fq) = pack8(acc[ai][bj][m][0] * gt, acc[ai][bj][m][1] * gt); }
    }
};

namespace att {
constexpr int KVBLK = 64, QBLK = 32;
constexpr int SHM_T = KVBLK * 256;
constexpr int OFF_K = 0, OFF_V = 3 * SHM_T, OFF_Q = 5 * SHM_T, OFF_WS = OFF_Q + 8 * 8192, OFF_BT = OFF_WS + 8 * 64 * 4, ATT_LDS_END = OFF_BT + 2048;
#define KSWZ(row, colB) ((row) * 256 + ((colB) ^ (((row) & 7) << 4)))
#define SBAR() __builtin_amdgcn_sched_barrier(0)
__device__ __forceinline__ int crow(int r, int hi) { return (r & 3) + 8 * (r >> 2) + 4 * hi; }
__device__ __forceinline__ int v_rd_base(int lane) { return ((lane & 3) << 3) | (((lane >> 2) & 3) << 6) | (((lane >> 4) & 1) << 5) | (((lane >> 5) & 1) << 8); }
constexpr int v_rd_off(int d0, int ks, int half) { return d0 * 512 + ks * 4096 + half * 2048; }
template <int OFF> __device__ __forceinline__ s16x4 tr_read(int vb) { s16x4 r; asm volatile("ds_read_b64_tr_b16 %0, %1 offset:%2" : "=&v"(r) : "v"(vb), "i"(OFF) : "memory"); return r; }
template <int D0> __device__ __forceinline__ void pv_one(f32x16& od, int vb, bf16x8 pa0, bf16x8 pa1, bf16x8 pa2, bf16x8 pa3) {
    const s16x4 l0 = tr_read<v_rd_off(D0, 0, 0)>(vb), h0 = tr_read<v_rd_off(D0, 0, 1)>(vb), l1 = tr_read<v_rd_off(D0, 1, 0)>(vb), h1 = tr_read<v_rd_off(D0, 1, 1)>(vb);
    const s16x4 l2 = tr_read<v_rd_off(D0, 2, 0)>(vb), h2 = tr_read<v_rd_off(D0, 2, 1)>(vb), l3 = tr_read<v_rd_off(D0, 3, 0)>(vb), h3 = tr_read<v_rd_off(D0, 3, 1)>(vb);
    asm volatile("s_waitcnt lgkmcnt(0)" ::: "memory"); SBAR();
#define PK(L, H) (bf16x8){L[0], L[1], L[2], L[3], H[0], H[1], H[2], H[3]}
    od = __builtin_amdgcn_mfma_f32_32x32x16_bf16(pa0, PK(l0, h0), od, 0, 0, 0);
    od = __builtin_amdgcn_mfma_f32_32x32x16_bf16(pa1, PK(l1, h1), od, 0, 0, 0);
    od = __builtin_amdgcn_mfma_f32_32x32x16_bf16(pa2, PK(l2, h2), od, 0, 0, 0);
    od = __builtin_amdgcn_mfma_f32_32x32x16_bf16(pa3, PK(l3, h3), od, 0, 0, 0);
#undef PK
}
__device__ __forceinline__ void pv_d0(f32x16* o, int vb, bf16x8 pa0, bf16x8 pa1, bf16x8 pa2, bf16x8 pa3) {
    pv_one<0>(o[0], vb, pa0, pa1, pa2, pa3); pv_one<1>(o[1], vb, pa0, pa1, pa2, pa3); pv_one<2>(o[2], vb, pa0, pa1, pa2, pa3); pv_one<3>(o[3], vb, pa0, pa1, pa2, pa3);
}
__device__ __forceinline__ int kq_addr(int row, int c) { return (c >> 2) * 4096 + row * 64 + (((c & 3) ^ ((row >> 2) & 3)) << 4); }
template <int COMP> __device__ __forceinline__ void qkt(f32x16& p0, f32x16& p1, const LAS char* Ks, const LAS char* Qs, int kq0, int kq1) {
    p0 = (f32x16){}; p1 = (f32x16){};
#pragma unroll
    for (int d0 = 0; d0 < 4; ++d0) { const int chi = COMP * 2 + (d0 >> 1); const int a = (d0 & 1) ? kq1 : kq0;
        const bf16x8 b0 = *(const LAS bf16x8*)(Ks + a + chi * 4096);
        const bf16x8 b1 = *(const LAS bf16x8*)(Ks + a + chi * 4096 + 2048);
        const bf16x8 qf = *(const LAS bf16x8*)(Qs + a + chi * 2048);
        p0 = __builtin_amdgcn_mfma_f32_32x32x16_bf16(b0, qf, p0, 0, 0, 0);
        p1 = __builtin_amdgcn_mfma_f32_32x32x16_bf16(b1, qf, p1, 0, 0, 0); }
}
__device__ __forceinline__ void sm_exp(f32x16& p0, f32x16& p1, const LAS float* bt, int relb, int dq, int hi) {
    if (dq > -191 && dq < 158) {
        const LAS float* bp = bt + relb + 4 * hi;
#pragma unroll
        for (int a = 0; a < 4; ++a) {
            float t0[4], t1[4];
#pragma unroll
            for (int b = 0; b < 4; ++b) { t0[b] = bp[8 * a + b]; t1[b] = bp[32 + 8 * a + b]; }
#pragma unroll
            for (int b = 0; b < 4; ++b) { p0[4 * a + b] += t0[b]; p1[4 * a + b] += t1[b]; }
            SBAR();
        } }
#pragma unroll
    for (int r = 0; r < 16; ++r) p0[r] = __builtin_amdgcn_exp2f(p0[r]);
#pragma unroll
    for (int r = 0; r < 16; ++r) p1[r] = __builtin_amdgcn_exp2f(p1[r]);
}
__device__ __forceinline__ void sm_fin(f32x16& p0, f32x16& p1, float& l_reg, bf16x8& pa0, bf16x8& pa1, bf16x8& pa2, bf16x8& pa3) {
    float ps = 0;
#pragma unroll
    for (int r = 0; r < 16; ++r) ps += p0[r];
#pragma unroll
    for (int r = 0; r < 16; ++r) ps += p1[r];
    { auto rr = __builtin_amdgcn_permlane32_swap(__float_as_uint(ps), __float_as_uint(ps), false, false);
      ps = __uint_as_float(rr[0]) + __uint_as_float(rr[1]); }
    l_reg += ps;
#define PK4(P, BASE, OUT) do { unsigned a0 = cvt_pk_bf16(P[BASE + 0], P[BASE + 1]), a1 = cvt_pk_bf16(P[BASE + 2], P[BASE + 3]);   \
    unsigned b0 = cvt_pk_bf16(P[BASE + 4], P[BASE + 5]), b1 = cvt_pk_bf16(P[BASE + 6], P[BASE + 7]);                              \
    auto r0 = __builtin_amdgcn_permlane32_swap(a0, b0, false, false); auto r1 = __builtin_amdgcn_permlane32_swap(a1, b1, false, false); \
    u32x4 w = {r0[0], r1[0], r0[1], r1[1]}; OUT = *reinterpret_cast<bf16x8*>(&w); } while (0)
    PK4(p0, 0, pa0); PK4(p0, 8, pa1); PK4(p1, 0, pa2); PK4(p1, 8, pa3);
#undef PK4
}
__device__ __forceinline__ void attn_dual(f32x16 (&o1)[4], f32x16 (&o2)[4], const bf16_t* __restrict__ Qg, const bf16_t* __restrict__ Kh, const bf16_t* __restrict__ Vh, LAS char* lds, int q0w) {
    int tz_ = threadIdx.x; asm volatile("" : "+v"(tz_));
    const int tid = tz_, wid = __builtin_amdgcn_readfirstlane(tid >> 6), lane = tid & 63, r32 = lane & 31, hi = lane >> 5;
    LAS char* K_lds = lds + OFF_K; LAS char* V_lds = lds + OFF_V; LAS char* Qs = lds + OFF_Q + wid * 8192;
    LAS float* ws = (LAS float*)(lds + OFF_WS) + wid * 64; LAS float* li_l = ws;
    const LAS float* bt = (const LAS float*)(lds + OFF_BT);
    float l1 = 0.f, l2 = 0.f;
#pragma unroll
    for (int d = 0; d < 4; ++d) { o1[d] = (f32x16){}; o2[d] = (f32x16){}; }
#pragma unroll
    for (int i = 0; i < 8; ++i) { const int ci = i * 64 + lane, row = (ci >> 2) & 31, c = (ci >> 7) * 4 + ((ci & 3) ^ ((row >> 2) & 3));
        __builtin_amdgcn_global_load_lds((const unsigned*)(Qg + (size_t)row * 1024 + c * 8), (LAS unsigned*)(Qs + i * 1024), 16, 0, 0); }
    const int kq0 = r32 * 64 + ((hi ^ ((r32 >> 2) & 3)) << 4), kq1 = r32 * 64 + (((2 + hi) ^ ((r32 >> 2) & 3)) << 4);
    unsigned ko0, vo0;
    { const int p = wid * 2;
        { const int ci = p * 64 + lane, row = (ci >> 2) & 63, c = (ci >> 8) * 4 + ((ci & 3) ^ ((row >> 2) & 3)); ko0 = (unsigned)(row * 1024 + c * 8) * 2u; }
        { const int ci = p * 64 + lane, sub = ci >> 5, kk = (sub >> 2) * 8 + ((ci >> 2) & 7), c = (sub & 3) * 32 + (ci & 3) * 8;
          const int k = (kk & ~0xC) | ((kk & 4) << 1) | ((kk & 8) >> 1); vo0 = (unsigned)(k * 1024 + c) * 2u; } }
    const unsigned pw = (unsigned)wid * 2048u;
#define DMA_K(buf, k0) do { const char* g_ = (const char*)(Kh + (size_t)(k0) * 1024); \
    __builtin_amdgcn_global_load_lds((const unsigned*)(g_ + ko0), (LAS unsigned*)(K_lds + (buf) * SHM_T + pw), 16, 0, 0); \
    __builtin_amdgcn_global_load_lds((const unsigned*)(g_ + ko0 + 32768u), (LAS unsigned*)(K_lds + (buf) * SHM_T + pw + 1024), 16, 0, 0); } while (0)
#define DMA_V(buf, k0) do { const char* g_ = (const char*)(Vh + (size_t)(k0) * 1024); \
    __builtin_amdgcn_global_load_lds((const unsigned*)(g_ + vo0), (LAS unsigned*)(V_lds + (buf) * SHM_T + pw), 16, 0, 0); \
    __builtin_amdgcn_global_load_lds((const unsigned*)(g_ + vo0 + 128u), (LAS unsigned*)(V_lds + (buf) * SHM_T + pw + 1024), 16, 0, 0); } while (0)
    const int vbb = (int)(size_t)V_lds + v_rd_base(lane);
    const int relq = 256 - (q0w + r32);
    f32x16 pA0, pA1, pB0, pB1; bf16x8 pa0, pa1, pa2, pa3; constexpr int NT = S / KVBLK;
    DMA_K(0, 0); DMA_K(1, KVBLK); DMA_V(0, 0);
    asm volatile("s_waitcnt vmcnt(0) lgkmcnt(0)" ::: "memory"); __syncthreads();
    qkt<0>(pA0, pA1, K_lds, Qs, kq0, kq1); sm_exp(pA0, pA1, bt, relq, 0 - q0w, hi);
    int kb = 0, vb = 0;
    int ureg = (0 - q0w <= -191) ? 0 : ((0 - q0w >= 158) ? 2 : 1);
    for (int j = 0; j < NT; ++j) {
        asm volatile("s_waitcnt vmcnt(0)" ::: "memory"); __syncthreads();
        const int kb1 = kb == 2 ? 0 : kb + 1, kb2 = kb1 == 2 ? 0 : kb1 + 1;
        if (j + 2 < NT) DMA_K(kb2, (j + 2) * KVBLK);
        if (j + 1 < NT) DMA_V(vb ^ 1, (j + 1) * KVBLK);
        const int dq = j * KVBLK - q0w;
        { const int u = (dq <= -191) ? 0 : ((dq >= 158) ? 2 : 1);
          if (u != ureg) {
              const float cp = ureg == 0 ? bt[0] : (ureg == 2 ? bt[511] : 0.f), cn = u == 0 ? bt[0] : (u == 2 ? bt[511] : 0.f);
              const float f = __builtin_amdgcn_exp2f(cp - cn);
#pragma unroll
              for (int d = 0; d < 4; ++d) { o1[d] = o1[d] * f; o2[d] = o2[d] * f; }
              l1 *= f; l2 *= f; ureg = u; } }
        sm_fin(pA0, pA1, l1, pa0, pa1, pa2, pa3); SBAR();
        qkt<1>(pB0, pB1, K_lds + kb * SHM_T, Qs, kq0, kq1); SBAR();
        pv_d0(o1, vbb + vb * SHM_T, pa0, pa1, pa2, pa3);
        sm_exp(pB0, pB1, bt, relq + j * KVBLK, dq, hi);
        sm_fin(pB0, pB1, l2, pa0, pa1, pa2, pa3); SBAR();
        if (j + 1 < NT) { qkt<0>(pA0, pA1, K_lds + kb1 * SHM_T, Qs, kq0, kq1); SBAR(); }
        pv_d0(o2, vbb + vb * SHM_T, pa0, pa1, pa2, pa3);
        if (j + 1 < NT) sm_exp(pA0, pA1, bt, relq + (j + 1) * KVBLK, dq + KVBLK, hi);
        kb = kb1; vb ^= 1;
    }
    if (hi == 0) li_l[r32] = l1; asm volatile("s_waitcnt lgkmcnt(0)" ::: "memory");
#pragma unroll
    for (int r = 0; r < 16; ++r) { const float rl = __builtin_amdgcn_rcpf(li_l[crow(r, hi)]);
#pragma unroll
        for (int d = 0; d < 4; ++d) o1[d][r] *= rl; }
    asm volatile("s_waitcnt lgkmcnt(0)" ::: "memory");
    if (hi == 0) li_l[r32] = l2; asm volatile("s_waitcnt lgkmcnt(0)" ::: "memory");
#pragma unroll
    for (int r = 0; r < 16; ++r) { const float rl = __builtin_amdgcn_rcpf(li_l[crow(r, hi)]);
#pragma unroll
        for (int d = 0; d < 4; ++d) o2[d][r] *= rl; }
#undef DMA_K
#undef DMA_V
}
}

__device__ __forceinline__ int t5_bucket(int rel) {
    const int side = rel > 0 ? 16 : 0; const int n = rel < 0 ? -rel : rel;
    if (n < 8) return side + n;
    const float v = logf((float)n / 8.0f) / 2.7725887f * 8.0f;
    int large = 8 + (int)v; large = large < 15 ? large : 15;
    return side + large;
}

struct Args { GAS const float* in[28]; GAS float* out; GAS unsigned char* ws; int ph_lo, ph_hi; };
typedef const Args __attribute__((address_space(4))) CArgs;
struct LayerW { bf16_t *WIN, *WGLU, *WBR, *WOUT, *WGU, *WD, *F, *BO; float *KTAB, *WRT; };
__device__ __forceinline__ LayerW layer_w(unsigned char* ws, int l) {
    unsigned char* b = ws + WS_LW + (size_t)l * LW_SIZE; LayerW w;
    w.WIN = (bf16_t*)(b + LW_WIN); w.WGLU = (bf16_t*)(b + LW_WGLU); w.WBR = (bf16_t*)(b + LW_WBR); w.WOUT = (bf16_t*)(b + LW_WOUT); w.WGU = (bf16_t*)(b + LW_WGU);
    w.WD = (bf16_t*)(b + LW_WD); w.F = (bf16_t*)(b + LW_F); w.BO = (bf16_t*)(b + LW_BO); w.KTAB = (float*)(b + LW_KTAB); w.WRT = (float*)(b + LW_WRT); return w;
}
enum { I_X = 0, I_WIN, I_ARE, I_AIM, I_LDT, I_BRE, I_BIM, I_CRE, I_CIM, I_SD, I_WGLU, I_WSB, I_QG, I_KG, I_LQ1, I_LK1, I_LQ2, I_LK2, I_SUBLN, I_WAB, I_RELB, I_WOUT,
       I_NMIX, I_NFFN, I_WR, I_WEG, I_WEU, I_WED };

struct TItem { const float* src; bf16_t* dst; const float* gain; int N, ldd, rowmode, f8; };
__device__ __forceinline__ void t_load(const TItem& t, f32x4 (&v)[16], int lane) {
    const int r = lane >> 4, q = lane & 15;
#pragma unroll
    for (int j = 0; j < 16; ++j) v[j] = __builtin_nontemporal_load((const f32x4*)(t.src + (size_t)(4 * j + r) * t.N + 4 * q));
}
__device__ __forceinline__ void t_lds(const f32x4 (&v)[16], LAS float* scr, int lane) {
    const int r = lane >> 4, q = lane & 15;
#pragma unroll
    for (int j = 0; j < 16; ++j) { LAS float* s = scr + (4 * j + r) * 65 + 4 * q; s[0] = v[j][0]; s[1] = v[j][1]; s[2] = v[j][2]; s[3] = v[j][3]; }
}
__device__ __forceinline__ void t_store(const TItem& t, int n0, LAS float* scr, int lane) {
    const int c = lane & 7;
    float gn[8];
#pragma unroll
    for (int i = 0; i < 8; ++i) gn[i] = t.gain ? t.gain[8 * c + i] : 1.f;
#pragma unroll
    for (int j = 0; j < 8; ++j) { const int n = (lane >> 3) + 8 * j; const LAS float* s = scr + (8 * c) * 65 + n;
        u32x4 o; o.x = cvt_pk_bf16(s[0 * 65] * gn[0], s[1 * 65] * gn[1]); o.y = cvt_pk_bf16(s[2 * 65] * gn[2], s[3 * 65] * gn[3]);
        o.z = cvt_pk_bf16(s[4 * 65] * gn[4], s[5 * 65] * gn[5]); o.w = cvt_pk_bf16(s[6 * 65] * gn[6], s[7 * 65] * gn[7]);
        const int ng = n0 + n; const int drow = t.rowmode == 0 ? ng : ((ng >> 7) * 256 + ((ng >> 5) & 3) * 64 + (ng & 31) + (t.rowmode == 2 ? 32 : 0));
        if (t.f8) { const f32x4 a = (f32x4){s[0 * 65] * gn[0], s[1 * 65] * gn[1], s[2 * 65] * gn[2], s[3 * 65] * gn[3]} * W8_SCALE, b = (f32x4){s[4 * 65] * gn[4], s[5 * 65] * gn[5], s[6 * 65] * gn[6], s[7 * 65] * gn[7]} * W8_SCALE;
            *(u32x2*)((unsigned char*)t.dst + (size_t)drow * t.ldd + 8 * c) = pack8_fp8(a, b); }
        else *(u32x4*)(t.dst + (size_t)drow * t.ldd + 8 * c) = o; }
}

constexpr int IT_WIN = (D / 64) * (INC / 64), IT_GLU = 16 * 16, IT_BR = 16 * 32, IT_OUT = 32 * 32, IT_E = 32 * 32;
constexpr int IT_LAYER0 = IT_WIN + IT_GLU + 2 * IT_BR + IT_OUT + 2 * NE * IT_E;
constexpr int IT_DOWN = NE * IT_E;
__device__ __forceinline__ TItem make_item(const float* src, bf16_t* dst, const float* gain, int N, int ldd, int rowmode, int f8, int r, int& n0) {
    const int nblk = N / 64, k0 = 64 * (r / nblk); n0 = 64 * (r % nblk);
    TItem t; t.src = src + (size_t)k0 * N + n0; t.dst = f8 ? (bf16_t*)((unsigned char*)dst + k0) : dst + k0; t.gain = gain ? gain + k0 : nullptr; t.N = N; t.ldd = ldd; t.rowmode = rowmode; t.f8 = f8; return t; }
struct DecMain { CArgs* ap; unsigned char* ws;
    __device__ __forceinline__ TItem operator()(int it, int& n0) const { CArgs& args = *ap;
        const int l = it / IT_LAYER0; int r = it % IT_LAYER0; const LayerW w = layer_w(ws, l);
        if (r < IT_WIN) { const bool gate = (r % (INC / 64)) >= 64;
            return gate ? make_item((const float*)args.in[I_WIN] + (size_t)l * D * INC, (bf16_t*)((unsigned char*)w.WIN + (size_t)16 * MiB - (size_t)4096 * D), (const float*)args.in[I_NMIX] + l * D, INC, D, 0, 1, r, n0)
                        : make_item((const float*)args.in[I_WIN] + (size_t)l * D * INC, w.WIN, (const float*)args.in[I_NMIX] + l * D, INC, D, 0, 0, r, n0); }
        if ((r -= IT_WIN) < IT_GLU) return make_item((const float*)args.in[I_WGLU] + (size_t)l * SSMW * SSMW, w.WGLU, nullptr, SSMW, SSMW, 0, 0, r, n0);
        if ((r -= IT_GLU) < IT_BR) return make_item((const float*)args.in[I_WSB] + (size_t)l * SSMW * D, w.WBR, nullptr, D, 2048, 0, 0, r, n0);
        if ((r -= IT_BR) < IT_BR) return make_item((const float*)args.in[I_WAB] + (size_t)l * 1024 * D, w.WBR + 1024, nullptr, D, 2048, 0, 0, r, n0);
        if ((r -= IT_BR) < IT_OUT) return make_item((const float*)args.in[I_WOUT] + (size_t)l * D * D, w.WOUT, nullptr, D, D, 0, 0, r, n0);
        r -= IT_OUT; const int which = r / (NE * IT_E), e = (r / IT_E) % NE; r = r % IT_E; const size_t eo = ((size_t)l * NE + e) * D * FF;
        return make_item((const float*)args.in[which == 0 ? I_WEG : I_WEU] + eo, (bf16_t*)((unsigned char*)w.WGU + (size_t)e * 4096 * D), (const float*)args.in[I_NFFN] + l * D, FF, D, which == 0 ? 1 : 2, 1, r, n0); } };
struct DecDown { CArgs* ap; unsigned char* ws; int l;
    __device__ __forceinline__ TItem operator()(int it, int& n0) const { CArgs& args = *ap; const LayerW w = layer_w(ws, l);
        const int e = it / IT_E, r = it % IT_E; const size_t eo = ((size_t)l * NE + e) * D * FF;
        return make_item((const float*)args.in[I_WED] + eo, (bf16_t*)((unsigned char*)w.WD + (size_t)e * D * FF), nullptr, D, FF, 0, 1, r, n0); } };
template <class Dec> __device__ __forceinline__ void convert_items(const Dec& dec, int first, int end, int step, LAS float* scr, int lane) {
    f32x4 tv[16]; int n0c = 0, n0n = 0; TItem cur, nxt; cur.src = nullptr; cur.dst = nullptr; cur.gain = nullptr; cur.N = 0; cur.ldd = 0; cur.rowmode = 0; cur.f8 = 0; nxt = cur;
    int it = first;
    if (it < end) { cur = dec(it, n0c); t_load(cur, tv, lane); }
    for (; it < end; it += step) {
        t_lds(tv, scr, lane);
        if (it + step < end) { nxt = dec(it + step, n0n); t_load(nxt, tv, lane); }
        LDS_WAIT(); asm volatile("" ::: "memory");
        t_store(cur, n0c, scr, lane);
        LDS_WAIT(); asm volatile("" ::: "memory");
        cur = nxt; n0c = n0n; }
}

template <bool ROUTER>
__device__ __forceinline__ void row_pass(const float* xrow, bf16_t* xb, float* rinv_out, const LAS float* WtL, float* afft, int row, int lane, unsigned char* xb8 = nullptr) {
    f32x4 v[8]; float ss = 0.f;
#pragma unroll
    for (int j = 0; j < 8; ++j) { v[j] = *(const f32x4*)(xrow + 4 * lane + 256 * j); ss += v[j][0] * v[j][0] + v[j][1] * v[j][1] + v[j][2] * v[j][2] + v[j][3] * v[j][3]; }
    ss = wave_sum(ss);
    const float rinv = __builtin_amdgcn_rsqf(ss * (1.f / D) + EPS);
#pragma unroll
    for (int j = 0; j < 8; ++j) { u32x2 w; w.x = cvt_pk_bf16(v[j][0], v[j][1]); w.y = cvt_pk_bf16(v[j][2], v[j][3]); *(u32x2*)(xb + 4 * lane + 256 * j) = w; }
    if (xb8) {
#pragma unroll
        for (int j = 0; j < 8; ++j) { int w8 = 0; w8 = __builtin_amdgcn_cvt_pk_fp8_f32(v[j][0], v[j][1], w8, false); w8 = __builtin_amdgcn_cvt_pk_fp8_f32(v[j][2], v[j][3], w8, true); *(int*)(xb8 + 4 * lane + 256 * j) = w8; } }
    if (lane == 0) *rinv_out = rinv;
    if constexpr (ROUTER) {
        float lg[16];
#pragma unroll
        for (int e = 0; e < 16; ++e) { float a = 0.f;
#pragma unroll
            for (int j = 0; j < 8; ++j) { const f32x4 w = *(const LAS f32x4*)(WtL + e * 2048 + 4 * lane + 256 * j); a += v[j][0] * w[0] + v[j][1] * w[1] + v[j][2] * w[2] + v[j][3] * w[3]; }
            lg[e] = wave_sum(a) * rinv; }
        float mx = lg[0];
#pragma unroll
        for (int e = 1; e < 16; ++e) mx = fmaxf(mx, lg[e]);
        float sum = 0.f;
#pragma unroll
        for (int e = 0; e < 16; ++e) { lg[e] = __expf(lg[e] - mx); sum += lg[e]; }
        const float inv = 1.f / sum;
        float mine = 0.f;
#pragma unroll
        for (int e = 0; e < 16; ++e) mine = (lane == e) ? lg[e] * inv : mine;
        if (lane < 16) afft[(size_t)lane * S + row] = mine;
    }
}

__device__ __forceinline__ void router_row(const u32x2 (&xw)[8], float* rinv_out, const LAS float* WtL, float* afft, int row, int lane) {
    f32x4 v[8]; float ss = 0.f;
#pragma unroll
    for (int j = 0; j < 8; ++j) { const u32x2 w = xw[j]; v[j] = (f32x4){bf_lo(w.x), bf_hi(w.x), bf_lo(w.y), bf_hi(w.y)}; ss += v[j][0] * v[j][0] + v[j][1] * v[j][1] + v[j][2] * v[j][2] + v[j][3] * v[j][3]; }
    ss = wave_sum(ss);
    const float rinv = __builtin_amdgcn_rsqf(ss * (1.f / D) + EPS);
    if (lane == 0) *rinv_out = rinv;
    float lg[16];
#pragma unroll
    for (int e = 0; e < 16; ++e) { float a = 0.f;
#pragma unroll
        for (int j = 0; j < 8; ++j) { const f32x4 w = *(const LAS f32x4*)(WtL + e * 2048 + 4 * lane + 256 * j); a += v[j][0] * w[0] + v[j][1] * w[1] + v[j][2] * w[2] + v[j][3] * w[3]; }
        lg[e] = wave_sum(a) * rinv; }
    float mx = lg[0];
#pragma unroll
    for (int e = 1; e < 16; ++e) mx = fmaxf(mx, lg[e]);
    float sum = 0.f;
#pragma unroll
    for (int e = 0; e < 16; ++e) { lg[e] = __expf(lg[e] - mx); sum += lg[e]; }
    const float inv = 1.f / sum;
    float mine = 0.f;
#pragma unroll
    for (int e = 0; e < 16; ++e) mine = (lane == e) ? lg[e] * inv : mine;
    if (lane < 16) afft[(size_t)lane * S + row] = mine;
}
__device__ __forceinline__ int block_sum_i(int v, LAS int* red, int wave, int lane) {
#pragma unroll
    for (int o = 1; o < 64; o <<= 1) v += __shfl_xor(v, o);
    __syncthreads();
    if (lane == 0) red[wave] = v;
    __syncthreads();
    int t = 0;
#pragma unroll
    for (int w = 0; w < 8; ++w) t += red[w];
    return t;
}

__global__ void __launch_bounds__(512, 2) fwd(Args kargs) {
    extern __shared__ __attribute__((aligned(16))) unsigned char lds_raw[];
    LAS unsigned char* lds = (LAS unsigned char*)lds_raw;
    volatile LAS unsigned* MISC = (volatile LAS unsigned*)(lds + MISC_OFF);
    const int G = gridDim.x;
    unsigned* ctl = (unsigned*)((unsigned char*)kargs.ws + WS_CTL);
    if (threadIdx.x < 64) MISC[threadIdx.x] = 0u;
    __syncthreads();
    XcdBarrier bar; bar.bar = ctl + 1024; bar.x = 0; bar.st = nullptr;
    if (!MK_PER_PHASE) bar = xcd_barrier_post(ctl + 1024, MISC + 8);
    const int lo = kargs.ph_lo, hi = kargs.ph_hi;
#ifndef PH_MASK
#define PH_MASK 0xFFFF
#endif
#define PON(b) ((PH_MASK >> (b)) & 1)
#ifndef REP_MASK
#define REP_MASK 0
#endif
#define REPS(b) (((REP_MASK >> (b)) & 1) ? 2 : 1)
#define IN(k) (lo <= (k) && (k) < hi)
#define PH_ENTER int tz0_ = threadIdx.x; asm volatile("" : "+v"(tz0_)); int bz0_ = blockIdx.x; asm volatile("" : "+s"(bz0_)); \
    const int tid = tz0_, lane = tid & 63, wave = __builtin_amdgcn_readfirstlane(tid >> 6), bx = bz0_, vcu = (G % 8 == 0) ? (bx % 8) * (G / 8) + bx / 8 : bx, gw = vcu * 8 + wave, NGW = G * 8; \
    (void)lane; (void)wave; (void)bx; (void)vcu; (void)gw; (void)NGW; \
      \
    CArgs* ap_ = (CArgs*)__builtin_amdgcn_kernarg_segment_ptr(); asm volatile("" : "+s"(ap_)); CArgs& args = *ap_; \
    unsigned char* const ws = (unsigned char*)args.ws; unsigned char* const act = ws + WS_ACT; unsigned char* const sm = act + A_SMALL; (void)sm; \
    bf16_t* const XB = (bf16_t*)(act + A_XB); unsigned char* const XB8 = act + A_O1; (void)XB8; bf16_t* const XB1 = (bf16_t*)(act + A_XB1); bf16_t* const UA = (bf16_t*)(act + A_UA); \
    bf16_t* const Qb = (bf16_t*)(act + A_Q); bf16_t* const Kb = (bf16_t*)(act + A_K); bf16_t* const Vb = (bf16_t*)(act + A_V); bf16_t* const Gb = (bf16_t*)(act + A_G); \
    float* const SSUM = (float*)(act + A_SSUM); bf16_t* const Yb = (bf16_t*)(act + A_Y); bf16_t* const YO = (bf16_t*)(act + A_YO); \
    bf16_t* const MG = (bf16_t*)(act + A_MG); float* const XA = (float*)(act + A_XA); bf16_t* const XG = (bf16_t*)(act + A_XG); bf16_t* const Hb = (bf16_t*)(act + A_H); bf16_t* const YX = (bf16_t*)(act + A_YX); \
    float* const RINV = (float*)(sm + SM_RINV); float* const RINV2 = (float*)(sm + SM_RINV2); float* const AFFT = (float*)(sm + SM_AFFT); int* const IDX = (int*)(sm + SM_IDX); \
    float* const GATE = (float*)(sm + SM_GATE); float* const RSL = (float*)(sm + SM_RSL); int* const INV = (int*)(sm + SM_INV); float* const LAMS = (float*)(sm + SM_LAM); \
    (void)XB; (void)XB1; (void)UA; (void)Qb; (void)Kb; (void)Vb; (void)Gb; (void)SSUM; (void)Yb; (void)YO; (void)MG; (void)XA; (void)XG; (void)Hb; (void)YX; \
    (void)RINV; (void)RINV2; (void)AFFT; (void)IDX; (void)GATE; (void)RSL; (void)INV; (void)LAMS;
#define INP(i) ((const float*)args.in[i])
#define OUTP ((float*)args.out)
#define LAYER_ENTER const LayerW w = layer_w(ws, l); const float lam_init = (l == 0) ? 0.2f : 0.35550906759f;   \
    (void)w; (void)lam_init;
#define SEAM(k) do { if (IN(k) && IN((k) + 1)) { if (!MK_PER_PHASE) xcd_barrier(bar); } } while (0)

    if (PON(0) && IN(0)) _Pragma("nounroll") for (int rep_ = 0; rep_ < REPS(0); ++rep_) { PH_ENTER
        LAS float* scr = (LAS float*)(lds + wave * 16640);
        convert_items(DecMain{ap_, ws}, gw, NL * IT_LAYER0, NGW, scr, lane);
        for (int i = gw * 64 + lane; i < NL * NE * D; i += NGW * 64) { const int l = i / (NE * D), e = (i / D) % NE, k = i % D;
            layer_w(ws, l).WRT[e * D + k] = INP(I_NFFN)[l * D + k] * INP(I_WR)[((size_t)l * D + k) * NE + e]; }
        for (int task = vcu; task < NL * NGRP * 2; task += G) {
            const int l = task / (NGRP * 2), g = (task >> 1) % NGRP, dir = task & 1;
            const size_t pb = ((size_t)(l * 2 + dir) * NGRP + g);
            LAS float* CR = (LAS float*)lds; LAS float* CI = CR + 16 * 65; LAS float* BR = CI + 16 * 65; LAS float* BI = BR + 64 * 16; LAS float* WD = BI + 64 * 16 + wave * 128;
            __syncthreads();
            for (int i = tid; i < 1024; i += 512) { const int pp = i >> 6, nn = i & 63; CR[pp * 65 + nn] = INP(I_CRE)[(pb * GP + pp) * NST + nn]; CI[pp * 65 + nn] = INP(I_CIM)[(pb * GP + pp) * NST + nn];
                BR[i] = INP(I_BRE)[pb * NST * GP + i]; BI[i] = INP(I_BIM)[pb * NST * GP + i]; }
            __syncthreads();
            const float are = INP(I_ARE)[pb * NST + lane], aim = INP(I_AIM)[pb * NST + lane], dt = expf(INP(I_LDT)[pb]);
            const float mag1 = expf(are * dt), ang1 = aim * dt, b1r = mag1 * cosf(ang1), b1i = mag1 * sinf(ang1);
            const float nr = b1r - 1.f, ni = b1i, den = are * are + aim * aim;
            const float cr = (nr * are + ni * aim) / den, ci = (ni * are - nr * aim) / den;
            const int p = lane >> 2, q0 = (lane & 3) * 4;
            for (int k = 0; k < 4; ++k) { const int dl = wave * 4 + k;
                const float magd = expf(are * dt * (float)dl), angd = aim * dt * (float)dl, pr = magd * cosf(angd), pi = magd * sinf(angd);
                WD[lane] = pr * cr - pi * ci; WD[64 + lane] = pr * ci + pi * cr;
                LDS_WAIT();
                f32x4 out = {0.f, 0.f, 0.f, 0.f};
#pragma unroll 8
                for (int n = 0; n < NST; ++n) {
                    const float wr_ = WD[n], wi_ = WD[64 + n];
                    const float c_r = CR[p * 65 + n], c_i = CI[p * 65 + n];
                    const float er = c_r * wr_ - c_i * wi_, ei = c_r * wi_ + c_i * wr_;
                    const f32x4 br = *(const LAS f32x4*)(BR + n * GP + q0), bi = *(const LAS f32x4*)(BI + n * GP + q0);
                    out += br * er - bi * ei;
                }
                *(f32x4*)(layer_w(ws, l).KTAB + ((((size_t)g * 2 + dir) * TC + dl) * GP + p) * GP + q0) = out;
                LDS_WAIT(); }
            { const LayerW w = layer_w(ws, l);
              for (int k = 0; k < 4; ++k) { const int t = wave * 4 + k;
                { const float e = dir == 0 ? (float)(t + 1) : (float)(TC - t); const float mg = expf(are * dt * e), an = aim * dt * e, pr = mg * cosf(an), pi = mg * sinf(an);
#pragma unroll
                  for (int pp = 0; pp < GP; ++pp) { const float c_r = CR[pp * 65 + lane], c_i = CI[pp * 65 + lane];
                      bf16_t* o = w.BO + ((size_t)g * 512 + t * 16 + pp) * UAW + 512 + dir * 128 + lane; o[0] = f2bf(c_r * pr - c_i * pi); o[64] = f2bf(-(c_r * pi + c_i * pr)); } }
                { const float e = dir == 0 ? (float)(TC - 1 - t) : (float)t; const float mg = expf(are * dt * e), an = aim * dt * e, pr = mg * cosf(an), pi = mg * sinf(an);
                  const float wre = pr * cr - pi * ci, wim = pr * ci + pi * cr;
                  f32x4 re[4], im[4];
#pragma unroll
                  for (int q = 0; q < 4; ++q) { const f32x4 br = *(const LAS f32x4*)(BR + lane * GP + 4 * q), bi = *(const LAS f32x4*)(BI + lane * GP + 4 * q); re[q] = br * wre - bi * wim; im[q] = bi * wre + br * wim; }
                  bf16_t* o = w.F + ((size_t)g * 256 + dir * 128 + lane) * 512 + t * 16;
                  *(u32x4*)o = pack8(re[0], re[1]); *(u32x4*)(o + 8) = pack8(re[2], re[3]);
                  *(u32x4*)(o + 64 * 512) = pack8(im[0], im[1]); *(u32x4*)(o + 64 * 512 + 8) = pack8(im[2], im[3]); } } }
        }
        __syncthreads();
        for (int m = gw; m < S; m += NGW) row_pass<false>(INP(I_X) + (size_t)m * D, XB + (size_t)m * D, RINV + m, nullptr, nullptr, m, lane, XB8 + (size_t)m * D);
        if (gw < NL) { const int l = gw; const float a = wave_sum(INP(I_LQ1)[l * QKD + lane] * INP(I_LK1)[l * QKD + lane]);
            const float b = wave_sum(INP(I_LQ2)[l * QKD + lane] * INP(I_LK2)[l * QKD + lane]);
            if (lane == 0) LAMS[l] = expf(a) - expf(b) + ((l == 0) ? 0.2f : 0.35550906759f); }
        for (int i = gw * 64 + lane; i < NH * 512; i += NGW * 64) { const int h = i >> 9, rel = (i & 511) - 256;
            ((float*)(sm + SM_BTAB))[i] = INP(I_RELB)[t5_bucket(rel) * NH + h] * LOG2E; }
    }
    SEAM(0);

    for (int l = 0; l < NL; ++l) {
        const int pbase = 2 + l * 14;
        if (PON(2) && IN(pbase + 0)) _Pragma("nounroll") for (int rep_ = 0; rep_ < REPS(2); ++rep_) { PH_ENTER LAYER_ENTER
            { pg::SchedGrid Sg; Sg.init(XB, D, w.WIN, D, S, 4096, G, bx);
              EpiInProj E{RINV, UA, Qb, Kb, Vb, Gb, INP(I_QG) + l * QKD, INP(I_KG) + l * QKD};
              pg::gemm_phase(lds, D, D, D, Sg, E); }
            { pg::SchedGrid Sg; Sg.init(XB8, D, (unsigned char*)w.WIN + (size_t)16 * MiB, D, S, 4096, G, bx, 1);
              EpiGates E{RINV, Gb};
              pg::gemm_phase<EpiGates, pg::SchedGrid, true, E8_ONE, E8_W>(lds, D, D, D, Sg, E); }
        }
        SEAM(pbase + 0);
        if (PON(3) && IN(pbase + 1)) _Pragma("nounroll") for (int rep_ = 0; rep_ < REPS(3); ++rep_) { PH_ENTER LAYER_ENTER
            pg::SchedGroup Sg; Sg.init(UA, UAW, (size_t)NCH * UAW * 2, w.F, 512, (size_t)256 * 512 * 2, 1, 1, NGRP, G, vcu);
            EpiSsum E{SSUM};
            pg::gemm_phase(lds, 512, UAW, 512, Sg, E);
            if (vcu >= NGRP) convert_items(DecDown{ap_, ws, l}, (vcu - NGRP) * 8 + wave, 4096, (G - NGRP) * 8, (LAS float*)(lds + wave * 16640), lane);
            if (vcu >= NGRP) for (long i = (long)((vcu - NGRP) * 8 + wave) * 64 + lane; i < (long)NGRP * 512 * 64; i += (long)(G - NGRP) * 8 * 64) {
            const int l2 = l, g = (int)(i / (512 * 64)) % NGRP, rr = (int)(i / 64) % 512, kc = (int)(i % 64);
            const int t = rr >> 4, p = rr & 15, tau = kc >> 1, q0 = (kc & 1) * 8;
            const LayerW w2 = layer_w(ws, l2);
            const float* kf = w2.KTAB + (((size_t)g * 2 + 0) * TC) * 256; const float* kb = w2.KTAB + (((size_t)g * 2 + 1) * TC) * 256;
            f32x4 a, b;
            if (tau < t) { const float* s = kf + ((t - tau) * GP + p) * GP + q0; a = *(const f32x4*)s; b = *(const f32x4*)(s + 4); }
            else if (tau > t) { const float* s = kb + ((tau - t) * GP + p) * GP + q0; a = *(const f32x4*)s; b = *(const f32x4*)(s + 4); }
            else { const float* s = kf + p * GP + q0; const float* s2 = kb + p * GP + q0; a = *(const f32x4*)s + *(const f32x4*)s2; b = *(const f32x4*)(s + 4) + *(const f32x4*)(s2 + 4);
                const float dd = INP(I_SD)[l2 * SSMW + g * GP + p];
#pragma unroll
                for (int j = 0; j < 4; ++j) { if (q0 + j == p) a[j] += dd; if (q0 + 4 + j == p) b[j] += dd; } }
            *(u32x4*)(w2.BO + ((size_t)g * 512 + rr) * UAW + tau * 16 + q0) = pack8(a, b);
        }
            if (vcu < NGRP && wave < 2) {
                const int g = vcu, dir = wave; const size_t pb = ((size_t)(l * 2 + dir) * NGRP + g);
                const float are = INP(I_ARE)[pb * NST + lane], aim = INP(I_AIM)[pb * NST + lane], dt = expf(INP(I_LDT)[pb]);
                const float mg = expf(are * dt * (float)TC), an = aim * dt * (float)TC, ar = mg * cosf(an), ai = mg * sinf(an);
                float sr = 0.f, si = 0.f;
                for (int cb = 0; cb < NCH; cb += 8) {
                    float xr[8], xi[8];
#pragma unroll
                    for (int k = 0; k < 8; ++k) { const int c = dir == 0 ? cb + k : NCH - 1 - cb - k; const float* s = SSUM + ((size_t)g * NCH + c) * 256 + dir * 128 + lane; xr[k] = s[0]; xi[k] = s[64]; }
#pragma unroll
                    for (int k = 0; k < 8; ++k) { const int c = dir == 0 ? cb + k : NCH - 1 - cb - k;
                        bf16_t* o = UA + ((size_t)g * NCH + c) * UAW + 512 + dir * 128 + lane; o[0] = f2bf(sr); o[64] = f2bf(si);
                        const float nr = ar * sr - ai * si + xr[k], ni = ar * si + ai * sr + xi[k]; sr = nr; si = ni; }
                }
            }
        }
        SEAM(pbase + 1);
        if (PON(5) && IN(pbase + 3)) _Pragma("nounroll") for (int rep_ = 0; rep_ < REPS(5); ++rep_) { PH_ENTER LAYER_ENTER
            pg::SchedGroup Sg; Sg.init(UA, UAW, (size_t)NCH * UAW * 2, w.BO, UAW, (size_t)512 * UAW * 2, 1, 2, NGRP, G, vcu);
            EpiSsmOut E{Yb};
            pg::gemm_phase(lds, UAW, UAW, UAW, Sg, E);
            if (vcu >= 2 * NGRP) convert_items(DecDown{ap_, ws, l}, 4096 + (vcu - 2 * NGRP) * 8 + wave, 10240, (G - 2 * NGRP) * 8, (LAS float*)(lds + wave * 16640), lane);
        }
        SEAM(pbase + 3);
        if (PON(6) && IN(pbase + 4)) _Pragma("nounroll") for (int rep_ = 0; rep_ < REPS(6); ++rep_) { PH_ENTER LAYER_ENTER
            pg::SchedGrid Sg; Sg.init(Yb, SSMW, w.WGLU, SSMW, S, SSMW, G, bx);
            EpiGlu E{Yb, YO};
            pg::gemm_phase(lds, SSMW, SSMW, SSMW, Sg, E);
            if (bx >= 128) convert_items(DecDown{ap_, ws, l}, 10240 + (bx - 128) * 8 + wave, IT_DOWN, (G - 128) * 8, (LAS float*)(lds + wave * 16640), lane);
        }
        SEAM(pbase + 4);
        if (PON(7) && IN(pbase + 5)) _Pragma("nounroll") for (int rep_ = 0; rep_ < REPS(7); ++rep_) { PH_ENTER LAYER_ENTER
            for (int un = vcu; un < NH * (S / 256); un += G) {
                const int h = un / (S / 256), qb = un % (S / 256);
                __syncthreads();
                { int tb = threadIdx.x; asm volatile("" : "+v"(tb)); ((LAS float*)(lds + att::OFF_BT))[tb] = ((const float*)(sm + SM_BTAB))[h * 512 + tb]; }
                const int q0w = qb * 256 + wave * 32;
                f32x16 o[4];
                { f32x16 o2[4];
                  att::attn_dual(o, o2, Qb + (size_t)q0w * 1024 + h * 128, Kb + h * 128, Vb + h * 128, (LAS char*)lds, q0w);
                  const float lam = LAMS[l];
#pragma unroll
                  for (int d = 0; d < 4; ++d) o[d] = o[d] - o2[d] * lam; }
                { int tz = threadIdx.x; asm volatile("" : "+v"(tz)); const int r32 = tz & 31, hi2 = (tz >> 5) & 1;
                  float ssq[16];
#pragma unroll
                  for (int r = 0; r < 16; ++r) { float s = 0.f;
#pragma unroll
                    for (int d = 0; d < 4; ++d) s += o[d][r] * o[d][r];
                    s += swz_xor<1>(s); s += swz_xor<2>(s); s += swz_xor<4>(s); s += swz_xor<8>(s); s += swz_xor<16>(s);
                    ssq[r] = __builtin_amdgcn_rsqf(s * (1.f / VD) + EPS) * (1.f - lam_init); }
                  bf16_t* yo = YO + (size_t)(q0w + 4 * hi2) * 2048 + 1024 + h * 128 + r32;
#pragma unroll
                  for (int d = 0; d < 4; ++d) { const float gn = INP(I_SUBLN)[l * VD + d * 32 + r32];
#pragma unroll
                    for (int r = 0; r < 16; ++r) yo[(size_t)((r & 3) + 8 * (r >> 2)) * 2048 + d * 32] = f2bf(o[d][r] * ssq[r] * gn); } }
            }
            __syncthreads();
        }
        SEAM(pbase + 5);
        if (PON(8) && IN(pbase + 6)) _Pragma("nounroll") for (int rep_ = 0; rep_ < REPS(8); ++rep_) { PH_ENTER LAYER_ENTER
            pg::SchedGrid Sg; Sg.init(YO, 2048, w.WBR, 2048, S, D, G, bx);
            EpiMerge E{Gb, MG};
            pg::gemm_phase(lds, 2048, 2048, 2048, Sg, E);
        }
        SEAM(pbase + 6);
        if (PON(9) && IN(pbase + 7)) _Pragma("nounroll") for (int rep_ = 0; rep_ < REPS(9); ++rep_) { PH_ENTER LAYER_ENTER
            pg::SchedGrid Sg; Sg.init(MG, D, w.WOUT, D, S, D, G, bx);
            EpiOutProj E{XB, XB1};
            pg::gemm_phase(lds, D, D, D, Sg, E);
        }
        SEAM(pbase + 7);
        if (PON(10) && IN(pbase + 8)) _Pragma("nounroll") for (int rep_ = 0; rep_ < REPS(10); ++rep_) { PH_ENTER LAYER_ENTER
            LAS float* WtL = (LAS float*)lds;
            for (int i = tid; i < NE * D / 4; i += 512) ((LAS f32x4*)WtL)[i] = ((const f32x4*)w.WRT)[i];
            __syncthreads();
            { u32x2 xc[8], xn[8];
#pragma unroll
              for (int j = 0; j < 8; ++j) { xc[j] = (u32x2){0u, 0u}; xn[j] = xc[j]; }
              if (gw < S) {
#pragma unroll
                  for (int j = 0; j < 8; ++j) xc[j] = *(const u32x2*)(XB1 + (size_t)gw * D + 4 * lane + 256 * j); }
              for (int m = gw; m < S; m += NGW) { int lz = lane; asm volatile("" : "+v"(lz));
                  if (m + NGW < S) {
#pragma unroll
                      for (int j = 0; j < 8; ++j) xn[j] = *(const u32x2*)(XB1 + (size_t)(m + NGW) * D + 4 * lz + 256 * j); }
                  router_row(xc, RINV2 + m, WtL, AFFT, m, lz);
#pragma unroll
                  for (int j = 0; j < 8; ++j) xc[j] = xn[j]; } }
            __syncthreads();
        }
        SEAM(pbase + 8);
        if (PON(11) && IN(pbase + 9)) _Pragma("nounroll") for (int rep_ = 0; rep_ < REPS(11); ++rep_) { PH_ENTER LAYER_ENTER
            const int nparts = G / NE > 0 ? G / NE : 1;
            if (vcu < nparts * NE) {
                const int e = vcu / nparts, part = vcu % nparts, per = (CAP + nparts - 1) / nparts, slo = part * per, shi = (slo + per < CAP) ? slo + per : CAP;
                LAS int* red = (LAS int*)lds; LAS int* list = (LAS int*)(lds + 1024);
                unsigned bits[16]; { const float* a = AFFT + (size_t)e * S + tid * 16;
#pragma unroll
                    for (int q = 0; q < 4; ++q) { const f32x4 v = *(const f32x4*)(a + 4 * q); bits[4 * q] = __float_as_uint(v[0]); bits[4 * q + 1] = __float_as_uint(v[1]); bits[4 * q + 2] = __float_as_uint(v[2]); bits[4 * q + 3] = __float_as_uint(v[3]); } }
                unsigned T = 0u;
                for (int bit = 30; bit >= 0; --bit) { const unsigned cand = T | (1u << bit); int c = 0;
#pragma unroll
                    for (int i = 0; i < 16; ++i) c += bits[i] >= cand ? 1 : 0;
                    if (block_sum_i(c, red, wave, lane) >= CAP) T = cand; }
                int cg = 0, ce = 0;
#pragma unroll
                for (int i = 0; i < 16; ++i) { cg += bits[i] > T ? 1 : 0; ce += bits[i] == T ? 1 : 0; }
                const int need_eq = CAP - block_sum_i(cg, red, wave, lane);
                int sg = cg, se = ce;
#pragma unroll
                for (int o = 1; o < 64; o <<= 1) { const int a = __shfl_up(sg, o), b = __shfl_up(se, o); if (lane >= o) { sg += a; se += b; } }
                __syncthreads();
                if (lane == 63) { red[16 + wave] = sg; red[32 + wave] = se; }
                __syncthreads();
                int og = 0, oe = 0;
#pragma unroll
                for (int wv = 0; wv < 8; ++wv) if (wv < wave) { og += red[16 + wv]; oe += red[32 + wv]; }
                int gbef = og + sg - cg, ebef = oe + se - ce;
                const bool inv_mine = (tid * nparts) / 512 == part;
#pragma unroll
                for (int i = 0; i < 16; ++i) { const int tok = tid * 16 + i; const bool isg = bits[i] > T, ise = bits[i] == T; const bool sel = isg || (ise && ebef < need_eq);
                    const int slot = gbef + (ebef < need_eq ? ebef : need_eq);
                    if (sel && slot >= slo && slot < shi) { IDX[e * CAP + slot] = tok; GATE[e * CAP + slot] = __uint_as_float(bits[i]); RSL[e * CAP + slot] = RINV2[tok]; list[slot - slo] = tok; }
                    if (inv_mine) INV[tok * NE + e] = sel ? slot : -1;
                    gbef += isg ? 1 : 0; ebef += ise ? 1 : 0; }
                __syncthreads();
                for (int r = wave; r < shi - slo; r += 32) {
                    u32x4 t[4][4];
#pragma unroll
                    for (int q = 0; q < 4; ++q) { const int rr = (r + 8 * q < shi - slo) ? r + 8 * q : r; const u32x4* s = (const u32x4*)(XB1 + (size_t)list[rr] * D) + lane;
#pragma unroll
                        for (int j = 0; j < 4; ++j) t[q][j] = s[64 * j]; }
#pragma unroll
                    for (int q = 0; q < 4; ++q) if (r + 8 * q < shi - slo) { u32x2* d = (u32x2*)((unsigned char*)XG + (size_t)(e * CAP + slo + r + 8 * q) * D) + lane;
#pragma unroll
                        for (int j = 0; j < 4; ++j) { f32x4 a, b; unpack8(t[q][j], a, b); d[64 * j] = pack8_fp8(a, b); } } }
                __syncthreads();
            }
        }
        SEAM(pbase + 9);
        if (PON(13) && IN(pbase + 11)) _Pragma("nounroll") for (int rep_ = 0; rep_ < REPS(13); ++rep_) { PH_ENTER LAYER_ENTER
            pg::SchedGroup Sg; Sg.init(XG, D, (size_t)CAP * D, w.WGU, D, (size_t)4096 * D, 4, 16, NE, G, vcu, 1);
            EpiExp1 E{RSL, Hb};
            pg::gemm_phase<EpiExp1, pg::SchedGroup, true, E8_ONE, E8_W>(lds, D, D, D, Sg, E);
        }
        SEAM(pbase + 11);
        if (PON(14) && IN(pbase + 12)) _Pragma("nounroll") for (int rep_ = 0; rep_ < REPS(14); ++rep_) { PH_ENTER LAYER_ENTER
            pg::SchedGroup Sg; Sg.init(Hb, FF, (size_t)CAP * FF, w.WD, FF, (size_t)D * FF, 4, 8, NE, G, vcu, 1);
            EpiExp2 E{GATE, YX};
            pg::gemm_phase<EpiExp2, pg::SchedGroup, true, E8_H, E8_W>(lds, FF, FF, FF, Sg, E);
        }
        SEAM(pbase + 12);
        if (PON(15) && IN(pbase + 13)) _Pragma("nounroll") for (int rep_ = 0; rep_ < REPS(15); ++rep_) { PH_ENTER LAYER_ENTER
            { u32x2 xc[8], xn[8]; int invc = -1, invn = -1;
#pragma unroll
              for (int j = 0; j < 8; ++j) { xc[j] = (u32x2){0u, 0u}; xn[j] = xc[j]; }
              if (gw < S) { invc = INV[gw * NE + (lane & 15)];
#pragma unroll
                  for (int j = 0; j < 8; ++j) xc[j] = *(const u32x2*)(XB1 + (size_t)gw * D + 4 * lane + 256 * j); }
              for (int m = gw; m < S; m += NGW) {
                if (m + NGW < S) { invn = INV[(m + NGW) * NE + (lane & 15)];
#pragma unroll
                    for (int j = 0; j < 8; ++j) xn[j] = *(const u32x2*)(XB1 + (size_t)(m + NGW) * D + 4 * lane + 256 * j); }
                f32x4 v[8];
#pragma unroll
                for (int j = 0; j < 8; ++j) v[j] = (f32x4){bf_lo(xc[j].x), bf_hi(xc[j].x), bf_lo(xc[j].y), bf_hi(xc[j].y)};
                const int myinv = invc;
                unsigned msk = (unsigned)(__ballot(myinv >= 0) & 0xFFFFull);
                while (msk) { const int e0 = __builtin_ctz(msk); msk &= msk - 1; const bool two = msk != 0u; const int e1 = two ? __builtin_ctz(msk) : e0; if (two) msk &= msk - 1;
                    const bf16_t* y0 = YX + ((size_t)e0 * CAP + __shfl(myinv, e0)) * D; const bf16_t* y1 = YX + ((size_t)e1 * CAP + __shfl(myinv, e1)) * D;
                    u32x2 a[8], b[8];
#pragma unroll
                    for (int j = 0; j < 8; ++j) a[j] = *(const u32x2*)(y0 + 4 * lane + 256 * j);
#pragma unroll
                    for (int j = 0; j < 8; ++j) b[j] = *(const u32x2*)(y1 + 4 * lane + 256 * j);
#pragma unroll
                    for (int j = 0; j < 8; ++j) { v[j][0] += bf_lo(a[j].x); v[j][1] += bf_hi(a[j].x); v[j][2] += bf_lo(a[j].y); v[j][3] += bf_hi(a[j].y); }
                    if (two) {
#pragma unroll
                        for (int j = 0; j < 8; ++j) { v[j][0] += bf_lo(b[j].x); v[j][1] += bf_hi(b[j].x); v[j][2] += bf_lo(b[j].y); v[j][3] += bf_hi(b[j].y); } } }
                if (l + 1 < NL) {
                    float ss = 0.f;
#pragma unroll
                    for (int j = 0; j < 8; ++j) ss += v[j][0] * v[j][0] + v[j][1] * v[j][1] + v[j][2] * v[j][2] + v[j][3] * v[j][3];
                    ss = wave_sum(ss);
#pragma unroll
                    for (int j = 0; j < 8; ++j) { u32x2 wv; wv.x = cvt_pk_bf16(v[j][0], v[j][1]); wv.y = cvt_pk_bf16(v[j][2], v[j][3]); *(u32x2*)(XB + (size_t)m * D + 4 * lane + 256 * j) = wv;
                        int w8 = 0; w8 = __builtin_amdgcn_cvt_pk_fp8_f32(v[j][0], v[j][1], w8, false); w8 = __builtin_amdgcn_cvt_pk_fp8_f32(v[j][2], v[j][3], w8, true); *(int*)(XB8 + (size_t)m * D + 4 * lane + 256 * j) = w8; }
                    if (lane == 0) RINV[m] = __builtin_amdgcn_rsqf(ss * (1.f / D) + EPS);
                } else { float* orow = OUTP + (size_t)m * D;
#pragma unroll
                    for (int j = 0; j < 8; ++j) *(f32x4*)(orow + 4 * lane + 256 * j) = v[j]; }
#pragma unroll
                for (int j = 0; j < 8; ++j) xc[j] = xn[j];
                invc = invn;
              } }
        }
        SEAM(pbase + 13);
    }
#undef IN
#undef SEAM
}

#if defined(DBG_STOP)
#ifndef DBG_OFF
#define DBG_OFF A_XA
#endif
#ifndef DBG_BF16
#define DBG_BF16 0
#endif
__global__ void dbg_dump(float* out, const unsigned char* ws) {
    const unsigned char* p = ws + WS_ACT + DBG_OFF;
    for (size_t i = (size_t)blockIdx.x * 256 + threadIdx.x; i < (size_t)S * D; i += (size_t)gridDim.x * 256)
#if defined(DBG_SUM2)
        out[i] = __uint_as_float(((unsigned)((const bf16_t*)p)[i]) << 16) + __uint_as_float(((unsigned)((const bf16_t*)p)[i + (size_t)S * D]) << 16);
#else
        out[i] = DBG_BF16 ? __uint_as_float(((unsigned)((const bf16_t*)p)[i]) << 16) : ((const float*)p)[i];
#endif
}
#endif
constexpr int N_PHASES = 2 + NL * 14;
extern "C" void kernel_launch(void* const* d_in, const int* in_sizes, int n_in, void* d_out, int out_size, void* d_ws, size_t ws_size, hipStream_t stream) {
    static int grid = 0;
    if (grid == 0) {
        if (n_in != 28 || in_sizes[0] != S * D || out_size != S * D || ws_size < WS_END) { fprintf(stderr, "kernel_launch: shape/workspace mismatch (n_in %d, ws %zu, need %zu)\n", n_in, ws_size, (size_t)WS_END); grid = -1; return; }
        int dev = 0, cus = 0, per_cu = 0;
        if (hipGetDevice(&dev) != hipSuccess || hipDeviceGetAttribute(&cus, hipDeviceAttributeMultiprocessorCount, dev) != hipSuccess) { grid = -1; return; }
        if (hipFuncSetAttribute((const void*)fwd, hipFuncAttributeMaxDynamicSharedMemorySize, LDS_BYTES) != hipSuccess) { fprintf(stderr, "kernel_launch: hipFuncSetAttribute failed\n"); grid = -1; return; }
        if (hipOccupancyMaxActiveBlocksPerMultiprocessor(&per_cu, (const void*)fwd, 512, LDS_BYTES) != hipSuccess || per_cu < 1) { fprintf(stderr, "kernel_launch: occupancy query says %d\n", per_cu); }
        (void)hipGetLastError();
        grid = cus;
    }
    if (grid < 0) return;
    (void)hipMemsetAsync((char*)d_ws + WS_CTL, 0, CTL_BYTES, stream);
    Args a{};
    for (int i = 0; i < 28; ++i) a.in[i] = (GAS const float*)d_in[i];
    a.out = (GAS float*)d_out; a.ws = (GAS unsigned char*)d_ws;
#if defined(DBG_STOP)
    for (int p = 0; p < DBG_STOP; ++p) { a.ph_lo = p; a.ph_hi = p + 1; hipLaunchKernelGGL(fwd, dim3(grid), dim3(512), LDS_BYTES, stream, a); }
#if !defined(DBG_NODUMP)
    hipLaunchKernelGGL(dbg_dump, dim3(2048), dim3(256), 0, stream, (float*)d_out, (const unsigned char*)d_ws);
#endif
#elif MK_PER_PHASE
    for (int p = 0; p < N_PHASES; ++p) { a.ph_lo = p; a.ph_hi = p + 1; hipLaunchKernelGGL(fwd, dim3(grid), dim3(512), LDS_BYTES, stream, a); }
#else
    a.ph_lo = 0; a.ph_hi = N_PHASES; hipLaunchKernelGGL(fwd, dim3(grid), dim3(512), LDS_BYTES, stream, a);
#endif
    const hipError_t le = hipPeekAtLastError();
    if (le != hipSuccess) fprintf(stderr, "kernel_launch: launch failed: %s\n", hipGetErrorName(le));
}
```

```cpp
#include <hip/hip_runtime.h>
#include <cstdio>
#include <cstdint>

#define REP_MASK 7168
#ifndef MK_PER_PHASE
#define MK_PER_PHASE 0
#endif

#define LAS __attribute__((address_space(3)))
#define GAS __attribute__((address_space(1)))
typedef unsigned short bf16_t;
typedef short bf16x8 __attribute__((ext_vector_type(8)));
typedef short s16x4 __attribute__((ext_vector_type(4)));
typedef float f32x4 __attribute__((ext_vector_type(4)));
typedef float f32x2 __attribute__((ext_vector_type(2)));
typedef float f32x16 __attribute__((ext_vector_type(16)));
typedef unsigned u32x4 __attribute__((ext_vector_type(4)));
typedef unsigned u32x2 __attribute__((ext_vector_type(2)));

constexpr int S = 8192, D = 2048, NL = 2;
constexpr int SSMW = 1024, NGRP = 64, GP = 16, NST = 64;
constexpr int NH = 8, QKD = 64, VD = 128;
constexpr int NE = 16, CAP = 1024, FF = 2048;
constexpr int INC = 8192;
constexpr float EPS = 1e-6f;
constexpr int TC = 32, NCH = S / TC;
constexpr int UAW = TC * GP + 256;
constexpr float LOG2E = 1.4426950408889634f;

constexpr size_t MiB = 1u << 20;
constexpr size_t WS_CTL = 0, CTL_BYTES = 1 * MiB;
constexpr size_t LW_WIN = 0, LW_WGLU = 32 * MiB, LW_WBR = 34 * MiB, LW_WOUT = 42 * MiB, LW_WGU = 50 * MiB, LW_WD = 306 * MiB,
                 LW_F = 434 * MiB, LW_BO = 450 * MiB, LW_KTAB = 498 * MiB, LW_WRT = 502 * MiB, LW_SIZE = 503 * MiB;
constexpr size_t WS_LW = 1 * MiB;
constexpr size_t WS_ACT = WS_LW + 2 * LW_SIZE;
constexpr size_t A_XB = 0, A_XB1 = 32 * MiB, A_UA = 64 * MiB, A_Q = 88 * MiB, A_K = 104 * MiB, A_V = 120 * MiB, A_G = 136 * MiB,
                 A_SSUM = 200 * MiB, A_Y = 216 * MiB, A_YO = 232 * MiB, A_O1 = 264 * MiB, A_MG = 296 * MiB, A_XA = 328 * MiB,
                 A_XG = 392 * MiB, A_H = 456 * MiB, A_YX = 520 * MiB, A_SMALL = 584 * MiB, A_END = 588 * MiB;
constexpr size_t SM_RINV = 0, SM_RINV2 = 64 * 1024, SM_AFFT = 128 * 1024, SM_IDX = 640 * 1024, SM_GATE = 704 * 1024, SM_RSL = 768 * 1024,
                 SM_INV = 1024 * 1024, SM_BTAB = 1536 * 1024, SM_LAM = 1600 * 1024;
constexpr size_t WS_END = WS_ACT + A_END;

constexpr int RING_BYTES = 131072;
constexpr int LDS_BYTES = 163840;
constexpr int MISC_OFF = 155648;

typedef __bf16 bf16v2_t __attribute__((ext_vector_type(2)));
__device__ __forceinline__ unsigned cvt_pk_bf16(float lo, float hi) { const f32x2 v = {lo, hi}; return __builtin_bit_cast(unsigned, __builtin_convertvector(v, bf16v2_t)); }
__device__ __forceinline__ float bf_lo(unsigned w) { return __uint_as_float(w << 16); }
__device__ __forceinline__ float bf_hi(unsigned w) { return __uint_as_float(w & 0xffff0000u); }
__device__ __forceinline__ unsigned short f2bf(float f) { return (unsigned short)(cvt_pk_bf16(f, 0.f) & 0xffffu); }
__device__ __forceinline__ float fast_sigmoid(float x) { return __builtin_amdgcn_rcpf(1.f + __builtin_amdgcn_exp2f(-x * LOG2E)); }
__device__ __forceinline__ float wave_sum(float v) {
#pragma unroll
    for (int o = 1; o < 64; o <<= 1) v += __shfl_xor(v, o);
    return v;
}
template <int X> __device__ __forceinline__ float swz_xor(float v) { return __int_as_float(__builtin_amdgcn_ds_swizzle(__float_as_int(v), (X << 10) | 0x1F)); }
__device__ __forceinline__ u32x2 pack8_fp8(const f32x4 a, const f32x4 b) { int w0 = 0, w1 = 0;
    w0 = __builtin_amdgcn_cvt_pk_fp8_f32(a[0], a[1], w0, false); w0 = __builtin_amdgcn_cvt_pk_fp8_f32(a[2], a[3], w0, true);
    w1 = __builtin_amdgcn_cvt_pk_fp8_f32(b[0], b[1], w1, false); w1 = __builtin_amdgcn_cvt_pk_fp8_f32(b[2], b[3], w1, true);
    u32x2 r; r.x = (unsigned)w0; r.y = (unsigned)w1; return r; }
constexpr float W8_SCALE = 64.f, H8_SCALE = 16.f;
constexpr int E8_ONE = 0x7F7F7F7F, E8_W = 0x79797979  , E8_H = 0x7B7B7B7B  ;
#define LDS_WAIT() asm volatile("s_waitcnt lgkmcnt(0)" ::: "memory")
#define VM_WAIT() asm volatile("s_waitcnt vmcnt(0)" ::: "memory")

#define XB_TMO      128
#define XB_XCNT(j)  (256  + 64 * (j))
#define XB_XSUB(j)  (1280 + 64 * (j))
#define XB_XGEN(j)  (2304 + 64 * (j))
#define XB_TOP      3328
#define XB_TOPGEN   3392
#define XCD_BAR_WORDS 3456
#define XB_SPIN_CAP (1u << 22)
__device__ __forceinline__ unsigned xb_ld(unsigned* p)              { return __hip_atomic_load(p, __ATOMIC_RELAXED, __HIP_MEMORY_SCOPE_AGENT); }
__device__ __forceinline__ unsigned xb_add(unsigned* p, unsigned v) { return __hip_atomic_fetch_add(p, v, __ATOMIC_RELAXED, __HIP_MEMORY_SCOPE_AGENT); }
__device__ __forceinline__ unsigned xb_xcc_id() { return (unsigned)__builtin_amdgcn_s_getreg((3 << 11) | 20) & 0xFu; }
#define XB_SPIN(cond, bar) do { unsigned _sp = 0; while (cond) { __builtin_amdgcn_s_sleep(1); \
    if ((++_sp & 255u) == 0u) { if (xb_ld(&(bar)[XB_TMO])) break; if (_sp > XB_SPIN_CAP) { atomicAdd(&(bar)[XB_TMO], 1u); break; } } } } while (0)
struct XcdBarrier { unsigned* bar; unsigned x; volatile LAS unsigned* st; };
__device__ __forceinline__ XcdBarrier xcd_barrier_post(unsigned* bar, volatile LAS unsigned* st) {
    XcdBarrier b; b.bar = bar; b.x = xb_xcc_id(); b.st = st;
    if (threadIdx.x == 0) (void)xb_add(&bar[XB_XCNT(b.x)], 1u);
    return b;
}
__device__ __forceinline__ void xcd_barrier_complete(unsigned* bar, unsigned x, unsigned& nloc, unsigned& nx) {
    const unsigned G = gridDim.x * gridDim.y * gridDim.z;
    unsigned sum, cnt, mine, sp = 0u;
    for (;;) {
        sum = 0u; cnt = 0u; mine = 0u;
#pragma nounroll
        for (unsigned j = 0; j < 16; ++j) { const unsigned c = xb_ld(&bar[XB_XCNT(j)]); sum += c; cnt += (c > 0u) ? 1u : 0u; mine = (j == x) ? c : mine; }
        if (sum == G) break;
        __builtin_amdgcn_s_sleep(1);
        if ((++sp & 255u) == 0u) { if (xb_ld(&bar[XB_TMO])) break; if (sp > XB_SPIN_CAP) { atomicAdd(&bar[XB_TMO], 1u); break; } }
    }
    nloc = mine > 0u ? mine : 1u; nx = cnt > 0u ? cnt : 1u;
}
__device__ __forceinline__ void xcd_barrier(const XcdBarrier& b) {
    asm volatile("s_waitcnt vmcnt(0)" ::: "memory");
    __syncthreads();
    if (threadIdx.x == 0) {
        unsigned* bar = b.bar;
        __builtin_amdgcn_s_waitcnt(0);
        unsigned nloc = b.st[0], nx = b.st[1];
        if (nloc == 0u) { xcd_barrier_complete(bar, b.x, nloc, nx); b.st[0] = nloc; b.st[1] = nx; }
        const unsigned old = xb_add(&bar[XB_XSUB(b.x)], 1u);
        const unsigned gen = old / nloc;
        if (old + 1u == (gen + 1u) * nloc) {
            __builtin_amdgcn_fence(__ATOMIC_RELEASE, "agent");
            asm volatile("s_waitcnt vmcnt(0)" ::: "memory");
            const unsigned og = xb_add(&bar[XB_TOP], 1u);
            const unsigned tg = og / nx;
            if (og + 1u == (tg + 1u) * nx) xb_add(&bar[XB_TOPGEN], 1u);
            else XB_SPIN(xb_ld(&bar[XB_TOPGEN]) == tg, bar);
            __builtin_amdgcn_fence(__ATOMIC_ACQUIRE, "agent");
            xb_add(&bar[XB_XGEN(b.x)], 1u);
            asm volatile("s_waitcnt vmcnt(0)" ::: "memory");
        } else {
            XB_SPIN(xb_ld(&bar[XB_XGEN(b.x)]) == gen, bar);
            __builtin_amdgcn_fence(__ATOMIC_ACQUIRE, "agent");
            asm volatile("s_waitcnt vmcnt(0)" ::: "memory");
        }
    }
    __syncthreads();
}

namespace pg {
constexpr int BM = 256, BK = 64, HALF = 128, HTB = HALF * BK * 2, STAGE_BYTES = 8 * HTB;
__device__ __forceinline__ int lds_byte(int r, int c) { const int st = (r >> 4) * 2 + (c >> 5), rr = r & 15, cc = c & 31, ob = rr * 64 + cc * 2; return st * 1024 + (ob ^ (((ob >> 9) & 1) << 5)); }
__device__ __forceinline__ void stage_rc(int b, int& R, int& C) { const int st = b / 1024, sb = b % 1024, swz = sb ^ (((sb >> 9) & 1) << 5); R = (st >> 1) * 16 + swz / 64; C = (st & 1) * 32 + (swz % 64) / 2; }
__device__ __forceinline__ int perm32(int rho) { const int n = rho >> 4, i = rho & 15; return 8 * (i >> 2) + 4 * n + (i & 3); }
struct Unit { const char* a; const char* b; int pm, pn, grp; };
typedef f32x4 Acc[2][2][4][2];

typedef int v8i_t __attribute__((ext_vector_type(8)));
template <class Epi, class Sched, bool F8 = false, int SA_ = 0x7F7F7F7F, int SB_ = 0x7F7F7F7F>
__device__ __forceinline__ void gemm_phase(LAS unsigned char* lds, const int K, const int lda, const int ldb, const Sched& S, const Epi& E) {
    int tz_ = threadIdx.x; asm volatile("" : "+v"(tz_));
    const int tid = tz_, wid = __builtin_amdgcn_readfirstlane(tid >> 6), lane = tid & 63, wr = wid >> 2, wc = wid & 3, fr = lane & 15, fq = lane >> 4;
    constexpr int ESZ = F8 ? 1 : 2;
    const int nt = K * ESZ / (BK * 2);
    unsigned voffA[2], voffB[2];
#pragma unroll
    for (int i = 0; i < 2; ++i) { int R, C; stage_rc(tid * 16 + i * 8192, R, C);
        voffA[i] = (unsigned)(R * lda * ESZ + C * 2); voffB[i] = (unsigned)((64 * (R >> 5) + perm32(R & 31)) * ldb * ESZ + C * 2); }
    const size_t kstep = (size_t)(BK * 2);
    const size_t hstepA = (size_t)HALF * lda * ESZ;
    const size_t hstepB = (size_t)32 * ldb * ESZ;
    const unsigned ldsw = (unsigned)wid * 1024u;
    const int aoff = F8 ? lds_byte(wr * 64 + fr, fq * 16) : lds_byte(wr * 64 + fr, fq * 8), boff = F8 ? lds_byte(wc * 32 + fr, fq * 16) : lds_byte(wc * 32 + fr, fq * 8);
#define PG8_SA(b, h) (((b) * 2 + (h)) * HTB)
#define PG8_SB(b, h) ((4 + (b) * 2 + (h)) * HTB)
#define PG8_STAGE(bufoff, gbase, voff) do { _Pragma("unroll") for (int _i = 0; _i < 2; ++_i) \
        __builtin_amdgcn_global_load_lds((const unsigned*)((const char*)(gbase) + (voff)[_i]), (LAS unsigned*)(lds + (bufoff) + ldsw + _i * 8192), 16, 0, 0); } while (0)
    typedef v8i_t v8i_a16 __attribute__((aligned(16)));
#define PG8_LD32(p) __builtin_bit_cast(v8i_t, __builtin_shufflevector(*(const LAS u32x4*)(p), *(const LAS u32x4*)((p) + 16), 0, 1, 2, 3, 4, 5, 6, 7))
#define PG8_LDA(dst, b, h) do { if constexpr (F8) { _Pragma("unroll") for (int m = 0; m < 4; ++m) dst##8[m] = PG8_LD32(lds + PG8_SA(b, h) + aoff + m * 2048); } \
        else { _Pragma("unroll") for (int m = 0; m < 4; ++m) _Pragma("unroll") for (int k = 0; k < 2; ++k) dst[m][k] = *(const LAS bf16x8*)(lds + PG8_SA(b, h) + aoff + m * 2048 + k * 1024); } } while (0)
#define PG8_LDB(dst, b, h) do { if constexpr (F8) { _Pragma("unroll") for (int n = 0; n < 2; ++n) dst##8[n] = PG8_LD32(lds + PG8_SB(b, h) + boff + n * 2048); } \
        else { _Pragma("unroll") for (int n = 0; n < 2; ++n) _Pragma("unroll") for (int k = 0; k < 2; ++k) dst[n][k] = *(const LAS bf16x8*)(lds + PG8_SB(b, h) + boff + n * 2048 + k * 1024); } } while (0)
#define PG8_MMA(ai, bj, At, Bt) do { __builtin_amdgcn_s_setprio(1); \
        if constexpr (F8) { _Pragma("unroll") for (int m = 0; m < 4; ++m) _Pragma("unroll") for (int n = 0; n < 2; ++n) \
            asm volatile("v_mfma_scale_f32_16x16x128_f8f6f4 %0, %1, %2, %0, %3, %4 op_sel_hi:[0,0,0]" : "+v"(acc[ai][bj][m][n]) : "v"(Bt##8[n]), "v"(At##8[m]), "v"(sbv), "v"(sav)); } \
        else { _Pragma("unroll") for (int m = 0; m < 4; ++m) _Pragma("unroll") for (int n = 0; n < 2; ++n) _Pragma("unroll") for (int k = 0; k < 2; ++k) \
            acc[ai][bj][m][n] = __builtin_amdgcn_mfma_f32_16x16x32_bf16(Bt[n][k], At[m][k], acc[ai][bj][m][n], 0, 0, 0); } \
        __builtin_amdgcn_s_setprio(0); } while (0)
#define PG8_WAIT_V(n) asm volatile("s_waitcnt vmcnt(" #n ")" ::: "memory")
#define PG8_WAIT_L(n) asm volatile("s_waitcnt lgkmcnt(" #n ")" ::: "memory")
#define PG8_BAR __builtin_amdgcn_s_barrier()
#define PG8_SCHED __builtin_amdgcn_sched_barrier(0)
    Unit cur, nxt; int ui = 0;
    if (!S.next(0, cur)) return;
    Acc acc;
#pragma unroll
    for (int a = 0; a < 2; ++a)
#pragma unroll
        for (int b = 0; b < 2; ++b)
#pragma unroll
            for (int m = 0; m < 4; ++m)
#pragma unroll
                for (int n = 0; n < 2; ++n) acc[a][b][m][n] = (f32x4){0.f, 0.f, 0.f, 0.f};
    bf16x8 At[4][2], B0[2][2], B1[2][2]; v8i_t At8[4], B08[2], B18[2];
    const int sav = SA_, sbv = SB_;
    const char* cA = cur.a; const char* cB = cur.b;
    PG8_STAGE(PG8_SB(0, 0), cB, voffB); PG8_STAGE(PG8_SA(0, 0), cA, voffA); PG8_STAGE(PG8_SB(0, 1), cB + hstepB, voffB); PG8_STAGE(PG8_SA(0, 1), cA + hstepA, voffA);
    if (wr == 1) PG8_BAR;
    PG8_WAIT_V(4); PG8_BAR;
    PG8_STAGE(PG8_SB(1, 0), cB + kstep, voffB); PG8_STAGE(PG8_SA(1, 0), cA + kstep, voffA); PG8_STAGE(PG8_SB(1, 1), cB + hstepB + kstep, voffB);
    PG8_WAIT_V(6); PG8_BAR;
    for (;;) {
        const bool has_next = S.next(ui + 1, nxt);
        const char* nA = has_next ? nxt.a : cA; const char* nB = has_next ? nxt.b : cB;
        for (int t = 0; t < nt; t += 2) {
            const bool last = (t == nt - 2);
            const char* a1 = cA + (size_t)(t + 1) * kstep;
            const char* a2 = last ? nA : cA + (size_t)(t + 2) * kstep; const char* b2 = last ? nB : cB + (size_t)(t + 2) * kstep;
            const char* a3 = a2 + kstep; const char* b3 = b2 + kstep;
            if constexpr (Epi::HAS_MID) { if (t == nt / 2) E.mid(acc, cur, wr, wc, fr, fq); }
            PG8_LDB(B0, 0, 0); PG8_SCHED; PG8_LDA(At, 0, 0); PG8_STAGE(PG8_SA(1, 1), a1 + hstepA, voffA);
            PG8_WAIT_L(8); PG8_BAR; PG8_WAIT_L(0); PG8_MMA(0, 0, At, B0); PG8_BAR; PG8_SCHED;
            PG8_LDB(B1, 0, 1); PG8_STAGE(PG8_SB(0, 0), b2, voffB);
            PG8_BAR; PG8_WAIT_L(0); PG8_MMA(0, 1, At, B1); PG8_BAR;
            PG8_LDA(At, 0, 1); PG8_STAGE(PG8_SA(0, 0), a2, voffA);
            PG8_BAR; PG8_WAIT_L(0); PG8_MMA(1, 0, At, B0); PG8_BAR; PG8_SCHED;
            PG8_STAGE(PG8_SB(0, 1), b2 + hstepB, voffB);
            PG8_WAIT_V(6); PG8_BAR; PG8_MMA(1, 1, At, B1); PG8_BAR;
            PG8_LDB(B0, 1, 0); PG8_SCHED; PG8_LDA(At, 1, 0); PG8_STAGE(PG8_SA(0, 1), a2 + hstepA, voffA);
            PG8_WAIT_L(8); PG8_BAR; PG8_WAIT_L(0); PG8_MMA(0, 0, At, B0); PG8_BAR; PG8_SCHED;
            PG8_LDB(B1, 1, 1); PG8_STAGE(PG8_SB(1, 0), b3, voffB);
            PG8_BAR; PG8_WAIT_L(0); PG8_MMA(0, 1, At, B1); PG8_BAR;
            PG8_LDA(At, 1, 1); PG8_STAGE(PG8_SA(1, 0), a3, voffA);
            PG8_BAR; PG8_WAIT_L(0); PG8_MMA(1, 0, At, B0); PG8_BAR; PG8_SCHED;
            PG8_STAGE(PG8_SB(1, 1), b3 + hstepB, voffB);
            PG8_WAIT_V(6); PG8_BAR; PG8_MMA(1, 1, At, B1); PG8_BAR;
        }
        if constexpr (F8) asm volatile("s_nop 15\n\ts_nop 15" ::: "memory");
        E(acc, cur, wr, wc, fr, fq);
        if (!has_next) break;
#pragma unroll
        for (int a = 0; a < 2; ++a)
#pragma unroll
            for (int b = 0; b < 2; ++b)
#pragma unroll
                for (int m = 0; m < 4; ++m)
#pragma unroll
                    for (int n = 0; n < 2; ++n) acc[a][b][m][n] = (f32x4){0.f, 0.f, 0.f, 0.f};
        cur = nxt; cA = nA; cB = nB; ++ui;
    }
    PG8_WAIT_V(0);
    if (wr == 0) PG8_BAR;
    PG8_BAR;
#undef PG8_SA
#undef PG8_SB
#undef PG8_STAGE
#undef PG8_LDA
#undef PG8_LD32
#undef PG8_LDB
#undef PG8_MMA
#undef PG8_WAIT_V
#undef PG8_WAIT_L
#undef PG8_BAR
#undef PG8_SCHED
}

struct SchedGrid {
    const char* A; const char* B; size_t tstepA, tstepB; int nM, nN, nwg, G, c; bool mix32 = false;
    __device__ void init(const void* A_, int lda, const void* B_, int ldb, int M, int N, int G_, int c_, int esz = 2) {
        A = (const char*)A_; B = (const char*)B_; tstepA = (size_t)256 * lda * esz; tstepB = (size_t)256 * ldb * esz; nM = M / 256; nN = N / 256; nwg = nM * nN; G = G_; c = c_; }
    __device__ __forceinline__ bool next(int i, Unit& u) const {
        const long L = (long)i * G + c; if (L >= nwg) return false;
        int wgid = (int)L; { const int q = nwg / 8, r = nwg % 8, xcd = wgid % 8, off = wgid / 8; wgid = (xcd < r ? xcd * (q + 1) : r * (q + 1) + (xcd - r) * q) + off; }
        const int nig = 8 * nN, gid = wgid / nig, fm = gid * 8, gsz = (nM - fm) < 8 ? (nM - fm) : 8;
        u.pm = fm + ((wgid % nig) % gsz); u.pn = (wgid % nig) / gsz; u.grp = 0;
        if (mix32) { const int a = u.pn >> 4, r4 = (u.pn >> 2) & 3, r = u.pn & 3; u.pn = ((r4 & 1) << 4) | (a << 3) | ((r4 >> 1) << 2) | r; }
        u.a = A + (size_t)u.pm * tstepA; u.b = B + (size_t)u.pn * tstepB; return true;
    }
};
struct SchedGroup {
    const char* A; const char* B; size_t tstepA, tstepB, gstepA, gstepB; int nM, nN, total, G, c;
    __device__ void init(const void* A_, int lda, size_t gA, const void* B_, int ldb, size_t gB, int nM_, int nN_, int NG, int G_, int c_, int esz = 2) {
        A = (const char*)A_; B = (const char*)B_; tstepA = (size_t)256 * lda * esz; tstepB = (size_t)256 * ldb * esz; gstepA = gA; gstepB = gB; nM = nM_; nN = nN_; total = NG * nM_ * nN_; G = G_; c = c_; }
    __device__ __forceinline__ bool next(int i, Unit& u) const {
        const long L = (long)i * G + c; if (L >= total) return false;
        const int per = nM * nN, g = (int)L / per, r = (int)L % per;
        u.grp = g; u.pm = r % nM; u.pn = r / nM;
        u.a = A + (size_t)g * gstepA + (size_t)u.pm * tstepA; u.b = B + (size_t)g * gstepB + (size_t)u.pn * tstepB; return true;
    }
};
}

#define EPI_LANES int tz_ = threadIdx.x; asm volatile("" : "+v"(tz_)); const int wr = tz_ >> 8, wc = (tz_ >> 6) & 3, fr = tz_ & 15, fq = (tz_ >> 4) & 3;
#define EPI_ROWVALS(name, ptr, base) float name[2][4]; _Pragma("unroll") for (int ai = 0; ai < 2; ++ai) _Pragma("unroll") for (int m = 0; m < 4; ++m) name[ai][m] = (ptr)[(base) + ai * 128 + wr * 64 + m * 16 + fr];
#define EPI_FOR _Pragma("unroll") for (int ai = 0; ai < 2; ++ai) _Pragma("unroll") for (int m = 0; m < 4; ++m)
#define EPI_RL const int rl = ai * 128 + wr * 64 + m * 16 + fr;
__device__ __forceinline__ u32x4 pack8(const f32x4 a, const f32x4 b) { u32x4 w; w.x = cvt_pk_bf16(a[0], a[1]); w.y = cvt_pk_bf16(a[2], a[3]); w.z = cvt_pk_bf16(b[0], b[1]); w.w = cvt_pk_bf16(b[2], b[3]); return w; }
__device__ __forceinline__ void unpack8(const u32x4 w, f32x4& a, f32x4& b) { a = (f32x4){bf_lo(w.x), bf_hi(w.x), bf_lo(w.y), bf_hi(w.y)}; b = (f32x4){bf_lo(w.z), bf_hi(w.z), bf_lo(w.w), bf_hi(w.w)}; }

struct EpiInProj {
    static constexpr bool HAS_MID = false;
    const float* rinv; bf16_t *UA, *Q, *Kb, *V, *G; const float *qg, *kg;
    __device__ __forceinline__ void operator()(const pg::Acc& acc, const pg::Unit& u, int, int, int, int) const { EPI_LANES
        const int pn = u.pn, row0 = u.pm * 256;
        EPI_ROWVALS(rsv, rinv, row0)
        if (pn < 4) {
            EPI_FOR { EPI_RL const int tok = row0 + rl; const float rs = rsv[ai][m]; const int c = tok >> 5, tau = tok & 31;
#pragma unroll
                for (int bj = 0; bj < 2; ++bj) { const int ch = 256 * pn + 64 * wc + 32 * bj + 8 * fq, g = ch >> 4, p0 = ch & 15;
                    *(u32x4*)(UA + ((size_t)(g * NCH + c) * UAW + tau * 16 + p0)) = pack8(acc[ai][bj][m][0] * rs, acc[ai][bj][m][1] * rs); } }
        } else if (pn < 12) {
            const bool isq = pn < 8; const int col0 = 256 * (pn - (isq ? 4 : 8)) + 64 * wc; const float* gp = isq ? qg : kg; const float sc = isq ? 0.125f * LOG2E : 1.f;
            bf16_t* dst = isq ? Q : Kb;
            f32x4 gv[2][2];
#pragma unroll
            for (int bj = 0; bj < 2; ++bj)
#pragma unroll
                for (int n = 0; n < 2; ++n) gv[bj][n] = *(const f32x4*)(gp + 32 * bj + 8 * fq + 4 * n) * sc;
            EPI_FOR { EPI_RL const int tok = row0 + rl; const float rs = rsv[ai][m];
                f32x4 v[2][2]; float ss = 0.f;
#pragma unroll
                for (int bj = 0; bj < 2; ++bj)
#pragma unroll
                    for (int n = 0; n < 2; ++n) { v[bj][n] = acc[ai][bj][m][n] * rs; ss += v[bj][n][0] * v[bj][n][0] + v[bj][n][1] * v[bj][n][1] + v[bj][n][2] * v[bj][n][2] + v[bj][n][3] * v[bj][n][3]; }
                ss += __shfl_xor(ss, 16); ss += __shfl_xor(ss, 32);
                const float r = __builtin_amdgcn_rsqf(ss * (1.f / 64.f) + EPS);
#pragma unroll
                for (int bj = 0; bj < 2; ++bj)
                    *(u32x4*)(dst + (size_t)tok * 1024 + col0 + 32 * bj + 8 * fq) = pack8(v[bj][0] * r * gv[bj][0], v[bj][1] * r * gv[bj][1]); }
        } else {
            EPI_FOR { EPI_RL const int tok = row0 + rl; const float rs = rsv[ai][m];
#pragma unroll
                for (int bj = 0; bj < 2; ++bj)
                    *(u32x4*)(V + (size_t)tok * 1024 + 256 * (pn - 12) + 64 * wc + 32 * bj + 8 * fq) = pack8(acc[ai][bj][m][0] * rs, acc[ai][bj][m][1] * rs); }
        }
    }
};
struct EpiGates {
    static constexpr bool HAS_MID = false;
    const float* rinv; bf16_t* G;
    __device__ __forceinline__ void operator()(const pg::Acc& acc, const pg::Unit& u, int, int, int, int) const { EPI_LANES
        EPI_ROWVALS(rsv, rinv, u.pm * 256)
        EPI_FOR { EPI_RL const int tok = u.pm * 256 + rl; const float rs = rsv[ai][m];
#pragma unroll
            for (int bj = 0; bj < 2; ++bj) { f32x4 a = acc[ai][bj][m][0] * rs, b = acc[ai][bj][m][1] * rs;
#pragma unroll
                for (int j = 0; j < 4; ++j) { a[j] = fast_sigmoid(a[j]); b[j] = fast_sigmoid(b[j]); }
                *(u32x4*)(G + (size_t)tok * 4096 + 256 * u.pn + 64 * wc + 32 * bj + 8 * fq) = pack8(a, b); } }
    }
};
struct EpiSsum {
    static constexpr bool HAS_MID = false;
    float* SS;
    __device__ __forceinline__ void operator()(const pg::Acc& acc, const pg::Unit& u, int, int, int, int) const { EPI_LANES
        EPI_FOR { EPI_RL float* rp = SS + ((size_t)u.grp * NCH + rl) * 256 + 64 * wc + 8 * fq;
#pragma unroll
            for (int bj = 0; bj < 2; ++bj) { *(f32x4*)(rp + 32 * bj) = acc[ai][bj][m][0]; *(f32x4*)(rp + 32 * bj + 4) = acc[ai][bj][m][1]; } }
    }
};
__device__ __forceinline__ float gelu_tanh(float x) {
    const float t = 1.5957691216057308f * (x + 0.044715f * x * x * x);
    return x * fast_sigmoid(t);
}
struct EpiSsmOut {
    static constexpr bool HAS_MID = false;
    bf16_t* Y;
    __device__ __forceinline__ void operator()(const pg::Acc& acc, const pg::Unit& u, int, int, int, int) const { EPI_LANES
        EPI_FOR { EPI_RL
#pragma unroll
            for (int bj = 0; bj < 2; ++bj) { const int col = 256 * u.pn + 64 * wc + 32 * bj + 8 * fq, t = col >> 4, p0 = col & 15;
                f32x4 a = acc[ai][bj][m][0], b = acc[ai][bj][m][1];
#pragma unroll
                for (int j = 0; j < 4; ++j) { a[j] = gelu_tanh(a[j]); b[j] = gelu_tanh(b[j]); }
                *(u32x4*)(Y + (size_t)(rl * TC + t) * SSMW + u.grp * GP + p0) = pack8(a, b); } }
    }
};
struct EpiGlu {
    static constexpr bool HAS_MID = false;
    const bf16_t* Y; bf16_t* YO;
    __device__ __forceinline__ void operator()(const pg::Acc& acc, const pg::Unit& u, int, int, int, int) const { EPI_LANES
        const int colb = 256 * u.pn + 64 * wc + 8 * fq; const size_t rb = (size_t)(u.pm * 256 + wr * 64 + fr);
        u32x4 cur[2], nxt[2];
        cur[0] = *(const u32x4*)(Y + rb * SSMW + colb); cur[1] = *(const u32x4*)(Y + rb * SSMW + colb + 32);
#pragma unroll
        for (int r_ = 0; r_ < 8; ++r_) { const int ai = r_ >> 2, m = r_ & 3; const size_t tok = rb + ai * 128 + m * 16;
            if (r_ < 7) { const size_t tn = rb + ((r_ + 1) >> 2) * 128 + ((r_ + 1) & 3) * 16; nxt[0] = *(const u32x4*)(Y + tn * SSMW + colb); nxt[1] = *(const u32x4*)(Y + tn * SSMW + colb + 32); }
#pragma unroll
            for (int bj = 0; bj < 2; ++bj) { f32x4 ya, yb; unpack8(cur[bj], ya, yb);
                f32x4 a = acc[ai][bj][m][0], b = acc[ai][bj][m][1];
#pragma unroll
                for (int j = 0; j < 4; ++j) { a[j] = ya[j] * fast_sigmoid(a[j]); b[j] = yb[j] * fast_sigmoid(b[j]); }
                *(u32x4*)(YO + tok * 2048 + colb + 32 * bj) = pack8(a, b); }
            cur[0] = nxt[0]; cur[1] = nxt[1]; }
    }
};
struct EpiMerge {
    static constexpr bool HAS_MID = true;
    const bf16_t* G; bf16_t* MG;
    __device__ __forceinline__ void mid(pg::Acc& acc, const pg::Unit& u, int, int, int, int) const { EPI_LANES
        const int colb = 256 * u.pn + 64 * wc + 8 * fq; const size_t rb = (size_t)(u.pm * 256 + wr * 64 + fr);
        u32x4 cur[4], nxt[4];
#pragma unroll
        for (int q = 0; q < 4; ++q) cur[q] = *(const u32x4*)(G + rb * 4096 + (q >> 1) * 2048 + colb + 32 * (q & 1));
#pragma unroll
        for (int r_ = 0; r_ < 8; ++r_) { const int ai = r_ >> 2, m = r_ & 3;
            if (r_ < 7) { const size_t tn = rb + ((r_ + 1) >> 2) * 128 + ((r_ + 1) & 3) * 16;
#pragma unroll
                for (int q = 0; q < 4; ++q) nxt[q] = *(const u32x4*)(G + tn * 4096 + (q >> 1) * 2048 + colb + 32 * (q & 1)); }
#pragma unroll
            for (int bj = 0; bj < 2; ++bj) { f32x4 sa, sb, ga, gb; unpack8(cur[bj], sa, sb); unpack8(cur[2 + bj], ga, gb);
#pragma unroll
                for (int j = 0; j < 4; ++j) { acc[ai][bj][m][0][j] *= sa[j] * __builtin_amdgcn_rcpf(ga[j]); acc[ai][bj][m][1][j] *= sb[j] * __builtin_amdgcn_rcpf(gb[j]); } }
#pragma unroll
            for (int q = 0; q < 4; ++q) cur[q] = nxt[q];
            __builtin_amdgcn_sched_barrier(0); }
    }
    __device__ __forceinline__ void operator()(const pg::Acc& acc, const pg::Unit& u, int, int, int, int) const { EPI_LANES
        const int colb = 256 * u.pn + 64 * wc + 8 * fq; const size_t rb = (size_t)(u.pm * 256 + wr * 64 + fr);
        u32x4 cur[2], nxt[2];
        cur[0] = *(const u32x4*)(G + rb * 4096 + 2048 + colb); cur[1] = *(const u32x4*)(G + rb * 4096 + 2048 + colb + 32);
#pragma unroll
        for (int r_ = 0; r_ < 8; ++r_) { const int ai = r_ >> 2, m = r_ & 3; const size_t tok = rb + ai * 128 + m * 16;
            if (r_ < 7) { const size_t tn = rb + ((r_ + 1) >> 2) * 128 + ((r_ + 1) & 3) * 16; nxt[0] = *(const u32x4*)(G + tn * 4096 + 2048 + colb); nxt[1] = *(const u32x4*)(G + tn * 4096 + 2048 + colb + 32); }
#pragma unroll
            for (int bj = 0; bj < 2; ++bj) { f32x4 ga, gb; unpack8(cur[bj], ga, gb);
                *(u32x4*)(MG + tok * 2048 + colb + 32 * bj) = pack8(acc[ai][bj][m][0] * ga, acc[ai][bj][m][1] * gb); }
            cur[0] = nxt[0]; cur[1] = nxt[1]; }
    }
};
struct EpiOutProj {
    static constexpr bool HAS_MID = false;
    const bf16_t* XR; bf16_t* XO;
    __device__ __forceinline__ void operator()(const pg::Acc& acc, const pg::Unit& u, int, int, int, int) const { EPI_LANES
        const int colb = 256 * u.pn + 64 * wc + 8 * fq; const size_t rb = (size_t)(u.pm * 256 + wr * 64 + fr);
        u32x4 cur[2], nxt[2];
        cur[0] = *(const u32x4*)(XR + rb * 2048 + colb); cur[1] = *(const u32x4*)(XR + rb * 2048 + colb + 32);
#pragma unroll
        for (int r_ = 0; r_ < 8; ++r_) { const int ai = r_ >> 2, m = r_ & 3; const size_t tok = rb + ai * 128 + m * 16;
            if (r_ < 7) { const size_t tn = rb + ((r_ + 1) >> 2) * 128 + ((r_ + 1) & 3) * 16; nxt[0] = *(const u32x4*)(XR + tn * 2048 + colb); nxt[1] = *(const u32x4*)(XR + tn * 2048 + colb + 32); }
#pragma unroll
            for (int bj = 0; bj < 2; ++bj) { f32x4 a, b; unpack8(cur[bj], a, b);
                *(u32x4*)(XO + tok * 2048 + colb + 32 * bj) = pack8(a + acc[ai][bj][m][0], b + acc[ai][bj][m][1]); }
            cur[0] = nxt[0]; cur[1] = nxt[1]; }
    }
};
struct EpiExp1 {
    static constexpr bool HAS_MID = false;
    const float* RSL; bf16_t* H;
    __device__ __forceinline__ void operator()(const pg::Acc& acc, const pg::Unit& u, int, int, int, int) const { EPI_LANES
        EPI_ROWVALS(rsv, RSL, u.grp * CAP + u.pm * 256)
        EPI_FOR { EPI_RL const int row = u.grp * CAP + u.pm * 256 + rl; const float rs = rsv[ai][m];
            f32x4 h[2];
#pragma unroll
            for (int n = 0; n < 2; ++n)
#pragma unroll
                for (int j = 0; j < 4; ++j) { const float g = acc[ai][0][m][n][j] * rs, up = acc[ai][1][m][n][j] * rs; h[n][j] = g * fast_sigmoid(g) * up; }
            *(u32x2*)((unsigned char*)H + (size_t)row * FF + 128 * u.pn + 32 * wc + 8 * fq) = pack8_fp8(h[0] * H8_SCALE, h[1] * H8_SCALE); }
    }
};
struct EpiExp2 {
    static constexpr bool HAS_MID = false;
    const float* GATE; bf16_t* YX;
    __device__ __forceinline__ void operator()(const pg::Acc& acc, const pg::Unit& u, int, int, int, int) const { EPI_LANES
        EPI_ROWVALS(gtv, GATE, u.grp * CAP + u.pm * 256)
        EPI_FOR { EPI_RL const int row = u.grp * CAP + u.pm * 256 + rl; const float gt = gtv[ai][m];
#pragma unroll
            for (int bj = 0; bj < 2; ++bj)
                *(u32x4*)(YX + (size_t)row * D + 256 * u.pn + 64 * wc + 32 * bj + 8 * fq) = pack8(acc[ai][bj][m][0] * gt, acc[ai][bj][m][1] * gt); }
    }
};

namespace att {
constexpr int KVBLK = 64, QBLK = 32;
constexpr int SHM_T = KVBLK * 256;
constexpr int OFF_K = 0, OFF_V = 3 * SHM_T, OFF_Q = 5 * SHM_T, OFF_WS = OFF_Q + 8 * 8192, OFF_BT = OFF_WS + 8 * 64 * 4, ATT_LDS_END = OFF_BT + 2048;
#define KSWZ(row, colB) ((row) * 256 + ((colB) ^ (((row) & 7) << 4)))
#define SBAR() __builtin_amdgcn_sched_barrier(0)
__device__ __forceinline__ int crow(int r, int hi) { return (r & 3) + 8 * (r >> 2) + 4 * hi; }
__device__ __forceinline__ int v_rd_base(int lane) { return ((lane & 3) << 3) | (((lane >> 2) & 3) << 6) | (((lane >> 4) & 1) << 5) | (((lane >> 5) & 1) << 8); }
constexpr int v_rd_off(int d0, int ks, int half) { return d0 * 512 + ks * 4096 + half * 2048; }
template <int OFF> __device__ __forceinline__ s16x4 tr_read(int vb) { s16x4 r; asm volatile("ds_read_b64_tr_b16 %0, %1 offset:%2" : "=&v"(r) : "v"(vb), "i"(OFF) : "memory"); return r; }
template <int D0> __device__ __forceinline__ void pv_one(f32x16& od, int vb, bf16x8 pa0, bf16x8 pa1, bf16x8 pa2, bf16x8 pa3) {
    const s16x4 l0 = tr_read<v_rd_off(D0, 0, 0)>(vb), h0 = tr_read<v_rd_off(D0, 0, 1)>(vb), l1 = tr_read<v_rd_off(D0, 1, 0)>(vb), h1 = tr_read<v_rd_off(D0, 1, 1)>(vb);
    const s16x4 l2 = tr_read<v_rd_off(D0, 2, 0)>(vb), h2 = tr_read<v_rd_off(D0, 2, 1)>(vb), l3 = tr_read<v_rd_off(D0, 3, 0)>(vb), h3 = tr_read<v_rd_off(D0, 3, 1)>(vb);
    asm volatile("s_waitcnt lgkmcnt(0)" ::: "memory"); SBAR();
#define PK(L, H) (bf16x8){L[0], L[1], L[2], L[3], H[0], H[1], H[2], H[3]}
    od = __builtin_amdgcn_mfma_f32_32x32x16_bf16(pa0, PK(l0, h0), od, 0, 0, 0);
    od = __builtin_amdgcn_mfma_f32_32x32x16_bf16(pa1, PK(l1, h1), od, 0, 0, 0);
    od = __builtin_amdgcn_mfma_f32_32x32x16_bf16(pa2, PK(l2, h2), od, 0, 0, 0);
    od = __builtin_amdgcn_mfma_f32_32x32x16_bf16(pa3, PK(l3, h3), od, 0, 0, 0);
#undef PK
}
__device__ __forceinline__ void pv_d0(f32x16* o, int vb, bf16x8 pa0, bf16x8 pa1, bf16x8 pa2, bf16x8 pa3) {
    pv_one<0>(o[0], vb, pa0, pa1, pa2, pa3); pv_one<1>(o[1], vb, pa0, pa1, pa2, pa3); pv_one<2>(o[2], vb, pa0, pa1, pa2, pa3); pv_one<3>(o[3], vb, pa0, pa1, pa2, pa3);
}
__device__ __forceinline__ int kq_addr(int row, int c) { return (c >> 2) * 4096 + row * 64 + (((c & 3) ^ ((row >> 2) & 3)) << 4); }
template <int COMP> __device__ __forceinline__ void qkt(f32x16& p0, f32x16& p1, const LAS char* Ks, const LAS char* Qs, int kq0, int kq1) {
    p0 = (f32x16){}; p1 = (f32x16){};
#pragma unroll
    for (int d0 = 0; d0 < 4; ++d0) { const int chi = COMP * 2 + (d0 >> 1); const int a = (d0 & 1) ? kq1 : kq0;
        const bf16x8 b0 = *(const LAS bf16x8*)(Ks + a + chi * 4096);
        const bf16x8 b1 = *(const LAS bf16x8*)(Ks + a + chi * 4096 + 2048);
        const bf16x8 qf = *(const LAS bf16x8*)(Qs + a + chi * 2048);
        p0 = __builtin_amdgcn_mfma_f32_32x32x16_bf16(b0, qf, p0, 0, 0, 0);
        p1 = __builtin_amdgcn_mfma_f32_32x32x16_bf16(b1, qf, p1, 0, 0, 0); }
}
__device__ __forceinline__ void sm_exp(f32x16& p0, f32x16& p1, const LAS float* bt, int relb, int dq, int hi) {
    if (dq > -191 && dq < 158) {
        const LAS float* bp = bt + relb + 4 * hi;
#pragma unroll
        for (int a = 0; a < 4; ++a) {
            float t0[4], t1[4];
#pragma unroll
            for (int b = 0; b < 4; ++b) { t0[b] = bp[8 * a + b]; t1[b] = bp[32 + 8 * a + b]; }
#pragma unroll
            for (int b = 0; b < 4; ++b) { p0[4 * a + b] += t0[b]; p1[4 * a + b] += t1[b]; }
            SBAR();
        } }
#pragma unroll
    for (int r = 0; r < 16; ++r) p0[r] = __builtin_amdgcn_exp2f(p0[r]);
#pragma unroll
    for (int r = 0; r < 16; ++r) p1[r] = __builtin_amdgcn_exp2f(p1[r]);
}
__device__ __forceinline__ void sm_fin(f32x16& p0, f32x16& p1, float& l_reg, bf16x8& pa0, bf16x8& pa1, bf16x8& pa2, bf16x8& pa3) {
    float ps = 0;
#pragma unroll
    for (int r = 0; r < 16; ++r) ps += p0[r];
#pragma unroll
    for (int r = 0; r < 16; ++r) ps += p1[r];
    { auto rr = __builtin_amdgcn_permlane32_swap(__float_as_uint(ps), __float_as_uint(ps), false, false);
      ps = __uint_as_float(rr[0]) + __uint_as_float(rr[1]); }
    l_reg += ps;
#define PK4(P, BASE, OUT) do { unsigned a0 = cvt_pk_bf16(P[BASE + 0], P[BASE + 1]), a1 = cvt_pk_bf16(P[BASE + 2], P[BASE + 3]);   \
    unsigned b0 = cvt_pk_bf16(P[BASE + 4], P[BASE + 5]), b1 = cvt_pk_bf16(P[BASE + 6], P[BASE + 7]);                              \
    auto r0 = __builtin_amdgcn_permlane32_swap(a0, b0, false, false); auto r1 = __builtin_amdgcn_permlane32_swap(a1, b1, false, false); \
    u32x4 w = {r0[0], r1[0], r0[1], r1[1]}; OUT = *reinterpret_cast<bf16x8*>(&w); } while (0)
    PK4(p0, 0, pa0); PK4(p0, 8, pa1); PK4(p1, 0, pa2); PK4(p1, 8, pa3);
#undef PK4
}
__device__ __forceinline__ void attn_dual(f32x16 (&o1)[4], f32x16 (&o2)[4], const bf16_t* __restrict__ Qg, const bf16_t* __restrict__ Kh, const bf16_t* __restrict__ Vh, LAS char* lds, int q0w) {
    int tz_ = threadIdx.x; asm volatile("" : "+v"(tz_));
    const int tid = tz_, wid = __builtin_amdgcn_readfirstlane(tid >> 6), lane = tid & 63, r32 = lane & 31, hi = lane >> 5;
    LAS char* K_lds = lds + OFF_K; LAS char* V_lds = lds + OFF_V; LAS char* Qs = lds + OFF_Q + wid * 8192;
    LAS float* ws = (LAS float*)(lds + OFF_WS) + wid * 64; LAS float* li_l = ws;
    const LAS float* bt = (const LAS float*)(lds + OFF_BT);
    float l1 = 0.f, l2 = 0.f;
#pragma unroll
    for (int d = 0; d < 4; ++d) { o1[d] = (f32x16){}; o2[d] = (f32x16){}; }
#pragma unroll
    for (int i = 0; i < 8; ++i) { const int ci = i * 64 + lane, row = (ci >> 2) & 31, c = (ci >> 7) * 4 + ((ci & 3) ^ ((row >> 2) & 3));
        __builtin_amdgcn_global_load_lds((const unsigned*)(Qg + (size_t)row * 1024 + c * 8), (LAS unsigned*)(Qs + i * 1024), 16, 0, 0); }
    const int kq0 = r32 * 64 + ((hi ^ ((r32 >> 2) & 3)) << 4), kq1 = r32 * 64 + (((2 + hi) ^ ((r32 >> 2) & 3)) << 4);
    unsigned ko0, vo0;
    { const int p = wid * 2;
        { const int ci = p * 64 + lane, row = (ci >> 2) & 63, c = (ci >> 8) * 4 + ((ci & 3) ^ ((row >> 2) & 3)); ko0 = (unsigned)(row * 1024 + c * 8) * 2u; }
        { const int ci = p * 64 + lane, sub = ci >> 5, kk = (sub >> 2) * 8 + ((ci >> 2) & 7), c = (sub & 3) * 32 + (ci & 3) * 8;
          const int k = (kk & ~0xC) | ((kk & 4) << 1) | ((kk & 8) >> 1); vo0 = (unsigned)(k * 1024 + c) * 2u; } }
    const unsigned pw = (unsigned)wid * 2048u;
#define DMA_K(buf, k0) do { const char* g_ = (const char*)(Kh + (size_t)(k0) * 1024); \
    __builtin_amdgcn_global_load_lds((const unsigned*)(g_ + ko0), (LAS unsigned*)(K_lds + (buf) * SHM_T + pw), 16, 0, 0); \
    __builtin_amdgcn_global_load_lds((const unsigned*)(g_ + ko0 + 32768u), (LAS unsigned*)(K_lds + (buf) * SHM_T + pw + 1024), 16, 0, 0); } while (0)
#define DMA_V(buf, k0) do { const char* g_ = (const char*)(Vh + (size_t)(k0) * 1024); \
    __builtin_amdgcn_global_load_lds((const unsigned*)(g_ + vo0), (LAS unsigned*)(V_lds + (buf) * SHM_T + pw), 16, 0, 0); \
    __builtin_amdgcn_global_load_lds((const unsigned*)(g_ + vo0 + 128u), (LAS unsigned*)(V_lds + (buf) * SHM_T + pw + 1024), 16, 0, 0); } while (0)
    const int vbb = (int)(size_t)V_lds + v_rd_base(lane);
    const int relq = 256 - (q0w + r32);
    f32x16 pA0, pA1, pB0, pB1; bf16x8 pa0, pa1, pa2, pa3; constexpr int NT = S / KVBLK;
    DMA_K(0, 0); DMA_K(1, KVBLK); DMA_V(0, 0);
    asm volatile("s_waitcnt vmcnt(0) lgkmcnt(0)" ::: "memory"); __syncthreads();
    qkt<0>(pA0, pA1, K_lds, Qs, kq0, kq1); sm_exp(pA0, pA1, bt, relq, 0 - q0w, hi);
    int kb = 0, vb = 0;
    int ureg = (0 - q0w <= -191) ? 0 : ((0 - q0w >= 158) ? 2 : 1);
    for (int j = 0; j < NT; ++j) {
        asm volatile("s_waitcnt vmcnt(0)" ::: "memory"); __syncthreads();
        const int kb1 = kb == 2 ? 0 : kb + 1, kb2 = kb1 == 2 ? 0 : kb1 + 1;
        if (j + 2 < NT) DMA_K(kb2, (j + 2) * KVBLK);
        if (j + 1 < NT) DMA_V(vb ^ 1, (j + 1) * KVBLK);
        const int dq = j * KVBLK - q0w;
        { const int u = (dq <= -191) ? 0 : ((dq >= 158) ? 2 : 1);
          if (u != ureg) {
              const float cp = ureg == 0 ? bt[0] : (ureg == 2 ? bt[511] : 0.f), cn = u == 0 ? bt[0] : (u == 2 ? bt[511] : 0.f);
              const float f = __builtin_amdgcn_exp2f(cp - cn);
#pragma unroll
              for (int d = 0; d < 4; ++d) { o1[d] = o1[d] * f; o2[d] = o2[d] * f; }
              l1 *= f; l2 *= f; ureg = u; } }
        sm_fin(pA0, pA1, l1, pa0, pa1, pa2, pa3); SBAR();
        qkt<1>(pB0, pB1, K_lds + kb * SHM_T, Qs, kq0, kq1); SBAR();
        pv_d0(o1, vbb + vb * SHM_T, pa0, pa1, pa2, pa3);
        sm_exp(pB0, pB1, bt, relq + j * KVBLK, dq, hi);
        sm_fin(pB0, pB1, l2, pa0, pa1, pa2, pa3); SBAR();
        if (j + 1 < NT) { qkt<0>(pA0, pA1, K_lds + kb1 * SHM_T, Qs, kq0, kq1); SBAR(); }
        pv_d0(o2, vbb + vb * SHM_T, pa0, pa1, pa2, pa3);
        if (j + 1 < NT) sm_exp(pA0, pA1, bt, relq + (j + 1) * KVBLK, dq + KVBLK, hi);
        kb = kb1; vb ^= 1;
    }
    if (hi == 0) li_l[r32] = l1; asm volatile("s_waitcnt lgkmcnt(0)" ::: "memory");
#pragma unroll
    for (int r = 0; r < 16; ++r) { const float rl = __builtin_amdgcn_rcpf(li_l[crow(r, hi)]);
#pragma unroll
        for (int d = 0; d < 4; ++d) o1[d][r] *= rl; }
    asm volatile("s_waitcnt lgkmcnt(0)" ::: "memory");
    if (hi == 0) li_l[r32] = l2; asm volatile("s_waitcnt lgkmcnt(0)" ::: "memory");
#pragma unroll
    for (int r = 0; r < 16; ++r) { const float rl = __builtin_amdgcn_rcpf(li_l[crow(r, hi)]);
#pragma unroll
        for (int d = 0; d < 4; ++d) o2[d][r] *= rl; }
#undef DMA_K
#undef DMA_V
}
}

__device__ __forceinline__ int t5_bucket(int rel) {
    const int side = rel > 0 ? 16 : 0; const int n = rel < 0 ? -rel : rel;
    if (n < 8) return side + n;
    const float v = logf((float)n / 8.0f) / 2.7725887f * 8.0f;
    int large = 8 + (int)v; large = large < 15 ? large : 15;
    return side + large;
}

struct Args { GAS const float* in[28]; GAS float* out; GAS unsigned char* ws; int ph_lo, ph_hi; };
typedef const Args __attribute__((address_space(4))) CArgs;
struct LayerW { bf16_t *WIN, *WGLU, *WBR, *WOUT, *WGU, *WD, *F, *BO; float *KTAB, *WRT; };
__device__ __forceinline__ LayerW layer_w(unsigned char* ws, int l) {
    unsigned char* b = ws + WS_LW + (size_t)l * LW_SIZE; LayerW w;
    w.WIN = (bf16_t*)(b + LW_WIN); w.WGLU = (bf16_t*)(b + LW_WGLU); w.WBR = (bf16_t*)(b + LW_WBR); w.WOUT = (bf16_t*)(b + LW_WOUT); w.WGU = (bf16_t*)(b + LW_WGU);
    w.WD = (bf16_t*)(b + LW_WD); w.F = (bf16_t*)(b + LW_F); w.BO = (bf16_t*)(b + LW_BO); w.KTAB = (float*)(b + LW_KTAB); w.WRT = (float*)(b + LW_WRT); return w;
}
enum { I_X = 0, I_WIN, I_ARE, I_AIM, I_LDT, I_BRE, I_BIM, I_CRE, I_CIM, I_SD, I_WGLU, I_WSB, I_QG, I_KG, I_LQ1, I_LK1, I_LQ2, I_LK2, I_SUBLN, I_WAB, I_RELB, I_WOUT,
       I_NMIX, I_NFFN, I_WR, I_WEG, I_WEU, I_WED };

struct TItem { const float* src; bf16_t* dst; const float* gain; int N, ldd, rowmode, f8; };
__device__ __forceinline__ void t_load(const TItem& t, f32x4 (&v)[16], int lane) {
    const int r = lane >> 4, q = lane & 15;
#pragma unroll
    for (int j = 0; j < 16; ++j) v[j] = __builtin_nontemporal_load((const f32x4*)(t.src + (size_t)(4 * j + r) * t.N + 4 * q));
}
__device__ __forceinline__ void t_lds(const f32x4 (&v)[16], LAS float* scr, int lane) {
    const int r = lane >> 4, q = lane & 15;
#pragma unroll
    for (int j = 0; j < 16; ++j) { LAS float* s = scr + (4 * j + r) * 65 + 4 * q; s[0] = v[j][0]; s[1] = v[j][1]; s[2] = v[j][2]; s[3] = v[j][3]; }
}
__device__ __forceinline__ void t_store(const TItem& t, int n0, LAS float* scr, int lane) {
    const int c = lane & 7;
    float gn[8];
#pragma unroll
    for (int i = 0; i < 8; ++i) gn[i] = t.gain ? t.gain[8 * c + i] : 1.f;
#pragma unroll
    for (int j = 0; j < 8; ++j) { const int n = (lane >> 3) + 8 * j; const LAS float* s = scr + (8 * c) * 65 + n;
        u32x4 o; o.x = cvt_pk_bf16(s[0 * 65] * gn[0], s[1 * 65] * gn[1]); o.y = cvt_pk_bf16(s[2 * 65] * gn[2], s[3 * 65] * gn[3]);
        o.z = cvt_pk_bf16(s[4 * 65] * gn[4], s[5 * 65] * gn[5]); o.w = cvt_pk_bf16(s[6 * 65] * gn[6], s[7 * 65] * gn[7]);
        const int ng = n0 + n; const int drow = t.rowmode == 0 ? ng : ((ng >> 7) * 256 + ((ng >> 5) & 3) * 64 + (ng & 31) + (t.rowmode == 2 ? 32 : 0));
        if (t.f8) { const f32x4 a = (f32x4){s[0 * 65] * gn[0], s[1 * 65] * gn[1], s[2 * 65] * gn[2], s[3 * 65] * gn[3]} * W8_SCALE, b = (f32x4){s[4 * 65] * gn[4], s[5 * 65] * gn[5], s[6 * 65] * gn[6], s[7 * 65] * gn[7]} * W8_SCALE;
            *(u32x2*)((unsigned char*)t.dst + (size_t)drow * t.ldd + 8 * c) = pack8_fp8(a, b); }
        else *(u32x4*)(t.dst + (size_t)drow * t.ldd + 8 * c) = o; }
}

constexpr int IT_WIN = (D / 64) * (INC / 64), IT_GLU = 16 * 16, IT_BR = 16 * 32, IT_OUT = 32 * 32, IT_E = 32 * 32;
constexpr int DQ_A_I = 6144, DQ_A_G = 512, DQ_B_I = 5120, DQ_B_G = 1024, DQ_C_I = 5120, DQ_C_G = 1024;
constexpr int DQ_A0 = 0, DQ_A1 = DQ_A0 + DQ_A_I, DQ_B0 = DQ_A1 + DQ_A_G, DQ_B1 = DQ_B0 + DQ_B_I, DQ_C0 = DQ_B1 + DQ_B_G, DQ_C1 = DQ_C0 + DQ_C_I, DQ_END = DQ_C1 + DQ_C_G;
constexpr int DEF_UP = DQ_END - NE * IT_E;
static_assert(DEF_UP >= 0 && DEF_UP <= NE * IT_E, "deferred share");
constexpr int IT_LAYER0 = IT_WIN + IT_GLU + 2 * IT_BR + IT_OUT + 2 * NE * IT_E - DEF_UP;
constexpr int IT_DOWN = NE * IT_E;
__device__ __forceinline__ TItem make_item(const float* src, bf16_t* dst, const float* gain, int N, int ldd, int rowmode, int f8, int r, int& n0) {
    const int nblk = N / 64, k0 = 64 * (r / nblk); n0 = 64 * (r % nblk);
    TItem t; t.src = src + (size_t)k0 * N + n0; t.dst = f8 ? (bf16_t*)((unsigned char*)dst + k0) : dst + k0; t.gain = gain ? gain + k0 : nullptr; t.N = N; t.ldd = ldd; t.rowmode = rowmode; t.f8 = f8; return t; }
struct DecMain { CArgs* ap; unsigned char* ws;
    __device__ __forceinline__ TItem operator()(int it, int& n0) const { CArgs& args = *ap;
        const int l = it / IT_LAYER0; int r = it % IT_LAYER0; const LayerW w = layer_w(ws, l);
        if (r < IT_WIN) { const bool gate = (r % (INC / 64)) >= 64;
            return gate ? make_item((const float*)args.in[I_WIN] + (size_t)l * D * INC, (bf16_t*)((unsigned char*)w.WIN + (size_t)16 * MiB - (size_t)4096 * D), (const float*)args.in[I_NMIX] + l * D, INC, D, 0, 1, r, n0)
                        : make_item((const float*)args.in[I_WIN] + (size_t)l * D * INC, w.WIN, (const float*)args.in[I_NMIX] + l * D, INC, D, 0, 0, r, n0); }
        if ((r -= IT_WIN) < IT_GLU) return make_item((const float*)args.in[I_WGLU] + (size_t)l * SSMW * SSMW, w.WGLU, nullptr, SSMW, SSMW, 0, 0, r, n0);
        if ((r -= IT_GLU) < IT_BR) return make_item((const float*)args.in[I_WSB] + (size_t)l * SSMW * D, w.WBR, nullptr, D, 2048, 0, 0, r, n0);
        if ((r -= IT_BR) < IT_BR) return make_item((const float*)args.in[I_WAB] + (size_t)l * 1024 * D, w.WBR + 1024, nullptr, D, 2048, 0, 0, r, n0);
        if ((r -= IT_BR) < IT_OUT) return make_item((const float*)args.in[I_WOUT] + (size_t)l * D * D, w.WOUT, nullptr, D, D, 0, 0, r, n0);
        r -= IT_OUT; const int which = r / (NE * IT_E), e = (r / IT_E) % NE; r = r % IT_E; const size_t eo = ((size_t)l * NE + e) * D * FF;
        return make_item((const float*)args.in[which == 0 ? I_WEG : I_WEU] + eo, (bf16_t*)((unsigned char*)w.WGU + (size_t)e * 4096 * D), (const float*)args.in[I_NFFN] + l * D, FF, D, which == 0 ? 1 : 2, 1, r, n0); } };
struct DecDown { CArgs* ap; unsigned char* ws; int l;
    __device__ __forceinline__ TItem operator()(int it, int& n0) const { CArgs& args = *ap; const LayerW w = layer_w(ws, l);
        if (it >= IT_DOWN) { const int uu = NE * IT_E - 1 - (it - IT_DOWN), e = uu / IT_E; const size_t eo = ((size_t)l * NE + e) * D * FF;
            return make_item((const float*)args.in[I_WEU] + eo, (bf16_t*)((unsigned char*)w.WGU + (size_t)e * 4096 * D), (const float*)args.in[I_NFFN] + l * D, FF, D, 2, 1, uu % IT_E, n0); }
        const int e = it / IT_E, r = it % IT_E; const size_t eo = ((size_t)l * NE + e) * D * FF;
        return make_item((const float*)args.in[I_WED] + eo, (bf16_t*)((unsigned char*)w.WD + (size_t)e * D * FF), nullptr, D, FF, 0, 1, r, n0); } };
template <class Dec> __device__ __forceinline__ void convert_items(const Dec& dec, int first, int end, int step, LAS float* scr, int lane) {
    f32x4 tv[16]; int n0c = 0, n0n = 0; TItem cur, nxt; cur.src = nullptr; cur.dst = nullptr; cur.gain = nullptr; cur.N = 0; cur.ldd = 0; cur.rowmode = 0; cur.f8 = 0; nxt = cur;
    int it = first;
    if (it < end) { cur = dec(it, n0c); t_load(cur, tv, lane); }
    for (; it < end; it += step) {
        t_lds(tv, scr, lane);
        if (it + step < end) { nxt = dec(it + step, n0n); t_load(nxt, tv, lane); }
        LDS_WAIT(); asm volatile("" ::: "memory");
        t_store(cur, n0c, scr, lane);
        LDS_WAIT(); asm volatile("" ::: "memory");
        cur = nxt; n0c = n0n; }
}

template <bool ROUTER>
__device__ __forceinline__ void row_pass(const float* xrow, bf16_t* xb, float* rinv_out, const LAS float* WtL, float* afft, int row, int lane, unsigned char* xb8 = nullptr) {
    f32x4 v[8]; float ss = 0.f;
#pragma unroll
    for (int j = 0; j < 8; ++j) { v[j] = *(const f32x4*)(xrow + 4 * lane + 256 * j); ss += v[j][0] * v[j][0] + v[j][1] * v[j][1] + v[j][2] * v[j][2] + v[j][3] * v[j][3]; }
    ss = wave_sum(ss);
    const float rinv = __builtin_amdgcn_rsqf(ss * (1.f / D) + EPS);
#pragma unroll
    for (int j = 0; j < 8; ++j) { u32x2 w; w.x = cvt_pk_bf16(v[j][0], v[j][1]); w.y = cvt_pk_bf16(v[j][2], v[j][3]); *(u32x2*)(xb + 4 * lane + 256 * j) = w; }
    if (xb8) {
#pragma unroll
        for (int j = 0; j < 8; ++j) { int w8 = 0; w8 = __builtin_amdgcn_cvt_pk_fp8_f32(v[j][0], v[j][1], w8, false); w8 = __builtin_amdgcn_cvt_pk_fp8_f32(v[j][2], v[j][3], w8, true); *(int*)(xb8 + 4 * lane + 256 * j) = w8; } }
    if (lane == 0) *rinv_out = rinv;
    if constexpr (ROUTER) {
        float lg[16];
#pragma unroll
        for (int e = 0; e < 16; ++e) { float a = 0.f;
#pragma unroll
            for (int j = 0; j < 8; ++j) { const f32x4 w = *(const LAS f32x4*)(WtL + e * 2048 + 4 * lane + 256 * j); a += v[j][0] * w[0] + v[j][1] * w[1] + v[j][2] * w[2] + v[j][3] * w[3]; }
            lg[e] = wave_sum(a) * rinv; }
        float mx = lg[0];
#pragma unroll
        for (int e = 1; e < 16; ++e) mx = fmaxf(mx, lg[e]);
        float sum = 0.f;
#pragma unroll
        for (int e = 0; e < 16; ++e) { lg[e] = __expf(lg[e] - mx); sum += lg[e]; }
        const float inv = 1.f / sum;
        float mine = 0.f;
#pragma unroll
        for (int e = 0; e < 16; ++e) mine = (lane == e) ? lg[e] * inv : mine;
        if (lane < 16) afft[(size_t)lane * S + row] = mine;
    }
}

__device__ __forceinline__ void router_row(const u32x2 (&xw)[8], float* rinv_out, const LAS float* WtL, float* afft, int row, int lane) {
    f32x4 v[8]; float ss = 0.f;
#pragma unroll
    for (int j = 0; j < 8; ++j) { const u32x2 w = xw[j]; v[j] = (f32x4){bf_lo(w.x), bf_hi(w.x), bf_lo(w.y), bf_hi(w.y)}; ss += v[j][0] * v[j][0] + v[j][1] * v[j][1] + v[j][2] * v[j][2] + v[j][3] * v[j][3]; }
    ss = wave_sum(ss);
    const float rinv = __builtin_amdgcn_rsqf(ss * (1.f / D) + EPS);
    if (lane == 0) *rinv_out = rinv;
    float lg[16];
#pragma unroll
    for (int e = 0; e < 16; ++e) { float a = 0.f;
#pragma unroll
        for (int j = 0; j < 8; ++j) { const f32x4 w = *(const LAS f32x4*)(WtL + e * 2048 + 4 * lane + 256 * j); a += v[j][0] * w[0] + v[j][1] * w[1] + v[j][2] * w[2] + v[j][3] * w[3]; }
        lg[e] = wave_sum(a) * rinv; }
    float mx = lg[0];
#pragma unroll
    for (int e = 1; e < 16; ++e) mx = fmaxf(mx, lg[e]);
    float sum = 0.f;
#pragma unroll
    for (int e = 0; e < 16; ++e) { lg[e] = __expf(lg[e] - mx); sum += lg[e]; }
    const float inv = 1.f / sum;
    float mine = 0.f;
#pragma unroll
    for (int e = 0; e < 16; ++e) mine = (lane == e) ? lg[e] * inv : mine;
    if (lane < 16) afft[(size_t)lane * S + row] = mine;
}
__device__ __forceinline__ int block_sum_i(int v, LAS int* red, int wave, int lane) {
#pragma unroll
    for (int o = 1; o < 64; o <<= 1) v += __shfl_xor(v, o);
    __syncthreads();
    if (lane == 0) red[wave] = v;
    __syncthreads();
    int t = 0;
#pragma unroll
    for (int w = 0; w < 8; ++w) t += red[w];
    return t;
}

__global__ void __launch_bounds__(512, 2) fwd(Args kargs) {
    extern __shared__ __attribute__((aligned(16))) unsigned char lds_raw[];
    LAS unsigned char* lds = (LAS unsigned char*)lds_raw;
    volatile LAS unsigned* MISC = (volatile LAS unsigned*)(lds + MISC_OFF);
    const int G = gridDim.x;
    unsigned* ctl = (unsigned*)((unsigned char*)kargs.ws + WS_CTL);
    if (threadIdx.x < 64) MISC[threadIdx.x] = 0u;
    __syncthreads();
    XcdBarrier bar; bar.bar = ctl + 1024; bar.x = 0; bar.st = nullptr;
    if (!MK_PER_PHASE) bar = xcd_barrier_post(ctl + 1024, MISC + 8);
    const int lo = kargs.ph_lo, hi = kargs.ph_hi;
#ifndef PH_MASK
#define PH_MASK 0xFFFF
#endif
#define PON(b) ((PH_MASK >> (b)) & 1)
#ifndef REP_MASK
#define REP_MASK 0
#endif
#define REPS(b) (((REP_MASK >> (b)) & 1) ? 2 : 1)
#define IN(k) (lo <= (k) && (k) < hi)
#define PH_ENTER int tz0_ = threadIdx.x; asm volatile("" : "+v"(tz0_)); int bz0_ = blockIdx.x; asm volatile("" : "+s"(bz0_)); \
    const int tid = tz0_, lane = tid & 63, wave = __builtin_amdgcn_readfirstlane(tid >> 6), bx = bz0_, vcu = (G % 8 == 0) ? (bx % 8) * (G / 8) + bx / 8 : bx, gw = vcu * 8 + wave, NGW = G * 8; \
    (void)lane; (void)wave; (void)bx; (void)vcu; (void)gw; (void)NGW; \
      \
    CArgs* ap_ = (CArgs*)__builtin_amdgcn_kernarg_segment_ptr(); asm volatile("" : "+s"(ap_)); CArgs& args = *ap_; \
    unsigned char* const ws = (unsigned char*)args.ws; unsigned char* const act = ws + WS_ACT; unsigned char* const sm = act + A_SMALL; (void)sm; \
    bf16_t* const XB = (bf16_t*)(act + A_XB); unsigned char* const XB8 = act + A_O1; (void)XB8; bf16_t* const XB1 = (bf16_t*)(act + A_XB1); bf16_t* const UA = (bf16_t*)(act + A_UA); \
    bf16_t* const Qb = (bf16_t*)(act + A_Q); bf16_t* const Kb = (bf16_t*)(act + A_K); bf16_t* const Vb = (bf16_t*)(act + A_V); bf16_t* const Gb = (bf16_t*)(act + A_G); \
    float* const SSUM = (float*)(act + A_SSUM); bf16_t* const Yb = (bf16_t*)(act + A_Y); bf16_t* const YO = (bf16_t*)(act + A_YO); \
    bf16_t* const MG = (bf16_t*)(act + A_MG); float* const XA = (float*)(act + A_XA); bf16_t* const XG = (bf16_t*)(act + A_XG); bf16_t* const Hb = (bf16_t*)(act + A_H); bf16_t* const YX = (bf16_t*)(act + A_YX); \
    float* const RINV = (float*)(sm + SM_RINV); float* const RINV2 = (float*)(sm + SM_RINV2); float* const AFFT = (float*)(sm + SM_AFFT); int* const IDX = (int*)(sm + SM_IDX); \
    float* const GATE = (float*)(sm + SM_GATE); float* const RSL = (float*)(sm + SM_RSL); int* const INV = (int*)(sm + SM_INV); float* const LAMS = (float*)(sm + SM_LAM); \
    (void)XB; (void)XB1; (void)UA; (void)Qb; (void)Kb; (void)Vb; (void)Gb; (void)SSUM; (void)Yb; (void)YO; (void)MG; (void)XA; (void)XG; (void)Hb; (void)YX; \
    (void)RINV; (void)RINV2; (void)AFFT; (void)IDX; (void)GATE; (void)RSL; (void)INV; (void)LAMS;
#define INP(i) ((const float*)args.in[i])
#define OUTP ((float*)args.out)
#define LAYER_ENTER const LayerW w = layer_w(ws, l); const float lam_init = (l == 0) ? 0.2f : 0.35550906759f;   \
    (void)w; (void)lam_init;
#define SEAM(k) do { if (IN(k) && IN((k) + 1)) { if (!MK_PER_PHASE) xcd_barrier(bar); } } while (0)

    if (PON(0) && IN(0)) _Pragma("nounroll") for (int rep_ = 0; rep_ < REPS(0); ++rep_) { PH_ENTER
        LAS float* scr = (LAS float*)(lds + wave * 16640);
        convert_items(DecMain{ap_, ws}, gw, NL * IT_LAYER0, NGW, scr, lane);
        for (int i = gw * 64 + lane; i < NL * NE * D; i += NGW * 64) { const int l = i / (NE * D), e = (i / D) % NE, k = i % D;
            layer_w(ws, l).WRT[e * D + k] = INP(I_NFFN)[l * D + k] * INP(I_WR)[((size_t)l * D + k) * NE + e]; }
        for (int task = vcu; task < NL * NGRP * 2; task += G) {
            const int l = task / (NGRP * 2), g = (task >> 1) % NGRP, dir = task & 1;
            const size_t pb = ((size_t)(l * 2 + dir) * NGRP + g);
            LAS float* CR = (LAS float*)lds; LAS float* CI = CR + 16 * 65; LAS float* BR = CI + 16 * 65; LAS float* BI = BR + 64 * 16; LAS float* WD = BI + 64 * 16 + wave * 128;
            __syncthreads();
            for (int i = tid; i < 1024; i += 512) { const int pp = i >> 6, nn = i & 63; CR[pp * 65 + nn] = INP(I_CRE)[(pb * GP + pp) * NST + nn]; CI[pp * 65 + nn] = INP(I_CIM)[(pb * GP + pp) * NST + nn];
                BR[i] = INP(I_BRE)[pb * NST * GP + i]; BI[i] = INP(I_BIM)[pb * NST * GP + i]; }
            __syncthreads();
            const float are = INP(I_ARE)[pb * NST + lane], aim = INP(I_AIM)[pb * NST + lane], dt = expf(INP(I_LDT)[pb]);
            const float mag1 = expf(are * dt), ang1 = aim * dt, b1r = mag1 * cosf(ang1), b1i = mag1 * sinf(ang1);
            const float nr = b1r - 1.f, ni = b1i, den = are * are + aim * aim;
            const float cr = (nr * are + ni * aim) / den, ci = (ni * are - nr * aim) / den;
            const int p = lane >> 2, q0 = (lane & 3) * 4;
            for (int k = 0; k < 4; ++k) { const int dl = wave * 4 + k;
                const float magd = expf(are * dt * (float)dl), angd = aim * dt * (float)dl, pr = magd * cosf(angd), pi = magd * sinf(angd);
                WD[lane] = pr * cr - pi * ci; WD[64 + lane] = pr * ci + pi * cr;
                LDS_WAIT();
                f32x4 out = {0.f, 0.f, 0.f, 0.f};
#pragma unroll 8
                for (int n = 0; n < NST; ++n) {
                    const float wr_ = WD[n], wi_ = WD[64 + n];
                    const float c_r = CR[p * 65 + n], c_i = CI[p * 65 + n];
                    const float er = c_r * wr_ - c_i * wi_, ei = c_r * wi_ + c_i * wr_;
                    const f32x4 br = *(const LAS f32x4*)(BR + n * GP + q0), bi = *(const LAS f32x4*)(BI + n * GP + q0);
                    out += br * er - bi * ei;
                }
                *(f32x4*)(layer_w(ws, l).KTAB + ((((size_t)g * 2 + dir) * TC + dl) * GP + p) * GP + q0) = out;
                LDS_WAIT(); }
            { const LayerW w = layer_w(ws, l);
              for (int k = 0; k < 4; ++k) { const int t = wave * 4 + k;
                { const float e = dir == 0 ? (float)(t + 1) : (float)(TC - t); const float mg = expf(are * dt * e), an = aim * dt * e, pr = mg * cosf(an), pi = mg * sinf(an);
#pragma unroll
                  for (int pp = 0; pp < GP; ++pp) { const float c_r = CR[pp * 65 + lane], c_i = CI[pp * 65 + lane];
                      bf16_t* o = w.BO + ((size_t)g * 512 + t * 16 + pp) * UAW + 512 + dir * 128 + lane; o[0] = f2bf(c_r * pr - c_i * pi); o[64] = f2bf(-(c_r * pi + c_i * pr)); } }
                { const float e = dir == 0 ? (float)(TC - 1 - t) : (float)t; const float mg = expf(are * dt * e), an = aim * dt * e, pr = mg * cosf(an), pi = mg * sinf(an);
                  const float wre = pr * cr - pi * ci, wim = pr * ci + pi * cr;
                  f32x4 re[4], im[4];
#pragma unroll
                  for (int q = 0; q < 4; ++q) { const f32x4 br = *(const LAS f32x4*)(BR + lane * GP + 4 * q), bi = *(const LAS f32x4*)(BI + lane * GP + 4 * q); re[q] = br * wre - bi * wim; im[q] = bi * wre + br * wim; }
                  bf16_t* o = w.F + ((size_t)g * 256 + dir * 128 + lane) * 512 + t * 16;
                  *(u32x4*)o = pack8(re[0], re[1]); *(u32x4*)(o + 8) = pack8(re[2], re[3]);
                  *(u32x4*)(o + 64 * 512) = pack8(im[0], im[1]); *(u32x4*)(o + 64 * 512 + 8) = pack8(im[2], im[3]); } } }
        }
        __syncthreads();
        for (int m = gw; m < S; m += NGW) row_pass<false>(INP(I_X) + (size_t)m * D, XB + (size_t)m * D, RINV + m, nullptr, nullptr, m, lane, XB8 + (size_t)m * D);
        if (gw < NL) { const int l = gw; const float a = wave_sum(INP(I_LQ1)[l * QKD + lane] * INP(I_LK1)[l * QKD + lane]);
            const float b = wave_sum(INP(I_LQ2)[l * QKD + lane] * INP(I_LK2)[l * QKD + lane]);
            if (lane == 0) LAMS[l] = expf(a) - expf(b) + ((l == 0) ? 0.2f : 0.35550906759f); }
        for (int i = gw * 64 + lane; i < NH * 512; i += NGW * 64) { const int h = i >> 9, rel = (i & 511) - 256;
            ((float*)(sm + SM_BTAB))[i] = INP(I_RELB)[t5_bucket(rel) * NH + h] * LOG2E; }
    }
    SEAM(0);

    for (int l = 0; l < NL; ++l) {
        const int pbase = 2 + l * 14;
        if (PON(2) && IN(pbase + 0)) _Pragma("nounroll") for (int rep_ = 0; rep_ < REPS(2); ++rep_) { PH_ENTER LAYER_ENTER
            { pg::SchedGrid Sg; Sg.init(XB, D, w.WIN, D, S, 4096, G, bx);
              EpiInProj E{RINV, UA, Qb, Kb, Vb, Gb, INP(I_QG) + l * QKD, INP(I_KG) + l * QKD};
              pg::gemm_phase(lds, D, D, D, Sg, E); }
            { pg::SchedGrid Sg; Sg.init(XB8, D, (unsigned char*)w.WIN + (size_t)16 * MiB, D, S, 4096, G, bx, 1);
              EpiGates E{RINV, Gb};
              pg::gemm_phase<EpiGates, pg::SchedGrid, true, E8_ONE, E8_W>(lds, D, D, D, Sg, E); }
        }
        SEAM(pbase + 0);
        if (PON(3) && IN(pbase + 1)) _Pragma("nounroll") for (int rep_ = 0; rep_ < REPS(3); ++rep_) { PH_ENTER LAYER_ENTER
            pg::SchedGroup Sg; Sg.init(UA, UAW, (size_t)NCH * UAW * 2, w.F, 512, (size_t)256 * 512 * 2, 1, 1, NGRP, G, vcu);
            EpiSsum E{SSUM};
            pg::gemm_phase(lds, 512, UAW, 512, Sg, E);
            if (vcu >= NGRP) convert_items(DecDown{ap_, ws, l}, DQ_A0 + (vcu - NGRP) * 8 + wave, DQ_A1, (G - NGRP) * 8, (LAS float*)(lds + wave * 16640), lane);
            if (vcu >= NGRP) for (int gq = vcu - NGRP; gq < NGRP * 4; gq += G - NGRP) { const int g = gq >> 2, rq = gq & 3;
                LAS float* kt = (LAS float*)lds;
                __syncthreads();
                for (int i = tid; i < 2 * TC * 256 / 4; i += 512) ((LAS f32x4*)kt)[i] = ((const f32x4*)(w.KTAB + (size_t)g * 2 * TC * 256))[i];
                __syncthreads();
                for (int idx = tid; idx < 128 * 64; idx += 512) { const int rr = rq * 128 + (idx >> 6), kc = idx & 63;
                    const int t = rr >> 4, p = rr & 15, tau = kc >> 1, q0 = (kc & 1) * 8;
                    const LAS float* kf = kt; const LAS float* kb = kt + TC * 256;
                    f32x4 a, b;
                    if (tau < t) { const LAS float* s = kf + ((t - tau) * GP + p) * GP + q0; a = *(const LAS f32x4*)s; b = *(const LAS f32x4*)(s + 4); }
                    else if (tau > t) { const LAS float* s = kb + ((tau - t) * GP + p) * GP + q0; a = *(const LAS f32x4*)s; b = *(const LAS f32x4*)(s + 4); }
                    else { const LAS float* s = kf + p * GP + q0; const LAS float* s2 = kb + p * GP + q0; a = *(const LAS f32x4*)s + *(const LAS f32x4*)s2; b = *(const LAS f32x4*)(s + 4) + *(const LAS f32x4*)(s2 + 4);
                        const float dd = INP(I_SD)[l * SSMW + g * GP + p];
#pragma unroll
                        for (int j = 0; j < 4; ++j) { if (q0 + j == p) a[j] += dd; if (q0 + 4 + j == p) b[j] += dd; } }
                    *(u32x4*)(w.BO + ((size_t)g * 512 + rr) * UAW + tau * 16 + q0) = pack8(a, b); }
            }
            if (vcu < NGRP && wave < 2) {
                const int g = vcu, dir = wave; const size_t pb = ((size_t)(l * 2 + dir) * NGRP + g);
                const float are = INP(I_ARE)[pb * NST + lane], aim = INP(I_AIM)[pb * NST + lane], dt = expf(INP(I_LDT)[pb]);
                const float mg = expf(are * dt * (float)TC), an = aim * dt * (float)TC, ar = mg * cosf(an), ai = mg * sinf(an);
                float sr = 0.f, si = 0.f;
                for (int cb = 0; cb < NCH; cb += 32) {
                    float xr[32], xi[32];
#pragma unroll
                    for (int k = 0; k < 32; ++k) { const int c = dir == 0 ? cb + k : NCH - 1 - cb - k; const float* s = SSUM + ((size_t)g * NCH + c) * 256 + dir * 128 + lane; xr[k] = s[0]; xi[k] = s[64]; }
#pragma unroll
                    for (int k = 0; k < 32; ++k) { const int c = dir == 0 ? cb + k : NCH - 1 - cb - k;
                        bf16_t* o = UA + ((size_t)g * NCH + c) * UAW + 512 + dir * 128 + lane; o[0] = f2bf(sr); o[64] = f2bf(si);
                        const float nr = ar * sr - ai * si + xr[k], ni = ar * si + ai * sr + xi[k]; sr = nr; si = ni; }
                }
            }
            if (vcu < NGRP) convert_items(DecDown{ap_, ws, l}, DQ_A1 + vcu * 8 + wave, DQ_B0, NGRP * 8, (LAS float*)(lds + wave * 16640), lane);
        }
        SEAM(pbase + 1);
        if (PON(5) && IN(pbase + 3)) _Pragma("nounroll") for (int rep_ = 0; rep_ < REPS(5); ++rep_) { PH_ENTER LAYER_ENTER
            pg::SchedGroup Sg; Sg.init(UA, UAW, (size_t)NCH * UAW * 2, w.BO, UAW, (size_t)512 * UAW * 2, 1, 2, NGRP, G, vcu);
            EpiSsmOut E{Yb};
            pg::gemm_phase(lds, UAW, UAW, UAW, Sg, E);
            if (vcu >= 2 * NGRP) convert_items(DecDown{ap_, ws, l}, DQ_B0 + (vcu - 2 * NGRP) * 8 + wave, DQ_B1, (G - 2 * NGRP) * 8, (LAS float*)(lds + wave * 16640), lane);
            else convert_items(DecDown{ap_, ws, l}, DQ_B1 + vcu * 8 + wave, DQ_C0, 2 * NGRP * 8, (LAS float*)(lds + wave * 16640), lane);
        }
        SEAM(pbase + 3);
        if (PON(6) && IN(pbase + 4)) _Pragma("nounroll") for (int rep_ = 0; rep_ < REPS(6); ++rep_) { PH_ENTER LAYER_ENTER
            pg::SchedGrid Sg; Sg.init(Yb, SSMW, w.WGLU, SSMW, S, SSMW, G, bx);
            EpiGlu E{Yb, YO};
            pg::gemm_phase(lds, SSMW, SSMW, SSMW, Sg, E);
            if (bx >= 128) convert_items(DecDown{ap_, ws, l}, DQ_C0 + (bx - 128) * 8 + wave, DQ_C1, (G - 128) * 8, (LAS float*)(lds + wave * 16640), lane);
            else convert_items(DecDown{ap_, ws, l}, DQ_C1 + bx * 8 + wave, DQ_END, 128 * 8, (LAS float*)(lds + wave * 16640), lane);
        }
        SEAM(pbase + 4);
        if (PON(7) && IN(pbase + 5)) _Pragma("nounroll") for (int rep_ = 0; rep_ < REPS(7); ++rep_) { PH_ENTER LAYER_ENTER
            for (int un = vcu; un < NH * (S / 256); un += G) {
                const int h = un / (S / 256), qb = un % (S / 256);
                __syncthreads();
                { int tb = threadIdx.x; asm volatile("" : "+v"(tb)); ((LAS float*)(lds + att::OFF_BT))[tb] = ((const float*)(sm + SM_BTAB))[h * 512 + tb]; }
                const int q0w = qb * 256 + wave * 32;
                f32x16 o[4];
                { f32x16 o2[4];
                  att::attn_dual(o, o2, Qb + (size_t)q0w * 1024 + h * 128, Kb + h * 128, Vb + h * 128, (LAS char*)lds, q0w);
                  const float lam = LAMS[l];
#pragma unroll
                  for (int d = 0; d < 4; ++d) o[d] = o[d] - o2[d] * lam; }
                { int tz = threadIdx.x; asm volatile("" : "+v"(tz)); const int r32 = tz & 31, hi2 = (tz >> 5) & 1;
                  float ssq[16];
#pragma unroll
                  for (int r = 0; r < 16; ++r) { float s = 0.f;
#pragma unroll
                    for (int d = 0; d < 4; ++d) s += o[d][r] * o[d][r];
                    s += swz_xor<1>(s); s += swz_xor<2>(s); s += swz_xor<4>(s); s += swz_xor<8>(s); s += swz_xor<16>(s);
                    ssq[r] = __builtin_amdgcn_rsqf(s * (1.f / VD) + EPS) * (1.f - lam_init); }
                  bf16_t* yo = YO + (size_t)(q0w + 4 * hi2) * 2048 + 1024 + h * 128 + r32;
#pragma unroll
                  for (int d = 0; d < 4; ++d) { const float gn = INP(I_SUBLN)[l * VD + d * 32 + r32];
#pragma unroll
                    for (int r = 0; r < 16; ++r) yo[(size_t)((r & 3) + 8 * (r >> 2)) * 2048 + d * 32] = f2bf(o[d][r] * ssq[r] * gn); } }
            }
            __syncthreads();
        }
        SEAM(pbase + 5);
        if (PON(8) && IN(pbase + 6)) _Pragma("nounroll") for (int rep_ = 0; rep_ < REPS(8); ++rep_) { PH_ENTER LAYER_ENTER
            pg::SchedGrid Sg; Sg.init(YO, 2048, w.WBR, 2048, S, D, G, bx);
            EpiMerge E{Gb, MG};
            pg::gemm_phase(lds, 2048, 2048, 2048, Sg, E);
        }
        SEAM(pbase + 6);
        if (PON(9) && IN(pbase + 7)) _Pragma("nounroll") for (int rep_ = 0; rep_ < REPS(9); ++rep_) { PH_ENTER LAYER_ENTER
            pg::SchedGrid Sg; Sg.init(MG, D, w.WOUT, D, S, D, G, bx);
            EpiOutProj E{XB, XB1};
            pg::gemm_phase(lds, D, D, D, Sg, E);
        }
        SEAM(pbase + 7);
        if (PON(10) && IN(pbase + 8)) _Pragma("nounroll") for (int rep_ = 0; rep_ < REPS(10); ++rep_) { PH_ENTER LAYER_ENTER
            LAS float* WtL = (LAS float*)lds;
            for (int i = tid; i < NE * D / 4; i += 512) ((LAS f32x4*)WtL)[i] = ((const f32x4*)w.WRT)[i];
            __syncthreads();
            { u32x2 xc[8], xn[8];
#pragma unroll
              for (int j = 0; j < 8; ++j) { xc[j] = (u32x2){0u, 0u}; xn[j] = xc[j]; }
              if (gw < S) {
#pragma unroll
                  for (int j = 0; j < 8; ++j) xc[j] = *(const u32x2*)(XB1 + (size_t)gw * D + 4 * lane + 256 * j); }
              for (int m = gw; m < S; m += NGW) { int lz = lane; asm volatile("" : "+v"(lz));
                  if (m + NGW < S) {
#pragma unroll
                      for (int j = 0; j < 8; ++j) xn[j] = *(const u32x2*)(XB1 + (size_t)(m + NGW) * D + 4 * lz + 256 * j); }
                  router_row(xc, RINV2 + m, WtL, AFFT, m, lz);
#pragma unroll
                  for (int j = 0; j < 8; ++j) xc[j] = xn[j]; } }
            __syncthreads();
        }
        SEAM(pbase + 8);
        if (PON(11) && IN(pbase + 9)) _Pragma("nounroll") for (int rep_ = 0; rep_ < REPS(11); ++rep_) { PH_ENTER LAYER_ENTER
            const int nparts = G / NE > 0 ? G / NE : 1;
            if (vcu < nparts * NE) {
                const int e = vcu / nparts, part = vcu % nparts, per = (CAP + nparts - 1) / nparts, slo = part * per, shi = (slo + per < CAP) ? slo + per : CAP;
                LAS int* red = (LAS int*)lds; LAS int* list = (LAS int*)(lds + 1024);
                unsigned bits[16]; { const float* a = AFFT + (size_t)e * S + tid * 16;
#pragma unroll
                    for (int q = 0; q < 4; ++q) { const f32x4 v = *(const f32x4*)(a + 4 * q); bits[4 * q] = __float_as_uint(v[0]); bits[4 * q + 1] = __float_as_uint(v[1]); bits[4 * q + 2] = __float_as_uint(v[2]); bits[4 * q + 3] = __float_as_uint(v[3]); } }
                unsigned T = 0u;
                for (int bit = 30; bit >= 0; --bit) { const unsigned cand = T | (1u << bit); int c = 0;
#pragma unroll
                    for (int i = 0; i < 16; ++i) c += bits[i] >= cand ? 1 : 0;
                    if (block_sum_i(c, red, wave, lane) >= CAP) T = cand; }
                int cg = 0, ce = 0;
#pragma unroll
                for (int i = 0; i < 16; ++i) { cg += bits[i] > T ? 1 : 0; ce += bits[i] == T ? 1 : 0; }
                const int need_eq = CAP - block_sum_i(cg, red, wave, lane);
                int sg = cg, se = ce;
#pragma unroll
                for (int o = 1; o < 64; o <<= 1) { const int a = __shfl_up(sg, o), b = __shfl_up(se, o); if (lane >= o) { sg += a; se += b; } }
                __syncthreads();
                if (lane == 63) { red[16 + wave] = sg; red[32 + wave] = se; }
                __syncthreads();
                int og = 0, oe = 0;
#pragma unroll
                for (int wv = 0; wv < 8; ++wv) if (wv < wave) { og += red[16 + wv]; oe += red[32 + wv]; }
                int gbef = og + sg - cg, ebef = oe + se - ce;
                const bool inv_mine = (tid * nparts) / 512 == part;
#pragma unroll
                for (int i = 0; i < 16; ++i) { const int tok = tid * 16 + i; const bool isg = bits[i] > T, ise = bits[i] == T; const bool sel = isg || (ise && ebef < need_eq);
                    const int slot = gbef + (ebef < need_eq ? ebef : need_eq);
                    if (sel && slot >= slo && slot < shi) { IDX[e * CAP + slot] = tok; GATE[e * CAP + slot] = __uint_as_float(bits[i]); RSL[e * CAP + slot] = RINV2[tok]; list[slot - slo] = tok; }
                    if (inv_mine) INV[tok * NE + e] = sel ? slot : -1;
                    gbef += isg ? 1 : 0; ebef += ise ? 1 : 0; }
                __syncthreads();
                for (int r = wave; r < shi - slo; r += 32) {
                    u32x4 t[4][4];
#pragma unroll
                    for (int q = 0; q < 4; ++q) { const int rr = (r + 8 * q < shi - slo) ? r + 8 * q : r; const u32x4* s = (const u32x4*)(XB1 + (size_t)list[rr] * D) + lane;
#pragma unroll
                        for (int j = 0; j < 4; ++j) t[q][j] = s[64 * j]; }
#pragma unroll
                    for (int q = 0; q < 4; ++q) if (r + 8 * q < shi - slo) { u32x2* d = (u32x2*)((unsigned char*)XG + (size_t)(e * CAP + slo + r + 8 * q) * D) + lane;
#pragma unroll
                        for (int j = 0; j < 4; ++j) { f32x4 a, b; unpack8(t[q][j], a, b); d[64 * j] = pack8_fp8(a, b); } } }
                __syncthreads();
            }
        }
        SEAM(pbase + 9);
        if (PON(13) && IN(pbase + 11)) _Pragma("nounroll") for (int rep_ = 0; rep_ < REPS(13); ++rep_) { PH_ENTER LAYER_ENTER
            pg::SchedGroup Sg; Sg.init(XG, D, (size_t)CAP * D, w.WGU, D, (size_t)4096 * D, 4, 16, NE, G, vcu, 1);
            EpiExp1 E{RSL, Hb};
            pg::gemm_phase<EpiExp1, pg::SchedGroup, true, E8_ONE, E8_W>(lds, D, D, D, Sg, E);
        }
        SEAM(pbase + 11);
        if (PON(14) && IN(pbase + 12)) _Pragma("nounroll") for (int rep_ = 0; rep_ < REPS(14); ++rep_) { PH_ENTER LAYER_ENTER
            pg::SchedGroup Sg; Sg.init(Hb, FF, (size_t)CAP * FF, w.WD, FF, (size_t)D * FF, 4, 8, NE, G, vcu, 1);
            EpiExp2 E{GATE, YX};
            pg::gemm_phase<EpiExp2, pg::SchedGroup, true, E8_H, E8_W>(lds, FF, FF, FF, Sg, E);
        }
        SEAM(pbase + 12);
        if (PON(15) && IN(pbase + 13)) _Pragma("nounroll") for (int rep_ = 0; rep_ < REPS(15); ++rep_) { PH_ENTER LAYER_ENTER
            { u32x2 xc[8], xn[8]; int invc = -1, invn = -1;
#pragma unroll
              for (int j = 0; j < 8; ++j) { xc[j] = (u32x2){0u, 0u}; xn[j] = xc[j]; }
              if (gw < S) { invc = INV[gw * NE + (lane & 15)];
#pragma unroll
                  for (int j = 0; j < 8; ++j) xc[j] = *(const u32x2*)(XB1 + (size_t)gw * D + 4 * lane + 256 * j); }
              for (int m = gw; m < S; m += NGW) {
                if (m + NGW < S) { invn = INV[(m + NGW) * NE + (lane & 15)];
#pragma unroll
                    for (int j = 0; j < 8; ++j) xn[j] = *(const u32x2*)(XB1 + (size_t)(m + NGW) * D + 4 * lane + 256 * j); }
                f32x4 v[8];
#pragma unroll
                for (int j = 0; j < 8; ++j) v[j] = (f32x4){bf_lo(xc[j].x), bf_hi(xc[j].x), bf_lo(xc[j].y), bf_hi(xc[j].y)};
                const int myinv = invc;
                unsigned msk = (unsigned)(__ballot(myinv >= 0) & 0xFFFFull);
                while (msk) { const int e0 = __builtin_ctz(msk); msk &= msk - 1; const bool two = msk != 0u; const int e1 = two ? __builtin_ctz(msk) : e0; if (two) msk &= msk - 1;
                    const bf16_t* y0 = YX + ((size_t)e0 * CAP + __shfl(myinv, e0)) * D; const bf16_t* y1 = YX + ((size_t)e1 * CAP + __shfl(myinv, e1)) * D;
                    u32x2 a[8], b[8];
#pragma unroll
                    for (int j = 0; j < 8; ++j) a[j] = *(const u32x2*)(y0 + 4 * lane + 256 * j);
#pragma unroll
                    for (int j = 0; j < 8; ++j) b[j] = *(const u32x2*)(y1 + 4 * lane + 256 * j);
#pragma unroll
                    for (int j = 0; j < 8; ++j) { v[j][0] += bf_lo(a[j].x); v[j][1] += bf_hi(a[j].x); v[j][2] += bf_lo(a[j].y); v[j][3] += bf_hi(a[j].y); }
                    if (two) {
#pragma unroll
                        for (int j = 0; j < 8; ++j) { v[j][0] += bf_lo(b[j].x); v[j][1] += bf_hi(b[j].x); v[j][2] += bf_lo(b[j].y); v[j][3] += bf_hi(b[j].y); } } }
                if (l + 1 < NL) {
                    float ss = 0.f;
#pragma unroll
                    for (int j = 0; j < 8; ++j) ss += v[j][0] * v[j][0] + v[j][1] * v[j][1] + v[j][2] * v[j][2] + v[j][3] * v[j][3];
                    ss = wave_sum(ss);
#pragma unroll
                    for (int j = 0; j < 8; ++j) { u32x2 wv; wv.x = cvt_pk_bf16(v[j][0], v[j][1]); wv.y = cvt_pk_bf16(v[j][2], v[j][3]); *(u32x2*)(XB + (size_t)m * D + 4 * lane + 256 * j) = wv;
                        int w8 = 0; w8 = __builtin_amdgcn_cvt_pk_fp8_f32(v[j][0], v[j][1], w8, false); w8 = __builtin_amdgcn_cvt_pk_fp8_f32(v[j][2], v[j][3], w8, true); *(int*)(XB8 + (size_t)m * D + 4 * lane + 256 * j) = w8; }
                    if (lane == 0) RINV[m] = __builtin_amdgcn_rsqf(ss * (1.f / D) + EPS);
                } else { float* orow = OUTP + (size_t)m * D;
#pragma unroll
                    for (int j = 0; j < 8; ++j) *(f32x4*)(orow + 4 * lane + 256 * j) = v[j]; }
#pragma unroll
                for (int j = 0; j < 8; ++j) xc[j] = xn[j];
                invc = invn;
              } }
        }
        SEAM(pbase + 13);
    }
#undef IN
#undef SEAM
}

#if defined(DBG_STOP)
#ifndef DBG_OFF
#define DBG_OFF A_XA
#endif
#ifndef DBG_BF16
#define DBG_BF16 0
#endif
__global__ void dbg_dump(float* out, const unsigned char* ws) {
    const unsigned char* p = ws + WS_ACT + DBG_OFF;
    for (size_t i = (size_t)blockIdx.x * 256 + threadIdx.x; i < (size_t)S * D; i += (size_t)gridDim.x * 256)
#if defined(DBG_SUM2)
        out[i] = __uint_as_float(((unsigned)((const bf16_t*)p)[i]) << 16) + __uint_as_float(((unsigned)((const bf16_t*)p)[i + (size_t)S * D]) << 16);
#else
        out[i] = DBG_BF16 ? __uint_as_float(((unsigned)((const bf16_t*)p)[i]) << 16) : ((const float*)p)[i];
#endif
}
#endif
constexpr int N_PHASES = 2 + NL * 14;
extern "C" void kernel_launch(void* const* d_in, const int* in_sizes, int n_in, void* d_out, int out_size, void* d_ws, size_t ws_size, hipStream_t stream) {
    static int grid = 0;
    if (grid == 0) {
        if (n_in != 28 || in_sizes[0] != S * D || out_size != S * D || ws_size < WS_END) { fprintf(stderr, "kernel_launch: shape/workspace mismatch (n_in %d, ws %zu, need %zu)\n", n_in, ws_size, (size_t)WS_END); grid = -1; return; }
        int dev = 0, cus = 0, per_cu = 0;
        if (hipGetDevice(&dev) != hipSuccess || hipDeviceGetAttribute(&cus, hipDeviceAttributeMultiprocessorCount, dev) != hipSuccess) { grid = -1; return; }
        if (hipFuncSetAttribute((const void*)fwd, hipFuncAttributeMaxDynamicSharedMemorySize, LDS_BYTES) != hipSuccess) { fprintf(stderr, "kernel_launch: hipFuncSetAttribute failed\n"); grid = -1; return; }
        if (hipOccupancyMaxActiveBlocksPerMultiprocessor(&per_cu, (const void*)fwd, 512, LDS_BYTES) != hipSuccess || per_cu < 1) { fprintf(stderr, "kernel_launch: occupancy query says %d\n", per_cu); }
        (void)hipGetLastError();
        grid = cus;
    }
    if (grid < 0) return;
    (void)hipMemsetAsync((char*)d_ws + WS_CTL, 0, CTL_BYTES, stream);
    Args a{};
    for (int i = 0; i < 28; ++i) a.in[i] = (GAS const float*)d_in[i];
    a.out = (GAS float*)d_out; a.ws = (GAS unsigned char*)d_ws;
#if defined(DBG_STOP)
    for (int p = 0; p < DBG_STOP; ++p) { a.ph_lo = p; a.ph_hi = p + 1; hipLaunchKernelGGL(fwd, dim3(grid), dim3(512), LDS_BYTES, stream, a); }
#if !defined(DBG_NODUMP)
    hipLaunchKernelGGL(dbg_dump, dim3(2048), dim3(256), 0, stream, (float*)d_out, (const unsigned char*)d_ws);
#endif
#elif MK_PER_PHASE
    for (int p = 0; p < N_PHASES; ++p) { a.ph_lo = p; a.ph_hi = p + 1; hipLaunchKernelGGL(fwd, dim3(grid), dim3(512), LDS_BYTES, stream, a); }
#else
    a.ph_lo = 0; a.ph_hi = N_PHASES; hipLaunchKernelGGL(fwd, dim3(grid), dim3(512), LDS_BYTES, stream, a);
#endif
    const hipError_t le = hipPeekAtLastError();
    if (le != hipSuccess) fprintf(stderr, "kernel_launch: launch failed: %s\n", hipGetErrorName(le));
}
```

```cpp
#include <hip/hip_runtime.h>
#include <cstdio>
#include <cstdint>

#define REP_MASK 7168
#ifndef MK_PER_PHASE
#define MK_PER_PHASE 0
#endif

#define LAS __attribute__((address_space(3)))
#define GAS __attribute__((address_space(1)))
typedef unsigned short bf16_t;
typedef short bf16x8 __attribute__((ext_vector_type(8)));
typedef short s16x4 __attribute__((ext_vector_type(4)));
typedef float f32x4 __attribute__((ext_vector_type(4)));
typedef float f32x2 __attribute__((ext_vector_type(2)));
typedef float f32x16 __attribute__((ext_vector_type(16)));
typedef unsigned u32x4 __attribute__((ext_vector_type(4)));
typedef unsigned u32x2 __attribute__((ext_vector_type(2)));

constexpr int S = 8192, D = 2048, NL = 2;
constexpr int SSMW = 1024, NGRP = 64, GP = 16, NST = 64;
constexpr int NH = 8, QKD = 64, VD = 128;
constexpr int NE = 16, CAP = 1024, FF = 2048;
constexpr int INC = 8192;
constexpr float EPS = 1e-6f;
constexpr int TC = 32, NCH = S / TC;
constexpr int UAW = TC * GP + 256;
constexpr float LOG2E = 1.4426950408889634f;

constexpr size_t MiB = 1u << 20;
constexpr size_t WS_CTL = 0, CTL_BYTES = 1 * MiB;
constexpr size_t LW_WIN = 0, LW_WGLU = 32 * MiB, LW_WBR = 34 * MiB, LW_WOUT = 42 * MiB, LW_WGU = 50 * MiB, LW_WD = 306 * MiB,
                 LW_F = 434 * MiB, LW_BO = 450 * MiB, LW_KTAB = 498 * MiB, LW_WRT = 502 * MiB, LW_SIZE = 503 * MiB;
constexpr size_t WS_LW = 1 * MiB;
constexpr size_t WS_ACT = WS_LW + 2 * LW_SIZE;
constexpr size_t A_XB = 0, A_XB1 = 32 * MiB, A_UA = 64 * MiB, A_Q = 88 * MiB, A_K = 104 * MiB, A_V = 120 * MiB, A_G = 136 * MiB,
                 A_SSUM = 200 * MiB, A_Y = 216 * MiB, A_YO = 232 * MiB, A_O1 = 264 * MiB, A_MG = 296 * MiB, A_XA = 328 * MiB,
                 A_XG = 392 * MiB, A_H = 456 * MiB, A_YX = 520 * MiB, A_SMALL = 584 * MiB, A_END = 588 * MiB;
constexpr size_t SM_RINV = 0, SM_RINV2 = 64 * 1024, SM_AFFT = 128 * 1024, SM_IDX = 640 * 1024, SM_GATE = 704 * 1024, SM_RSL = 768 * 1024,
                 SM_INV = 1024 * 1024, SM_BTAB = 1536 * 1024, SM_LAM = 1600 * 1024;
constexpr size_t WS_END = WS_ACT + A_END;

constexpr int RING_BYTES = 131072;
constexpr int LDS_BYTES = 163840;
constexpr int MISC_OFF = 155648;

typedef __bf16 bf16v2_t __attribute__((ext_vector_type(2)));
__device__ __forceinline__ unsigned cvt_pk_bf16(float lo, float hi) { const f32x2 v = {lo, hi}; return __builtin_bit_cast(unsigned, __builtin_convertvector(v, bf16v2_t)); }
__device__ __forceinline__ float bf_lo(unsigned w) { return __uint_as_float(w << 16); }
__device__ __forceinline__ float bf_hi(unsigned w) { return __uint_as_float(w & 0xffff0000u); }
__device__ __forceinline__ unsigned short f2bf(float f) { return (unsigned short)(cvt_pk_bf16(f, 0.f) & 0xffffu); }
__device__ __forceinline__ float fast_sigmoid(float x) { return __builtin_amdgcn_rcpf(1.f + __builtin_amdgcn_exp2f(-x * LOG2E)); }
__device__ __forceinline__ float wave_sum(float v) {
#pragma unroll
    for (int o = 1; o < 64; o <<= 1) v += __shfl_xor(v, o);
    return v;
}
template <int X> __device__ __forceinline__ float swz_xor(float v) { return __int_as_float(__builtin_amdgcn_ds_swizzle(__float_as_int(v), (X << 10) | 0x1F)); }
__device__ __forceinline__ int lane_now() { int t; asm volatile("v_mbcnt_lo_u32_b32 %0, -1, 0\n\tv_mbcnt_hi_u32_b32 %0, -1, %0" : "=v"(t)); return t; }
constexpr int WTAB_OFF = MISC_OFF + 512;
__device__ __forceinline__ unsigned hw_slot() { return (unsigned)__builtin_amdgcn_s_getreg((5 << 11) | 4) & 63u; }
__device__ __forceinline__ int wave_now() { return __builtin_amdgcn_readfirstlane(*(volatile LAS int*)(unsigned)(WTAB_OFF + 4u * hw_slot())); }
__device__ __forceinline__ int tid_now() { return wave_now() * 64 + lane_now(); }
__device__ __forceinline__ u32x2 pack8_fp8(const f32x4 a, const f32x4 b) { int w0 = 0, w1 = 0;
    w0 = __builtin_amdgcn_cvt_pk_fp8_f32(a[0], a[1], w0, false); w0 = __builtin_amdgcn_cvt_pk_fp8_f32(a[2], a[3], w0, true);
    w1 = __builtin_amdgcn_cvt_pk_fp8_f32(b[0], b[1], w1, false); w1 = __builtin_amdgcn_cvt_pk_fp8_f32(b[2], b[3], w1, true);
    u32x2 r; r.x = (unsigned)w0; r.y = (unsigned)w1; return r; }
constexpr float W8_SCALE = 64.f, H8_SCALE = 16.f;
constexpr int E8_ONE = 0x7F7F7F7F, E8_W = 0x79797979  , E8_H = 0x7B7B7B7B  ;
#define LDS_WAIT() asm volatile("s_waitcnt lgkmcnt(0)" ::: "memory")
#define VM_WAIT() asm volatile("s_waitcnt vmcnt(0)" ::: "memory")

#define XB_TMO      128
#define XB_XCNT(j)  (256  + 64 * (j))
#define XB_XSUB(j)  (1280 + 64 * (j))
#define XB_XGEN(j)  (2304 + 64 * (j))
#define XB_TOP      3328
#define XB_TOPGEN   3392
#define XCD_BAR_WORDS 3456
#define XB_SPIN_CAP (1u << 22)
__device__ __forceinline__ unsigned xb_ld(unsigned* p)              { return __hip_atomic_load(p, __ATOMIC_RELAXED, __HIP_MEMORY_SCOPE_AGENT); }
__device__ __forceinline__ unsigned xb_add(unsigned* p, unsigned v) { return __hip_atomic_fetch_add(p, v, __ATOMIC_RELAXED, __HIP_MEMORY_SCOPE_AGENT); }
__device__ __forceinline__ unsigned xb_xcc_id() { return (unsigned)__builtin_amdgcn_s_getreg((3 << 11) | 20) & 0xFu; }
#define XB_SPIN(cond, bar) do { unsigned _sp = 0; while (cond) { __builtin_amdgcn_s_sleep(1); \
    if ((++_sp & 255u) == 0u) { if (xb_ld(&(bar)[XB_TMO])) break; if (_sp > XB_SPIN_CAP) { atomicAdd(&(bar)[XB_TMO], 1u); break; } } } } while (0)
struct XcdBarrier { unsigned* bar; unsigned x; volatile LAS unsigned* st; };
__device__ __forceinline__ XcdBarrier xcd_barrier_post(unsigned* bar, volatile LAS unsigned* st) {
    XcdBarrier b; b.bar = bar; b.x = xb_xcc_id(); b.st = st;
    if (tid_now() == 0) (void)xb_add(&bar[XB_XCNT(b.x)], 1u);
    return b;
}
__device__ __forceinline__ void xcd_barrier_complete(unsigned* bar, unsigned x, unsigned& nloc, unsigned& nx) {
    const unsigned G = gridDim.x * gridDim.y * gridDim.z;
    unsigned sum, cnt, mine, sp = 0u;
    for (;;) {
        sum = 0u; cnt = 0u; mine = 0u;
#pragma nounroll
        for (unsigned j = 0; j < 16; ++j) { const unsigned c = xb_ld(&bar[XB_XCNT(j)]); sum += c; cnt += (c > 0u) ? 1u : 0u; mine = (j == x) ? c : mine; }
        if (sum == G) break;
        __builtin_amdgcn_s_sleep(1);
        if ((++sp & 255u) == 0u) { if (xb_ld(&bar[XB_TMO])) break; if (sp > XB_SPIN_CAP) { atomicAdd(&bar[XB_TMO], 1u); break; } }
    }
    nloc = mine > 0u ? mine : 1u; nx = cnt > 0u ? cnt : 1u;
}
__device__ __forceinline__ void xcd_barrier(const XcdBarrier& b) {
    asm volatile("s_waitcnt vmcnt(0)" ::: "memory");
    __syncthreads();
    if (tid_now() == 0) {
        unsigned* bar = b.bar;
        __builtin_amdgcn_s_waitcnt(0);
        unsigned nloc = b.st[0], nx = b.st[1];
        if (nloc == 0u) { xcd_barrier_complete(bar, b.x, nloc, nx); b.st[0] = nloc; b.st[1] = nx; }
        const unsigned old = xb_add(&bar[XB_XSUB(b.x)], 1u);
        const unsigned gen = old / nloc;
        if (old + 1u == (gen + 1u) * nloc) {
            __builtin_amdgcn_fence(__ATOMIC_RELEASE, "agent");
            asm volatile("s_waitcnt vmcnt(0)" ::: "memory");
            const unsigned og = xb_add(&bar[XB_TOP], 1u);
            const unsigned tg = og / nx;
            if (og + 1u == (tg + 1u) * nx) xb_add(&bar[XB_TOPGEN], 1u);
            else XB_SPIN(xb_ld(&bar[XB_TOPGEN]) == tg, bar);
            __builtin_amdgcn_fence(__ATOMIC_ACQUIRE, "agent");
            xb_add(&bar[XB_XGEN(b.x)], 1u);
            asm volatile("s_waitcnt vmcnt(0)" ::: "memory");
        } else {
            XB_SPIN(xb_ld(&bar[XB_XGEN(b.x)]) == gen, bar);
            __builtin_amdgcn_fence(__ATOMIC_ACQUIRE, "agent");
            asm volatile("s_waitcnt vmcnt(0)" ::: "memory");
        }
    }
    __syncthreads();
}

namespace pg {
constexpr int BM = 256, BK = 64, HALF = 128, HTB = HALF * BK * 2, STAGE_BYTES = 8 * HTB;
__device__ __forceinline__ int lds_byte(int r, int c) { const int st = (r >> 4) * 2 + (c >> 5), rr = r & 15, cc = c & 31, ob = rr * 64 + cc * 2; return st * 1024 + (ob ^ (((ob >> 9) & 1) << 5)); }
__device__ __forceinline__ void stage_rc(int b, int& R, int& C) { const int st = b / 1024, sb = b % 1024, swz = sb ^ (((sb >> 9) & 1) << 5); R = (st >> 1) * 16 + swz / 64; C = (st & 1) * 32 + (swz % 64) / 2; }
__device__ __forceinline__ int perm32(int rho) { const int n = rho >> 4, i = rho & 15; return 8 * (i >> 2) + 4 * n + (i & 3); }
struct Unit { const char* a; const char* b; int pm, pn, grp; };
typedef f32x4 Acc[2][2][4][2];

typedef int v8i_t __attribute__((ext_vector_type(8)));
template <class Epi, class Sched, bool F8 = false, int SA_ = 0x7F7F7F7F, int SB_ = 0x7F7F7F7F>
__device__ __forceinline__ void gemm_phase(LAS unsigned char* lds, const int K, const int lda, const int ldb, const Sched& S, const Epi& E) {
    int tz_ = tid_now(); asm volatile("" : "+v"(tz_));
    const int tid = tz_, wid = __builtin_amdgcn_readfirstlane(tid >> 6), lane = tid & 63, wr = wid >> 2, wc = wid & 3, fr = lane & 15, fq = lane >> 4;
    constexpr int ESZ = F8 ? 1 : 2;
    const int nt = K * ESZ / (BK * 2);
    unsigned voffA[2], voffB[2];
#pragma unroll
    for (int i = 0; i < 2; ++i) { int R, C; stage_rc(tid * 16 + i * 8192, R, C);
        voffA[i] = (unsigned)(R * lda * ESZ + C * 2); voffB[i] = (unsigned)((64 * (R >> 5) + perm32(R & 31)) * ldb * ESZ + C * 2); }
    const size_t kstep = (size_t)(BK * 2);
    const size_t hstepA = (size_t)HALF * lda * ESZ;
    const size_t hstepB = (size_t)32 * ldb * ESZ;
    const unsigned ldsw = (unsigned)wid * 1024u;
    const int aoff = F8 ? lds_byte(wr * 64 + fr, fq * 16) : lds_byte(wr * 64 + fr, fq * 8), boff = F8 ? lds_byte(wc * 32 + fr, fq * 16) : lds_byte(wc * 32 + fr, fq * 8);
#define PG8_SA(b, h) (((b) * 2 + (h)) * HTB)
#define PG8_SB(b, h) ((4 + (b) * 2 + (h)) * HTB)
#define PG8_STAGE(bufoff, gbase, voff) do { _Pragma("unroll") for (int _i = 0; _i < 2; ++_i) \
        __builtin_amdgcn_global_load_lds((const unsigned*)((const char*)(gbase) + (voff)[_i]), (LAS unsigned*)(lds + (bufoff) + ldsw + _i * 8192), 16, 0, 0); } while (0)
    typedef v8i_t v8i_a16 __attribute__((aligned(16)));
#define PG8_LD32(p) __builtin_bit_cast(v8i_t, __builtin_shufflevector(*(const LAS u32x4*)(p), *(const LAS u32x4*)((p) + 16), 0, 1, 2, 3, 4, 5, 6, 7))
#define PG8_LDA(dst, b, h) do { if constexpr (F8) { _Pragma("unroll") for (int m = 0; m < 4; ++m) dst##8[m] = PG8_LD32(lds + PG8_SA(b, h) + aoff + m * 2048); } \
        else { _Pragma("unroll") for (int m = 0; m < 4; ++m) _Pragma("unroll") for (int k = 0; k < 2; ++k) dst[m][k] = *(const LAS bf16x8*)(lds + PG8_SA(b, h) + aoff + m * 2048 + k * 1024); } } while (0)
#define PG8_LDB(dst, b, h) do { if constexpr (F8) { _Pragma("unroll") for (int n = 0; n < 2; ++n) dst##8[n] = PG8_LD32(lds + PG8_SB(b, h) + boff + n * 2048); } \
        else { _Pragma("unroll") for (int n = 0; n < 2; ++n) _Pragma("unroll") for (int k = 0; k < 2; ++k) dst[n][k] = *(const LAS bf16x8*)(lds + PG8_SB(b, h) + boff + n * 2048 + k * 1024); } } while (0)
#define PG8_MMA(ai, bj, At, Bt) do { __builtin_amdgcn_s_setprio(1); \
        if constexpr (F8) { _Pragma("unroll") for (int m = 0; m < 4; ++m) _Pragma("unroll") for (int n = 0; n < 2; ++n) \
            asm volatile("v_mfma_scale_f32_16x16x128_f8f6f4 %0, %1, %2, %0, %3, %4 op_sel_hi:[0,0,0]" : "+v"(acc[ai][bj][m][n]) : "v"(Bt##8[n]), "v"(At##8[m]), "v"(sbv), "v"(sav)); } \
        else { _Pragma("unroll") for (int m = 0; m < 4; ++m) _Pragma("unroll") for (int n = 0; n < 2; ++n) _Pragma("unroll") for (int k = 0; k < 2; ++k) \
            acc[ai][bj][m][n] = __builtin_amdgcn_mfma_f32_16x16x32_bf16(Bt[n][k], At[m][k], acc[ai][bj][m][n], 0, 0, 0); } \
        __builtin_amdgcn_s_setprio(0); } while (0)
#define PG8_WAIT_V(n) asm volatile("s_waitcnt vmcnt(" #n ")" ::: "memory")
#define PG8_WAIT_L(n) asm volatile("s_waitcnt lgkmcnt(" #n ")" ::: "memory")
#define PG8_BAR __builtin_amdgcn_s_barrier()
#define PG8_SCHED __builtin_amdgcn_sched_barrier(0)
    Unit cur, nxt; int ui = 0;
    if (!S.next(0, cur)) return;
    Acc acc;
#pragma unroll
    for (int a = 0; a < 2; ++a)
#pragma unroll
        for (int b = 0; b < 2; ++b)
#pragma unroll
            for (int m = 0; m < 4; ++m)
#pragma unroll
                for (int n = 0; n < 2; ++n) acc[a][b][m][n] = (f32x4){0.f, 0.f, 0.f, 0.f};
    bf16x8 At[4][2], B0[2][2], B1[2][2]; v8i_t At8[4], B08[2], B18[2];
    int sav = SA_, sbv = SB_;
    if (F8) { asm volatile("" : "+v"(sav)); asm volatile("" : "+v"(sbv)); }
    const char* cA = cur.a; const char* cB = cur.b;
    PG8_STAGE(PG8_SB(0, 0), cB, voffB); PG8_STAGE(PG8_SA(0, 0), cA, voffA); PG8_STAGE(PG8_SB(0, 1), cB + hstepB, voffB); PG8_STAGE(PG8_SA(0, 1), cA + hstepA, voffA);
    if (wr == 1) PG8_BAR;
    PG8_WAIT_V(4); PG8_BAR;
    PG8_STAGE(PG8_SB(1, 0), cB + kstep, voffB); PG8_STAGE(PG8_SA(1, 0), cA + kstep, voffA); PG8_STAGE(PG8_SB(1, 1), cB + hstepB + kstep, voffB);
    PG8_WAIT_V(6); PG8_BAR;
    for (;;) {
        const bool has_next = S.next(ui + 1, nxt);
        const char* nA = has_next ? nxt.a : cA; const char* nB = has_next ? nxt.b : cB;
        for (int t = 0; t < nt; t += 2) {
            const bool last = (t == nt - 2);
            const char* a1 = cA + (size_t)(t + 1) * kstep;
            const char* a2 = last ? nA : cA + (size_t)(t + 2) * kstep; const char* b2 = last ? nB : cB + (size_t)(t + 2) * kstep;
            const char* a3 = a2 + kstep; const char* b3 = b2 + kstep;
            if constexpr (Epi::HAS_MID) { if (t == nt / 2) E.mid(acc, cur, wr, wc, fr, fq); }
            PG8_LDB(B0, 0, 0); PG8_SCHED; PG8_LDA(At, 0, 0); PG8_STAGE(PG8_SA(1, 1), a1 + hstepA, voffA);
            PG8_WAIT_L(8); PG8_BAR; PG8_WAIT_L(0); PG8_MMA(0, 0, At, B0); PG8_BAR; PG8_SCHED;
            PG8_LDB(B1, 0, 1); PG8_STAGE(PG8_SB(0, 0), b2, voffB);
            PG8_BAR; PG8_WAIT_L(0); PG8_MMA(0, 1, At, B1); PG8_BAR;
            PG8_LDA(At, 0, 1); PG8_STAGE(PG8_SA(0, 0), a2, voffA);
            PG8_BAR; PG8_WAIT_L(0); PG8_MMA(1, 0, At, B0); PG8_BAR; PG8_SCHED;
            PG8_STAGE(PG8_SB(0, 1), b2 + hstepB, voffB);
            PG8_WAIT_V(6); PG8_BAR; PG8_MMA(1, 1, At, B1); PG8_BAR;
            PG8_LDB(B0, 1, 0); PG8_SCHED; PG8_LDA(At, 1, 0); PG8_STAGE(PG8_SA(0, 1), a2 + hstepA, voffA);
            PG8_WAIT_L(8); PG8_BAR; PG8_WAIT_L(0); PG8_MMA(0, 0, At, B0); PG8_BAR; PG8_SCHED;
            PG8_LDB(B1, 1, 1); PG8_STAGE(PG8_SB(1, 0), b3, voffB);
            PG8_BAR; PG8_WAIT_L(0); PG8_MMA(0, 1, At, B1); PG8_BAR;
            PG8_LDA(At, 1, 1); PG8_STAGE(PG8_SA(1, 0), a3, voffA);
            PG8_BAR; PG8_WAIT_L(0); PG8_MMA(1, 0, At, B0); PG8_BAR; PG8_SCHED;
            PG8_STAGE(PG8_SB(1, 1), b3 + hstepB, voffB);
            PG8_WAIT_V(6); PG8_BAR; PG8_MMA(1, 1, At, B1); PG8_BAR;
        }
        if constexpr (F8) asm volatile("s_nop 15\n\ts_nop 15" ::: "memory");
        E(acc, cur, wr, wc, fr, fq);
        if (!has_next) break;
#pragma unroll
        for (int a = 0; a < 2; ++a)
#pragma unroll
            for (int b = 0; b < 2; ++b)
#pragma unroll
                for (int m = 0; m < 4; ++m)
#pragma unroll
                    for (int n = 0; n < 2; ++n) acc[a][b][m][n] = (f32x4){0.f, 0.f, 0.f, 0.f};
        cur = nxt; cA = nA; cB = nB; ++ui;
    }
    PG8_WAIT_V(0);
    if (wr == 0) PG8_BAR;
    PG8_BAR;
#undef PG8_SA
#undef PG8_SB
#undef PG8_STAGE
#undef PG8_LDA
#undef PG8_LD32
#undef PG8_LDB
#undef PG8_MMA
#undef PG8_WAIT_V
#undef PG8_WAIT_L
#undef PG8_BAR
#undef PG8_SCHED
}

struct SchedGrid {
    const char* A; const char* B; size_t tstepA, tstepB; int nM, nN, nwg, G, c; bool mix32 = false;
    __device__ void init(const void* A_, int lda, const void* B_, int ldb, int M, int N, int G_, int c_, int esz = 2) {
        A = (const char*)A_; B = (const char*)B_; tstepA = (size_t)256 * lda * esz; tstepB = (size_t)256 * ldb * esz; nM = M / 256; nN = N / 256; nwg = nM * nN; G = G_; c = c_; }
    __device__ __forceinline__ bool next(int i, Unit& u) const {
        const long L = (long)i * G + c; if (L >= nwg) return false;
        int wgid = (int)L; { const int q = nwg / 8, r = nwg % 8, xcd = wgid % 8, off = wgid / 8; wgid = (xcd < r ? xcd * (q + 1) : r * (q + 1) + (xcd - r) * q) + off; }
        const int nig = 8 * nN, gid = wgid / nig, fm = gid * 8, gsz = (nM - fm) < 8 ? (nM - fm) : 8;
        u.pm = fm + ((wgid % nig) % gsz); u.pn = (wgid % nig) / gsz; u.grp = 0;
        if (mix32) { const int a = u.pn >> 4, r4 = (u.pn >> 2) & 3, r = u.pn & 3; u.pn = ((r4 & 1) << 4) | (a << 3) | ((r4 >> 1) << 2) | r; }
        u.a = A + (size_t)u.pm * tstepA; u.b = B + (size_t)u.pn * tstepB; return true;
    }
};
struct SchedGroup {
    const char* A; const char* B; size_t tstepA, tstepB, gstepA, gstepB; int nM, nN, total, G, c;
    __device__ void init(const void* A_, int lda, size_t gA, const void* B_, int ldb, size_t gB, int nM_, int nN_, int NG, int G_, int c_, int esz = 2) {
        A = (const char*)A_; B = (const char*)B_; tstepA = (size_t)256 * lda * esz; tstepB = (size_t)256 * ldb * esz; gstepA = gA; gstepB = gB; nM = nM_; nN = nN_; total = NG * nM_ * nN_; G = G_; c = c_; }
    __device__ __forceinline__ bool next(int i, Unit& u) const {
        const long L = (long)i * G + c; if (L >= total) return false;
        const int per = nM * nN, g = (int)L / per, r = (int)L % per;
        u.grp = g; u.pm = r % nM; u.pn = r / nM;
        u.a = A + (size_t)g * gstepA + (size_t)u.pm * tstepA; u.b = B + (size_t)g * gstepB + (size_t)u.pn * tstepB; return true;
    }
};
}

#define EPI_LANES int tz_ = tid_now(); asm volatile("" : "+v"(tz_)); const int wr = tz_ >> 8, wc = (tz_ >> 6) & 3, fr = tz_ & 15, fq = (tz_ >> 4) & 3;
#define EPI_ROWVALS(name, ptr, base) float name[2][4]; _Pragma("unroll") for (int ai = 0; ai < 2; ++ai) _Pragma("unroll") for (int m = 0; m < 4; ++m) name[ai][m] = (ptr)[(base) + ai * 128 + wr * 64 + m * 16 + fr];
#define EPI_FOR _Pragma("unroll") for (int ai = 0; ai < 2; ++ai) _Pragma("unroll") for (int m = 0; m < 4; ++m)
#define EPI_RL const int rl = ai * 128 + wr * 64 + m * 16 + fr;
__device__ __forceinline__ u32x4 pack8(const f32x4 a, const f32x4 b) { u32x4 w; w.x = cvt_pk_bf16(a[0], a[1]); w.y = cvt_pk_bf16(a[2], a[3]); w.z = cvt_pk_bf16(b[0], b[1]); w.w = cvt_pk_bf16(b[2], b[3]); return w; }
__device__ __forceinline__ void unpack8(const u32x4 w, f32x4& a, f32x4& b) { a = (f32x4){bf_lo(w.x), bf_hi(w.x), bf_lo(w.y), bf_hi(w.y)}; b = (f32x4){bf_lo(w.z), bf_hi(w.z), bf_lo(w.w), bf_hi(w.w)}; }

struct EpiInProj {
    static constexpr bool HAS_MID = false;
    const float* rinv; bf16_t *UA, *Q, *Kb, *V, *G; const float *qg, *kg;
    __device__ __forceinline__ void operator()(const pg::Acc& acc, const pg::Unit& u, int, int, int, int) const { EPI_LANES
        const int pn = u.pn, row0 = u.pm * 256;
        EPI_ROWVALS(rsv, rinv, row0)
        if (pn < 4) {
            EPI_FOR { EPI_RL const int tok = row0 + rl; const float rs = rsv[ai][m]; const int c = tok >> 5, tau = tok & 31;
#pragma unroll
                for (int bj = 0; bj < 2; ++bj) { const int ch = 256 * pn + 64 * wc + 32 * bj + 8 * fq, g = ch >> 4, p0 = ch & 15;
                    *(u32x4*)(UA + ((size_t)(g * NCH + c) * UAW + tau * 16 + p0)) = pack8(acc[ai][bj][m][0] * rs, acc[ai][bj][m][1] * rs); } }
        } else if (pn < 12) {
            const bool isq = pn < 8; const int col0 = 256 * (pn - (isq ? 4 : 8)) + 64 * wc; const float* gp = isq ? qg : kg; const float sc = isq ? 0.125f * LOG2E : 1.f;
            bf16_t* dst = isq ? Q : Kb;
            f32x4 gv[2][2];
#pragma unroll
            for (int bj = 0; bj < 2; ++bj)
#pragma unroll
                for (int n = 0; n < 2; ++n) gv[bj][n] = *(const f32x4*)(gp + 32 * bj + 8 * fq + 4 * n) * sc;
            EPI_FOR { EPI_RL const int tok = row0 + rl; const float rs = rsv[ai][m];
                f32x4 v[2][2]; float ss = 0.f;
#pragma unroll
                for (int bj = 0; bj < 2; ++bj)
#pragma unroll
                    for (int n = 0; n < 2; ++n) { v[bj][n] = acc[ai][bj][m][n] * rs; ss += v[bj][n][0] * v[bj][n][0] + v[bj][n][1] * v[bj][n][1] + v[bj][n][2] * v[bj][n][2] + v[bj][n][3] * v[bj][n][3]; }
                ss += __shfl_xor(ss, 16); ss += __shfl_xor(ss, 32);
                const float r = __builtin_amdgcn_rsqf(ss * (1.f / 64.f) + EPS);
#pragma unroll
                for (int bj = 0; bj < 2; ++bj)
                    *(u32x4*)(dst + (size_t)tok * 1024 + col0 + 32 * bj + 8 * fq) = pack8(v[bj][0] * r * gv[bj][0], v[bj][1] * r * gv[bj][1]); }
        } else {
            EPI_FOR { EPI_RL const int tok = row0 + rl; const float rs = rsv[ai][m];
#pragma unroll
                for (int bj = 0; bj < 2; ++bj)
                    *(u32x4*)(V + (size_t)tok * 1024 + 256 * (pn - 12) + 64 * wc + 32 * bj + 8 * fq) = pack8(acc[ai][bj][m][0] * rs, acc[ai][bj][m][1] * rs); }
        }
    }
};
struct EpiGates {
    static constexpr bool HAS_MID = false;
    const float* rinv; bf16_t* G;
    __device__ __forceinline__ void operator()(const pg::Acc& acc, const pg::Unit& u, int, int, int, int) const { EPI_LANES
        EPI_ROWVALS(rsv, rinv, u.pm * 256)
        EPI_FOR { EPI_RL const int tok = u.pm * 256 + rl; const float rs = rsv[ai][m];
#pragma unroll
            for (int bj = 0; bj < 2; ++bj) { f32x4 a = acc[ai][bj][m][0] * rs, b = acc[ai][bj][m][1] * rs;
#pragma unroll
                for (int j = 0; j < 4; ++j) { a[j] = fast_sigmoid(a[j]); b[j] = fast_sigmoid(b[j]); }
                *(u32x4*)(G + (size_t)tok * 4096 + 256 * u.pn + 64 * wc + 32 * bj + 8 * fq) = pack8(a, b); } }
    }
};
struct EpiSsum {
    static constexpr bool HAS_MID = false;
    float* SS;
    __device__ __forceinline__ void operator()(const pg::Acc& acc, const pg::Unit& u, int, int, int, int) const { EPI_LANES
        EPI_FOR { EPI_RL float* rp = SS + ((size_t)u.grp * NCH + rl) * 256 + 64 * wc + 8 * fq;
#pragma unroll
            for (int bj = 0; bj < 2; ++bj) { *(f32x4*)(rp + 32 * bj) = acc[ai][bj][m][0]; *(f32x4*)(rp + 32 * bj + 4) = acc[ai][bj][m][1]; } }
    }
};
__device__ __forceinline__ float gelu_tanh(float x) {
    const float t = 1.5957691216057308f * (x + 0.044715f * x * x * x);
    return x * fast_sigmoid(t);
}
struct EpiSsmOut {
    static constexpr bool HAS_MID = false;
    bf16_t* Y;
    __device__ __forceinline__ void operator()(const pg::Acc& acc, const pg::Unit& u, int, int, int, int) const { EPI_LANES
        EPI_FOR { EPI_RL
#pragma unroll
            for (int bj = 0; bj < 2; ++bj) { const int col = 256 * u.pn + 64 * wc + 32 * bj + 8 * fq, t = col >> 4, p0 = col & 15;
                f32x4 a = acc[ai][bj][m][0], b = acc[ai][bj][m][1];
#pragma unroll
                for (int j = 0; j < 4; ++j) { a[j] = gelu_tanh(a[j]); b[j] = gelu_tanh(b[j]); }
                *(u32x4*)(Y + (size_t)(rl * TC + t) * SSMW + u.grp * GP + p0) = pack8(a, b); } }
    }
};
struct EpiGlu {
    static constexpr bool HAS_MID = false;
    const bf16_t* Y; bf16_t* YO;
    __device__ __forceinline__ void operator()(const pg::Acc& acc, const pg::Unit& u, int, int, int, int) const { EPI_LANES
        const int colb = 256 * u.pn + 64 * wc + 8 * fq; const size_t rb = (size_t)(u.pm * 256 + wr * 64 + fr);
        u32x4 cur[2], nxt[2];
        cur[0] = *(const u32x4*)(Y + rb * SSMW + colb); cur[1] = *(const u32x4*)(Y + rb * SSMW + colb + 32);
#pragma unroll
        for (int r_ = 0; r_ < 8; ++r_) { const int ai = r_ >> 2, m = r_ & 3; const size_t tok = rb + ai * 128 + m * 16;
            if (r_ < 7) { const size_t tn = rb + ((r_ + 1) >> 2) * 128 + ((r_ + 1) & 3) * 16; nxt[0] = *(const u32x4*)(Y + tn * SSMW + colb); nxt[1] = *(const u32x4*)(Y + tn * SSMW + colb + 32); }
#pragma unroll
            for (int bj = 0; bj < 2; ++bj) { f32x4 ya, yb; unpack8(cur[bj], ya, yb);
                f32x4 a = acc[ai][bj][m][0], b = acc[ai][bj][m][1];
#pragma unroll
                for (int j = 0; j < 4; ++j) { a[j] = ya[j] * fast_sigmoid(a[j]); b[j] = yb[j] * fast_sigmoid(b[j]); }
                *(u32x4*)(YO + tok * 2048 + colb + 32 * bj) = pack8(a, b); }
            cur[0] = nxt[0]; cur[1] = nxt[1]; }
    }
};
struct EpiMerge {
    static constexpr bool HAS_MID = true;
    const bf16_t* G; bf16_t* MG;
    __device__ __forceinline__ void mid(pg::Acc& acc, const pg::Unit& u, int, int, int, int) const { EPI_LANES
        const int colb = 256 * u.pn + 64 * wc + 8 * fq; const size_t rb = (size_t)(u.pm * 256 + wr * 64 + fr);
        u32x4 cur[4], nxt[4];
#pragma unroll
        for (int q = 0; q < 4; ++q) cur[q] = *(const u32x4*)(G + rb * 4096 + (q >> 1) * 2048 + colb + 32 * (q & 1));
#pragma unroll
        for (int r_ = 0; r_ < 8; ++r_) { const int ai = r_ >> 2, m = r_ & 3;
            if (r_ < 7) { const size_t tn = rb + ((r_ + 1) >> 2) * 128 + ((r_ + 1) & 3) * 16;
#pragma unroll
                for (int q = 0; q < 4; ++q) nxt[q] = *(const u32x4*)(G + tn * 4096 + (q >> 1) * 2048 + colb + 32 * (q & 1)); }
#pragma unroll
            for (int bj = 0; bj < 2; ++bj) { f32x4 sa, sb, ga, gb; unpack8(cur[bj], sa, sb); unpack8(cur[2 + bj], ga, gb);
#pragma unroll
                for (int j = 0; j < 4; ++j) { acc[ai][bj][m][0][j] *= sa[j] * __builtin_amdgcn_rcpf(ga[j]); acc[ai][bj][m][1][j] *= sb[j] * __builtin_amdgcn_rcpf(gb[j]); } }
#pragma unroll
            for (int q = 0; q < 4; ++q) cur[q] = nxt[q];
            __builtin_amdgcn_sched_barrier(0); }
    }
    __device__ __forceinline__ void operator()(const pg::Acc& acc, const pg::Unit& u, int, int, int, int) const { EPI_LANES
        const int colb = 256 * u.pn + 64 * wc + 8 * fq; const size_t rb = (size_t)(u.pm * 256 + wr * 64 + fr);
        u32x4 cur[2], nxt[2];
        cur[0] = *(const u32x4*)(G + rb * 4096 + 2048 + colb); cur[1] = *(const u32x4*)(G + rb * 4096 + 2048 + colb + 32);
#pragma unroll
        for (int r_ = 0; r_ < 8; ++r_) { const int ai = r_ >> 2, m = r_ & 3; const size_t tok = rb + ai * 128 + m * 16;
            if (r_ < 7) { const size_t tn = rb + ((r_ + 1) >> 2) * 128 + ((r_ + 1) & 3) * 16; nxt[0] = *(const u32x4*)(G + tn * 4096 + 2048 + colb); nxt[1] = *(const u32x4*)(G + tn * 4096 + 2048 + colb + 32); }
#pragma unroll
            for (int bj = 0; bj < 2; ++bj) { f32x4 ga, gb; unpack8(cur[bj], ga, gb);
                *(u32x4*)(MG + tok * 2048 + colb + 32 * bj) = pack8(acc[ai][bj][m][0] * ga, acc[ai][bj][m][1] * gb); }
            cur[0] = nxt[0]; cur[1] = nxt[1]; }
    }
};
struct EpiOutProj {
    static constexpr bool HAS_MID = false;
    const bf16_t* XR; bf16_t* XO;
    __device__ __forceinline__ void operator()(const pg::Acc& acc, const pg::Unit& u, int, int, int, int) const { EPI_LANES
        const int colb = 256 * u.pn + 64 * wc + 8 * fq; const size_t rb = (size_t)(u.pm * 256 + wr * 64 + fr);
        u32x4 cur[2], nxt[2];
        cur[0] = *(const u32x4*)(XR + rb * 2048 + colb); cur[1] = *(const u32x4*)(XR + rb * 2048 + colb + 32);
#pragma unroll
        for (int r_ = 0; r_ < 8; ++r_) { const int ai = r_ >> 2, m = r_ & 3; const size_t tok = rb + ai * 128 + m * 16;
            if (r_ < 7) { const size_t tn = rb + ((r_ + 1) >> 2) * 128 + ((r_ + 1) & 3) * 16; nxt[0] = *(const u32x4*)(XR + tn * 2048 + colb); nxt[1] = *(const u32x4*)(XR + tn * 2048 + colb + 32); }
#pragma unroll
            for (int bj = 0; bj < 2; ++bj) { f32x4 a, b; unpack8(cur[bj], a, b);
                *(u32x4*)(XO + tok * 2048 + colb + 32 * bj) = pack8(a + acc[ai][bj][m][0], b + acc[ai][bj][m][1]); }
            cur[0] = nxt[0]; cur[1] = nxt[1]; }
    }
};
struct EpiExp1 {
    static constexpr bool HAS_MID = false;
    const float* RSL; bf16_t* H;
    __device__ __forceinline__ void operator()(const pg::Acc& acc, const pg::Unit& u, int, int, int, int) const { EPI_LANES
        EPI_ROWVALS(rsv, RSL, u.grp * CAP + u.pm * 256)
        EPI_FOR { EPI_RL const int row = u.grp * CAP + u.pm * 256 + rl; const float rs = rsv[ai][m];
            f32x4 h[2];
#pragma unroll
            for (int n = 0; n < 2; ++n)
#pragma unroll
                for (int j = 0; j < 4; ++j) { const float g = acc[ai][0][m][n][j] * rs, up = acc[ai][1][m][n][j] * rs; h[n][j] = g * fast_sigmoid(g) * up; }
            *(u32x2*)((unsigned char*)H + (size_t)row * FF + 128 * u.pn + 32 * wc + 8 * fq) = pack8_fp8(h[0] * H8_SCALE, h[1] * H8_SCALE); }
    }
};
struct EpiExp2 {
    static constexpr bool HAS_MID = false;
    const float* GATE; bf16_t* YX;
    __device__ __forceinline__ void operator()(const pg::Acc& acc, const pg::Unit& u, int, int, int, int) const { EPI_LANES
        EPI_ROWVALS(gtv, GATE, u.grp * CAP + u.pm * 256)
        EPI_FOR { EPI_RL const int row = u.grp * CAP + u.pm * 256 + rl; const float gt = gtv[ai][m];
#pragma unroll
            for (int bj = 0; bj < 2; ++bj)
                *(u32x4*)(YX + (size_t)row * D + 256 * u.pn + 64 * wc + 32 * bj + 8 * fq) = pack8(acc[ai][bj][m][0] * gt, acc[ai][bj][m][1] * gt); }
    }
};

namespace att {
constexpr int KVBLK = 64, QBLK = 32;
constexpr int SHM_T = KVBLK * 256;
constexpr int OFF_K = 0, OFF_V = 3 * SHM_T, OFF_Q = 5 * SHM_T, OFF_WS = OFF_Q + 8 * 8192, OFF_BT = OFF_WS + 8 * 64 * 4, ATT_LDS_END = OFF_BT + 2048;
#define KSWZ(row, colB) ((row) * 256 + ((colB) ^ (((row) & 7) << 4)))
#define SBAR() __builtin_amdgcn_sched_barrier(0)
__device__ __forceinline__ int crow(int r, int hi) { return (r & 3) + 8 * (r >> 2) + 4 * hi; }
__device__ __forceinline__ int v_rd_base(int lane) { return ((lane & 3) << 3) | (((lane >> 2) & 3) << 6) | (((lane >> 4) & 1) << 5) | (((lane >> 5) & 1) << 8); }
constexpr int v_rd_off(int d0, int ks, int half) { return d0 * 512 + ks * 4096 + half * 2048; }
template <int OFF> __device__ __forceinline__ s16x4 tr_read(int vb) { s16x4 r; asm volatile("ds_read_b64_tr_b16 %0, %1 offset:%2" : "=&v"(r) : "v"(vb), "i"(OFF) : "memory"); return r; }
template <int D0> __device__ __forceinline__ void pv_one(f32x16& od, int vb, bf16x8 pa0, bf16x8 pa1, bf16x8 pa2, bf16x8 pa3) {
    const s16x4 l0 = tr_read<v_rd_off(D0, 0, 0)>(vb), h0 = tr_read<v_rd_off(D0, 0, 1)>(vb), l1 = tr_read<v_rd_off(D0, 1, 0)>(vb), h1 = tr_read<v_rd_off(D0, 1, 1)>(vb);
    const s16x4 l2 = tr_read<v_rd_off(D0, 2, 0)>(vb), h2 = tr_read<v_rd_off(D0, 2, 1)>(vb), l3 = tr_read<v_rd_off(D0, 3, 0)>(vb), h3 = tr_read<v_rd_off(D0, 3, 1)>(vb);
    asm volatile("s_waitcnt lgkmcnt(0)" ::: "memory"); SBAR();
#define PK(L, H) (bf16x8){L[0], L[1], L[2], L[3], H[0], H[1], H[2], H[3]}
    od = __builtin_amdgcn_mfma_f32_32x32x16_bf16(pa0, PK(l0, h0), od, 0, 0, 0);
    od = __builtin_amdgcn_mfma_f32_32x32x16_bf16(pa1, PK(l1, h1), od, 0, 0, 0);
    od = __builtin_amdgcn_mfma_f32_32x32x16_bf16(pa2, PK(l2, h2), od, 0, 0, 0);
    od = __builtin_amdgcn_mfma_f32_32x32x16_bf16(pa3, PK(l3, h3), od, 0, 0, 0);
#undef PK
}
__device__ __forceinline__ void pv_d0(f32x16* o, int vb, bf16x8 pa0, bf16x8 pa1, bf16x8 pa2, bf16x8 pa3) {
    pv_one<0>(o[0], vb, pa0, pa1, pa2, pa3); pv_one<1>(o[1], vb, pa0, pa1, pa2, pa3); pv_one<2>(o[2], vb, pa0, pa1, pa2, pa3); pv_one<3>(o[3], vb, pa0, pa1, pa2, pa3);
}
__device__ __forceinline__ int kq_addr(int row, int c) { return (c >> 2) * 4096 + row * 64 + (((c & 3) ^ ((row >> 2) & 3)) << 4); }
template <int COMP> __device__ __forceinline__ void qkt(f32x16& p0, f32x16& p1, const LAS char* Ks, const LAS char* Qs, int kq0, int kq1) {
    p0 = (f32x16){}; p1 = (f32x16){};
    bf16x8 b0[4], b1[4], qf[4];
#define QK_LD(d0) { constexpr int chi = COMP * 2 + ((d0) >> 1); const int a = ((d0) & 1) ? kq1 : kq0; \
        b0[d0] = *(const LAS bf16x8*)(Ks + a + chi * 4096); b1[d0] = *(const LAS bf16x8*)(Ks + a + chi * 4096 + 2048); qf[d0] = *(const LAS bf16x8*)(Qs + a + chi * 2048); }
#define QK_MM(d0) { p0 = __builtin_amdgcn_mfma_f32_32x32x16_bf16(b0[d0], qf[d0], p0, 0, 0, 0); p1 = __builtin_amdgcn_mfma_f32_32x32x16_bf16(b1[d0], qf[d0], p1, 0, 0, 0); }
    QK_LD(0) QK_LD(1) SBAR();
    QK_MM(0) QK_MM(1) QK_LD(2) QK_LD(3) SBAR();
    QK_MM(2) QK_MM(3)
#undef QK_LD
#undef QK_MM
}
__device__ __forceinline__ void sm_exp(f32x16& p0, f32x16& p1, const LAS float* bt, int relb, int dq, int hi) {
    if (dq > -191 && dq < 158) {
        const LAS float* bp = bt + relb + 4 * hi;
#pragma unroll
        for (int a = 0; a < 4; ++a) {
            float t0[4], t1[4];
#pragma unroll
            for (int b = 0; b < 4; ++b) { t0[b] = bp[8 * a + b]; t1[b] = bp[32 + 8 * a + b]; }
#pragma unroll
            for (int b = 0; b < 4; ++b) { p0[4 * a + b] += t0[b]; p1[4 * a + b] += t1[b]; }
            SBAR();
        } }
#pragma unroll
    for (int r = 0; r < 16; ++r) p0[r] = __builtin_amdgcn_exp2f(p0[r]);
#pragma unroll
    for (int r = 0; r < 16; ++r) p1[r] = __builtin_amdgcn_exp2f(p1[r]);
}
__device__ __forceinline__ void sm_fin(f32x16& p0, f32x16& p1, float& l_reg, bf16x8& pa0, bf16x8& pa1, bf16x8& pa2, bf16x8& pa3) {
    float ps = 0;
#pragma unroll
    for (int r = 0; r < 16; ++r) ps += p0[r];
#pragma unroll
    for (int r = 0; r < 16; ++r) ps += p1[r];
    { auto rr = __builtin_amdgcn_permlane32_swap(__float_as_uint(ps), __float_as_uint(ps), false, false);
      ps = __uint_as_float(rr[0]) + __uint_as_float(rr[1]); }
    l_reg += ps;
#define PK4(P, BASE, OUT) do { unsigned a0 = cvt_pk_bf16(P[BASE + 0], P[BASE + 1]), a1 = cvt_pk_bf16(P[BASE + 2], P[BASE + 3]);   \
    unsigned b0 = cvt_pk_bf16(P[BASE + 4], P[BASE + 5]), b1 = cvt_pk_bf16(P[BASE + 6], P[BASE + 7]);                              \
    auto r0 = __builtin_amdgcn_permlane32_swap(a0, b0, false, false); auto r1 = __builtin_amdgcn_permlane32_swap(a1, b1, false, false); \
    u32x4 w = {r0[0], r1[0], r0[1], r1[1]}; OUT = *reinterpret_cast<bf16x8*>(&w); } while (0)
    PK4(p0, 0, pa0); PK4(p0, 8, pa1); PK4(p1, 0, pa2); PK4(p1, 8, pa3);
#undef PK4
}
__device__ __forceinline__ void attn_dual(f32x16 (&o1)[4], f32x16 (&o2)[4], const bf16_t* __restrict__ Qg, const bf16_t* __restrict__ Kh, const bf16_t* __restrict__ Vh, LAS char* lds, int q0w) {
    int tz_ = tid_now(); asm volatile("" : "+v"(tz_));
    const int tid = tz_, wid = __builtin_amdgcn_readfirstlane(tid >> 6), lane = tid & 63, r32 = lane & 31, hi = lane >> 5;
    LAS char* K_lds = lds + OFF_K; LAS char* V_lds = lds + OFF_V; LAS char* Qs = lds + OFF_Q + wid * 8192;
    const LAS float* bt = (const LAS float*)(lds + OFF_BT);
    float l1 = 0.f, l2 = 0.f;
#pragma unroll
    for (int d = 0; d < 4; ++d) { o1[d] = (f32x16){}; o2[d] = (f32x16){}; }
#pragma unroll
    for (int i = 0; i < 8; ++i) { const int ci = i * 64 + lane, row = (ci >> 2) & 31, c = (ci >> 7) * 4 + ((ci & 3) ^ ((row >> 2) & 3));
        __builtin_amdgcn_global_load_lds((const unsigned*)(Qg + (size_t)row * 1024 + c * 8), (LAS unsigned*)(Qs + i * 1024), 16, 0, 0); }
    const int kq0 = r32 * 64 + ((hi ^ ((r32 >> 2) & 3)) << 4), kq1 = r32 * 64 + (((2 + hi) ^ ((r32 >> 2) & 3)) << 4);
    unsigned ko0, vo0;
    { const int p = wid * 2;
        { const int ci = p * 64 + lane, row = (ci >> 2) & 63, c = (ci >> 8) * 4 + ((ci & 3) ^ ((row >> 2) & 3)); ko0 = (unsigned)(row * 1024 + c * 8) * 2u; }
        { const int ci = p * 64 + lane, sub = ci >> 5, kk = (sub >> 2) * 8 + ((ci >> 2) & 7), c = (sub & 3) * 32 + (ci & 3) * 8;
          const int k = (kk & ~0xC) | ((kk & 4) << 1) | ((kk & 8) >> 1); vo0 = (unsigned)(k * 1024 + c) * 2u; } }
    const unsigned pw = (unsigned)wid * 2048u;
#define DMA_K(buf, k0) do { const char* g_ = (const char*)(Kh + (size_t)(k0) * 1024); unsigned o_ = ko0; asm volatile("" : "+v"(o_)); \
    __builtin_amdgcn_global_load_lds((const unsigned*)(g_ + o_), (LAS unsigned*)(K_lds + (buf) * SHM_T + pw), 16, 0, 0); \
    __builtin_amdgcn_global_load_lds((const unsigned*)(g_ + o_ + 32768u), (LAS unsigned*)(K_lds + (buf) * SHM_T + pw + 1024), 16, 0, 0); } while (0)
#define DMA_V(buf, k0) do { const char* g_ = (const char*)(Vh + (size_t)(k0) * 1024); unsigned o_ = vo0; asm volatile("" : "+v"(o_)); \
    __builtin_amdgcn_global_load_lds((const unsigned*)(g_ + o_), (LAS unsigned*)(V_lds + (buf) * SHM_T + pw), 16, 0, 0); \
    __builtin_amdgcn_global_load_lds((const unsigned*)(g_ + o_ + 128u), (LAS unsigned*)(V_lds + (buf) * SHM_T + pw + 1024), 16, 0, 0); } while (0)
    const int vbb = (int)(size_t)V_lds + v_rd_base(lane);
    const int relq = 256 - (q0w + r32);
    f32x16 pA0, pA1, pB0, pB1; bf16x8 pa0, pa1, pa2, pa3; constexpr int NT = S / KVBLK;
    DMA_K(0, 0); DMA_K(1, KVBLK); DMA_V(0, 0);
    asm volatile("s_waitcnt vmcnt(0) lgkmcnt(0)" ::: "memory"); __syncthreads();
    qkt<0>(pA0, pA1, K_lds, Qs, kq0, kq1); sm_exp(pA0, pA1, bt, relq, 0 - q0w, hi);
    int kb = 0, vb = 0;
    int ureg = (0 - q0w <= -191) ? 0 : ((0 - q0w >= 158) ? 2 : 1);
    for (int j = 0; j < NT; ++j) {
        asm volatile("s_waitcnt vmcnt(0)" ::: "memory"); __syncthreads();
        const int kb1 = kb == 2 ? 0 : kb + 1, kb2 = kb1 == 2 ? 0 : kb1 + 1;
        if (j + 2 < NT) DMA_K(kb2, (j + 2) * KVBLK);
        if (j + 1 < NT) DMA_V(vb ^ 1, (j + 1) * KVBLK);
        const int dq = j * KVBLK - q0w;
        { const int u = (dq <= -191) ? 0 : ((dq >= 158) ? 2 : 1);
          if (u != ureg) {
              const float cp = ureg == 0 ? bt[0] : (ureg == 2 ? bt[511] : 0.f), cn = u == 0 ? bt[0] : (u == 2 ? bt[511] : 0.f);
              const float f = __builtin_amdgcn_exp2f(cp - cn);
#pragma unroll
              for (int d = 0; d < 4; ++d) { o1[d] = o1[d] * f; o2[d] = o2[d] * f; }
              l1 *= f; l2 *= f; ureg = u; } }
        sm_fin(pA0, pA1, l1, pa0, pa1, pa2, pa3); SBAR();
        qkt<1>(pB0, pB1, K_lds + kb * SHM_T, Qs, kq0, kq1); SBAR();
        pv_d0(o1, vbb + vb * SHM_T, pa0, pa1, pa2, pa3);
        sm_exp(pB0, pB1, bt, relq + j * KVBLK, dq, hi);
        sm_fin(pB0, pB1, l2, pa0, pa1, pa2, pa3); SBAR();
        if (j + 1 < NT) { qkt<0>(pA0, pA1, K_lds + kb1 * SHM_T, Qs, kq0, kq1); SBAR(); }
        pv_d0(o2, vbb + vb * SHM_T, pa0, pa1, pa2, pa3);
        if (j + 1 < NT) sm_exp(pA0, pA1, bt, relq + (j + 1) * KVBLK, dq + KVBLK, hi);
        kb = kb1; vb ^= 1;
    }
    const int ln2_ = lane_now(), r32b = ln2_ & 31, hib = ln2_ >> 5;
    LAS float* li2 = (LAS float*)(lds + OFF_WS) + wid * 64;
    if (hib == 0) li2[r32b] = l1; asm volatile("s_waitcnt lgkmcnt(0)" ::: "memory");
#pragma unroll
    for (int r = 0; r < 16; ++r) { const float rl = __builtin_amdgcn_rcpf(li2[crow(r, hib)]);
#pragma unroll
        for (int d = 0; d < 4; ++d) o1[d][r] *= rl; }
    asm volatile("s_waitcnt lgkmcnt(0)" ::: "memory");
    if (hib == 0) li2[r32b] = l2; asm volatile("s_waitcnt lgkmcnt(0)" ::: "memory");
#pragma unroll
    for (int r = 0; r < 16; ++r) { const float rl = __builtin_amdgcn_rcpf(li2[crow(r, hib)]);
#pragma unroll
        for (int d = 0; d < 4; ++d) o2[d][r] *= rl; }
#undef DMA_K
#undef DMA_V
}
}

__device__ __forceinline__ int t5_bucket(int rel) {
    const int side = rel > 0 ? 16 : 0; const int n = rel < 0 ? -rel : rel;
    if (n < 8) return side + n;
    const float v = logf((float)n / 8.0f) / 2.7725887f * 8.0f;
    int large = 8 + (int)v; large = large < 15 ? large : 15;
    return side + large;
}

struct Args { GAS const float* in[28]; GAS float* out; GAS unsigned char* ws; int ph_lo, ph_hi; };
typedef const Args __attribute__((address_space(4))) CArgs;
struct LayerW { bf16_t *WIN, *WGLU, *WBR, *WOUT, *WGU, *WD, *F, *BO; float *KTAB, *WRT; };
__device__ __forceinline__ LayerW layer_w(unsigned char* ws, int l) {
    unsigned char* b = ws + WS_LW + (size_t)l * LW_SIZE; LayerW w;
    w.WIN = (bf16_t*)(b + LW_WIN); w.WGLU = (bf16_t*)(b + LW_WGLU); w.WBR = (bf16_t*)(b + LW_WBR); w.WOUT = (bf16_t*)(b + LW_WOUT); w.WGU = (bf16_t*)(b + LW_WGU);
    w.WD = (bf16_t*)(b + LW_WD); w.F = (bf16_t*)(b + LW_F); w.BO = (bf16_t*)(b + LW_BO); w.KTAB = (float*)(b + LW_KTAB); w.WRT = (float*)(b + LW_WRT); return w;
}
enum { I_X = 0, I_WIN, I_ARE, I_AIM, I_LDT, I_BRE, I_BIM, I_CRE, I_CIM, I_SD, I_WGLU, I_WSB, I_QG, I_KG, I_LQ1, I_LK1, I_LQ2, I_LK2, I_SUBLN, I_WAB, I_RELB, I_WOUT,
       I_NMIX, I_NFFN, I_WR, I_WEG, I_WEU, I_WED };

struct TItem { const float* src; bf16_t* dst; const float* gain; int N, ldd, rowmode, f8; };
__device__ __forceinline__ void t_load(const TItem& t, f32x4 (&v)[16], int lane) {
    const int r = lane >> 4, q = lane & 15;
#pragma unroll
    for (int j = 0; j < 16; ++j) v[j] = __builtin_nontemporal_load((const f32x4*)(t.src + (size_t)(4 * j + r) * t.N + 4 * q));
}
__device__ __forceinline__ void t_lds(const f32x4 (&v)[16], LAS float* scr, int lane) {
    const int r = lane >> 4, q = lane & 15;
#pragma unroll
    for (int j = 0; j < 16; ++j) { LAS float* s = scr + (4 * j + r) * 65 + 4 * q; s[0] = v[j][0]; s[1] = v[j][1]; s[2] = v[j][2]; s[3] = v[j][3]; }
}
__device__ __forceinline__ void t_store(const TItem& t, int n0, LAS float* scr, int lane) {
    const int c = lane & 7;
    float gn[8];
#pragma unroll
    for (int i = 0; i < 8; ++i) gn[i] = t.gain ? t.gain[8 * c + i] : 1.f;
#pragma unroll
    for (int j = 0; j < 8; ++j) { const int n = (lane >> 3) + 8 * j; const LAS float* s = scr + (8 * c) * 65 + n;
        u32x4 o; o.x = cvt_pk_bf16(s[0 * 65] * gn[0], s[1 * 65] * gn[1]); o.y = cvt_pk_bf16(s[2 * 65] * gn[2], s[3 * 65] * gn[3]);
        o.z = cvt_pk_bf16(s[4 * 65] * gn[4], s[5 * 65] * gn[5]); o.w = cvt_pk_bf16(s[6 * 65] * gn[6], s[7 * 65] * gn[7]);
        const int ng = n0 + n; const int drow = t.rowmode == 0 ? ng : ((ng >> 7) * 256 + ((ng >> 5) & 3) * 64 + (ng & 31) + (t.rowmode == 2 ? 32 : 0));
        if (t.f8) { const f32x4 a = (f32x4){s[0 * 65] * gn[0], s[1 * 65] * gn[1], s[2 * 65] * gn[2], s[3 * 65] * gn[3]} * W8_SCALE, b = (f32x4){s[4 * 65] * gn[4], s[5 * 65] * gn[5], s[6 * 65] * gn[6], s[7 * 65] * gn[7]} * W8_SCALE;
            *(u32x2*)((unsigned char*)t.dst + (size_t)drow * t.ldd + 8 * c) = pack8_fp8(a, b); }
        else *(u32x4*)(t.dst + (size_t)drow * t.ldd + 8 * c) = o; }
}

constexpr int IT_WIN = (D / 64) * (INC / 64), IT_GLU = 16 * 16, IT_BR = 16 * 32, IT_OUT = 32 * 32, IT_E = 32 * 32;
constexpr int DQ_A_I = 6144, DQ_A_G = 512, DQ_B_I = 5120, DQ_B_G = 1024, DQ_C_I = 5120, DQ_C_G = 1024;
constexpr int DQ_A0 = 0, DQ_A1 = DQ_A0 + DQ_A_I, DQ_B0 = DQ_A1 + DQ_A_G, DQ_B1 = DQ_B0 + DQ_B_I, DQ_C0 = DQ_B1 + DQ_B_G, DQ_C1 = DQ_C0 + DQ_C_I, DQ_END = DQ_C1 + DQ_C_G;
constexpr int DEF_UP = DQ_END - NE * IT_E;
static_assert(DEF_UP >= 0 && DEF_UP <= NE * IT_E, "deferred share");
constexpr int IT_LAYER0 = IT_WIN + IT_GLU + 2 * IT_BR + IT_OUT + 2 * NE * IT_E - DEF_UP;
constexpr int IT_DOWN = NE * IT_E;
__device__ __forceinline__ TItem make_item(const float* src, bf16_t* dst, const float* gain, int N, int ldd, int rowmode, int f8, int r, int& n0) {
    const int nblk = N / 64, k0 = 64 * (r / nblk); n0 = 64 * (r % nblk);
    TItem t; t.src = src + (size_t)k0 * N + n0; t.dst = f8 ? (bf16_t*)((unsigned char*)dst + k0) : dst + k0; t.gain = gain ? gain + k0 : nullptr; t.N = N; t.ldd = ldd; t.rowmode = rowmode; t.f8 = f8; return t; }
struct DecMain { CArgs* ap; unsigned char* ws;
    __device__ __forceinline__ TItem operator()(int it, int& n0) const { CArgs& args = *ap;
        const int l = it / IT_LAYER0; int r = it % IT_LAYER0; const LayerW w = layer_w(ws, l);
        if (r < IT_WIN) { const bool gate = (r % (INC / 64)) >= 64;
            return gate ? make_item((const float*)args.in[I_WIN] + (size_t)l * D * INC, (bf16_t*)((unsigned char*)w.WIN + (size_t)16 * MiB - (size_t)4096 * D), (const float*)args.in[I_NMIX] + l * D, INC, D, 0, 1, r, n0)
                        : make_item((const float*)args.in[I_WIN] + (size_t)l * D * INC, w.WIN, (const float*)args.in[I_NMIX] + l * D, INC, D, 0, 0, r, n0); }
        if ((r -= IT_WIN) < IT_GLU) return make_item((const float*)args.in[I_WGLU] + (size_t)l * SSMW * SSMW, w.WGLU, nullptr, SSMW, SSMW, 0, 0, r, n0);
        if ((r -= IT_GLU) < IT_BR) return make_item((const float*)args.in[I_WSB] + (size_t)l * SSMW * D, w.WBR, nullptr, D, 2048, 0, 0, r, n0);
        if ((r -= IT_BR) < IT_BR) return make_item((const float*)args.in[I_WAB] + (size_t)l * 1024 * D, w.WBR + 1024, nullptr, D, 2048, 0, 0, r, n0);
        if ((r -= IT_BR) < IT_OUT) return make_item((const float*)args.in[I_WOUT] + (size_t)l * D * D, w.WOUT, nullptr, D, D, 0, 0, r, n0);
        r -= IT_OUT; const int which = r / (NE * IT_E), e = (r / IT_E) % NE; r = r % IT_E; const size_t eo = ((size_t)l * NE + e) * D * FF;
        return make_item((const float*)args.in[which == 0 ? I_WEG : I_WEU] + eo, (bf16_t*)((unsigned char*)w.WGU + (size_t)e * 4096 * D), (const float*)args.in[I_NFFN] + l * D, FF, D, which == 0 ? 1 : 2, 1, r, n0); } };
struct DecDown { CArgs* ap; unsigned char* ws; int l;
    __device__ __forceinline__ TItem operator()(int it, int& n0) const { CArgs& args = *ap; const LayerW w = layer_w(ws, l);
        if (it >= IT_DOWN) { const int uu = NE * IT_E - 1 - (it - IT_DOWN), e = uu / IT_E; const size_t eo = ((size_t)l * NE + e) * D * FF;
            return make_item((const float*)args.in[I_WEU] + eo, (bf16_t*)((unsigned char*)w.WGU + (size_t)e * 4096 * D), (const float*)args.in[I_NFFN] + l * D, FF, D, 2, 1, uu % IT_E, n0); }
        const int e = it / IT_E, r = it % IT_E; const size_t eo = ((size_t)l * NE + e) * D * FF;
        return make_item((const float*)args.in[I_WED] + eo, (bf16_t*)((unsigned char*)w.WD + (size_t)e * D * FF), nullptr, D, FF, 0, 1, r, n0); } };
template <class Dec> __device__ __forceinline__ void convert_items(const Dec& dec, int first, int end, int step, LAS float* scr, int lane) {
    f32x4 tv[16]; int n0c = 0, n0n = 0; TItem cur, nxt; cur.src = nullptr; cur.dst = nullptr; cur.gain = nullptr; cur.N = 0; cur.ldd = 0; cur.rowmode = 0; cur.f8 = 0; nxt = cur;
    int it = first;
    if (it < end) { cur = dec(it, n0c); t_load(cur, tv, lane); }
    for (; it < end; it += step) {
        t_lds(tv, scr, lane);
        if (it + step < end) { nxt = dec(it + step, n0n); t_load(nxt, tv, lane); }
        LDS_WAIT(); asm volatile("" ::: "memory");
        t_store(cur, n0c, scr, lane);
        LDS_WAIT(); asm volatile("" ::: "memory");
        cur = nxt; n0c = n0n; }
}

template <bool ROUTER>
__device__ __forceinline__ void row_pass(const float* xrow, bf16_t* xb, float* rinv_out, const LAS float* WtL, float* afft, int row, int lane, unsigned char* xb8 = nullptr) {
    f32x4 v[8]; float ss = 0.f;
#pragma unroll
    for (int j = 0; j < 8; ++j) { v[j] = *(const f32x4*)(xrow + 4 * lane + 256 * j); ss += v[j][0] * v[j][0] + v[j][1] * v[j][1] + v[j][2] * v[j][2] + v[j][3] * v[j][3]; }
    ss = wave_sum(ss);
    const float rinv = __builtin_amdgcn_rsqf(ss * (1.f / D) + EPS);
#pragma unroll
    for (int j = 0; j < 8; ++j) { u32x2 w; w.x = cvt_pk_bf16(v[j][0], v[j][1]); w.y = cvt_pk_bf16(v[j][2], v[j][3]); *(u32x2*)(xb + 4 * lane + 256 * j) = w; }
    if (xb8) {
#pragma unroll
        for (int j = 0; j < 8; ++j) { int w8 = 0; w8 = __builtin_amdgcn_cvt_pk_fp8_f32(v[j][0], v[j][1], w8, false); w8 = __builtin_amdgcn_cvt_pk_fp8_f32(v[j][2], v[j][3], w8, true); *(int*)(xb8 + 4 * lane + 256 * j) = w8; } }
    if (lane == 0) *rinv_out = rinv;
    if constexpr (ROUTER) {
        float lg[16];
#pragma unroll
        for (int e = 0; e < 16; ++e) { float a = 0.f;
#pragma unroll
            for (int j = 0; j < 8; ++j) { const f32x4 w = *(const LAS f32x4*)(WtL + e * 2048 + 4 * lane + 256 * j); a += v[j][0] * w[0] + v[j][1] * w[1] + v[j][2] * w[2] + v[j][3] * w[3]; }
            lg[e] = wave_sum(a) * rinv; }
        float mx = lg[0];
#pragma unroll
        for (int e = 1; e < 16; ++e) mx = fmaxf(mx, lg[e]);
        float sum = 0.f;
#pragma unroll
        for (int e = 0; e < 16; ++e) { lg[e] = __expf(lg[e] - mx); sum += lg[e]; }
        const float inv = 1.f / sum;
        float mine = 0.f;
#pragma unroll
        for (int e = 0; e < 16; ++e) mine = (lane == e) ? lg[e] * inv : mine;
        if (lane < 16) afft[(size_t)lane * S + row] = mine;
    }
}

__device__ __forceinline__ void router_row(const u32x2 (&xw)[8], float* rinv_out, const LAS float* WtL, float* afft, int row, int lane) {
    f32x4 v[8]; float ss = 0.f;
#pragma unroll
    for (int j = 0; j < 8; ++j) { const u32x2 w = xw[j]; v[j] = (f32x4){bf_lo(w.x), bf_hi(w.x), bf_lo(w.y), bf_hi(w.y)}; ss += v[j][0] * v[j][0] + v[j][1] * v[j][1] + v[j][2] * v[j][2] + v[j][3] * v[j][3]; }
    ss = wave_sum(ss);
    const float rinv = __builtin_amdgcn_rsqf(ss * (1.f / D) + EPS);
    if (lane == 0) *rinv_out = rinv;
    float lg[16];
#pragma unroll
    for (int e = 0; e < 16; ++e) { float a = 0.f;
#pragma unroll
        for (int j = 0; j < 8; ++j) { const f32x4 w = *(const LAS f32x4*)(WtL + e * 2048 + 4 * lane + 256 * j); a += v[j][0] * w[0] + v[j][1] * w[1] + v[j][2] * w[2] + v[j][3] * w[3]; }
        lg[e] = wave_sum(a) * rinv; }
    float mx = lg[0];
#pragma unroll
    for (int e = 1; e < 16; ++e) mx = fmaxf(mx, lg[e]);
    float sum = 0.f;
#pragma unroll
    for (int e = 0; e < 16; ++e) { lg[e] = __expf(lg[e] - mx); sum += lg[e]; }
    const float inv = 1.f / sum;
    float mine = 0.f;
#pragma unroll
    for (int e = 0; e < 16; ++e) mine = (lane == e) ? lg[e] * inv : mine;
    if (lane < 16) afft[(size_t)lane * S + row] = mine;
}
__device__ __forceinline__ int block_sum_i(int v, LAS int* red, int wave, int lane) {
#pragma unroll
    for (int o = 1; o < 64; o <<= 1) v += __shfl_xor(v, o);
    __syncthreads();
    if (lane == 0) red[wave] = v;
    __syncthreads();
    int t = 0;
#pragma unroll
    for (int w = 0; w < 8; ++w) t += red[w];
    return t;
}

__global__ void __launch_bounds__(512, 2) fwd(Args kargs) {
    extern __shared__ __attribute__((aligned(16))) unsigned char lds_raw[];
    LAS unsigned char* lds = (LAS unsigned char*)lds_raw;
    volatile LAS unsigned* MISC = (volatile LAS unsigned*)(lds + MISC_OFF);
    const int G = gridDim.x;
    unsigned* ctl = (unsigned*)((unsigned char*)kargs.ws + WS_CTL);
    if (threadIdx.x < 64) MISC[threadIdx.x] = 0u;
    if ((threadIdx.x & 63) == 0) *(volatile LAS int*)(unsigned)(WTAB_OFF + 4u * hw_slot()) = (int)(threadIdx.x >> 6);
    __syncthreads();
    XcdBarrier bar; bar.bar = ctl + 1024; bar.x = 0; bar.st = nullptr;
    if (!MK_PER_PHASE) bar = xcd_barrier_post(ctl + 1024, MISC + 8);
    const int lo = kargs.ph_lo, hi = kargs.ph_hi;
#ifndef PH_MASK
#define PH_MASK 0xFFFF
#endif
#define PON(b) ((PH_MASK >> (b)) & 1)
#ifndef REP_MASK
#define REP_MASK 0
#endif
#define REPS(b) (((REP_MASK >> (b)) & 1) ? 2 : 1)
#define IN(k) (lo <= (k) && (k) < hi)
#define PH_ENTER int tz0_ = tid_now(); asm volatile("" : "+v"(tz0_)); int bz0_ = blockIdx.x; asm volatile("" : "+s"(bz0_)); \
    const int tid = tz0_, lane = tid & 63, wave = __builtin_amdgcn_readfirstlane(tid >> 6), bx = bz0_, vcu = (G % 8 == 0) ? (bx % 8) * (G / 8) + bx / 8 : bx, gw = vcu * 8 + wave, NGW = G * 8; \
    (void)lane; (void)wave; (void)bx; (void)vcu; (void)gw; (void)NGW; \
      \
    CArgs* ap_ = (CArgs*)__builtin_amdgcn_kernarg_segment_ptr(); asm volatile("" : "+s"(ap_)); CArgs& args = *ap_; \
    unsigned char* const ws = (unsigned char*)args.ws; unsigned char* const act = ws + WS_ACT; unsigned char* const sm = act + A_SMALL; (void)sm; \
    bf16_t* const XB = (bf16_t*)(act + A_XB); unsigned char* const XB8 = act + A_O1; (void)XB8; bf16_t* const XB1 = (bf16_t*)(act + A_XB1); bf16_t* const UA = (bf16_t*)(act + A_UA); \
    bf16_t* const Qb = (bf16_t*)(act + A_Q); bf16_t* const Kb = (bf16_t*)(act + A_K); bf16_t* const Vb = (bf16_t*)(act + A_V); bf16_t* const Gb = (bf16_t*)(act + A_G); \
    float* const SSUM = (float*)(act + A_SSUM); bf16_t* const Yb = (bf16_t*)(act + A_Y); bf16_t* const YO = (bf16_t*)(act + A_YO); \
    bf16_t* const MG = (bf16_t*)(act + A_MG); float* const XA = (float*)(act + A_XA); bf16_t* const XG = (bf16_t*)(act + A_XG); bf16_t* const Hb = (bf16_t*)(act + A_H); bf16_t* const YX = (bf16_t*)(act + A_YX); \
    float* const RINV = (float*)(sm + SM_RINV); float* const RINV2 = (float*)(sm + SM_RINV2); float* const AFFT = (float*)(sm + SM_AFFT); int* const IDX = (int*)(sm + SM_IDX); \
    float* const GATE = (float*)(sm + SM_GATE); float* const RSL = (float*)(sm + SM_RSL); int* const INV = (int*)(sm + SM_INV); float* const LAMS = (float*)(sm + SM_LAM); \
    (void)XB; (void)XB1; (void)UA; (void)Qb; (void)Kb; (void)Vb; (void)Gb; (void)SSUM; (void)Yb; (void)YO; (void)MG; (void)XA; (void)XG; (void)Hb; (void)YX; \
    (void)RINV; (void)RINV2; (void)AFFT; (void)IDX; (void)GATE; (void)RSL; (void)INV; (void)LAMS;
#define INP(i) ((const float*)args.in[i])
#define OUTP ((float*)args.out)
#define LAYER_ENTER const LayerW w = layer_w(ws, l); const float lam_init = (l == 0) ? 0.2f : 0.35550906759f;   \
    (void)w; (void)lam_init;
#define SEAM(k) do { if (IN(k) && IN((k) + 1)) { if (!MK_PER_PHASE) xcd_barrier(bar); } } while (0)

    if (PON(0) && IN(0)) _Pragma("nounroll") for (int rep_ = 0; rep_ < REPS(0); ++rep_) { PH_ENTER
        LAS float* scr = (LAS float*)(lds + wave * 16640);
        convert_items(DecMain{ap_, ws}, gw, NL * IT_LAYER0, NGW, scr, lane);
        for (int i = gw * 64 + lane; i < NL * NE * D; i += NGW * 64) { const int l = i / (NE * D), e = (i / D) % NE, k = i % D;
            layer_w(ws, l).WRT[e * D + k] = INP(I_NFFN)[l * D + k] * INP(I_WR)[((size_t)l * D + k) * NE + e]; }
        for (int task = vcu; task < NL * NGRP * 2; task += G) {
            const int l = task / (NGRP * 2), g = (task >> 1) % NGRP, dir = task & 1;
            const size_t pb = ((size_t)(l * 2 + dir) * NGRP + g);
            LAS float* CR = (LAS float*)lds; LAS float* CI = CR + 16 * 65; LAS float* BR = CI + 16 * 65; LAS float* BI = BR + 64 * 16; LAS float* WD = BI + 64 * 16 + wave * 128;
            __syncthreads();
            for (int i = tid; i < 1024; i += 512) { const int pp = i >> 6, nn = i & 63; CR[pp * 65 + nn] = INP(I_CRE)[(pb * GP + pp) * NST + nn]; CI[pp * 65 + nn] = INP(I_CIM)[(pb * GP + pp) * NST + nn];
                BR[i] = INP(I_BRE)[pb * NST * GP + i]; BI[i] = INP(I_BIM)[pb * NST * GP + i]; }
            __syncthreads();
            const float are = INP(I_ARE)[pb * NST + lane], aim = INP(I_AIM)[pb * NST + lane], dt = expf(INP(I_LDT)[pb]);
            const float mag1 = expf(are * dt), ang1 = aim * dt, b1r = mag1 * cosf(ang1), b1i = mag1 * sinf(ang1);
            const float nr = b1r - 1.f, ni = b1i, den = are * are + aim * aim;
            const float cr = (nr * are + ni * aim) / den, ci = (ni * are - nr * aim) / den;
            const int p = lane >> 2, q0 = (lane & 3) * 4;
            for (int k = 0; k < 4; ++k) { const int dl = wave * 4 + k;
                const float magd = expf(are * dt * (float)dl), angd = aim * dt * (float)dl, pr = magd * cosf(angd), pi = magd * sinf(angd);
                WD[lane] = pr * cr - pi * ci; WD[64 + lane] = pr * ci + pi * cr;
                LDS_WAIT();
                f32x4 out = {0.f, 0.f, 0.f, 0.f};
#pragma unroll 8
                for (int n = 0; n < NST; ++n) {
                    const float wr_ = WD[n], wi_ = WD[64 + n];
                    const float c_r = CR[p * 65 + n], c_i = CI[p * 65 + n];
                    const float er = c_r * wr_ - c_i * wi_, ei = c_r * wi_ + c_i * wr_;
                    const f32x4 br = *(const LAS f32x4*)(BR + n * GP + q0), bi = *(const LAS f32x4*)(BI + n * GP + q0);
                    out += br * er - bi * ei;
                }
                *(f32x4*)(layer_w(ws, l).KTAB + ((((size_t)g * 2 + dir) * TC + dl) * GP + p) * GP + q0) = out;
                LDS_WAIT(); }
            { const LayerW w = layer_w(ws, l);
              for (int k = 0; k < 4; ++k) { const int t = wave * 4 + k;
                { const float e = dir == 0 ? (float)(t + 1) : (float)(TC - t); const float mg = expf(are * dt * e), an = aim * dt * e, pr = mg * cosf(an), pi = mg * sinf(an);
#pragma unroll
                  for (int pp = 0; pp < GP; ++pp) { const float c_r = CR[pp * 65 + lane], c_i = CI[pp * 65 + lane];
                      bf16_t* o = w.BO + ((size_t)g * 512 + t * 16 + pp) * UAW + 512 + dir * 128 + lane; o[0] = f2bf(c_r * pr - c_i * pi); o[64] = f2bf(-(c_r * pi + c_i * pr)); } }
                { const float e = dir == 0 ? (float)(TC - 1 - t) : (float)t; const float mg = expf(are * dt * e), an = aim * dt * e, pr = mg * cosf(an), pi = mg * sinf(an);
                  const float wre = pr * cr - pi * ci, wim = pr * ci + pi * cr;
                  f32x4 re[4], im[4];
#pragma unroll
                  for (int q = 0; q < 4; ++q) { const f32x4 br = *(const LAS f32x4*)(BR + lane * GP + 4 * q), bi = *(const LAS f32x4*)(BI + lane * GP + 4 * q); re[q] = br * wre - bi * wim; im[q] = bi * wre + br * wim; }
                  bf16_t* o = w.F + ((size_t)g * 256 + dir * 128 + lane) * 512 + t * 16;
                  *(u32x4*)o = pack8(re[0], re[1]); *(u32x4*)(o + 8) = pack8(re[2], re[3]);
                  *(u32x4*)(o + 64 * 512) = pack8(im[0], im[1]); *(u32x4*)(o + 64 * 512 + 8) = pack8(im[2], im[3]); } } }
        }
        __syncthreads();
        for (int m = gw; m < S; m += NGW) row_pass<false>(INP(I_X) + (size_t)m * D, XB + (size_t)m * D, RINV + m, nullptr, nullptr, m, lane, XB8 + (size_t)m * D);
        if (gw < NL) { const int l = gw; const float a = wave_sum(INP(I_LQ1)[l * QKD + lane] * INP(I_LK1)[l * QKD + lane]);
            const float b = wave_sum(INP(I_LQ2)[l * QKD + lane] * INP(I_LK2)[l * QKD + lane]);
            if (lane == 0) LAMS[l] = expf(a) - expf(b) + ((l == 0) ? 0.2f : 0.35550906759f); }
        for (int i = gw * 64 + lane; i < NH * 512; i += NGW * 64) { const int h = i >> 9, rel = (i & 511) - 256;
            ((float*)(sm + SM_BTAB))[i] = INP(I_RELB)[t5_bucket(rel) * NH + h] * LOG2E; }
    }
    SEAM(0);

    for (int l = 0; l < NL; ++l) {
        const int pbase = 2 + l * 14;
        if (PON(2) && IN(pbase + 0)) _Pragma("nounroll") for (int rep_ = 0; rep_ < REPS(2); ++rep_) { PH_ENTER LAYER_ENTER
            { pg::SchedGrid Sg; Sg.init(XB, D, w.WIN, D, S, 4096, G, bx);
              EpiInProj E{RINV, UA, Qb, Kb, Vb, Gb, INP(I_QG) + l * QKD, INP(I_KG) + l * QKD};
              pg::gemm_phase(lds, D, D, D, Sg, E); }
            { pg::SchedGrid Sg; Sg.init(XB8, D, (unsigned char*)w.WIN + (size_t)16 * MiB, D, S, 4096, G, bx, 1);
              EpiGates E{RINV, Gb};
              pg::gemm_phase<EpiGates, pg::SchedGrid, true, E8_ONE, E8_W>(lds, D, D, D, Sg, E); }
        }
        SEAM(pbase + 0);
        if (PON(3) && IN(pbase + 1)) _Pragma("nounroll") for (int rep_ = 0; rep_ < REPS(3); ++rep_) { PH_ENTER LAYER_ENTER
            pg::SchedGroup Sg; Sg.init(UA, UAW, (size_t)NCH * UAW * 2, w.F, 512, (size_t)256 * 512 * 2, 1, 1, NGRP, G, vcu);
            EpiSsum E{SSUM};
            pg::gemm_phase(lds, 512, UAW, 512, Sg, E);
            if (vcu >= NGRP) convert_items(DecDown{ap_, ws, l}, DQ_A0 + (vcu - NGRP) * 8 + wave, DQ_A1, (G - NGRP) * 8, (LAS float*)(lds + wave * 16640), lane);
            if (vcu >= NGRP) for (int gq = vcu - NGRP; gq < NGRP * 4; gq += G - NGRP) { const int g = gq >> 2, rq = gq & 3;
                LAS float* kt = (LAS float*)lds;
                __syncthreads();
                for (int i = tid; i < 2 * TC * 256 / 4; i += 512) ((LAS f32x4*)kt)[i] = ((const f32x4*)(w.KTAB + (size_t)g * 2 * TC * 256))[i];
                __syncthreads();
                for (int idx = tid; idx < 128 * 64; idx += 512) { const int rr = rq * 128 + (idx >> 6), kc = idx & 63;
                    const int t = rr >> 4, p = rr & 15, tau = kc >> 1, q0 = (kc & 1) * 8;
                    const LAS float* kf = kt; const LAS float* kb = kt + TC * 256;
                    f32x4 a, b;
                    if (tau < t) { const LAS float* s = kf + ((t - tau) * GP + p) * GP + q0; a = *(const LAS f32x4*)s; b = *(const LAS f32x4*)(s + 4); }
                    else if (tau > t) { const LAS float* s = kb + ((tau - t) * GP + p) * GP + q0; a = *(const LAS f32x4*)s; b = *(const LAS f32x4*)(s + 4); }
                    else { const LAS float* s = kf + p * GP + q0; const LAS float* s2 = kb + p * GP + q0; a = *(const LAS f32x4*)s + *(const LAS f32x4*)s2; b = *(const LAS f32x4*)(s + 4) + *(const LAS f32x4*)(s2 + 4);
                        const float dd = INP(I_SD)[l * SSMW + g * GP + p];
#pragma unroll
                        for (int j = 0; j < 4; ++j) { if (q0 + j == p) a[j] += dd; if (q0 + 4 + j == p) b[j] += dd; } }
                    *(u32x4*)(w.BO + ((size_t)g * 512 + rr) * UAW + tau * 16 + q0) = pack8(a, b); }
            }
            if (vcu < NGRP && wave < 2) {
                const int g = vcu, dir = wave; const size_t pb = ((size_t)(l * 2 + dir) * NGRP + g);
                const float are = INP(I_ARE)[pb * NST + lane], aim = INP(I_AIM)[pb * NST + lane], dt = expf(INP(I_LDT)[pb]);
                const float mg = expf(are * dt * (float)TC), an = aim * dt * (float)TC, ar = mg * cosf(an), ai = mg * sinf(an);
                float sr = 0.f, si = 0.f;
                for (int cb = 0; cb < NCH; cb += 32) {
                    float xr[32], xi[32];
#pragma unroll
                    for (int k = 0; k < 32; ++k) { const int c = dir == 0 ? cb + k : NCH - 1 - cb - k; const float* s = SSUM + ((size_t)g * NCH + c) * 256 + dir * 128 + lane; xr[k] = s[0]; xi[k] = s[64]; }
#pragma unroll
                    for (int k = 0; k < 32; ++k) { const int c = dir == 0 ? cb + k : NCH - 1 - cb - k;
                        bf16_t* o = UA + ((size_t)g * NCH + c) * UAW + 512 + dir * 128 + lane; o[0] = f2bf(sr); o[64] = f2bf(si);
                        const float nr = ar * sr - ai * si + xr[k], ni = ar * si + ai * sr + xi[k]; sr = nr; si = ni; }
                }
            }
            if (vcu < NGRP) convert_items(DecDown{ap_, ws, l}, DQ_A1 + vcu * 8 + wave, DQ_B0, NGRP * 8, (LAS float*)(lds + wave * 16640), lane);
        }
        SEAM(pbase + 1);
        if (PON(5) && IN(pbase + 3)) _Pragma("nounroll") for (int rep_ = 0; rep_ < REPS(5); ++rep_) { PH_ENTER LAYER_ENTER
            pg::SchedGroup Sg; Sg.init(UA, UAW, (size_t)NCH * UAW * 2, w.BO, UAW, (size_t)512 * UAW * 2, 1, 2, NGRP, G, vcu);
            EpiSsmOut E{Yb};
            pg::gemm_phase(lds, UAW, UAW, UAW, Sg, E);
            if (vcu >= 2 * NGRP) convert_items(DecDown{ap_, ws, l}, DQ_B0 + (vcu - 2 * NGRP) * 8 + wave, DQ_B1, (G - 2 * NGRP) * 8, (LAS float*)(lds + wave * 16640), lane);
            else convert_items(DecDown{ap_, ws, l}, DQ_B1 + vcu * 8 + wave, DQ_C0, 2 * NGRP * 8, (LAS float*)(lds + wave * 16640), lane);
        }
        SEAM(pbase + 3);
        if (PON(6) && IN(pbase + 4)) _Pragma("nounroll") for (int rep_ = 0; rep_ < REPS(6); ++rep_) { PH_ENTER LAYER_ENTER
            pg::SchedGrid Sg; Sg.init(Yb, SSMW, w.WGLU, SSMW, S, SSMW, G, bx);
            EpiGlu E{Yb, YO};
            pg::gemm_phase(lds, SSMW, SSMW, SSMW, Sg, E);
            if (bx >= 128) convert_items(DecDown{ap_, ws, l}, DQ_C0 + (bx - 128) * 8 + wave, DQ_C1, (G - 128) * 8, (LAS float*)(lds + wave * 16640), lane);
            else convert_items(DecDown{ap_, ws, l}, DQ_C1 + bx * 8 + wave, DQ_END, 128 * 8, (LAS float*)(lds + wave * 16640), lane);
        }
        SEAM(pbase + 4);
        if (PON(7) && IN(pbase + 5)) _Pragma("nounroll") for (int rep_ = 0; rep_ < REPS(7); ++rep_) { PH_ENTER LAYER_ENTER
            for (int un = vcu; un < NH * (S / 256); un += G) {
                const int h = un / (S / 256), qb = un % (S / 256);
                __syncthreads();
                { int tb = tid_now(); asm volatile("" : "+v"(tb)); ((LAS float*)(lds + att::OFF_BT))[tb] = ((const float*)(sm + SM_BTAB))[h * 512 + tb]; }
                const int q0w = qb * 256 + wave * 32;
                f32x16 o[4];
                { f32x16 o2[4];
                  att::attn_dual(o, o2, Qb + (size_t)q0w * 1024 + h * 128, Kb + h * 128, Vb + h * 128, (LAS char*)lds, q0w);
                  const float lam = LAMS[l];
#pragma unroll
                  for (int d = 0; d < 4; ++d) o[d] = o[d] - o2[d] * lam; }
                { const int tz = lane_now(), r32 = tz & 31, hi2 = tz >> 5;
                  float ssq[16];
#pragma unroll
                  for (int r = 0; r < 16; ++r) { float s = 0.f;
#pragma unroll
                    for (int d = 0; d < 4; ++d) s += o[d][r] * o[d][r];
                    s += swz_xor<1>(s); s += swz_xor<2>(s); s += swz_xor<4>(s); s += swz_xor<8>(s); s += swz_xor<16>(s);
                    ssq[r] = __builtin_amdgcn_rsqf(s * (1.f / VD) + EPS) * (1.f - lam_init); }
                  bf16_t* yo = YO + (size_t)(q0w + 4 * hi2) * 2048 + 1024 + h * 128 + r32;
#pragma unroll
                  for (int d = 0; d < 4; ++d) { const float gn = INP(I_SUBLN)[l * VD + d * 32 + r32];
#pragma unroll
                    for (int r = 0; r < 16; ++r) yo[(size_t)((r & 3) + 8 * (r >> 2)) * 2048 + d * 32] = f2bf(o[d][r] * ssq[r] * gn); } }
            }
            __syncthreads();
        }
        SEAM(pbase + 5);
        if (PON(8) && IN(pbase + 6)) _Pragma("nounroll") for (int rep_ = 0; rep_ < REPS(8); ++rep_) { PH_ENTER LAYER_ENTER
            pg::SchedGrid Sg; Sg.init(YO, 2048, w.WBR, 2048, S, D, G, bx);
            EpiMerge E{Gb, MG};
            pg::gemm_phase(lds, 2048, 2048, 2048, Sg, E);
        }
        SEAM(pbase + 6);
        if (PON(9) && IN(pbase + 7)) _Pragma("nounroll") for (int rep_ = 0; rep_ < REPS(9); ++rep_) { PH_ENTER LAYER_ENTER
            pg::SchedGrid Sg; Sg.init(MG, D, w.WOUT, D, S, D, G, bx);
            EpiOutProj E{XB, XB1};
            pg::gemm_phase(lds, D, D, D, Sg, E);
        }
        SEAM(pbase + 7);
        if (PON(10) && IN(pbase + 8)) _Pragma("nounroll") for (int rep_ = 0; rep_ < REPS(10); ++rep_) { PH_ENTER LAYER_ENTER
            LAS float* WtL = (LAS float*)lds;
            for (int i = tid; i < NE * D / 4; i += 512) ((LAS f32x4*)WtL)[i] = ((const f32x4*)w.WRT)[i];
            __syncthreads();
            { u32x2 xc[8], xn[8];
#pragma unroll
              for (int j = 0; j < 8; ++j) { xc[j] = (u32x2){0u, 0u}; xn[j] = xc[j]; }
              if (gw < S) {
#pragma unroll
                  for (int j = 0; j < 8; ++j) xc[j] = *(const u32x2*)(XB1 + (size_t)gw * D + 4 * lane + 256 * j); }
              for (int m = gw; m < S; m += NGW) { int lz = lane; asm volatile("" : "+v"(lz));
                  if (m + NGW < S) {
#pragma unroll
                      for (int j = 0; j < 8; ++j) xn[j] = *(const u32x2*)(XB1 + (size_t)(m + NGW) * D + 4 * lz + 256 * j); }
                  router_row(xc, RINV2 + m, WtL, AFFT, m, lz);
#pragma unroll
                  for (int j = 0; j < 8; ++j) xc[j] = xn[j]; } }
            __syncthreads();
        }
        SEAM(pbase + 8);
        if (PON(11) && IN(pbase + 9)) _Pragma("nounroll") for (int rep_ = 0; rep_ < REPS(11); ++rep_) { PH_ENTER LAYER_ENTER
            const int nparts = G / NE > 0 ? G / NE : 1;
            if (vcu < nparts * NE) {
                const int e = vcu / nparts, part = vcu % nparts, per = (CAP + nparts - 1) / nparts, slo = part * per, shi = (slo + per < CAP) ? slo + per : CAP;
                LAS int* red = (LAS int*)lds; LAS int* list = (LAS int*)(lds + 1024);
                unsigned bits[16]; { const float* a = AFFT + (size_t)e * S + tid * 16;
#pragma unroll
                    for (int q = 0; q < 4; ++q) { const f32x4 v = *(const f32x4*)(a + 4 * q); bits[4 * q] = __float_as_uint(v[0]); bits[4 * q + 1] = __float_as_uint(v[1]); bits[4 * q + 2] = __float_as_uint(v[2]); bits[4 * q + 3] = __float_as_uint(v[3]); } }
                unsigned T = 0u;
                for (int bit = 30; bit >= 0; --bit) { const unsigned cand = T | (1u << bit); int c = 0;
#pragma unroll
                    for (int i = 0; i < 16; ++i) c += bits[i] >= cand ? 1 : 0;
                    if (block_sum_i(c, red, wave, lane) >= CAP) T = cand; }
                int cg = 0, ce = 0;
#pragma unroll
                for (int i = 0; i < 16; ++i) { cg += bits[i] > T ? 1 : 0; ce += bits[i] == T ? 1 : 0; }
                const int need_eq = CAP - block_sum_i(cg, red, wave, lane);
                int sg = cg, se = ce;
#pragma unroll
                for (int o = 1; o < 64; o <<= 1) { const int a = __shfl_up(sg, o), b = __shfl_up(se, o); if (lane >= o) { sg += a; se += b; } }
                __syncthreads();
                if (lane == 63) { red[16 + wave] = sg; red[32 + wave] = se; }
                __syncthreads();
                int og = 0, oe = 0;
#pragma unroll
                for (int wv = 0; wv < 8; ++wv) if (wv < wave) { og += red[16 + wv]; oe += red[32 + wv]; }
                int gbef = og + sg - cg, ebef = oe + se - ce;
                const bool inv_mine = (tid * nparts) / 512 == part;
#pragma unroll
                for (int i = 0; i < 16; ++i) { const int tok = tid * 16 + i; const bool isg = bits[i] > T, ise = bits[i] == T; const bool sel = isg || (ise && ebef < need_eq);
                    const int slot = gbef + (ebef < need_eq ? ebef : need_eq);
                    if (sel && slot >= slo && slot < shi) { IDX[e * CAP + slot] = tok; GATE[e * CAP + slot] = __uint_as_float(bits[i]); RSL[e * CAP + slot] = RINV2[tok]; list[slot - slo] = tok; }
                    if (inv_mine) INV[tok * NE + e] = sel ? slot : -1;
                    gbef += isg ? 1 : 0; ebef += ise ? 1 : 0; }
                __syncthreads();
                for (int r = wave; r < shi - slo; r += 32) {
                    u32x4 t[4][4];
#pragma unroll
                    for (int q = 0; q < 4; ++q) { const int rr = (r + 8 * q < shi - slo) ? r + 8 * q : r; const u32x4* s = (const u32x4*)(XB1 + (size_t)list[rr] * D) + lane;
#pragma unroll
                        for (int j = 0; j < 4; ++j) t[q][j] = s[64 * j]; }
#pragma unroll
                    for (int q = 0; q < 4; ++q) if (r + 8 * q < shi - slo) { u32x2* d = (u32x2*)((unsigned char*)XG + (size_t)(e * CAP + slo + r + 8 * q) * D) + lane;
#pragma unroll
                        for (int j = 0; j < 4; ++j) { f32x4 a, b; unpack8(t[q][j], a, b); d[64 * j] = pack8_fp8(a, b); } } }
                __syncthreads();
            }
        }
        SEAM(pbase + 9);
        if (PON(13) && IN(pbase + 11)) _Pragma("nounroll") for (int rep_ = 0; rep_ < REPS(13); ++rep_) { PH_ENTER LAYER_ENTER
            pg::SchedGroup Sg; Sg.init(XG, D, (size_t)CAP * D, w.WGU, D, (size_t)4096 * D, 4, 16, NE, G, vcu, 1);
            EpiExp1 E{RSL, Hb};
            pg::gemm_phase<EpiExp1, pg::SchedGroup, true, E8_ONE, E8_W>(lds, D, D, D, Sg, E);
        }
        SEAM(pbase + 11);
        if (PON(14) && IN(pbase + 12)) _Pragma("nounroll") for (int rep_ = 0; rep_ < REPS(14); ++rep_) { PH_ENTER LAYER_ENTER
            pg::SchedGroup Sg; Sg.init(Hb, FF, (size_t)CAP * FF, w.WD, FF, (size_t)D * FF, 4, 8, NE, G, vcu, 1);
            EpiExp2 E{GATE, YX};
            pg::gemm_phase<EpiExp2, pg::SchedGroup, true, E8_H, E8_W>(lds, FF, FF, FF, Sg, E);
        }
        SEAM(pbase + 12);
        if (PON(15) && IN(pbase + 13)) _Pragma("nounroll") for (int rep_ = 0; rep_ < REPS(15); ++rep_) { PH_ENTER LAYER_ENTER
            { u32x2 xc[8], xn[8]; int invc = -1, invn = -1;
#pragma unroll
              for (int j = 0; j < 8; ++j) { xc[j] = (u32x2){0u, 0u}; xn[j] = xc[j]; }
              if (gw < S) { invc = INV[gw * NE + (lane & 15)];
#pragma unroll
                  for (int j = 0; j < 8; ++j) xc[j] = *(const u32x2*)(XB1 + (size_t)gw * D + 4 * lane + 256 * j); }
              for (int m = gw; m < S; m += NGW) {
                if (m + NGW < S) { invn = INV[(m + NGW) * NE + (lane & 15)];
#pragma unroll
                    for (int j = 0; j < 8; ++j) xn[j] = *(const u32x2*)(XB1 + (size_t)(m + NGW) * D + 4 * lane + 256 * j); }
                f32x4 v[8];
#pragma unroll
                for (int j = 0; j < 8; ++j) v[j] = (f32x4){bf_lo(xc[j].x), bf_hi(xc[j].x), bf_lo(xc[j].y), bf_hi(xc[j].y)};
                const int myinv = invc;
                unsigned msk = (unsigned)(__ballot(myinv >= 0) & 0xFFFFull);
                while (msk) { const int e0 = __builtin_ctz(msk); msk &= msk - 1; const bool two = msk != 0u; const int e1 = two ? __builtin_ctz(msk) : e0; if (two) msk &= msk - 1;
                    const bf16_t* y0 = YX + ((size_t)e0 * CAP + __shfl(myinv, e0)) * D; const bf16_t* y1 = YX + ((size_t)e1 * CAP + __shfl(myinv, e1)) * D;
                    u32x2 a[8], b[8];
#pragma unroll
                    for (int j = 0; j < 8; ++j) a[j] = *(const u32x2*)(y0 + 4 * lane + 256 * j);
#pragma unroll
                    for (int j = 0; j < 8; ++j) b[j] = *(const u32x2*)(y1 + 4 * lane + 256 * j);
#pragma unroll
                    for (int j = 0; j < 8; ++j) { v[j][0] += bf_lo(a[j].x); v[j][1] += bf_hi(a[j].x); v[j][2] += bf_lo(a[j].y); v[j][3] += bf_hi(a[j].y); }
                    if (two) {
#pragma unroll
                        for (int j = 0; j < 8; ++j) { v[j][0] += bf_lo(b[j].x); v[j][1] += bf_hi(b[j].x); v[j][2] += bf_lo(b[j].y); v[j][3] += bf_hi(b[j].y); } } }
                if (l + 1 < NL) {
                    float ss = 0.f;
#pragma unroll
                    for (int j = 0; j < 8; ++j) ss += v[j][0] * v[j][0] + v[j][1] * v[j][1] + v[j][2] * v[j][2] + v[j][3] * v[j][3];
                    ss = wave_sum(ss);
#pragma unroll
                    for (int j = 0; j < 8; ++j) { u32x2 wv; wv.x = cvt_pk_bf16(v[j][0], v[j][1]); wv.y = cvt_pk_bf16(v[j][2], v[j][3]); *(u32x2*)(XB + (size_t)m * D + 4 * lane + 256 * j) = wv;
                        int w8 = 0; w8 = __builtin_amdgcn_cvt_pk_fp8_f32(v[j][0], v[j][1], w8, false); w8 = __builtin_amdgcn_cvt_pk_fp8_f32(v[j][2], v[j][3], w8, true); *(int*)(XB8 + (size_t)m * D + 4 * lane + 256 * j) = w8; }
                    if (lane == 0) RINV[m] = __builtin_amdgcn_rsqf(ss * (1.f / D) + EPS);
                } else { float* orow = OUTP + (size_t)m * D;
#pragma unroll
                    for (int j = 0; j < 8; ++j) *(f32x4*)(orow + 4 * lane + 256 * j) = v[j]; }
#pragma unroll
                for (int j = 0; j < 8; ++j) xc[j] = xn[j];
                invc = invn;
              } }
        }
        SEAM(pbase + 13);
    }
#undef IN
#undef SEAM
}

#if defined(DBG_STOP)
#ifndef DBG_OFF
#define DBG_OFF A_XA
#endif
#ifndef DBG_BF16
#define DBG_BF16 0
#endif
__global__ void dbg_dump(float* out, const unsigned char* ws) {
    const unsigned char* p = ws + WS_ACT + DBG_OFF;
    for (size_t i = (size_t)blockIdx.x * 256 + threadIdx.x; i < (size_t)S * D; i += (size_t)gridDim.x * 256)
#if defined(DBG_SUM2)
        out[i] = __uint_as_float(((unsigned)((const bf16_t*)p)[i]) << 16) + __uint_as_float(((unsigned)((const bf16_t*)p)[i + (size_t)S * D]) << 16);
#else
        out[i] = DBG_BF16 ? __uint_as_float(((unsigned)((const bf16_t*)p)[i]) << 16) : ((const float*)p)[i];
#endif
}
#endif
constexpr int N_PHASES = 2 + NL * 14;
extern "C" void kernel_launch(void* const* d_in, const int* in_sizes, int n_in, void* d_out, int out_size, void* d_ws, size_t ws_size, hipStream_t stream) {
    static int grid = 0;
    if (grid == 0) {
        if (n_in != 28 || in_sizes[0] != S * D || out_size != S * D || ws_size < WS_END) { fprintf(stderr, "kernel_launch: shape/workspace mismatch (n_in %d, ws %zu, need %zu)\n", n_in, ws_size, (size_t)WS_END); grid = -1; return; }
        int dev = 0, cus = 0, per_cu = 0;
        if (hipGetDevice(&dev) != hipSuccess || hipDeviceGetAttribute(&cus, hipDeviceAttributeMultiprocessorCount, dev) != hipSuccess) { grid = -1; return; }
        if (hipFuncSetAttribute((const void*)fwd, hipFuncAttributeMaxDynamicSharedMemorySize, LDS_BYTES) != hipSuccess) { fprintf(stderr, "kernel_launch: hipFuncSetAttribute failed\n"); grid = -1; return; }
        if (hipOccupancyMaxActiveBlocksPerMultiprocessor(&per_cu, (const void*)fwd, 512, LDS_BYTES) != hipSuccess || per_cu < 1) { fprintf(stderr, "kernel_launch: occupancy query says %d\n", per_cu); }
        (void)hipGetLastError();
        grid = cus;
    }
    if (grid < 0) return;
    (void)hipMemsetAsync((char*)d_ws + WS_CTL, 0, CTL_BYTES, stream);
    Args a{};
    for (int i = 0; i < 28; ++i) a.in[i] = (GAS const float*)d_in[i];
    a.out = (GAS float*)d_out; a.ws = (GAS unsigned char*)d_ws;
#if defined(DBG_STOP)
    for (int p = 0; p < DBG_STOP; ++p) { a.ph_lo = p; a.ph_hi = p + 1; hipLaunchKernelGGL(fwd, dim3(grid), dim3(512), LDS_BYTES, stream, a); }
#if !defined(DBG_NODUMP)
    hipLaunchKernelGGL(dbg_dump, dim3(2048), dim3(256), 0, stream, (float*)d_out, (const unsigned char*)d_ws);
#endif
#elif MK_PER_PHASE
    for (int p = 0; p < N_PHASES; ++p) { a.ph_lo = p; a.ph_hi = p + 1; hipLaunchKernelGGL(fwd, dim3(grid), dim3(512), LDS_BYTES, stream, a); }
#else
    a.ph_lo = 0; a.ph_hi = N_PHASES; hipLaunchKernelGGL(fwd, dim3(grid), dim3(512), LDS_BYTES, stream, a);
#endif
    const hipError_t le = hipPeekAtLastError();
    if (le != hipSuccess) fprintf(stderr, "kernel_launch: launch failed: %s\n", hipGetErrorName(le));
}
```

```cpp
#include <hip/hip_runtime.h>
#include <cstdio>
#include <cstdint>

#define REP_MASK 7168
#ifndef MK_PER_PHASE
#define MK_PER_PHASE 0
#endif

#define LAS __attribute__((address_space(3)))
#define GAS __attribute__((address_space(1)))
typedef unsigned short bf16_t;
typedef short bf16x8 __attribute__((ext_vector_type(8)));
typedef short s16x4 __attribute__((ext_vector_type(4)));
typedef float f32x4 __attribute__((ext_vector_type(4)));
typedef float f32x2 __attribute__((ext_vector_type(2)));
typedef float f32x16 __attribute__((ext_vector_type(16)));
typedef unsigned u32x4 __attribute__((ext_vector_type(4)));
typedef unsigned u32x2 __attribute__((ext_vector_type(2)));

constexpr int S = 8192, D = 2048, NL = 2;
constexpr int SSMW = 1024, NGRP = 64, GP = 16, NST = 64;
constexpr int NH = 8, QKD = 64, VD = 128;
constexpr int NE = 16, CAP = 1024, FF = 2048;
constexpr int INC = 8192;
constexpr float EPS = 1e-6f;
constexpr int TC = 32, NCH = S / TC;
constexpr int UAW = TC * GP + 256;
constexpr float LOG2E = 1.4426950408889634f;

constexpr size_t MiB = 1u << 20;
constexpr size_t WS_CTL = 0, CTL_BYTES = 1 * MiB;
constexpr size_t LW_WIN = 0, LW_WGLU = 32 * MiB, LW_WBR = 34 * MiB, LW_WOUT = 42 * MiB, LW_WGU = 50 * MiB, LW_WD = 306 * MiB,
                 LW_F = 434 * MiB, LW_BO = 450 * MiB, LW_KTAB = 498 * MiB, LW_WRT = 502 * MiB, LW_SIZE = 503 * MiB;
constexpr size_t WS_LW = 1 * MiB;
constexpr size_t WS_ACT = WS_LW + 2 * LW_SIZE;
constexpr size_t A_XB = 0, A_XB1 = 32 * MiB, A_UA = 64 * MiB, A_Q = 88 * MiB, A_K = 104 * MiB, A_V = 120 * MiB, A_G = 136 * MiB,
                 A_SSUM = 200 * MiB, A_Y = 216 * MiB, A_YO = 232 * MiB, A_O1 = 264 * MiB, A_MG = 296 * MiB, A_XA = 328 * MiB,
                 A_XG = 392 * MiB, A_H = 456 * MiB, A_YX = 520 * MiB, A_SMALL = 584 * MiB, A_END = 588 * MiB;
constexpr size_t SM_RINV = 0, SM_RINV2 = 64 * 1024, SM_AFFT = 128 * 1024, SM_IDX = 640 * 1024, SM_GATE = 704 * 1024, SM_RSL = 768 * 1024,
                 SM_INV = 1024 * 1024, SM_BTAB = 1536 * 1024, SM_LAM = 1600 * 1024;
constexpr size_t WS_END = WS_ACT + A_END;

constexpr int RING_BYTES = 131072;
constexpr int LDS_BYTES = 163840;
constexpr int MISC_OFF = 155648;

typedef __bf16 bf16v2_t __attribute__((ext_vector_type(2)));
__device__ __forceinline__ unsigned cvt_pk_bf16(float lo, float hi) { const f32x2 v = {lo, hi}; return __builtin_bit_cast(unsigned, __builtin_convertvector(v, bf16v2_t)); }
__device__ __forceinline__ float bf_lo(unsigned w) { return __uint_as_float(w << 16); }
__device__ __forceinline__ float bf_hi(unsigned w) { return __uint_as_float(w & 0xffff0000u); }
__device__ __forceinline__ unsigned short f2bf(float f) { return (unsigned short)(cvt_pk_bf16(f, 0.f) & 0xffffu); }
__device__ __forceinline__ float fast_sigmoid(float x) { return __builtin_amdgcn_rcpf(1.f + __builtin_amdgcn_exp2f(-x * LOG2E)); }
__device__ __forceinline__ float wave_sum(float v) {
#pragma unroll
    for (int o = 1; o < 64; o <<= 1) v += __shfl_xor(v, o);
    return v;
}
template <int X> __device__ __forceinline__ float swz_xor(float v) { return __int_as_float(__builtin_amdgcn_ds_swizzle(__float_as_int(v), (X << 10) | 0x1F)); }
__device__ __forceinline__ int lane_now() { int t; asm volatile("v_mbcnt_lo_u32_b32 %0, -1, 0\n\tv_mbcnt_hi_u32_b32 %0, -1, %0" : "=v"(t)); return t; }
constexpr int WTAB_OFF = MISC_OFF + 512;
__device__ __forceinline__ unsigned hw_slot() { return (unsigned)__builtin_amdgcn_s_getreg((5 << 11) | 4) & 63u; }
__device__ __forceinline__ int wave_now() { return __builtin_amdgcn_readfirstlane(*(volatile LAS int*)(unsigned)(WTAB_OFF + 4u * hw_slot())); }
__device__ __forceinline__ int tid_now() { return wave_now() * 64 + lane_now(); }
__device__ __forceinline__ u32x2 pack8_fp8(const f32x4 a, const f32x4 b) { int w0 = 0, w1 = 0;
    w0 = __builtin_amdgcn_cvt_pk_fp8_f32(a[0], a[1], w0, false); w0 = __builtin_amdgcn_cvt_pk_fp8_f32(a[2], a[3], w0, true);
    w1 = __builtin_amdgcn_cvt_pk_fp8_f32(b[0], b[1], w1, false); w1 = __builtin_amdgcn_cvt_pk_fp8_f32(b[2], b[3], w1, true);
    u32x2 r; r.x = (unsigned)w0; r.y = (unsigned)w1; return r; }
constexpr float W8_SCALE = 64.f, H8_SCALE = 16.f;
constexpr int E8_ONE = 0x7F7F7F7F, E8_W = 0x79797979  , E8_H = 0x7B7B7B7B  ;
#define LDS_WAIT() asm volatile("s_waitcnt lgkmcnt(0)" ::: "memory")
#define VM_WAIT() asm volatile("s_waitcnt vmcnt(0)" ::: "memory")

#define XB_TMO      128
#define XB_XCNT(j)  (256  + 64 * (j))
#define XB_XSUB(j)  (1280 + 64 * (j))
#define XB_XGEN(j)  (2304 + 64 * (j))
#define XB_TOP      3328
#define XB_TOPGEN   3392
#define XCD_BAR_WORDS 3456
#define XB_SPIN_CAP (1u << 22)
__device__ __forceinline__ unsigned xb_ld(unsigned* p)              { return __hip_atomic_load(p, __ATOMIC_RELAXED, __HIP_MEMORY_SCOPE_AGENT); }
__device__ __forceinline__ unsigned xb_add(unsigned* p, unsigned v) { return __hip_atomic_fetch_add(p, v, __ATOMIC_RELAXED, __HIP_MEMORY_SCOPE_AGENT); }
__device__ __forceinline__ unsigned xb_xcc_id() { return (unsigned)__builtin_amdgcn_s_getreg((3 << 11) | 20) & 0xFu; }
#define XB_SPIN(cond, bar) do { unsigned _sp = 0; while (cond) { __builtin_amdgcn_s_sleep(1); \
    if ((++_sp & 255u) == 0u) { if (xb_ld(&(bar)[XB_TMO])) break; if (_sp > XB_SPIN_CAP) { atomicAdd(&(bar)[XB_TMO], 1u); break; } } } } while (0)
struct XcdBarrier { unsigned* bar; unsigned x; volatile LAS unsigned* st; };
__device__ __forceinline__ XcdBarrier xcd_barrier_post(unsigned* bar, volatile LAS unsigned* st) {
    XcdBarrier b; b.bar = bar; b.x = xb_xcc_id(); b.st = st;
    if (tid_now() == 0) (void)xb_add(&bar[XB_XCNT(b.x)], 1u);
    return b;
}
__device__ __forceinline__ void xcd_barrier_complete(unsigned* bar, unsigned x, unsigned& nloc, unsigned& nx) {
    const unsigned G = gridDim.x * gridDim.y * gridDim.z;
    unsigned sum, cnt, mine, sp = 0u;
    for (;;) {
        sum = 0u; cnt = 0u; mine = 0u;
#pragma nounroll
        for (unsigned j = 0; j < 16; ++j) { const unsigned c = xb_ld(&bar[XB_XCNT(j)]); sum += c; cnt += (c > 0u) ? 1u : 0u; mine = (j == x) ? c : mine; }
        if (sum == G) break;
        __builtin_amdgcn_s_sleep(1);
        if ((++sp & 255u) == 0u) { if (xb_ld(&bar[XB_TMO])) break; if (sp > XB_SPIN_CAP) { atomicAdd(&bar[XB_TMO], 1u); break; } }
    }
    nloc = mine > 0u ? mine : 1u; nx = cnt > 0u ? cnt : 1u;
}
__device__ __forceinline__ void xcd_barrier(const XcdBarrier& b) {
    asm volatile("s_waitcnt vmcnt(0)" ::: "memory");
    __syncthreads();
    if (tid_now() == 0) {
        unsigned* bar = b.bar;
        __builtin_amdgcn_s_waitcnt(0);
        unsigned nloc = b.st[0], nx = b.st[1];
        if (nloc == 0u) { xcd_barrier_complete(bar, b.x, nloc, nx); b.st[0] = nloc; b.st[1] = nx; }
        const unsigned old = xb_add(&bar[XB_XSUB(b.x)], 1u);
        const unsigned gen = old / nloc;
        if (old + 1u == (gen + 1u) * nloc) {
            __builtin_amdgcn_fence(__ATOMIC_RELEASE, "agent");
            asm volatile("s_waitcnt vmcnt(0)" ::: "memory");
            const unsigned og = xb_add(&bar[XB_TOP], 1u);
            const unsigned tg = og / nx;
            if (og + 1u == (tg + 1u) * nx) xb_add(&bar[XB_TOPGEN], 1u);
            else XB_SPIN(xb_ld(&bar[XB_TOPGEN]) == tg, bar);
            __builtin_amdgcn_fence(__ATOMIC_ACQUIRE, "agent");
            xb_add(&bar[XB_XGEN(b.x)], 1u);
            asm volatile("s_waitcnt vmcnt(0)" ::: "memory");
        } else {
            XB_SPIN(xb_ld(&bar[XB_XGEN(b.x)]) == gen, bar);
            __builtin_amdgcn_fence(__ATOMIC_ACQUIRE, "agent");
            asm volatile("s_waitcnt vmcnt(0)" ::: "memory");
        }
    }
    __syncthreads();
}

namespace pg {
constexpr int BM = 256, BK = 64, HALF = 128, HTB = HALF * BK * 2, STAGE_BYTES = 8 * HTB;
__device__ __forceinline__ int lds_byte(int r, int c) { const int st = (r >> 4) * 2 + (c >> 5), rr = r & 15, cc = c & 31, ob = rr * 64 + cc * 2; return st * 1024 + (ob ^ (((ob >> 9) & 1) << 5)); }
__device__ __forceinline__ void stage_rc(int b, int& R, int& C) { const int st = b / 1024, sb = b % 1024, swz = sb ^ (((sb >> 9) & 1) << 5); R = (st >> 1) * 16 + swz / 64; C = (st & 1) * 32 + (swz % 64) / 2; }
__device__ __forceinline__ int perm32(int rho) { const int n = rho >> 4, i = rho & 15; return 8 * (i >> 2) + 4 * n + (i & 3); }
struct Unit { const char* a; const char* b; int pm, pn, grp; };
typedef f32x4 Acc[2][2][4][2];

typedef int v8i_t __attribute__((ext_vector_type(8)));
template <class Epi, class Sched, bool F8 = false, int SA_ = 0x7F7F7F7F, int SB_ = 0x7F7F7F7F>
__device__ __forceinline__ void gemm_phase(LAS unsigned char* lds, const int K, const int lda, const int ldb, const Sched& S, const Epi& E) {
    int tz_ = tid_now(); asm volatile("" : "+v"(tz_));
    const int tid = tz_, wid = __builtin_amdgcn_readfirstlane(tid >> 6), lane = tid & 63, wr = wid >> 2, wc = wid & 3, fr = lane & 15, fq = lane >> 4;
    constexpr int ESZ = F8 ? 1 : 2;
    const int nt = K * ESZ / (BK * 2);
    unsigned voffA[2], voffB[2];
#pragma unroll
    for (int i = 0; i < 2; ++i) { int R, C; stage_rc(tid * 16 + i * 8192, R, C);
        voffA[i] = (unsigned)(R * lda * ESZ + C * 2); voffB[i] = (unsigned)((64 * (R >> 5) + perm32(R & 31)) * ldb * ESZ + C * 2); }
    const size_t kstep = (size_t)(BK * 2);
    const size_t hstepA = (size_t)HALF * lda * ESZ;
    const size_t hstepB = (size_t)32 * ldb * ESZ;
    const unsigned ldsw = (unsigned)wid * 1024u;
    const int aoff = F8 ? lds_byte(wr * 64 + fr, fq * 16) : lds_byte(wr * 64 + fr, fq * 8), boff = F8 ? lds_byte(wc * 32 + fr, fq * 16) : lds_byte(wc * 32 + fr, fq * 8);
#define PG8_SA(b, h) (((b) * 2 + (h)) * HTB)
#define PG8_SB(b, h) ((4 + (b) * 2 + (h)) * HTB)
#define PG8_STAGE(bufoff, gbase, voff) do { _Pragma("unroll") for (int _i = 0; _i < 2; ++_i) \
        __builtin_amdgcn_global_load_lds((const unsigned*)((const char*)(gbase) + (voff)[_i]), (LAS unsigned*)(lds + (bufoff) + ldsw + _i * 8192), 16, 0, 0); } while (0)
    typedef v8i_t v8i_a16 __attribute__((aligned(16)));
#define PG8_LD32(p) __builtin_bit_cast(v8i_t, __builtin_shufflevector(*(const LAS u32x4*)(p), *(const LAS u32x4*)((p) + 16), 0, 1, 2, 3, 4, 5, 6, 7))
#define PG8_LDA(dst, b, h) do { if constexpr (F8) { _Pragma("unroll") for (int m = 0; m < 4; ++m) dst##8[m] = PG8_LD32(lds + PG8_SA(b, h) + aoff + m * 2048); } \
        else { _Pragma("unroll") for (int m = 0; m < 4; ++m) _Pragma("unroll") for (int k = 0; k < 2; ++k) dst[m][k] = *(const LAS bf16x8*)(lds + PG8_SA(b, h) + aoff + m * 2048 + k * 1024); } } while (0)
#define PG8_LDB(dst, b, h) do { if constexpr (F8) { _Pragma("unroll") for (int n = 0; n < 2; ++n) dst##8[n] = PG8_LD32(lds + PG8_SB(b, h) + boff + n * 2048); } \
        else { _Pragma("unroll") for (int n = 0; n < 2; ++n) _Pragma("unroll") for (int k = 0; k < 2; ++k) dst[n][k] = *(const LAS bf16x8*)(lds + PG8_SB(b, h) + boff + n * 2048 + k * 1024); } } while (0)
#define PG8_MMA(ai, bj, At, Bt) do { __builtin_amdgcn_s_setprio(1); \
        if constexpr (F8) { _Pragma("unroll") for (int m = 0; m < 4; ++m) _Pragma("unroll") for (int n = 0; n < 2; ++n) \
            asm volatile("v_mfma_scale_f32_16x16x128_f8f6f4 %0, %1, %2, %0, %3, %4 op_sel_hi:[0,0,0]" : "+v"(acc[ai][bj][m][n]) : "v"(Bt##8[n]), "v"(At##8[m]), "v"(sbv), "v"(sav)); } \
        else { _Pragma("unroll") for (int m = 0; m < 4; ++m) _Pragma("unroll") for (int n = 0; n < 2; ++n) _Pragma("unroll") for (int k = 0; k < 2; ++k) \
            acc[ai][bj][m][n] = __builtin_amdgcn_mfma_f32_16x16x32_bf16(Bt[n][k], At[m][k], acc[ai][bj][m][n], 0, 0, 0); } \
        __builtin_amdgcn_s_setprio(0); } while (0)
#define PG8_WAIT_V(n) asm volatile("s_waitcnt vmcnt(" #n ")" ::: "memory")
#define PG8_WAIT_L(n) asm volatile("s_waitcnt lgkmcnt(" #n ")" ::: "memory")
#define PG8_BAR __builtin_amdgcn_s_barrier()
#define PG8_SCHED __builtin_amdgcn_sched_barrier(0)
    Unit cur, nxt; int ui = 0;
    if (!S.next(0, cur)) return;
    Acc acc;
#pragma unroll
    for (int a = 0; a < 2; ++a)
#pragma unroll
        for (int b = 0; b < 2; ++b)
#pragma unroll
            for (int m = 0; m < 4; ++m)
#pragma unroll
                for (int n = 0; n < 2; ++n) acc[a][b][m][n] = (f32x4){0.f, 0.f, 0.f, 0.f};
    bf16x8 At[4][2], B0[2][2], B1[2][2]; v8i_t At8[4], B08[2], B18[2];
    int sav = SA_, sbv = SB_;
    if (F8) { asm volatile("" : "+v"(sav)); asm volatile("" : "+v"(sbv)); }
    const char* cA = cur.a; const char* cB = cur.b;
    PG8_STAGE(PG8_SB(0, 0), cB, voffB); PG8_STAGE(PG8_SA(0, 0), cA, voffA); PG8_STAGE(PG8_SB(0, 1), cB + hstepB, voffB); PG8_STAGE(PG8_SA(0, 1), cA + hstepA, voffA);
    if (wr == 1) PG8_BAR;
    PG8_WAIT_V(4); PG8_BAR;
    PG8_STAGE(PG8_SB(1, 0), cB + kstep, voffB); PG8_STAGE(PG8_SA(1, 0), cA + kstep, voffA); PG8_STAGE(PG8_SB(1, 1), cB + hstepB + kstep, voffB);
    PG8_WAIT_V(6); PG8_BAR;
    for (;;) {
        const bool has_next = S.next(ui + 1, nxt);
        const char* nA = has_next ? nxt.a : cA; const char* nB = has_next ? nxt.b : cB;
        for (int t = 0; t < nt; t += 2) {
            const bool last = (t == nt - 2);
            const char* a1 = cA + (size_t)(t + 1) * kstep;
            const char* a2 = last ? nA : cA + (size_t)(t + 2) * kstep; const char* b2 = last ? nB : cB + (size_t)(t + 2) * kstep;
            const char* a3 = a2 + kstep; const char* b3 = b2 + kstep;
            if constexpr (Epi::HAS_MID) { if (t == nt / 2) E.mid(acc, cur, wr, wc, fr, fq); }
            PG8_LDB(B0, 0, 0); PG8_SCHED; PG8_LDA(At, 0, 0); PG8_STAGE(PG8_SA(1, 1), a1 + hstepA, voffA);
            PG8_WAIT_L(8); PG8_BAR; PG8_WAIT_L(0); PG8_MMA(0, 0, At, B0); PG8_BAR; PG8_SCHED;
            PG8_LDB(B1, 0, 1); PG8_STAGE(PG8_SB(0, 0), b2, voffB);
            PG8_BAR; PG8_WAIT_L(0); PG8_MMA(0, 1, At, B1); PG8_BAR;
            PG8_LDA(At, 0, 1); PG8_STAGE(PG8_SA(0, 0), a2, voffA);
            PG8_BAR; PG8_WAIT_L(0); PG8_MMA(1, 0, At, B0); PG8_BAR; PG8_SCHED;
            PG8_STAGE(PG8_SB(0, 1), b2 + hstepB, voffB);
            PG8_WAIT_V(6); PG8_BAR; PG8_MMA(1, 1, At, B1); PG8_BAR;
            PG8_LDB(B0, 1, 0); PG8_SCHED; PG8_LDA(At, 1, 0); PG8_STAGE(PG8_SA(0, 1), a2 + hstepA, voffA);
            PG8_WAIT_L(8); PG8_BAR; PG8_WAIT_L(0); PG8_MMA(0, 0, At, B0); PG8_BAR; PG8_SCHED;
            PG8_LDB(B1, 1, 1); PG8_STAGE(PG8_SB(1, 0), b3, voffB);
            PG8_BAR; PG8_WAIT_L(0); PG8_MMA(0, 1, At, B1); PG8_BAR;
            PG8_LDA(At, 1, 1); PG8_STAGE(PG8_SA(1, 0), a3, voffA);
            PG8_BAR; PG8_WAIT_L(0); PG8_MMA(1, 0, At, B0); PG8_BAR; PG8_SCHED;
            PG8_STAGE(PG8_SB(1, 1), b3 + hstepB, voffB);
            PG8_WAIT_V(6); PG8_BAR; PG8_MMA(1, 1, At, B1); PG8_BAR;
        }
        if constexpr (F8) asm volatile("s_nop 15\n\ts_nop 15" ::: "memory");
        E(acc, cur, wr, wc, fr, fq);
        if (!has_next) break;
#pragma unroll
        for (int a = 0; a < 2; ++a)
#pragma unroll
            for (int b = 0; b < 2; ++b)
#pragma unroll
                for (int m = 0; m < 4; ++m)
#pragma unroll
                    for (int n = 0; n < 2; ++n) acc[a][b][m][n] = (f32x4){0.f, 0.f, 0.f, 0.f};
        cur = nxt; cA = nA; cB = nB; ++ui;
    }
    PG8_WAIT_V(0);
    if (wr == 0) PG8_BAR;
    PG8_BAR;
#undef PG8_SA
#undef PG8_SB
#undef PG8_STAGE
#undef PG8_LDA
#undef PG8_LD32
#undef PG8_LDB
#undef PG8_MMA
#undef PG8_WAIT_V
#undef PG8_WAIT_L
#undef PG8_BAR
#undef PG8_SCHED
}

struct SchedGrid {
    const char* A; const char* B; size_t tstepA, tstepB; int nM, nN, nwg, G, c; bool mix32 = false;
    __device__ void init(const void* A_, int lda, const void* B_, int ldb, int M, int N, int G_, int c_, int esz = 2) {
        A = (const char*)A_; B = (const char*)B_; tstepA = (size_t)256 * lda * esz; tstepB = (size_t)256 * ldb * esz; nM = M / 256; nN = N / 256; nwg = nM * nN; G = G_; c = c_; }
    __device__ __forceinline__ bool next(int i, Unit& u) const {
        const long L = (long)i * G + c; if (L >= nwg) return false;
        int wgid = (int)L; { const int q = nwg / 8, r = nwg % 8, xcd = wgid % 8, off = wgid / 8; wgid = (xcd < r ? xcd * (q + 1) : r * (q + 1) + (xcd - r) * q) + off; }
        const int nig = 8 * nN, gid = wgid / nig, fm = gid * 8, gsz = (nM - fm) < 8 ? (nM - fm) : 8;
        u.pm = fm + ((wgid % nig) % gsz); u.pn = (wgid % nig) / gsz; u.grp = 0;
        if (mix32) { const int a = u.pn >> 4, r4 = (u.pn >> 2) & 3, r = u.pn & 3; u.pn = ((r4 & 1) << 4) | (a << 3) | ((r4 >> 1) << 2) | r; }
        u.a = A + (size_t)u.pm * tstepA; u.b = B + (size_t)u.pn * tstepB; return true;
    }
};
struct SchedGroup {
    const char* A; const char* B; size_t tstepA, tstepB, gstepA, gstepB; int nM, nN, total, G, c;
    __device__ void init(const void* A_, int lda, size_t gA, const void* B_, int ldb, size_t gB, int nM_, int nN_, int NG, int G_, int c_, int esz = 2) {
        A = (const char*)A_; B = (const char*)B_; tstepA = (size_t)256 * lda * esz; tstepB = (size_t)256 * ldb * esz; gstepA = gA; gstepB = gB; nM = nM_; nN = nN_; total = NG * nM_ * nN_; G = G_; c = c_; }
    __device__ __forceinline__ bool next(int i, Unit& u) const {
        const long L = (long)i * G + c; if (L >= total) return false;
        const int per = nM * nN, g = (int)L / per, r = (int)L % per;
        u.grp = g; u.pm = r % nM; u.pn = r / nM;
        u.a = A + (size_t)g * gstepA + (size_t)u.pm * tstepA; u.b = B + (size_t)g * gstepB + (size_t)u.pn * tstepB; return true;
    }
};
}

#define EPI_LANES int tz_ = tid_now(); asm volatile("" : "+v"(tz_)); const int wr = tz_ >> 8, wc = (tz_ >> 6) & 3, fr = tz_ & 15, fq = (tz_ >> 4) & 3;
#define EPI_ROWVALS(name, ptr, base) float name[2][4]; _Pragma("unroll") for (int ai = 0; ai < 2; ++ai) _Pragma("unroll") for (int m = 0; m < 4; ++m) name[ai][m] = (ptr)[(base) + ai * 128 + wr * 64 + m * 16 + fr];
#define EPI_FOR _Pragma("unroll") for (int ai = 0; ai < 2; ++ai) _Pragma("unroll") for (int m = 0; m < 4; ++m)
#define EPI_RL const int rl = ai * 128 + wr * 64 + m * 16 + fr;
__device__ __forceinline__ u32x4 pack8(const f32x4 a, const f32x4 b) { u32x4 w; w.x = cvt_pk_bf16(a[0], a[1]); w.y = cvt_pk_bf16(a[2], a[3]); w.z = cvt_pk_bf16(b[0], b[1]); w.w = cvt_pk_bf16(b[2], b[3]); return w; }
__device__ __forceinline__ void unpack8(const u32x4 w, f32x4& a, f32x4& b) { a = (f32x4){bf_lo(w.x), bf_hi(w.x), bf_lo(w.y), bf_hi(w.y)}; b = (f32x4){bf_lo(w.z), bf_hi(w.z), bf_lo(w.w), bf_hi(w.w)}; }

struct EpiInProj {
    static constexpr bool HAS_MID = false;
    const float* rinv; bf16_t *UA, *Q, *Kb, *V, *G; const float *qg, *kg;
    __device__ __forceinline__ void operator()(const pg::Acc& acc, const pg::Unit& u, int, int, int, int) const { EPI_LANES
        const int pn = u.pn, row0 = u.pm * 256;
        EPI_ROWVALS(rsv, rinv, row0)
        if (pn < 4) {
            EPI_FOR { EPI_RL const int tok = row0 + rl; const float rs = rsv[ai][m]; const int c = tok >> 5, tau = tok & 31;
#pragma unroll
                for (int bj = 0; bj < 2; ++bj) { const int ch = 256 * pn + 64 * wc + 32 * bj + 8 * fq, g = ch >> 4, p0 = ch & 15;
                    *(u32x4*)(UA + ((size_t)(g * NCH + c) * UAW + tau * 16 + p0)) = pack8(acc[ai][bj][m][0] * rs, acc[ai][bj][m][1] * rs); } }
        } else if (pn < 12) {
            const bool isq = pn < 8; const int col0 = 256 * (pn - (isq ? 4 : 8)) + 64 * wc; const float* gp = isq ? qg : kg; const float sc = isq ? 0.125f * LOG2E : 1.f;
            bf16_t* dst = isq ? Q : Kb;
            f32x4 gv[2][2];
#pragma unroll
            for (int bj = 0; bj < 2; ++bj)
#pragma unroll
                for (int n = 0; n < 2; ++n) gv[bj][n] = *(const f32x4*)(gp + 32 * bj + 8 * fq + 4 * n) * sc;
            EPI_FOR { EPI_RL const int tok = row0 + rl; const float rs = rsv[ai][m];
                f32x4 v[2][2]; float ss = 0.f;
#pragma unroll
                for (int bj = 0; bj < 2; ++bj)
#pragma unroll
                    for (int n = 0; n < 2; ++n) { v[bj][n] = acc[ai][bj][m][n] * rs; ss += v[bj][n][0] * v[bj][n][0] + v[bj][n][1] * v[bj][n][1] + v[bj][n][2] * v[bj][n][2] + v[bj][n][3] * v[bj][n][3]; }
                ss += __shfl_xor(ss, 16); ss += __shfl_xor(ss, 32);
                const float r = __builtin_amdgcn_rsqf(ss * (1.f / 64.f) + EPS);
#pragma unroll
                for (int bj = 0; bj < 2; ++bj)
                    *(u32x4*)(dst + (size_t)tok * 1024 + col0 + 32 * bj + 8 * fq) = pack8(v[bj][0] * r * gv[bj][0], v[bj][1] * r * gv[bj][1]); }
        } else {
            EPI_FOR { EPI_RL const int tok = row0 + rl; const float rs = rsv[ai][m];
#pragma unroll
                for (int bj = 0; bj < 2; ++bj)
                    *(u32x4*)(V + (size_t)tok * 1024 + 256 * (pn - 12) + 64 * wc + 32 * bj + 8 * fq) = pack8(acc[ai][bj][m][0] * rs, acc[ai][bj][m][1] * rs); }
        }
    }
};
struct EpiGates {
    static constexpr bool HAS_MID = false;
    const float* rinv; bf16_t* G;
    __device__ __forceinline__ void operator()(const pg::Acc& acc, const pg::Unit& u, int, int, int, int) const { EPI_LANES
        EPI_ROWVALS(rsv, rinv, u.pm * 256)
        EPI_FOR { EPI_RL const int tok = u.pm * 256 + rl; const float rs = rsv[ai][m];
#pragma unroll
            for (int bj = 0; bj < 2; ++bj) { f32x4 a = acc[ai][bj][m][0] * rs, b = acc[ai][bj][m][1] * rs;
#pragma unroll
                for (int j = 0; j < 4; ++j) { a[j] = fast_sigmoid(a[j]); b[j] = fast_sigmoid(b[j]); }
                *(u32x4*)(G + (size_t)tok * 4096 + 256 * u.pn + 64 * wc + 32 * bj + 8 * fq) = pack8(a, b); } }
    }
};
struct EpiSsum {
    static constexpr bool HAS_MID = false;
    float* SS;
    __device__ __forceinline__ void operator()(const pg::Acc& acc, const pg::Unit& u, int, int, int, int) const { EPI_LANES
        EPI_FOR { EPI_RL float* rp = SS + ((size_t)u.grp * NCH + rl) * 256 + 64 * wc + 8 * fq;
#pragma unroll
            for (int bj = 0; bj < 2; ++bj) { *(f32x4*)(rp + 32 * bj) = acc[ai][bj][m][0]; *(f32x4*)(rp + 32 * bj + 4) = acc[ai][bj][m][1]; } }
    }
};
__device__ __forceinline__ float gelu_tanh(float x) {
    const float t = 1.5957691216057308f * (x + 0.044715f * x * x * x);
    return x * fast_sigmoid(t);
}
struct EpiSsmOut {
    static constexpr bool HAS_MID = false;
    bf16_t* Y;
    __device__ __forceinline__ void operator()(const pg::Acc& acc, const pg::Unit& u, int, int, int, int) const { EPI_LANES
        EPI_FOR { EPI_RL
#pragma unroll
            for (int bj = 0; bj < 2; ++bj) { const int col = 256 * u.pn + 64 * wc + 32 * bj + 8 * fq, t = col >> 4, p0 = col & 15;
                f32x4 a = acc[ai][bj][m][0], b = acc[ai][bj][m][1];
#pragma unroll
                for (int j = 0; j < 4; ++j) { a[j] = gelu_tanh(a[j]); b[j] = gelu_tanh(b[j]); }
                *(u32x4*)(Y + (size_t)(rl * TC + t) * SSMW + u.grp * GP + p0) = pack8(a, b); } }
    }
};
struct EpiGlu {
    static constexpr bool HAS_MID = false;
    const bf16_t* Y; bf16_t* YO;
    __device__ __forceinline__ void operator()(const pg::Acc& acc, const pg::Unit& u, int, int, int, int) const { EPI_LANES
        const int colb = 256 * u.pn + 64 * wc + 8 * fq; const size_t rb = (size_t)(u.pm * 256 + wr * 64 + fr);
        u32x4 cur[2], nxt[2];
        cur[0] = *(const u32x4*)(Y + rb * SSMW + colb); cur[1] = *(const u32x4*)(Y + rb * SSMW + colb + 32);
#pragma unroll
        for (int r_ = 0; r_ < 8; ++r_) { const int ai = r_ >> 2, m = r_ & 3; const size_t tok = rb + ai * 128 + m * 16;
            if (r_ < 7) { const size_t tn = rb + ((r_ + 1) >> 2) * 128 + ((r_ + 1) & 3) * 16; nxt[0] = *(const u32x4*)(Y + tn * SSMW + colb); nxt[1] = *(const u32x4*)(Y + tn * SSMW + colb + 32); }
#pragma unroll
            for (int bj = 0; bj < 2; ++bj) { f32x4 ya, yb; unpack8(cur[bj], ya, yb);
                f32x4 a = acc[ai][bj][m][0], b = acc[ai][bj][m][1];
#pragma unroll
                for (int j = 0; j < 4; ++j) { a[j] = ya[j] * fast_sigmoid(a[j]); b[j] = yb[j] * fast_sigmoid(b[j]); }
                *(u32x4*)(YO + tok * 2048 + colb + 32 * bj) = pack8(a, b); }
            cur[0] = nxt[0]; cur[1] = nxt[1]; }
    }
};
struct EpiMerge {
    static constexpr bool HAS_MID = true;
    const bf16_t* G; bf16_t* MG;
    __device__ __forceinline__ void mid(pg::Acc& acc, const pg::Unit& u, int, int, int, int) const { EPI_LANES
        const int colb = 256 * u.pn + 64 * wc + 8 * fq; const size_t rb = (size_t)(u.pm * 256 + wr * 64 + fr);
        u32x4 cur[4], nxt[4];
#pragma unroll
        for (int q = 0; q < 4; ++q) cur[q] = *(const u32x4*)(G + rb * 4096 + (q >> 1) * 2048 + colb + 32 * (q & 1));
#pragma unroll
        for (int r_ = 0; r_ < 8; ++r_) { const int ai = r_ >> 2, m = r_ & 3;
            if (r_ < 7) { const size_t tn = rb + ((r_ + 1) >> 2) * 128 + ((r_ + 1) & 3) * 16;
#pragma unroll
                for (int q = 0; q < 4; ++q) nxt[q] = *(const u32x4*)(G + tn * 4096 + (q >> 1) * 2048 + colb + 32 * (q & 1)); }
#pragma unroll
            for (int bj = 0; bj < 2; ++bj) { f32x4 sa, sb, ga, gb; unpack8(cur[bj], sa, sb); unpack8(cur[2 + bj], ga, gb);
#pragma unroll
                for (int j = 0; j < 4; ++j) { acc[ai][bj][m][0][j] *= sa[j] * __builtin_amdgcn_rcpf(ga[j]); acc[ai][bj][m][1][j] *= sb[j] * __builtin_amdgcn_rcpf(gb[j]); } }
#pragma unroll
            for (int q = 0; q < 4; ++q) cur[q] = nxt[q];
            __builtin_amdgcn_sched_barrier(0); }
    }
    __device__ __forceinline__ void operator()(const pg::Acc& acc, const pg::Unit& u, int, int, int, int) const { EPI_LANES
        const int colb = 256 * u.pn + 64 * wc + 8 * fq; const size_t rb = (size_t)(u.pm * 256 + wr * 64 + fr);
        u32x4 cur[2], nxt[2];
        cur[0] = *(const u32x4*)(G + rb * 4096 + 2048 + colb); cur[1] = *(const u32x4*)(G + rb * 4096 + 2048 + colb + 32);
#pragma unroll
        for (int r_ = 0; r_ < 8; ++r_) { const int ai = r_ >> 2, m = r_ & 3; const size_t tok = rb + ai * 128 + m * 16;
            if (r_ < 7) { const size_t tn = rb + ((r_ + 1) >> 2) * 128 + ((r_ + 1) & 3) * 16; nxt[0] = *(const u32x4*)(G + tn * 4096 + 2048 + colb); nxt[1] = *(const u32x4*)(G + tn * 4096 + 2048 + colb + 32); }
#pragma unroll
            for (int bj = 0; bj < 2; ++bj) { f32x4 ga, gb; unpack8(cur[bj], ga, gb);
                *(u32x4*)(MG + tok * 2048 + colb + 32 * bj) = pack8(acc[ai][bj][m][0] * ga, acc[ai][bj][m][1] * gb); }
            cur[0] = nxt[0]; cur[1] = nxt[1]; }
    }
};
struct EpiOutProj {
    static constexpr bool HAS_MID = false;
    const bf16_t* XR; bf16_t* XO;
    __device__ __forceinline__ void operator()(const pg::Acc& acc, const pg::Unit& u, int, int, int, int) const { EPI_LANES
        const int colb = 256 * u.pn + 64 * wc + 8 * fq; const size_t rb = (size_t)(u.pm * 256 + wr * 64 + fr);
        u32x4 cur[2], nxt[2];
        cur[0] = *(const u32x4*)(XR + rb * 2048 + colb); cur[1] = *(const u32x4*)(XR + rb * 2048 + colb + 32);
#pragma unroll
        for (int r_ = 0; r_ < 8; ++r_) { const int ai = r_ >> 2, m = r_ & 3; const size_t tok = rb + ai * 128 + m * 16;
            if (r_ < 7) { const size_t tn = rb + ((r_ + 1) >> 2) * 128 + ((r_ + 1) & 3) * 16; nxt[0] = *(const u32x4*)(XR + tn * 2048 + colb); nxt[1] = *(const u32x4*)(XR + tn * 2048 + colb + 32); }
#pragma unroll
            for (int bj = 0; bj < 2; ++bj) { f32x4 a, b; unpack8(cur[bj], a, b);
                *(u32x4*)(XO + tok * 2048 + colb + 32 * bj) = pack8(a + acc[ai][bj][m][0], b + acc[ai][bj][m][1]); }
            cur[0] = nxt[0]; cur[1] = nxt[1]; }
    }
};
struct EpiExp1 {
    static constexpr bool HAS_MID = false;
    const float* RSL; bf16_t* H;
    __device__ __forceinline__ void operator()(const pg::Acc& acc, const pg::Unit& u, int, int, int, int) const { EPI_LANES
        EPI_ROWVALS(rsv, RSL, u.grp * CAP + u.pm * 256)
        EPI_FOR { EPI_RL const int row = u.grp * CAP + u.pm * 256 + rl; const float rs = rsv[ai][m];
            f32x4 h[2];
#pragma unroll
            for (int n = 0; n < 2; ++n)
#pragma unroll
                for (int j = 0; j < 4; ++j) { const float g = acc[ai][0][m][n][j] * rs, up = acc[ai][1][m][n][j] * rs; h[n][j] = g * fast_sigmoid(g) * up; }
            *(u32x2*)((unsigned char*)H + (size_t)row * FF + 128 * u.pn + 32 * wc + 8 * fq) = pack8_fp8(h[0] * H8_SCALE, h[1] * H8_SCALE); }
    }
};
struct EpiExp2 {
    static constexpr bool HAS_MID = false;
    const float* GATE; bf16_t* YX;
    __device__ __forceinline__ void operator()(const pg::Acc& acc, const pg::Unit& u, int, int, int, int) const { EPI_LANES
        EPI_ROWVALS(gtv, GATE, u.grp * CAP + u.pm * 256)
        EPI_FOR { EPI_RL const int row = u.grp * CAP + u.pm * 256 + rl; const float gt = gtv[ai][m];
#pragma unroll
            for (int bj = 0; bj < 2; ++bj)
                *(u32x4*)(YX + (size_t)row * D + 256 * u.pn + 64 * wc + 32 * bj + 8 * fq) = pack8(acc[ai][bj][m][0] * gt, acc[ai][bj][m][1] * gt); }
    }
};


struct CJob { const float* src; unsigned char* dst; int on; };
constexpr unsigned CJ_N = 2048u;
__device__ __forceinline__ void cj_load(const CJob& J, unsigned soff, int j, f32x4 (&v)[2]) {
    const char* p = (const char*)J.src + (size_t)j * 32u * CJ_N; asm volatile("" : "+v"(soff));
#pragma unroll
    for (int jj = 0; jj < 2; ++jj) v[jj] = __builtin_nontemporal_load((const f32x4*)(p + (size_t)jj * 16u * CJ_N + soff));
}
__device__ __forceinline__ f32x4 cj_tr(const f32x4 v) {
    unsigned x0 = __float_as_uint(v[0]), x1 = __float_as_uint(v[1]), x2 = __float_as_uint(v[2]), x3 = __float_as_uint(v[3]);
    { auto a = __builtin_amdgcn_permlane32_swap(x0, x2, false, false); x0 = a[0]; x2 = a[1]; }
    { auto a = __builtin_amdgcn_permlane32_swap(x1, x3, false, false); x1 = a[0]; x3 = a[1]; }
    { auto a = __builtin_amdgcn_permlane16_swap(x0, x1, false, false); x0 = a[0]; x1 = a[1]; }
    { auto a = __builtin_amdgcn_permlane16_swap(x2, x3, false, false); x2 = a[0]; x3 = a[1]; }
    return (f32x4){__uint_as_float(x0), __uint_as_float(x1), __uint_as_float(x2), __uint_as_float(x3)};
}
__device__ __forceinline__ void cj_store(const CJob& J, unsigned doff, int j, const f32x4 (&v)[2]) {
    asm volatile("" : "+v"(doff));
    const f32x4 t0 = cj_tr(v[0]) * W8_SCALE, t1 = cj_tr(v[1]) * W8_SCALE;
    *(u32x2*)(J.dst + doff + 8u * (unsigned)j) = pack8_fp8(t0, t1);
}
namespace att {
constexpr int KVBLK = 64, QBLK = 32;
constexpr int SHM_T = KVBLK * 256;
constexpr int OFF_K = 0, OFF_V = 3 * SHM_T, OFF_Q = 5 * SHM_T, OFF_WS = OFF_Q + 8 * 8192, OFF_BT = OFF_WS + 8 * 64 * 4, ATT_LDS_END = OFF_BT + 2048;
#define KSWZ(row, colB) ((row) * 256 + ((colB) ^ (((row) & 7) << 4)))
#define SBAR() __builtin_amdgcn_sched_barrier(0)
__device__ __forceinline__ int crow(int r, int hi) { return (r & 3) + 8 * (r >> 2) + 4 * hi; }
__device__ __forceinline__ int v_rd_base(int lane) { return ((lane & 3) << 3) | (((lane >> 2) & 3) << 6) | (((lane >> 4) & 1) << 5) | (((lane >> 5) & 1) << 8); }
constexpr int v_rd_off(int d0, int ks, int half) { return d0 * 512 + ks * 4096 + half * 2048; }
template <int OFF> __device__ __forceinline__ s16x4 tr_read(int vb) { s16x4 r; asm volatile("ds_read_b64_tr_b16 %0, %1 offset:%2" : "=&v"(r) : "v"(vb), "i"(OFF) : "memory"); return r; }
template <int D0> __device__ __forceinline__ void pv_one(f32x16& od, int vb, bf16x8 pa0, bf16x8 pa1, bf16x8 pa2, bf16x8 pa3) {
    const s16x4 l0 = tr_read<v_rd_off(D0, 0, 0)>(vb), h0 = tr_read<v_rd_off(D0, 0, 1)>(vb), l1 = tr_read<v_rd_off(D0, 1, 0)>(vb), h1 = tr_read<v_rd_off(D0, 1, 1)>(vb);
    const s16x4 l2 = tr_read<v_rd_off(D0, 2, 0)>(vb), h2 = tr_read<v_rd_off(D0, 2, 1)>(vb), l3 = tr_read<v_rd_off(D0, 3, 0)>(vb), h3 = tr_read<v_rd_off(D0, 3, 1)>(vb);
    asm volatile("s_waitcnt lgkmcnt(0)" ::: "memory"); SBAR();
#define PK(L, H) (bf16x8){L[0], L[1], L[2], L[3], H[0], H[1], H[2], H[3]}
    od = __builtin_amdgcn_mfma_f32_32x32x16_bf16(pa0, PK(l0, h0), od, 0, 0, 0);
    od = __builtin_amdgcn_mfma_f32_32x32x16_bf16(pa1, PK(l1, h1), od, 0, 0, 0);
    od = __builtin_amdgcn_mfma_f32_32x32x16_bf16(pa2, PK(l2, h2), od, 0, 0, 0);
    od = __builtin_amdgcn_mfma_f32_32x32x16_bf16(pa3, PK(l3, h3), od, 0, 0, 0);
#undef PK
}
__device__ __forceinline__ void pv_d0(f32x16* o, int vb, bf16x8 pa0, bf16x8 pa1, bf16x8 pa2, bf16x8 pa3) {
    pv_one<0>(o[0], vb, pa0, pa1, pa2, pa3); pv_one<1>(o[1], vb, pa0, pa1, pa2, pa3); pv_one<2>(o[2], vb, pa0, pa1, pa2, pa3); pv_one<3>(o[3], vb, pa0, pa1, pa2, pa3);
}
__device__ __forceinline__ int kq_addr(int row, int c) { return (c >> 2) * 4096 + row * 64 + (((c & 3) ^ ((row >> 2) & 3)) << 4); }
template <int COMP> __device__ __forceinline__ void qkt(f32x16& p0, f32x16& p1, const LAS char* Ks, const LAS char* Qs, int kq0, int kq1) {
    p0 = (f32x16){}; p1 = (f32x16){};
    bf16x8 b0[4], b1[4], qf[4];
#define QK_LD(d0) { constexpr int chi = COMP * 2 + ((d0) >> 1); const int a = ((d0) & 1) ? kq1 : kq0; \
        b0[d0] = *(const LAS bf16x8*)(Ks + a + chi * 4096); b1[d0] = *(const LAS bf16x8*)(Ks + a + chi * 4096 + 2048); qf[d0] = *(const LAS bf16x8*)(Qs + a + chi * 2048); }
#define QK_MM(d0) { p0 = __builtin_amdgcn_mfma_f32_32x32x16_bf16(b0[d0], qf[d0], p0, 0, 0, 0); p1 = __builtin_amdgcn_mfma_f32_32x32x16_bf16(b1[d0], qf[d0], p1, 0, 0, 0); }
    QK_LD(0) QK_LD(1) SBAR();
    QK_MM(0) QK_MM(1) QK_LD(2) QK_LD(3) SBAR();
    QK_MM(2) QK_MM(3)
#undef QK_LD
#undef QK_MM
}
__device__ __forceinline__ void sm_exp(f32x16& p0, f32x16& p1, const LAS float* bt, int relb, int dq, int hi) {
    if (dq > -191 && dq < 158) {
        const LAS float* bp = bt + relb + 4 * hi;
#pragma unroll
        for (int a = 0; a < 4; ++a) {
            float t0[4], t1[4];
#pragma unroll
            for (int b = 0; b < 4; ++b) { t0[b] = bp[8 * a + b]; t1[b] = bp[32 + 8 * a + b]; }
#pragma unroll
            for (int b = 0; b < 4; ++b) { p0[4 * a + b] += t0[b]; p1[4 * a + b] += t1[b]; }
            SBAR();
        } }
#pragma unroll
    for (int r = 0; r < 16; ++r) p0[r] = __builtin_amdgcn_exp2f(p0[r]);
#pragma unroll
    for (int r = 0; r < 16; ++r) p1[r] = __builtin_amdgcn_exp2f(p1[r]);
}
__device__ __forceinline__ void sm_fin(f32x16& p0, f32x16& p1, float& l_reg, bf16x8& pa0, bf16x8& pa1, bf16x8& pa2, bf16x8& pa3) {
    float ps = 0;
#pragma unroll
    for (int r = 0; r < 16; ++r) ps += p0[r];
#pragma unroll
    for (int r = 0; r < 16; ++r) ps += p1[r];
    { auto rr = __builtin_amdgcn_permlane32_swap(__float_as_uint(ps), __float_as_uint(ps), false, false);
      ps = __uint_as_float(rr[0]) + __uint_as_float(rr[1]); }
    l_reg += ps;
#define PK4(P, BASE, OUT) do { unsigned a0 = cvt_pk_bf16(P[BASE + 0], P[BASE + 1]), a1 = cvt_pk_bf16(P[BASE + 2], P[BASE + 3]);   \
    unsigned b0 = cvt_pk_bf16(P[BASE + 4], P[BASE + 5]), b1 = cvt_pk_bf16(P[BASE + 6], P[BASE + 7]);                              \
    auto r0 = __builtin_amdgcn_permlane32_swap(a0, b0, false, false); auto r1 = __builtin_amdgcn_permlane32_swap(a1, b1, false, false); \
    u32x4 w = {r0[0], r1[0], r0[1], r1[1]}; OUT = *reinterpret_cast<bf16x8*>(&w); } while (0)
    PK4(p0, 0, pa0); PK4(p0, 8, pa1); PK4(p1, 0, pa2); PK4(p1, 8, pa3);
#undef PK4
}
__device__ __forceinline__ void attn_dual(f32x16 (&o1)[4], f32x16 (&o2)[4], const bf16_t* __restrict__ Qg, const bf16_t* __restrict__ Kh, const bf16_t* __restrict__ Vh, LAS char* lds, int q0w, const CJob& J) {
    int tz_ = tid_now(); asm volatile("" : "+v"(tz_));
    const int tid = tz_, wid = __builtin_amdgcn_readfirstlane(tid >> 6), lane = tid & 63, r32 = lane & 31, hi = lane >> 5;
    LAS char* K_lds = lds + OFF_K; LAS char* V_lds = lds + OFF_V; LAS char* Qs = lds + OFF_Q + wid * 8192;
    const LAS float* bt = (const LAS float*)(lds + OFF_BT);
    float l1 = 0.f, l2 = 0.f;
#pragma unroll
    for (int d = 0; d < 4; ++d) { o1[d] = (f32x16){}; o2[d] = (f32x16){}; }
#pragma unroll
    for (int i = 0; i < 8; ++i) { const int ci = i * 64 + lane, row = (ci >> 2) & 31, c = (ci >> 7) * 4 + ((ci & 3) ^ ((row >> 2) & 3));
        __builtin_amdgcn_global_load_lds((const unsigned*)(Qg + (size_t)row * 1024 + c * 8), (LAS unsigned*)(Qs + i * 1024), 16, 0, 0); }
    const int kq0 = r32 * 64 + ((hi ^ ((r32 >> 2) & 3)) << 4), kq1 = r32 * 64 + (((2 + hi) ^ ((r32 >> 2) & 3)) << 4);
    unsigned ko0, vo0;
    { const int p = wid * 2;
        { const int ci = p * 64 + lane, row = (ci >> 2) & 63, c = (ci >> 8) * 4 + ((ci & 3) ^ ((row >> 2) & 3)); ko0 = (unsigned)(row * 1024 + c * 8) * 2u; }
        { const int ci = p * 64 + lane, sub = ci >> 5, kk = (sub >> 2) * 8 + ((ci >> 2) & 7), c = (sub & 3) * 32 + (ci & 3) * 8;
          const int k = (kk & ~0xC) | ((kk & 4) << 1) | ((kk & 8) >> 1); vo0 = (unsigned)(k * 1024 + c) * 2u; } }
    const unsigned pw = (unsigned)wid * 2048u;
#define DMA_K(buf, k0) do { const char* g_ = (const char*)(Kh + (size_t)(k0) * 1024); unsigned o_ = ko0; asm volatile("" : "+v"(o_)); \
    __builtin_amdgcn_global_load_lds((const unsigned*)(g_ + o_), (LAS unsigned*)(K_lds + (buf) * SHM_T + pw), 16, 0, 0); \
    __builtin_amdgcn_global_load_lds((const unsigned*)(g_ + o_ + 32768u), (LAS unsigned*)(K_lds + (buf) * SHM_T + pw + 1024), 16, 0, 0); } while (0)
#define DMA_V(buf, k0) do { const char* g_ = (const char*)(Vh + (size_t)(k0) * 1024); unsigned o_ = vo0; asm volatile("" : "+v"(o_)); \
    __builtin_amdgcn_global_load_lds((const unsigned*)(g_ + o_), (LAS unsigned*)(V_lds + (buf) * SHM_T + pw), 16, 0, 0); \
    __builtin_amdgcn_global_load_lds((const unsigned*)(g_ + o_ + 128u), (LAS unsigned*)(V_lds + (buf) * SHM_T + pw + 1024), 16, 0, 0); } while (0)
    const int vbb = (int)(size_t)V_lds + v_rd_base(lane);
    const int relq = 256 - (q0w + r32);
    f32x16 pA0, pA1, pB0, pB1; bf16x8 pa0, pa1, pa2, pa3; constexpr int NT = S / KVBLK;
#define CJ_SOFF() ({ const int l_ = lane_now(); (unsigned)((l_ >> 4) * (int)CJ_N + 4 * (l_ & 15)) * 4u; })
#define CJ_DOFF() ({ const int l_ = lane_now(); (unsigned)(4 * (l_ & 15) + (l_ >> 4)) * CJ_N; })
    f32x4 cv[2] = {{0.f, 0.f, 0.f, 0.f}, {0.f, 0.f, 0.f, 0.f}}; const int cjon = J.on;
    DMA_K(0, 0); DMA_K(1, KVBLK); DMA_V(0, 0);
    asm volatile("s_waitcnt vmcnt(0) lgkmcnt(0)" ::: "memory"); __syncthreads();
    qkt<0>(pA0, pA1, K_lds, Qs, kq0, kq1); sm_exp(pA0, pA1, bt, relq, 0 - q0w, hi);
    int kb = 0, vb = 0;
    int ureg = (0 - q0w <= -191) ? 0 : ((0 - q0w >= 158) ? 2 : 1);
    for (int j = 0; j < NT; ++j) {
        asm volatile("s_waitcnt vmcnt(0)" ::: "memory"); __syncthreads();
        const int kb1 = kb == 2 ? 0 : kb + 1, kb2 = kb1 == 2 ? 0 : kb1 + 1;
        if (cjon && j >= 1) cj_store(J, CJ_DOFF(), j - 1, cv);
        if (j + 2 < NT) DMA_K(kb2, (j + 2) * KVBLK);
        if (j + 1 < NT) DMA_V(vb ^ 1, (j + 1) * KVBLK);
        if (cjon) cj_load(J, CJ_SOFF(), j, cv);
        const int dq = j * KVBLK - q0w;
        { const int u = (dq <= -191) ? 0 : ((dq >= 158) ? 2 : 1);
          if (u != ureg) {
              const float cp = ureg == 0 ? bt[0] : (ureg == 2 ? bt[511] : 0.f), cn = u == 0 ? bt[0] : (u == 2 ? bt[511] : 0.f);
              const float f = __builtin_amdgcn_exp2f(cp - cn);
#pragma unroll
              for (int d = 0; d < 4; ++d) { o1[d] = o1[d] * f; o2[d] = o2[d] * f; }
              l1 *= f; l2 *= f; ureg = u; } }
        sm_fin(pA0, pA1, l1, pa0, pa1, pa2, pa3); SBAR();
        qkt<1>(pB0, pB1, K_lds + kb * SHM_T, Qs, kq0, kq1); SBAR();
        pv_d0(o1, vbb + vb * SHM_T, pa0, pa1, pa2, pa3);
        sm_exp(pB0, pB1, bt, relq + j * KVBLK, dq, hi);
        sm_fin(pB0, pB1, l2, pa0, pa1, pa2, pa3); SBAR();
        if (j + 1 < NT) { qkt<0>(pA0, pA1, K_lds + kb1 * SHM_T, Qs, kq0, kq1); SBAR(); }
        pv_d0(o2, vbb + vb * SHM_T, pa0, pa1, pa2, pa3);
        if (j + 1 < NT) sm_exp(pA0, pA1, bt, relq + (j + 1) * KVBLK, dq + KVBLK, hi);
        kb = kb1; vb ^= 1;
    }
    if (cjon) { int jl = NT - 1; asm volatile("s_waitcnt vmcnt(0)" : "+s"(jl) :: "memory"); cj_store(J, CJ_DOFF(), jl, cv); }
    const int ln2_ = lane_now(), r32b = ln2_ & 31, hib = ln2_ >> 5;
    LAS float* li2 = (LAS float*)(lds + OFF_WS) + wid * 64;
    if (hib == 0) li2[r32b] = l1; asm volatile("s_waitcnt lgkmcnt(0)" ::: "memory");
#pragma unroll
    for (int r = 0; r < 16; ++r) { const float rl = __builtin_amdgcn_rcpf(li2[crow(r, hib)]);
#pragma unroll
        for (int d = 0; d < 4; ++d) o1[d][r] *= rl; }
    asm volatile("s_waitcnt lgkmcnt(0)" ::: "memory");
    if (hib == 0) li2[r32b] = l2; asm volatile("s_waitcnt lgkmcnt(0)" ::: "memory");
#pragma unroll
    for (int r = 0; r < 16; ++r) { const float rl = __builtin_amdgcn_rcpf(li2[crow(r, hib)]);
#pragma unroll
        for (int d = 0; d < 4; ++d) o2[d][r] *= rl; }
#undef DMA_K
#undef DMA_V
}
}

__device__ __forceinline__ int t5_bucket(int rel) {
    const int side = rel > 0 ? 16 : 0; const int n = rel < 0 ? -rel : rel;
    if (n < 8) return side + n;
    const float v = logf((float)n / 8.0f) / 2.7725887f * 8.0f;
    int large = 8 + (int)v; large = large < 15 ? large : 15;
    return side + large;
}

struct Args { GAS const float* in[28]; GAS float* out; GAS unsigned char* ws; int ph_lo, ph_hi; };
typedef const Args __attribute__((address_space(4))) CArgs;
struct LayerW { bf16_t *WIN, *WGLU, *WBR, *WOUT, *WGU, *WD, *F, *BO; float *KTAB, *WRT; };
__device__ __forceinline__ LayerW layer_w(unsigned char* ws, int l) {
    unsigned char* b = ws + WS_LW + (size_t)l * LW_SIZE; LayerW w;
    w.WIN = (bf16_t*)(b + LW_WIN); w.WGLU = (bf16_t*)(b + LW_WGLU); w.WBR = (bf16_t*)(b + LW_WBR); w.WOUT = (bf16_t*)(b + LW_WOUT); w.WGU = (bf16_t*)(b + LW_WGU);
    w.WD = (bf16_t*)(b + LW_WD); w.F = (bf16_t*)(b + LW_F); w.BO = (bf16_t*)(b + LW_BO); w.KTAB = (float*)(b + LW_KTAB); w.WRT = (float*)(b + LW_WRT); return w;
}
enum { I_X = 0, I_WIN, I_ARE, I_AIM, I_LDT, I_BRE, I_BIM, I_CRE, I_CIM, I_SD, I_WGLU, I_WSB, I_QG, I_KG, I_LQ1, I_LK1, I_LQ2, I_LK2, I_SUBLN, I_WAB, I_RELB, I_WOUT,
       I_NMIX, I_NFFN, I_WR, I_WEG, I_WEU, I_WED };

struct TItem { const float* src; bf16_t* dst; const float* gain; int N, ldd, rowmode, f8; };
__device__ __forceinline__ void t_load(const TItem& t, f32x4 (&v)[16], int lane) {
    const int r = lane >> 4, q = lane & 15;
#pragma unroll
    for (int j = 0; j < 16; ++j) v[j] = __builtin_nontemporal_load((const f32x4*)(t.src + (size_t)(4 * j + r) * t.N + 4 * q));
}
__device__ __forceinline__ void t_lds(const f32x4 (&v)[16], LAS float* scr, int lane) {
    const int r = lane >> 4, q = lane & 15;
#pragma unroll
    for (int j = 0; j < 16; ++j) { LAS float* s = scr + (4 * j + r) * 65 + 4 * q; s[0] = v[j][0]; s[1] = v[j][1]; s[2] = v[j][2]; s[3] = v[j][3]; }
}
__device__ __forceinline__ void t_store(const TItem& t, int n0, LAS float* scr, int lane) {
    const int c = lane & 7;
    float gn[8];
#pragma unroll
    for (int i = 0; i < 8; ++i) gn[i] = t.gain ? t.gain[8 * c + i] : 1.f;
#pragma unroll
    for (int j = 0; j < 8; ++j) { const int n = (lane >> 3) + 8 * j; const LAS float* s = scr + (8 * c) * 65 + n;
        u32x4 o; o.x = cvt_pk_bf16(s[0 * 65] * gn[0], s[1 * 65] * gn[1]); o.y = cvt_pk_bf16(s[2 * 65] * gn[2], s[3 * 65] * gn[3]);
        o.z = cvt_pk_bf16(s[4 * 65] * gn[4], s[5 * 65] * gn[5]); o.w = cvt_pk_bf16(s[6 * 65] * gn[6], s[7 * 65] * gn[7]);
        const int ng = n0 + n; const int drow = t.rowmode == 0 ? ng : ((ng >> 7) * 256 + ((ng >> 5) & 3) * 64 + (ng & 31) + (t.rowmode == 2 ? 32 : 0));
        if (t.f8) { const f32x4 a = (f32x4){s[0 * 65] * gn[0], s[1 * 65] * gn[1], s[2 * 65] * gn[2], s[3 * 65] * gn[3]} * W8_SCALE, b = (f32x4){s[4 * 65] * gn[4], s[5 * 65] * gn[5], s[6 * 65] * gn[6], s[7 * 65] * gn[7]} * W8_SCALE;
            *(u32x2*)((unsigned char*)t.dst + (size_t)drow * t.ldd + 8 * c) = pack8_fp8(a, b); }
        else *(u32x4*)(t.dst + (size_t)drow * t.ldd + 8 * c) = o; }
}

constexpr int IT_WIN = (D / 64) * (INC / 64), IT_GLU = 16 * 16, IT_BR = 16 * 32, IT_OUT = 32 * 32, IT_E = 32 * 32;
constexpr int DQ_A_I = 6144, DQ_A_G = 512, DQ_B_I = 5120, DQ_B_G = 1024, DQ_C_I = 5120, DQ_C_G = 1024;
constexpr int DQ_A0 = 0, DQ_A1 = DQ_A0 + DQ_A_I, DQ_B0 = DQ_A1 + DQ_A_G, DQ_B1 = DQ_B0 + DQ_B_I, DQ_C0 = DQ_B1 + DQ_B_G, DQ_C1 = DQ_C0 + DQ_C_I, DQ_END = DQ_C1 + DQ_C_G;
constexpr int DEF_UP = DQ_END - NE * IT_E;
static_assert(DEF_UP >= 0 && DEF_UP <= NE * IT_E, "deferred share");
constexpr int IT_LAYER0 = IT_WIN + IT_GLU + 2 * IT_BR + IT_OUT + NE * IT_E - DEF_UP;
constexpr int IT_DOWN = NE * IT_E;
__device__ __forceinline__ TItem make_item(const float* src, bf16_t* dst, const float* gain, int N, int ldd, int rowmode, int f8, int r, int& n0) {
    const int nblk = N / 64, k0 = 64 * (r / nblk); n0 = 64 * (r % nblk);
    TItem t; t.src = src + (size_t)k0 * N + n0; t.dst = f8 ? (bf16_t*)((unsigned char*)dst + k0) : dst + k0; t.gain = gain ? gain + k0 : nullptr; t.N = N; t.ldd = ldd; t.rowmode = rowmode; t.f8 = f8; return t; }
struct DecMain { CArgs* ap; unsigned char* ws;
    __device__ __forceinline__ TItem operator()(int it, int& n0) const { CArgs& args = *ap;
        const int l = it / IT_LAYER0; int r = it % IT_LAYER0; const LayerW w = layer_w(ws, l);
        if (r < IT_WIN) { const bool gate = (r % (INC / 64)) >= 64;
            return gate ? make_item((const float*)args.in[I_WIN] + (size_t)l * D * INC, (bf16_t*)((unsigned char*)w.WIN + (size_t)16 * MiB - (size_t)4096 * D), (const float*)args.in[I_NMIX] + l * D, INC, D, 0, 1, r, n0)
                        : make_item((const float*)args.in[I_WIN] + (size_t)l * D * INC, w.WIN, (const float*)args.in[I_NMIX] + l * D, INC, D, 0, 0, r, n0); }
        if ((r -= IT_WIN) < IT_GLU) return make_item((const float*)args.in[I_WGLU] + (size_t)l * SSMW * SSMW, w.WGLU, nullptr, SSMW, SSMW, 0, 0, r, n0);
        if ((r -= IT_GLU) < IT_BR) return make_item((const float*)args.in[I_WSB] + (size_t)l * SSMW * D, w.WBR, nullptr, D, 2048, 0, 0, r, n0);
        if ((r -= IT_BR) < IT_BR) return make_item((const float*)args.in[I_WAB] + (size_t)l * 1024 * D, w.WBR + 1024, nullptr, D, 2048, 0, 0, r, n0);
        if ((r -= IT_BR) < IT_OUT) return make_item((const float*)args.in[I_WOUT] + (size_t)l * D * D, w.WOUT, nullptr, D, D, 0, 0, r, n0);
        r -= IT_OUT; const int which = r / (NE * IT_E), e = (r / IT_E) % NE; r = r % IT_E; const size_t eo = ((size_t)l * NE + e) * D * FF;
        return make_item((const float*)args.in[which == 0 ? I_WEG : I_WEU] + eo, (bf16_t*)((unsigned char*)w.WGU + (size_t)e * 4096 * D), (const float*)args.in[I_NFFN] + l * D, FF, D, which == 0 ? 1 : 2, 1, r, n0); } };
struct DecDown { CArgs* ap; unsigned char* ws; int l;
    __device__ __forceinline__ TItem operator()(int it, int& n0) const { CArgs& args = *ap; const LayerW w = layer_w(ws, l);
        if (it >= IT_DOWN) { const int uu = NE * IT_E - 1 - (it - IT_DOWN), e = uu / IT_E; const size_t eo = ((size_t)l * NE + e) * D * FF;
            return make_item((const float*)args.in[I_WEG] + eo, (bf16_t*)((unsigned char*)w.WGU + (size_t)e * 4096 * D), (const float*)args.in[I_NFFN] + l * D, FF, D, 1, 1, uu % IT_E, n0); }
        const int e = it / IT_E, r = it % IT_E; const size_t eo = ((size_t)l * NE + e) * D * FF;
        return make_item((const float*)args.in[I_WEU] + eo, (bf16_t*)((unsigned char*)w.WGU + (size_t)e * 4096 * D), (const float*)args.in[I_NFFN] + l * D, FF, D, 2, 1, r, n0); } };
struct DecDn { CArgs* ap; unsigned char* ws; int l;
    __device__ __forceinline__ TItem operator()(int it, int& n0) const { CArgs& args = *ap; const LayerW w = layer_w(ws, l);
        const int e = it / IT_E, r = it % IT_E; const size_t eo = ((size_t)l * NE + e) * D * FF;
        return make_item((const float*)args.in[I_WED] + eo, (bf16_t*)((unsigned char*)w.WD + (size_t)e * D * FF), nullptr, D, FF, 0, 1, r, n0); } };
template <class Dec> __device__ __forceinline__ void convert_items(const Dec& dec, int first, int end, int step, LAS float* scr, int lane) {
    f32x4 tv[16]; int n0c = 0, n0n = 0; TItem cur, nxt; cur.src = nullptr; cur.dst = nullptr; cur.gain = nullptr; cur.N = 0; cur.ldd = 0; cur.rowmode = 0; cur.f8 = 0; nxt = cur;
    int it = first;
    if (it < end) { cur = dec(it, n0c); t_load(cur, tv, lane); }
    for (; it < end; it += step) {
        t_lds(tv, scr, lane);
        if (it + step < end) { nxt = dec(it + step, n0n); t_load(nxt, tv, lane); }
        LDS_WAIT(); asm volatile("" ::: "memory");
        t_store(cur, n0c, scr, lane);
        LDS_WAIT(); asm volatile("" ::: "memory");
        cur = nxt; n0c = n0n; }
}

template <bool ROUTER>
__device__ __forceinline__ void row_pass(const float* xrow, bf16_t* xb, float* rinv_out, const LAS float* WtL, float* afft, int row, int lane, unsigned char* xb8 = nullptr) {
    f32x4 v[8]; float ss = 0.f;
#pragma unroll
    for (int j = 0; j < 8; ++j) { v[j] = *(const f32x4*)(xrow + 4 * lane + 256 * j); ss += v[j][0] * v[j][0] + v[j][1] * v[j][1] + v[j][2] * v[j][2] + v[j][3] * v[j][3]; }
    ss = wave_sum(ss);
    const float rinv = __builtin_amdgcn_rsqf(ss * (1.f / D) + EPS);
#pragma unroll
    for (int j = 0; j < 8; ++j) { u32x2 w; w.x = cvt_pk_bf16(v[j][0], v[j][1]); w.y = cvt_pk_bf16(v[j][2], v[j][3]); *(u32x2*)(xb + 4 * lane + 256 * j) = w; }
    if (xb8) {
#pragma unroll
        for (int j = 0; j < 8; ++j) { int w8 = 0; w8 = __builtin_amdgcn_cvt_pk_fp8_f32(v[j][0], v[j][1], w8, false); w8 = __builtin_amdgcn_cvt_pk_fp8_f32(v[j][2], v[j][3], w8, true); *(int*)(xb8 + 4 * lane + 256 * j) = w8; } }
    if (lane == 0) *rinv_out = rinv;
    if constexpr (ROUTER) {
        float lg[16];
#pragma unroll
        for (int e = 0; e < 16; ++e) { float a = 0.f;
#pragma unroll
            for (int j = 0; j < 8; ++j) { const f32x4 w = *(const LAS f32x4*)(WtL + e * 2048 + 4 * lane + 256 * j); a += v[j][0] * w[0] + v[j][1] * w[1] + v[j][2] * w[2] + v[j][3] * w[3]; }
            lg[e] = wave_sum(a) * rinv; }
        float mx = lg[0];
#pragma unroll
        for (int e = 1; e < 16; ++e) mx = fmaxf(mx, lg[e]);
        float sum = 0.f;
#pragma unroll
        for (int e = 0; e < 16; ++e) { lg[e] = __expf(lg[e] - mx); sum += lg[e]; }
        const float inv = 1.f / sum;
        float mine = 0.f;
#pragma unroll
        for (int e = 0; e < 16; ++e) mine = (lane == e) ? lg[e] * inv : mine;
        if (lane < 16) afft[(size_t)lane * S + row] = mine;
    }
}

__device__ __forceinline__ void router_row(const u32x2 (&xw)[8], float* rinv_out, const LAS float* WtL, float* afft, int row, int lane) {
    f32x4 v[8]; float ss = 0.f;
#pragma unroll
    for (int j = 0; j < 8; ++j) { const u32x2 w = xw[j]; v[j] = (f32x4){bf_lo(w.x), bf_hi(w.x), bf_lo(w.y), bf_hi(w.y)}; ss += v[j][0] * v[j][0] + v[j][1] * v[j][1] + v[j][2] * v[j][2] + v[j][3] * v[j][3]; }
    ss = wave_sum(ss);
    const float rinv = __builtin_amdgcn_rsqf(ss * (1.f / D) + EPS);
    if (lane == 0) *rinv_out = rinv;
    float lg[16];
#pragma unroll
    for (int e = 0; e < 16; ++e) { float a = 0.f;
#pragma unroll
        for (int j = 0; j < 8; ++j) { const f32x4 w = *(const LAS f32x4*)(WtL + e * 2048 + 4 * lane + 256 * j); a += v[j][0] * w[0] + v[j][1] * w[1] + v[j][2] * w[2] + v[j][3] * w[3]; }
        lg[e] = wave_sum(a) * rinv; }
    float mx = lg[0];
#pragma unroll
    for (int e = 1; e < 16; ++e) mx = fmaxf(mx, lg[e]);
    float sum = 0.f;
#pragma unroll
    for (int e = 0; e < 16; ++e) { lg[e] = __expf(lg[e] - mx); sum += lg[e]; }
    const float inv = 1.f / sum;
    float mine = 0.f;
#pragma unroll
    for (int e = 0; e < 16; ++e) mine = (lane == e) ? lg[e] * inv : mine;
    if (lane < 16) afft[(size_t)lane * S + row] = mine;
}
__device__ __forceinline__ int block_sum_i(int v, LAS int* red, int wave, int lane) {
#pragma unroll
    for (int o = 1; o < 64; o <<= 1) v += __shfl_xor(v, o);
    __syncthreads();
    if (lane == 0) red[wave] = v;
    __syncthreads();
    int t = 0;
#pragma unroll
    for (int w = 0; w < 8; ++w) t += red[w];
    return t;
}

__global__ void __launch_bounds__(512, 2) fwd(Args kargs) {
    extern __shared__ __attribute__((aligned(16))) unsigned char lds_raw[];
    LAS unsigned char* lds = (LAS unsigned char*)lds_raw;
    volatile LAS unsigned* MISC = (volatile LAS unsigned*)(lds + MISC_OFF);
    const int G = gridDim.x;
    unsigned* ctl = (unsigned*)((unsigned char*)kargs.ws + WS_CTL);
    if (threadIdx.x < 64) MISC[threadIdx.x] = 0u;
    if ((threadIdx.x & 63) == 0) *(volatile LAS int*)(unsigned)(WTAB_OFF + 4u * hw_slot()) = (int)(threadIdx.x >> 6);
    __syncthreads();
    XcdBarrier bar; bar.bar = ctl + 1024; bar.x = 0; bar.st = nullptr;
    if (!MK_PER_PHASE) bar = xcd_barrier_post(ctl + 1024, MISC + 8);
    const int lo = kargs.ph_lo, hi = kargs.ph_hi;
#ifndef PH_MASK
#define PH_MASK 0xFFFF
#endif
#define PON(b) ((PH_MASK >> (b)) & 1)
#ifndef REP_MASK
#define REP_MASK 0
#endif
#define REPS(b) (((REP_MASK >> (b)) & 1) ? 2 : 1)
#define IN(k) (lo <= (k) && (k) < hi)
#define PH_ENTER int tz0_ = tid_now(); asm volatile("" : "+v"(tz0_)); int bz0_ = blockIdx.x; asm volatile("" : "+s"(bz0_)); \
    const int tid = tz0_, lane = tid & 63, wave = __builtin_amdgcn_readfirstlane(tid >> 6), bx = bz0_, vcu = (G % 8 == 0) ? (bx % 8) * (G / 8) + bx / 8 : bx, gw = vcu * 8 + wave, NGW = G * 8; \
    (void)lane; (void)wave; (void)bx; (void)vcu; (void)gw; (void)NGW; \
      \
    CArgs* ap_ = (CArgs*)__builtin_amdgcn_kernarg_segment_ptr(); asm volatile("" : "+s"(ap_)); CArgs& args = *ap_; \
    unsigned char* const ws = (unsigned char*)args.ws; unsigned char* const act = ws + WS_ACT; unsigned char* const sm = act + A_SMALL; (void)sm; \
    bf16_t* const XB = (bf16_t*)(act + A_XB); unsigned char* const XB8 = act + A_O1; (void)XB8; bf16_t* const XB1 = (bf16_t*)(act + A_XB1); bf16_t* const UA = (bf16_t*)(act + A_UA); \
    bf16_t* const Qb = (bf16_t*)(act + A_Q); bf16_t* const Kb = (bf16_t*)(act + A_K); bf16_t* const Vb = (bf16_t*)(act + A_V); bf16_t* const Gb = (bf16_t*)(act + A_G); \
    float* const SSUM = (float*)(act + A_SSUM); bf16_t* const Yb = (bf16_t*)(act + A_Y); bf16_t* const YO = (bf16_t*)(act + A_YO); \
    bf16_t* const MG = (bf16_t*)(act + A_MG); float* const XA = (float*)(act + A_XA); bf16_t* const XG = (bf16_t*)(act + A_XG); bf16_t* const Hb = (bf16_t*)(act + A_H); bf16_t* const YX = (bf16_t*)(act + A_YX); \
    float* const RINV = (float*)(sm + SM_RINV); float* const RINV2 = (float*)(sm + SM_RINV2); float* const AFFT = (float*)(sm + SM_AFFT); int* const IDX = (int*)(sm + SM_IDX); \
    float* const GATE = (float*)(sm + SM_GATE); float* const RSL = (float*)(sm + SM_RSL); int* const INV = (int*)(sm + SM_INV); float* const LAMS = (float*)(sm + SM_LAM); \
    (void)XB; (void)XB1; (void)UA; (void)Qb; (void)Kb; (void)Vb; (void)Gb; (void)SSUM; (void)Yb; (void)YO; (void)MG; (void)XA; (void)XG; (void)Hb; (void)YX; \
    (void)RINV; (void)RINV2; (void)AFFT; (void)IDX; (void)GATE; (void)RSL; (void)INV; (void)LAMS;
#define INP(i) ((const float*)args.in[i])
#define OUTP ((float*)args.out)
#define LAYER_ENTER const LayerW w = layer_w(ws, l); const float lam_init = (l == 0) ? 0.2f : 0.35550906759f;   \
    (void)w; (void)lam_init;
#define SEAM(k) do { if (IN(k) && IN((k) + 1)) { if (!MK_PER_PHASE) xcd_barrier(bar); } } while (0)

    if (PON(0) && IN(0)) _Pragma("nounroll") for (int rep_ = 0; rep_ < REPS(0); ++rep_) { PH_ENTER
        LAS float* scr = (LAS float*)(lds + wave * 16640);
        convert_items(DecMain{ap_, ws}, gw, NL * IT_LAYER0, NGW, scr, lane);
        for (int i = gw * 64 + lane; i < NL * NE * D; i += NGW * 64) { const int l = i / (NE * D), e = (i / D) % NE, k = i % D;
            layer_w(ws, l).WRT[e * D + k] = INP(I_NFFN)[l * D + k] * INP(I_WR)[((size_t)l * D + k) * NE + e]; }
        for (int task = vcu; task < NL * NGRP * 2; task += G) {
            const int l = task / (NGRP * 2), g = (task >> 1) % NGRP, dir = task & 1;
            const size_t pb = ((size_t)(l * 2 + dir) * NGRP + g);
            LAS float* CR = (LAS float*)lds; LAS float* CI = CR + 16 * 65; LAS float* BR = CI + 16 * 65; LAS float* BI = BR + 64 * 16; LAS float* WD = BI + 64 * 16 + wave * 128;
            __syncthreads();
            for (int i = tid; i < 1024; i += 512) { const int pp = i >> 6, nn = i & 63; CR[pp * 65 + nn] = INP(I_CRE)[(pb * GP + pp) * NST + nn]; CI[pp * 65 + nn] = INP(I_CIM)[(pb * GP + pp) * NST + nn];
                BR[i] = INP(I_BRE)[pb * NST * GP + i]; BI[i] = INP(I_BIM)[pb * NST * GP + i]; }
            __syncthreads();
            const float are = INP(I_ARE)[pb * NST + lane], aim = INP(I_AIM)[pb * NST + lane], dt = expf(INP(I_LDT)[pb]);
            const float mag1 = expf(are * dt), ang1 = aim * dt, b1r = mag1 * cosf(ang1), b1i = mag1 * sinf(ang1);
            const float nr = b1r - 1.f, ni = b1i, den = are * are + aim * aim;
            const float cr = (nr * are + ni * aim) / den, ci = (ni * are - nr * aim) / den;
            const int p = lane >> 2, q0 = (lane & 3) * 4;
            for (int k = 0; k < 4; ++k) { const int dl = wave * 4 + k;
                const float magd = expf(are * dt * (float)dl), angd = aim * dt * (float)dl, pr = magd * cosf(angd), pi = magd * sinf(angd);
                WD[lane] = pr * cr - pi * ci; WD[64 + lane] = pr * ci + pi * cr;
                LDS_WAIT();
                f32x4 out = {0.f, 0.f, 0.f, 0.f};
#pragma unroll 8
                for (int n = 0; n < NST; ++n) {
                    const float wr_ = WD[n], wi_ = WD[64 + n];
                    const float c_r = CR[p * 65 + n], c_i = CI[p * 65 + n];
                    const float er = c_r * wr_ - c_i * wi_, ei = c_r * wi_ + c_i * wr_;
                    const f32x4 br = *(const LAS f32x4*)(BR + n * GP + q0), bi = *(const LAS f32x4*)(BI + n * GP + q0);
                    out += br * er - bi * ei;
                }
                *(f32x4*)(layer_w(ws, l).KTAB + ((((size_t)g * 2 + dir) * TC + dl) * GP + p) * GP + q0) = out;
                LDS_WAIT(); }
            { const LayerW w = layer_w(ws, l);
              for (int k = 0; k < 4; ++k) { const int t = wave * 4 + k;
                { const float e = dir == 0 ? (float)(t + 1) : (float)(TC - t); const float mg = expf(are * dt * e), an = aim * dt * e, pr = mg * cosf(an), pi = mg * sinf(an);
#pragma unroll
                  for (int pp = 0; pp < GP; ++pp) { const float c_r = CR[pp * 65 + lane], c_i = CI[pp * 65 + lane];
                      bf16_t* o = w.BO + ((size_t)g * 512 + t * 16 + pp) * UAW + 512 + dir * 128 + lane; o[0] = f2bf(c_r * pr - c_i * pi); o[64] = f2bf(-(c_r * pi + c_i * pr)); } }
                { const float e = dir == 0 ? (float)(TC - 1 - t) : (float)t; const float mg = expf(are * dt * e), an = aim * dt * e, pr = mg * cosf(an), pi = mg * sinf(an);
                  const float wre = pr * cr - pi * ci, wim = pr * ci + pi * cr;
                  f32x4 re[4], im[4];
#pragma unroll
                  for (int q = 0; q < 4; ++q) { const f32x4 br = *(const LAS f32x4*)(BR + lane * GP + 4 * q), bi = *(const LAS f32x4*)(BI + lane * GP + 4 * q); re[q] = br * wre - bi * wim; im[q] = bi * wre + br * wim; }
                  bf16_t* o = w.F + ((size_t)g * 256 + dir * 128 + lane) * 512 + t * 16;
                  *(u32x4*)o = pack8(re[0], re[1]); *(u32x4*)(o + 8) = pack8(re[2], re[3]);
                  *(u32x4*)(o + 64 * 512) = pack8(im[0], im[1]); *(u32x4*)(o + 64 * 512 + 8) = pack8(im[2], im[3]); } } }
        }
        __syncthreads();
        for (int m = gw; m < S; m += NGW) row_pass<false>(INP(I_X) + (size_t)m * D, XB + (size_t)m * D, RINV + m, nullptr, nullptr, m, lane, XB8 + (size_t)m * D);
        if (gw < NL) { const int l = gw; const float a = wave_sum(INP(I_LQ1)[l * QKD + lane] * INP(I_LK1)[l * QKD + lane]);
            const float b = wave_sum(INP(I_LQ2)[l * QKD + lane] * INP(I_LK2)[l * QKD + lane]);
            if (lane == 0) LAMS[l] = expf(a) - expf(b) + ((l == 0) ? 0.2f : 0.35550906759f); }
        for (int i = gw * 64 + lane; i < NH * 512; i += NGW * 64) { const int h = i >> 9, rel = (i & 511) - 256;
            ((float*)(sm + SM_BTAB))[i] = INP(I_RELB)[t5_bucket(rel) * NH + h] * LOG2E; }
    }
    SEAM(0);

    for (int l = 0; l < NL; ++l) {
        const int pbase = 2 + l * 14;
        if (PON(2) && IN(pbase + 0)) _Pragma("nounroll") for (int rep_ = 0; rep_ < REPS(2); ++rep_) { PH_ENTER LAYER_ENTER
            { pg::SchedGrid Sg; Sg.init(XB, D, w.WIN, D, S, 4096, G, bx);
              EpiInProj E{RINV, UA, Qb, Kb, Vb, Gb, INP(I_QG) + l * QKD, INP(I_KG) + l * QKD};
              pg::gemm_phase(lds, D, D, D, Sg, E); }
            { pg::SchedGrid Sg; Sg.init(XB8, D, (unsigned char*)w.WIN + (size_t)16 * MiB, D, S, 4096, G, bx, 1);
              EpiGates E{RINV, Gb};
              pg::gemm_phase<EpiGates, pg::SchedGrid, true, E8_ONE, E8_W>(lds, D, D, D, Sg, E); }
        }
        SEAM(pbase + 0);
        if (PON(3) && IN(pbase + 1)) _Pragma("nounroll") for (int rep_ = 0; rep_ < REPS(3); ++rep_) { PH_ENTER LAYER_ENTER
            pg::SchedGroup Sg; Sg.init(UA, UAW, (size_t)NCH * UAW * 2, w.F, 512, (size_t)256 * 512 * 2, 1, 1, NGRP, G, vcu);
            EpiSsum E{SSUM};
            pg::gemm_phase(lds, 512, UAW, 512, Sg, E);
            if (vcu >= NGRP) convert_items(DecDown{ap_, ws, l}, DQ_A0 + (vcu - NGRP) * 8 + wave, DQ_A1, (G - NGRP) * 8, (LAS float*)(lds + wave * 16640), lane);
            if (vcu >= NGRP) for (int gq = vcu - NGRP; gq < NGRP * 4; gq += G - NGRP) { const int g = gq >> 2, rq = gq & 3;
                LAS float* kt = (LAS float*)lds;
                __syncthreads();
                for (int i = tid; i < 2 * TC * 256 / 4; i += 512) ((LAS f32x4*)kt)[i] = ((const f32x4*)(w.KTAB + (size_t)g * 2 * TC * 256))[i];
                __syncthreads();
                for (int idx = tid; idx < 128 * 64; idx += 512) { const int rr = rq * 128 + (idx >> 6), kc = idx & 63;
                    const int t = rr >> 4, p = rr & 15, tau = kc >> 1, q0 = (kc & 1) * 8;
                    const LAS float* kf = kt; const LAS float* kb = kt + TC * 256;
                    f32x4 a, b;
                    if (tau < t) { const LAS float* s = kf + ((t - tau) * GP + p) * GP + q0; a = *(const LAS f32x4*)s; b = *(const LAS f32x4*)(s + 4); }
                    else if (tau > t) { const LAS float* s = kb + ((tau - t) * GP + p) * GP + q0; a = *(const LAS f32x4*)s; b = *(const LAS f32x4*)(s + 4); }
                    else { const LAS float* s = kf + p * GP + q0; const LAS float* s2 = kb + p * GP + q0; a = *(const LAS f32x4*)s + *(const LAS f32x4*)s2; b = *(const LAS f32x4*)(s + 4) + *(const LAS f32x4*)(s2 + 4);
                        const float dd = INP(I_SD)[l * SSMW + g * GP + p];
#pragma unroll
                        for (int j = 0; j < 4; ++j) { if (q0 + j == p) a[j] += dd; if (q0 + 4 + j == p) b[j] += dd; } }
                    *(u32x4*)(w.BO + ((size_t)g * 512 + rr) * UAW + tau * 16 + q0) = pack8(a, b); }
            }
            if (vcu < NGRP && wave < 2) {
                const int g = vcu, dir = wave; const size_t pb = ((size_t)(l * 2 + dir) * NGRP + g);
                const float are = INP(I_ARE)[pb * NST + lane], aim = INP(I_AIM)[pb * NST + lane], dt = expf(INP(I_LDT)[pb]);
                const float mg = expf(are * dt * (float)TC), an = aim * dt * (float)TC, ar = mg * cosf(an), ai = mg * sinf(an);
                float sr = 0.f, si = 0.f;
                for (int cb = 0; cb < NCH; cb += 32) {
                    float xr[32], xi[32];
#pragma unroll
                    for (int k = 0; k < 32; ++k) { const int c = dir == 0 ? cb + k : NCH - 1 - cb - k; const float* s = SSUM + ((size_t)g * NCH + c) * 256 + dir * 128 + lane; xr[k] = s[0]; xi[k] = s[64]; }
#pragma unroll
                    for (int k = 0; k < 32; ++k) { const int c = dir == 0 ? cb + k : NCH - 1 - cb - k;
                        bf16_t* o = UA + ((size_t)g * NCH + c) * UAW + 512 + dir * 128 + lane; o[0] = f2bf(sr); o[64] = f2bf(si);
                        const float nr = ar * sr - ai * si + xr[k], ni = ar * si + ai * sr + xi[k]; sr = nr; si = ni; }
                }
            }
            if (vcu < NGRP) convert_items(DecDown{ap_, ws, l}, DQ_A1 + vcu * 8 + wave, DQ_B0, NGRP * 8, (LAS float*)(lds + wave * 16640), lane);
        }
        SEAM(pbase + 1);
        if (PON(5) && IN(pbase + 3)) _Pragma("nounroll") for (int rep_ = 0; rep_ < REPS(5); ++rep_) { PH_ENTER LAYER_ENTER
            pg::SchedGroup Sg; Sg.init(UA, UAW, (size_t)NCH * UAW * 2, w.BO, UAW, (size_t)512 * UAW * 2, 1, 2, NGRP, G, vcu);
            EpiSsmOut E{Yb};
            pg::gemm_phase(lds, UAW, UAW, UAW, Sg, E);
            if (vcu >= 2 * NGRP) convert_items(DecDown{ap_, ws, l}, DQ_B0 + (vcu - 2 * NGRP) * 8 + wave, DQ_B1, (G - 2 * NGRP) * 8, (LAS float*)(lds + wave * 16640), lane);
            else convert_items(DecDown{ap_, ws, l}, DQ_B1 + vcu * 8 + wave, DQ_C0, 2 * NGRP * 8, (LAS float*)(lds + wave * 16640), lane);
        }
        SEAM(pbase + 3);
        if (PON(6) && IN(pbase + 4)) _Pragma("nounroll") for (int rep_ = 0; rep_ < REPS(6); ++rep_) { PH_ENTER LAYER_ENTER
            pg::SchedGrid Sg; Sg.init(Yb, SSMW, w.WGLU, SSMW, S, SSMW, G, bx);
            EpiGlu E{Yb, YO};
            pg::gemm_phase(lds, SSMW, SSMW, SSMW, Sg, E);
            if (bx >= 128) convert_items(DecDown{ap_, ws, l}, DQ_C0 + (bx - 128) * 8 + wave, DQ_C1, (G - 128) * 8, (LAS float*)(lds + wave * 16640), lane);
            else convert_items(DecDown{ap_, ws, l}, DQ_C1 + bx * 8 + wave, DQ_END, 128 * 8, (LAS float*)(lds + wave * 16640), lane);
        }
        SEAM(pbase + 4);
        if (PON(7) && IN(pbase + 5)) _Pragma("nounroll") for (int rep_ = 0; rep_ < REPS(7); ++rep_) { PH_ENTER LAYER_ENTER
            for (int un = vcu; un < NH * (S / 256); un += G) {
                const int h = un / (S / 256), qb = un % (S / 256);
                __syncthreads();
                { int tb = tid_now(); asm volatile("" : "+v"(tb)); ((LAS float*)(lds + att::OFF_BT))[tb] = ((const float*)(sm + SM_BTAB))[h * 512 + tb]; }
                const int q0w = qb * 256 + wave * 32;
                f32x16 o[4];
                { f32x16 o2[4];
                  CJob J; J.src = nullptr; J.dst = nullptr; J.on = 0;
                  if (un == vcu && wave >= 4 && G == 256) { const int cb = (wave - 4) * 256 + vcu, e = cb >> 6, kh = ((cb >> 5) & 1) * 1024, n0 = (cb & 31) * 64;
                      const size_t eo = ((size_t)l * NE + e) * D * FF;
                      J.src = INP(I_WED) + eo + (size_t)kh * D + n0; J.dst = (unsigned char*)w.WD + (size_t)e * D * FF + (size_t)n0 * FF + kh; J.on = 1; }
                  att::attn_dual(o, o2, Qb + (size_t)q0w * 1024 + h * 128, Kb + h * 128, Vb + h * 128, (LAS char*)lds, q0w, J);
                  const float lam = LAMS[l];
#pragma unroll
                  for (int d = 0; d < 4; ++d) o[d] = o[d] - o2[d] * lam; }
                { const int tz = lane_now(), r32 = tz & 31, hi2 = tz >> 5;
                  float ssq[16];
#pragma unroll
                  for (int r = 0; r < 16; ++r) { float s = 0.f;
#pragma unroll
                    for (int d = 0; d < 4; ++d) s += o[d][r] * o[d][r];
                    s += swz_xor<1>(s); s += swz_xor<2>(s); s += swz_xor<4>(s); s += swz_xor<8>(s); s += swz_xor<16>(s);
                    ssq[r] = __builtin_amdgcn_rsqf(s * (1.f / VD) + EPS) * (1.f - lam_init); }
                  bf16_t* yo = YO + (size_t)(q0w + 4 * hi2) * 2048 + 1024 + h * 128 + r32;
#pragma unroll
                  for (int d = 0; d < 4; ++d) { const float gn = INP(I_SUBLN)[l * VD + d * 32 + r32];
#pragma unroll
                    for (int r = 0; r < 16; ++r) yo[(size_t)((r & 3) + 8 * (r >> 2)) * 2048 + d * 32] = f2bf(o[d][r] * ssq[r] * gn); } }
            }
            __syncthreads();
            if (G != 256) convert_items(DecDn{ap_, ws, l}, gw, IT_DOWN, NGW, (LAS float*)(lds + wave * 16640), lane_now());
        }
        SEAM(pbase + 5);
        if (PON(8) && IN(pbase + 6)) _Pragma("nounroll") for (int rep_ = 0; rep_ < REPS(8); ++rep_) { PH_ENTER LAYER_ENTER
            pg::SchedGrid Sg; Sg.init(YO, 2048, w.WBR, 2048, S, D, G, bx);
            EpiMerge E{Gb, MG};
            pg::gemm_phase(lds, 2048, 2048, 2048, Sg, E);
        }
        SEAM(pbase + 6);
        if (PON(9) && IN(pbase + 7)) _Pragma("nounroll") for (int rep_ = 0; rep_ < REPS(9); ++rep_) { PH_ENTER LAYER_ENTER
            pg::SchedGrid Sg; Sg.init(MG, D, w.WOUT, D, S, D, G, bx);
            EpiOutProj E{XB, XB1};
            pg::gemm_phase(lds, D, D, D, Sg, E);
        }
        SEAM(pbase + 7);
        if (PON(10) && IN(pbase + 8)) _Pragma("nounroll") for (int rep_ = 0; rep_ < REPS(10); ++rep_) { PH_ENTER LAYER_ENTER
            LAS float* WtL = (LAS float*)lds;
            for (int i = tid; i < NE * D / 4; i += 512) ((LAS f32x4*)WtL)[i] = ((const f32x4*)w.WRT)[i];
            __syncthreads();
            { u32x2 xc[8], xn[8];
#pragma unroll
              for (int j = 0; j < 8; ++j) { xc[j] = (u32x2){0u, 0u}; xn[j] = xc[j]; }
              if (gw < S) {
#pragma unroll
                  for (int j = 0; j < 8; ++j) xc[j] = *(const u32x2*)(XB1 + (size_t)gw * D + 4 * lane + 256 * j); }
              for (int m = gw; m < S; m += NGW) { int lz = lane; asm volatile("" : "+v"(lz));
                  if (m + NGW < S) {
#pragma unroll
                      for (int j = 0; j < 8; ++j) xn[j] = *(const u32x2*)(XB1 + (size_t)(m + NGW) * D + 4 * lz + 256 * j); }
                  router_row(xc, RINV2 + m, WtL, AFFT, m, lz);
#pragma unroll
                  for (int j = 0; j < 8; ++j) xc[j] = xn[j]; } }
            __syncthreads();
        }
        SEAM(pbase + 8);
        if (PON(11) && IN(pbase + 9)) _Pragma("nounroll") for (int rep_ = 0; rep_ < REPS(11); ++rep_) { PH_ENTER LAYER_ENTER
            const int nparts = G / NE > 0 ? G / NE : 1;
            if (vcu < nparts * NE) {
                const int e = vcu / nparts, part = vcu % nparts, per = (CAP + nparts - 1) / nparts, slo = part * per, shi = (slo + per < CAP) ? slo + per : CAP;
                LAS int* red = (LAS int*)lds; LAS int* list = (LAS int*)(lds + 1024);
                unsigned bits[16]; { const float* a = AFFT + (size_t)e * S + tid * 16;
#pragma unroll
                    for (int q = 0; q < 4; ++q) { const f32x4 v = *(const f32x4*)(a + 4 * q); bits[4 * q] = __float_as_uint(v[0]); bits[4 * q + 1] = __float_as_uint(v[1]); bits[4 * q + 2] = __float_as_uint(v[2]); bits[4 * q + 3] = __float_as_uint(v[3]); } }
                unsigned T = 0u;
                for (int bit = 30; bit >= 0; --bit) { const unsigned cand = T | (1u << bit); int c = 0;
#pragma unroll
                    for (int i = 0; i < 16; ++i) c += bits[i] >= cand ? 1 : 0;
                    if (block_sum_i(c, red, wave, lane) >= CAP) T = cand; }
                int cg = 0, ce = 0;
#pragma unroll
                for (int i = 0; i < 16; ++i) { cg += bits[i] > T ? 1 : 0; ce += bits[i] == T ? 1 : 0; }
                const int need_eq = CAP - block_sum_i(cg, red, wave, lane);
                int sg = cg, se = ce;
#pragma unroll
                for (int o = 1; o < 64; o <<= 1) { const int a = __shfl_up(sg, o), b = __shfl_up(se, o); if (lane >= o) { sg += a; se += b; } }
                __syncthreads();
                if (lane == 63) { red[16 + wave] = sg; red[32 + wave] = se; }
                __syncthreads();
                int og = 0, oe = 0;
#pragma unroll
                for (int wv = 0; wv < 8; ++wv) if (wv < wave) { og += red[16 + wv]; oe += red[32 + wv]; }
                int gbef = og + sg - cg, ebef = oe + se - ce;
                const bool inv_mine = (tid * nparts) / 512 == part;
#pragma unroll
                for (int i = 0; i < 16; ++i) { const int tok = tid * 16 + i; const bool isg = bits[i] > T, ise = bits[i] == T; const bool sel = isg || (ise && ebef < need_eq);
                    const int slot = gbef + (ebef < need_eq ? ebef : need_eq);
                    if (sel && slot >= slo && slot < shi) { IDX[e * CAP + slot] = tok; GATE[e * CAP + slot] = __uint_as_float(bits[i]); RSL[e * CAP + slot] = RINV2[tok]; list[slot - slo] = tok; }
                    if (inv_mine) INV[tok * NE + e] = sel ? slot : -1;
                    gbef += isg ? 1 : 0; ebef += ise ? 1 : 0; }
                __syncthreads();
                for (int r = wave; r < shi - slo; r += 32) {
                    u32x4 t[4][4];
#pragma unroll
                    for (int q = 0; q < 4; ++q) { const int rr = (r + 8 * q < shi - slo) ? r + 8 * q : r; const u32x4* s = (const u32x4*)(XB1 + (size_t)list[rr] * D) + lane;
#pragma unroll
                        for (int j = 0; j < 4; ++j) t[q][j] = s[64 * j]; }
#pragma unroll
                    for (int q = 0; q < 4; ++q) if (r + 8 * q < shi - slo) { u32x2* d = (u32x2*)((unsigned char*)XG + (size_t)(e * CAP + slo + r + 8 * q) * D) + lane;
#pragma unroll
                        for (int j = 0; j < 4; ++j) { f32x4 a, b; unpack8(t[q][j], a, b); d[64 * j] = pack8_fp8(a, b); } } }
                __syncthreads();
            }
        }
        SEAM(pbase + 9);
        if (PON(13) && IN(pbase + 11)) _Pragma("nounroll") for (int rep_ = 0; rep_ < REPS(13); ++rep_) { PH_ENTER LAYER_ENTER
            pg::SchedGroup Sg; Sg.init(XG, D, (size_t)CAP * D, w.WGU, D, (size_t)4096 * D, 4, 16, NE, G, vcu, 1);
            EpiExp1 E{RSL, Hb};
            pg::gemm_phase<EpiExp1, pg::SchedGroup, true, E8_ONE, E8_W>(lds, D, D, D, Sg, E);
        }
        SEAM(pbase + 11);
        if (PON(14) && IN(pbase + 12)) _Pragma("nounroll") for (int rep_ = 0; rep_ < REPS(14); ++rep_) { PH_ENTER LAYER_ENTER
            pg::SchedGroup Sg; Sg.init(Hb, FF, (size_t)CAP * FF, w.WD, FF, (size_t)D * FF, 4, 8, NE, G, vcu, 1);
            EpiExp2 E{GATE, YX};
            pg::gemm_phase<EpiExp2, pg::SchedGroup, true, E8_H, E8_W>(lds, FF, FF, FF, Sg, E);
        }
        SEAM(pbase + 12);
        if (PON(15) && IN(pbase + 13)) _Pragma("nounroll") for (int rep_ = 0; rep_ < REPS(15); ++rep_) { PH_ENTER LAYER_ENTER
            { u32x2 xc[8], xn[8]; int invc = -1, invn = -1;
#pragma unroll
              for (int j = 0; j < 8; ++j) { xc[j] = (u32x2){0u, 0u}; xn[j] = xc[j]; }
              if (gw < S) { invc = INV[gw * NE + (lane & 15)];
#pragma unroll
                  for (int j = 0; j < 8; ++j) xc[j] = *(const u32x2*)(XB1 + (size_t)gw * D + 4 * lane + 256 * j); }
              for (int m = gw; m < S; m += NGW) {
                if (m + NGW < S) { invn = INV[(m + NGW) * NE + (lane & 15)];
#pragma unroll
                    for (int j = 0; j < 8; ++j) xn[j] = *(const u32x2*)(XB1 + (size_t)(m + NGW) * D + 4 * lane + 256 * j); }
                f32x4 v[8];
#pragma unroll
                for (int j = 0; j < 8; ++j) v[j] = (f32x4){bf_lo(xc[j].x), bf_hi(xc[j].x), bf_lo(xc[j].y), bf_hi(xc[j].y)};
                const int myinv = invc;
                unsigned msk = (unsigned)(__ballot(myinv >= 0) & 0xFFFFull);
                while (msk) { const int e0 = __builtin_ctz(msk); msk &= msk - 1; const bool two = msk != 0u; const int e1 = two ? __builtin_ctz(msk) : e0; if (two) msk &= msk - 1;
                    const bf16_t* y0 = YX + ((size_t)e0 * CAP + __shfl(myinv, e0)) * D; const bf16_t* y1 = YX + ((size_t)e1 * CAP + __shfl(myinv, e1)) * D;
                    u32x2 a[8], b[8];
#pragma unroll
                    for (int j = 0; j < 8; ++j) a[j] = *(const u32x2*)(y0 + 4 * lane + 256 * j);
#pragma unroll
                    for (int j = 0; j < 8; ++j) b[j] = *(const u32x2*)(y1 + 4 * lane + 256 * j);
#pragma unroll
                    for (int j = 0; j < 8; ++j) { v[j][0] += bf_lo(a[j].x); v[j][1] += bf_hi(a[j].x); v[j][2] += bf_lo(a[j].y); v[j][3] += bf_hi(a[j].y); }
                    if (two) {
#pragma unroll
                        for (int j = 0; j < 8; ++j) { v[j][0] += bf_lo(b[j].x); v[j][1] += bf_hi(b[j].x); v[j][2] += bf_lo(b[j].y); v[j][3] += bf_hi(b[j].y); } } }
                if (l + 1 < NL) {
                    float ss = 0.f;
#pragma unroll
                    for (int j = 0; j < 8; ++j) ss += v[j][0] * v[j][0] + v[j][1] * v[j][1] + v[j][2] * v[j][2] + v[j][3] * v[j][3];
                    ss = wave_sum(ss);
#pragma unroll
                    for (int j = 0; j < 8; ++j) { u32x2 wv; wv.x = cvt_pk_bf16(v[j][0], v[j][1]); wv.y = cvt_pk_bf16(v[j][2], v[j][3]); *(u32x2*)(XB + (size_t)m * D + 4 * lane + 256 * j) = wv;
                        int w8 = 0; w8 = __builtin_amdgcn_cvt_pk_fp8_f32(v[j][0], v[j][1], w8, false); w8 = __builtin_amdgcn_cvt_pk_fp8_f32(v[j][2], v[j][3], w8, true); *(int*)(XB8 + (size_t)m * D + 4 * lane + 256 * j) = w8; }
                    if (lane == 0) RINV[m] = __builtin_amdgcn_rsqf(ss * (1.f / D) + EPS);
                } else { float* orow = OUTP + (size_t)m * D;
#pragma unroll
                    for (int j = 0; j < 8; ++j) *(f32x4*)(orow + 4 * lane + 256 * j) = v[j]; }
#pragma unroll
                for (int j = 0; j < 8; ++j) xc[j] = xn[j];
                invc = invn;
              } }
        }
        SEAM(pbase + 13);
    }
#undef IN
#undef SEAM
}

#if defined(DBG_STOP)
#ifndef DBG_OFF
#define DBG_OFF A_XA
#endif
#ifndef DBG_BF16
#define DBG_BF16 0
#endif
__global__ void dbg_dump(float* out, const unsigned char* ws) {
    const unsigned char* p = ws + WS_ACT + DBG_OFF;
    for (size_t i = (size_t)blockIdx.x * 256 + threadIdx.x; i < (size_t)S * D; i += (size_t)gridDim.x * 256)
#if defined(DBG_SUM2)
        out[i] = __uint_as_float(((unsigned)((const bf16_t*)p)[i]) << 16) + __uint_as_float(((unsigned)((const bf16_t*)p)[i + (size_t)S * D]) << 16);
#else
        out[i] = DBG_BF16 ? __uint_as_float(((unsigned)((const bf16_t*)p)[i]) << 16) : ((const float*)p)[i];
#endif
}
#endif
constexpr int N_PHASES = 2 + NL * 14;
extern "C" void kernel_launch(void* const* d_in, const int* in_sizes, int n_in, void* d_out, int out_size, void* d_ws, size_t ws_size, hipStream_t stream) {
    static int grid = 0;
    if (grid == 0) {
        if (n_in != 28 || in_sizes[0] != S * D || out_size != S * D || ws_size < WS_END) { fprintf(stderr, "kernel_launch: shape/workspace mismatch (n_in %d, ws %zu, need %zu)\n", n_in, ws_size, (size_t)WS_END); grid = -1; return; }
        int dev = 0, cus = 0, per_cu = 0;
        if (hipGetDevice(&dev) != hipSuccess || hipDeviceGetAttribute(&cus, hipDeviceAttributeMultiprocessorCount, dev) != hipSuccess) { grid = -1; return; }
        if (hipFuncSetAttribute((const void*)fwd, hipFuncAttributeMaxDynamicSharedMemorySize, LDS_BYTES) != hipSuccess) { fprintf(stderr, "kernel_launch: hipFuncSetAttribute failed\n"); grid = -1; return; }
        if (hipOccupancyMaxActiveBlocksPerMultiprocessor(&per_cu, (const void*)fwd, 512, LDS_BYTES) != hipSuccess || per_cu < 1) { fprintf(stderr, "kernel_launch: occupancy query says %d\n", per_cu); }
        (void)hipGetLastError();
        grid = cus;
    }
    if (grid < 0) return;
    (void)hipMemsetAsync((char*)d_ws + WS_CTL, 0, CTL_BYTES, stream);
    Args a{};
    for (int i = 0; i < 28; ++i) a.in[i] = (GAS const float*)d_in[i];
    a.out = (GAS float*)d_out; a.ws = (GAS unsigned char*)d_ws;
#if defined(DBG_STOP)
    for (int p = 0; p < DBG_STOP; ++p) { a.ph_lo = p; a.ph_hi = p + 1; hipLaunchKernelGGL(fwd, dim3(grid), dim3(512), LDS_BYTES, stream, a); }
#if !defined(DBG_NODUMP)
    hipLaunchKernelGGL(dbg_dump, dim3(2048), dim3(256), 0, stream, (float*)d_out, (const unsigned char*)d_ws);
#endif
#elif MK_PER_PHASE
    for (int p = 0; p < N_PHASES; ++p) { a.ph_lo = p; a.ph_hi = p + 1; hipLaunchKernelGGL(fwd, dim3(grid), dim3(512), LDS_BYTES, stream, a); }
#else
    a.ph_lo = 0; a.ph_hi = N_PHASES; hipLaunchKernelGGL(fwd, dim3(grid), dim3(512), LDS_BYTES, stream, a);
#endif
    const hipError_t le = hipPeekAtLastError();
    if (le != hipSuccess) fprintf(stderr, "kernel_launch: launch failed: %s\n", hipGetErrorName(le));
}
```

```cpp
#include <hip/hip_runtime.h>
#include <cstdio>
#include <cstdint>

#ifndef MK_PER_PHASE
#define MK_PER_PHASE 0
#endif

#define LAS __attribute__((address_space(3)))
#define GAS __attribute__((address_space(1)))
typedef unsigned short bf16_t;
typedef short bf16x8 __attribute__((ext_vector_type(8)));
typedef short s16x4 __attribute__((ext_vector_type(4)));
typedef float f32x4 __attribute__((ext_vector_type(4)));
typedef float f32x2 __attribute__((ext_vector_type(2)));
typedef float f32x16 __attribute__((ext_vector_type(16)));
typedef unsigned u32x4 __attribute__((ext_vector_type(4)));
typedef unsigned u32x2 __attribute__((ext_vector_type(2)));

constexpr int S = 8192, D = 2048, NL = 2;
constexpr int SSMW = 1024, NGRP = 64, GP = 16, NST = 64;
constexpr int NH = 8, QKD = 64, VD = 128;
constexpr int NE = 16, CAP = 1024, FF = 2048;
constexpr int INC = 8192;
constexpr float EPS = 1e-6f;
constexpr int TC = 32, NCH = S / TC;
constexpr int UAW = TC * GP + 256;
constexpr float LOG2E = 1.4426950408889634f;

constexpr size_t MiB = 1u << 20;
constexpr size_t WS_CTL = 0, CTL_BYTES = 1 * MiB;
constexpr size_t LW_WIN = 0, LW_WGLU = 32 * MiB, LW_WBR = 34 * MiB, LW_WOUT = 42 * MiB, LW_WGU = 50 * MiB, LW_WD = 306 * MiB,
                 LW_F = 434 * MiB, LW_BO = 450 * MiB, LW_KTAB = 498 * MiB, LW_WRT = 502 * MiB, LW_SIZE = 503 * MiB;
constexpr size_t WS_LW = 1 * MiB;
constexpr size_t WS_ACT = WS_LW + 2 * LW_SIZE;
constexpr size_t A_XB = 0, A_XB1 = 32 * MiB, A_UA = 64 * MiB, A_Q = 88 * MiB, A_K = 104 * MiB, A_V = 120 * MiB, A_G = 136 * MiB,
                 A_SSUM = 200 * MiB, A_Y = 216 * MiB, A_YO = 232 * MiB, A_O1 = 264 * MiB, A_MG = 296 * MiB, A_XA = 328 * MiB,
                 A_XG = 392 * MiB, A_H = 456 * MiB, A_YX = 520 * MiB, A_SMALL = 584 * MiB, A_END = 588 * MiB;
constexpr size_t SM_RINV = 0, SM_RINV2 = 64 * 1024, SM_AFFT = 128 * 1024, SM_IDX = 640 * 1024, SM_GATE = 704 * 1024, SM_RSL = 768 * 1024,
                 SM_INV = 1024 * 1024, SM_BTAB = 1536 * 1024, SM_LAM = 1600 * 1024;
constexpr size_t WS_END = WS_ACT + A_END;

constexpr int RING_BYTES = 131072;
constexpr int LDS_BYTES = 163840;
constexpr int MISC_OFF = 155648;

typedef __bf16 bf16v2_t __attribute__((ext_vector_type(2)));
__device__ __forceinline__ unsigned cvt_pk_bf16(float lo, float hi) { const f32x2 v = {lo, hi}; return __builtin_bit_cast(unsigned, __builtin_convertvector(v, bf16v2_t)); }
__device__ __forceinline__ float bf_lo(unsigned w) { return __uint_as_float(w << 16); }
__device__ __forceinline__ float bf_hi(unsigned w) { return __uint_as_float(w & 0xffff0000u); }
__device__ __forceinline__ unsigned short f2bf(float f) { return (unsigned short)(cvt_pk_bf16(f, 0.f) & 0xffffu); }
__device__ __forceinline__ float fast_sigmoid(float x) { return __builtin_amdgcn_rcpf(1.f + __builtin_amdgcn_exp2f(-x * LOG2E)); }
__device__ __forceinline__ float wave_sum(float v) {
#pragma unroll
    for (int o = 1; o < 64; o <<= 1) v += __shfl_xor(v, o);
    return v;
}
template <int X> __device__ __forceinline__ float swz_xor(float v) { return __int_as_float(__builtin_amdgcn_ds_swizzle(__float_as_int(v), (X << 10) | 0x1F)); }
__device__ __forceinline__ int lane_now() { int t; asm volatile("v_mbcnt_lo_u32_b32 %0, -1, 0\n\tv_mbcnt_hi_u32_b32 %0, -1, %0" : "=v"(t)); return t; }
constexpr int WTAB_OFF = MISC_OFF + 512;
__device__ __forceinline__ unsigned hw_slot() { return (unsigned)__builtin_amdgcn_s_getreg((5 << 11) | 4) & 63u; }
__device__ __forceinline__ int wave_now() { return __builtin_amdgcn_readfirstlane(*(volatile LAS int*)(unsigned)(WTAB_OFF + 4u * hw_slot())); }
__device__ __forceinline__ int tid_now() { return wave_now() * 64 + lane_now(); }
__device__ __forceinline__ u32x2 pack8_fp8(const f32x4 a, const f32x4 b) { int w0 = 0, w1 = 0;
    w0 = __builtin_amdgcn_cvt_pk_fp8_f32(a[0], a[1], w0, false); w0 = __builtin_amdgcn_cvt_pk_fp8_f32(a[2], a[3], w0, true);
    w1 = __builtin_amdgcn_cvt_pk_fp8_f32(b[0], b[1], w1, false); w1 = __builtin_amdgcn_cvt_pk_fp8_f32(b[2], b[3], w1, true);
    u32x2 r; r.x = (unsigned)w0; r.y = (unsigned)w1; return r; }
constexpr float W8_SCALE = 64.f, H8_SCALE = 16.f;
constexpr int E8_ONE = 0x7F7F7F7F, E8_W = 0x79797979  , E8_H = 0x7B7B7B7B  ;
#define LDS_WAIT() asm volatile("s_waitcnt lgkmcnt(0)" ::: "memory")
#define VM_WAIT() asm volatile("s_waitcnt vmcnt(0)" ::: "memory")

#define XB_TMO      128
#define XB_XCNT(j)  (256  + 64 * (j))
#define XB_XSUB(j)  (1280 + 64 * (j))
#define XB_XGEN(j)  (2304 + 64 * (j))
#define XB_TOP      3328
#define XB_TOPGEN   3392
#define XCD_BAR_WORDS 3456
#define XB_SPIN_CAP (1u << 22)
__device__ __forceinline__ unsigned xb_ld(unsigned* p)              { return __hip_atomic_load(p, __ATOMIC_RELAXED, __HIP_MEMORY_SCOPE_AGENT); }
__device__ __forceinline__ unsigned xb_add(unsigned* p, unsigned v) { return __hip_atomic_fetch_add(p, v, __ATOMIC_RELAXED, __HIP_MEMORY_SCOPE_AGENT); }
__device__ __forceinline__ unsigned xb_xcc_id() { return (unsigned)__builtin_amdgcn_s_getreg((3 << 11) | 20) & 0xFu; }
#define XB_SPIN(cond, bar) do { unsigned _sp = 0; while (cond) { __builtin_amdgcn_s_sleep(1); \
    if ((++_sp & 255u) == 0u) { if (xb_ld(&(bar)[XB_TMO])) break; if (_sp > XB_SPIN_CAP) { atomicAdd(&(bar)[XB_TMO], 1u); break; } } } } while (0)
struct XcdBarrier { unsigned* bar; unsigned x; volatile LAS unsigned* st; };
__device__ __forceinline__ XcdBarrier xcd_barrier_post(unsigned* bar, volatile LAS unsigned* st) {
    XcdBarrier b; b.bar = bar; b.x = xb_xcc_id(); b.st = st;
    if (tid_now() == 0) (void)xb_add(&bar[XB_XCNT(b.x)], 1u);
    return b;
}
__device__ __forceinline__ void xcd_barrier_complete(unsigned* bar, unsigned x, unsigned& nloc, unsigned& nx) {
    const unsigned G = gridDim.x * gridDim.y * gridDim.z;
    unsigned sum, cnt, mine, sp = 0u;
    for (;;) {
        sum = 0u; cnt = 0u; mine = 0u;
#pragma nounroll
        for (unsigned j = 0; j < 16; ++j) { const unsigned c = xb_ld(&bar[XB_XCNT(j)]); sum += c; cnt += (c > 0u) ? 1u : 0u; mine = (j == x) ? c : mine; }
        if (sum == G) break;
        __builtin_amdgcn_s_sleep(1);
        if ((++sp & 255u) == 0u) { if (xb_ld(&bar[XB_TMO])) break; if (sp > XB_SPIN_CAP) { atomicAdd(&bar[XB_TMO], 1u); break; } }
    }
    nloc = mine > 0u ? mine : 1u; nx = cnt > 0u ? cnt : 1u;
}
__device__ __forceinline__ void xcd_barrier(const XcdBarrier& b) {
    asm volatile("s_waitcnt vmcnt(0)" ::: "memory");
    __syncthreads();
    if (tid_now() == 0) {
        unsigned* bar = b.bar;
        __builtin_amdgcn_s_waitcnt(0);
        unsigned nloc = b.st[0], nx = b.st[1];
        if (nloc == 0u) { xcd_barrier_complete(bar, b.x, nloc, nx); b.st[0] = nloc; b.st[1] = nx; }
        const unsigned old = xb_add(&bar[XB_XSUB(b.x)], 1u);
        const unsigned gen = old / nloc;
        if (old + 1u == (gen + 1u) * nloc) {
            __builtin_amdgcn_fence(__ATOMIC_RELEASE, "agent");
            asm volatile("s_waitcnt vmcnt(0)" ::: "memory");
            const unsigned og = xb_add(&bar[XB_TOP], 1u);
            const unsigned tg = og / nx;
            if (og + 1u == (tg + 1u) * nx) xb_add(&bar[XB_TOPGEN], 1u);
            else XB_SPIN(xb_ld(&bar[XB_TOPGEN]) == tg, bar);
            __builtin_amdgcn_fence(__ATOMIC_ACQUIRE, "agent");
            xb_add(&bar[XB_XGEN(b.x)], 1u);
            asm volatile("s_waitcnt vmcnt(0)" ::: "memory");
        } else {
            XB_SPIN(xb_ld(&bar[XB_XGEN(b.x)]) == gen, bar);
            __builtin_amdgcn_fence(__ATOMIC_ACQUIRE, "agent");
            asm volatile("s_waitcnt vmcnt(0)" ::: "memory");
        }
    }
    __syncthreads();
}

namespace pg {
constexpr int BM = 256, BK = 64, HALF = 128, HTB = HALF * BK * 2, STAGE_BYTES = 8 * HTB;
__device__ __forceinline__ int lds_byte(int r, int c) { const int st = (r >> 4) * 2 + (c >> 5), rr = r & 15, cc = c & 31, ob = rr * 64 + cc * 2; return st * 1024 + (ob ^ (((ob >> 9) & 1) << 5)); }
__device__ __forceinline__ void stage_rc(int b, int& R, int& C) { const int st = b / 1024, sb = b % 1024, swz = sb ^ (((sb >> 9) & 1) << 5); R = (st >> 1) * 16 + swz / 64; C = (st & 1) * 32 + (swz % 64) / 2; }
__device__ __forceinline__ int perm32(int rho) { const int n = rho >> 4, i = rho & 15; return 8 * (i >> 2) + 4 * n + (i & 3); }
struct Unit { const char* a; const char* b; int pm, pn, grp; };
typedef f32x4 Acc[2][2][4][2];

typedef int v8i_t __attribute__((ext_vector_type(8)));
template <class Epi, class Sched, bool F8 = false, int SA_ = 0x7F7F7F7F, int SB_ = 0x7F7F7F7F>
__device__ __forceinline__ void gemm_phase(LAS unsigned char* lds, const int K, const int lda, const int ldb, const Sched& S, const Epi& E) {
    int tz_ = tid_now(); asm volatile("" : "+v"(tz_));
    const int tid = tz_, wid = __builtin_amdgcn_readfirstlane(tid >> 6), lane = tid & 63, wr = wid >> 2, wc = wid & 3, fr = lane & 15, fq = lane >> 4;
    constexpr int ESZ = F8 ? 1 : 2;
    const int nt = K * ESZ / (BK * 2);
    unsigned voffA[2], voffB[2];
#pragma unroll
    for (int i = 0; i < 2; ++i) { int R, C; stage_rc(tid * 16 + i * 8192, R, C);
        voffA[i] = (unsigned)(R * lda * ESZ + C * 2); voffB[i] = (unsigned)((64 * (R >> 5) + perm32(R & 31)) * ldb * ESZ + C * 2); }
    const size_t kstep = (size_t)(BK * 2);
    const size_t hstepA = (size_t)HALF * lda * ESZ;
    const size_t hstepB = (size_t)32 * ldb * ESZ;
    const unsigned ldsw = (unsigned)wid * 1024u;
    const int aoff = F8 ? lds_byte(wr * 64 + fr, fq * 16) : lds_byte(wr * 64 + fr, fq * 8), boff = F8 ? lds_byte(wc * 32 + fr, fq * 16) : lds_byte(wc * 32 + fr, fq * 8);
#define PG8_SA(b, h) (((b) * 2 + (h)) * HTB)
#define PG8_SB(b, h) ((4 + (b) * 2 + (h)) * HTB)
#define PG8_STAGE(bufoff, gbase, voff) do { _Pragma("unroll") for (int _i = 0; _i < 2; ++_i) \
        __builtin_amdgcn_global_load_lds((const unsigned*)((const char*)(gbase) + (voff)[_i]), (LAS unsigned*)(lds + (bufoff) + ldsw + _i * 8192), 16, 0, 0); } while (0)
    typedef v8i_t v8i_a16 __attribute__((aligned(16)));
#define PG8_LD32(p) __builtin_bit_cast(v8i_t, __builtin_shufflevector(*(const LAS u32x4*)(p), *(const LAS u32x4*)((p) + 16), 0, 1, 2, 3, 4, 5, 6, 7))
#define PG8_LDA(dst, b, h) do { if constexpr (F8) { _Pragma("unroll") for (int m = 0; m < 4; ++m) dst##8[m] = PG8_LD32(lds + PG8_SA(b, h) + aoff + m * 2048); } \
        else { _Pragma("unroll") for (int m = 0; m < 4; ++m) _Pragma("unroll") for (int k = 0; k < 2; ++k) dst[m][k] = *(const LAS bf16x8*)(lds + PG8_SA(b, h) + aoff + m * 2048 + k * 1024); } } while (0)
#define PG8_LDB(dst, b, h) do { if constexpr (F8) { _Pragma("unroll") for (int n = 0; n < 2; ++n) dst##8[n] = PG8_LD32(lds + PG8_SB(b, h) + boff + n * 2048); } \
        else { _Pragma("unroll") for (int n = 0; n < 2; ++n) _Pragma("unroll") for (int k = 0; k < 2; ++k) dst[n][k] = *(const LAS bf16x8*)(lds + PG8_SB(b, h) + boff + n * 2048 + k * 1024); } } while (0)
#define PG8_MMA(ai, bj, At, Bt) do { __builtin_amdgcn_s_setprio(1); \
        if constexpr (F8) { _Pragma("unroll") for (int m = 0; m < 4; ++m) _Pragma("unroll") for (int n = 0; n < 2; ++n) \
            asm volatile("v_mfma_scale_f32_16x16x128_f8f6f4 %0, %1, %2, %0, %3, %4 op_sel_hi:[0,0,0]" : "+v"(acc[ai][bj][m][n]) : "v"(Bt##8[n]), "v"(At##8[m]), "v"(sbv), "v"(sav)); } \
        else { _Pragma("unroll") for (int m = 0; m < 4; ++m) _Pragma("unroll") for (int n = 0; n < 2; ++n) _Pragma("unroll") for (int k = 0; k < 2; ++k) \
            acc[ai][bj][m][n] = __builtin_amdgcn_mfma_f32_16x16x32_bf16(Bt[n][k], At[m][k], acc[ai][bj][m][n], 0, 0, 0); } \
        __builtin_amdgcn_s_setprio(0); } while (0)
#define PG8_WAIT_V(n) asm volatile("s_waitcnt vmcnt(" #n ")" ::: "memory")
#define PG8_WAIT_L(n) asm volatile("s_waitcnt lgkmcnt(" #n ")" ::: "memory")
#define PG8_BAR __builtin_amdgcn_s_barrier()
#define PG8_SCHED __builtin_amdgcn_sched_barrier(0)
    Unit cur, nxt; int ui = 0;
    if (!S.next(0, cur)) return;
    Acc acc;
#pragma unroll
    for (int a = 0; a < 2; ++a)
#pragma unroll
        for (int b = 0; b < 2; ++b)
#pragma unroll
            for (int m = 0; m < 4; ++m)
#pragma unroll
                for (int n = 0; n < 2; ++n) acc[a][b][m][n] = (f32x4){0.f, 0.f, 0.f, 0.f};
    bf16x8 At[4][2], B0[2][2], B1[2][2]; v8i_t At8[4], B08[2], B18[2];
    int sav = SA_, sbv = SB_;
    if (F8) { asm volatile("" : "+v"(sav)); asm volatile("" : "+v"(sbv)); }
    const char* cA = cur.a; const char* cB = cur.b;
    PG8_STAGE(PG8_SB(0, 0), cB, voffB); PG8_STAGE(PG8_SA(0, 0), cA, voffA); PG8_STAGE(PG8_SB(0, 1), cB + hstepB, voffB); PG8_STAGE(PG8_SA(0, 1), cA + hstepA, voffA);
    if (wr == 1) PG8_BAR;
    PG8_WAIT_V(4); PG8_BAR;
    PG8_STAGE(PG8_SB(1, 0), cB + kstep, voffB); PG8_STAGE(PG8_SA(1, 0), cA + kstep, voffA); PG8_STAGE(PG8_SB(1, 1), cB + hstepB + kstep, voffB);
    PG8_WAIT_V(6); PG8_BAR;
    for (;;) {
        const bool has_next = S.next(ui + 1, nxt);
        const char* nA = has_next ? nxt.a : cA; const char* nB = has_next ? nxt.b : cB;
        for (int t = 0; t < nt; t += 2) {
            const bool last = (t == nt - 2);
            const char* a1 = cA + (size_t)(t + 1) * kstep;
            const char* a2 = last ? nA : cA + (size_t)(t + 2) * kstep; const char* b2 = last ? nB : cB + (size_t)(t + 2) * kstep;
            const char* a3 = a2 + kstep; const char* b3 = b2 + kstep;
            if constexpr (Epi::HAS_MID) { if (t == nt / 2) E.mid(acc, cur, wr, wc, fr, fq); }
            PG8_LDB(B0, 0, 0); PG8_SCHED; PG8_LDA(At, 0, 0); PG8_STAGE(PG8_SA(1, 1), a1 + hstepA, voffA);
            PG8_WAIT_L(8); PG8_BAR; PG8_WAIT_L(0); PG8_MMA(0, 0, At, B0); PG8_BAR; PG8_SCHED;
            PG8_LDB(B1, 0, 1); PG8_STAGE(PG8_SB(0, 0), b2, voffB);
            PG8_BAR; PG8_WAIT_L(0); PG8_MMA(0, 1, At, B1); PG8_BAR;
            PG8_LDA(At, 0, 1); PG8_STAGE(PG8_SA(0, 0), a2, voffA);
            PG8_BAR; PG8_WAIT_L(0); PG8_MMA(1, 0, At, B0); PG8_BAR; PG8_SCHED;
            PG8_STAGE(PG8_SB(0, 1), b2 + hstepB, voffB);
            PG8_WAIT_V(6); PG8_BAR; PG8_MMA(1, 1, At, B1); PG8_BAR;
            PG8_LDB(B0, 1, 0); PG8_SCHED; PG8_LDA(At, 1, 0); PG8_STAGE(PG8_SA(0, 1), a2 + hstepA, voffA);
            PG8_WAIT_L(8); PG8_BAR; PG8_WAIT_L(0); PG8_MMA(0, 0, At, B0); PG8_BAR; PG8_SCHED;
            PG8_LDB(B1, 1, 1); PG8_STAGE(PG8_SB(1, 0), b3, voffB);
            PG8_BAR; PG8_WAIT_L(0); PG8_MMA(0, 1, At, B1); PG8_BAR;
            PG8_LDA(At, 1, 1); PG8_STAGE(PG8_SA(1, 0), a3, voffA);
            PG8_BAR; PG8_WAIT_L(0); PG8_MMA(1, 0, At, B0); PG8_BAR; PG8_SCHED;
            PG8_STAGE(PG8_SB(1, 1), b3 + hstepB, voffB);
            PG8_WAIT_V(6); PG8_BAR; PG8_MMA(1, 1, At, B1); PG8_BAR;
        }
        if constexpr (F8) asm volatile("s_nop 15\n\ts_nop 15" ::: "memory");
        E(acc, cur, wr, wc, fr, fq);
        if (!has_next) break;
#pragma unroll
        for (int a = 0; a < 2; ++a)
#pragma unroll
            for (int b = 0; b < 2; ++b)
#pragma unroll
                for (int m = 0; m < 4; ++m)
#pragma unroll
                    for (int n = 0; n < 2; ++n) acc[a][b][m][n] = (f32x4){0.f, 0.f, 0.f, 0.f};
        cur = nxt; cA = nA; cB = nB; ++ui;
    }
    PG8_WAIT_V(0);
    if (wr == 0) PG8_BAR;
    PG8_BAR;
#undef PG8_SA
#undef PG8_SB
#undef PG8_STAGE
#undef PG8_LDA
#undef PG8_LD32
#undef PG8_LDB
#undef PG8_MMA
#undef PG8_WAIT_V
#undef PG8_WAIT_L
#undef PG8_BAR
#undef PG8_SCHED
}

struct SchedGrid {
    const char* A; const char* B; size_t tstepA, tstepB; int nM, nN, nwg, G, c; bool mix32 = false;
    __device__ void init(const void* A_, int lda, const void* B_, int ldb, int M, int N, int G_, int c_, int esz = 2) {
        A = (const char*)A_; B = (const char*)B_; tstepA = (size_t)256 * lda * esz; tstepB = (size_t)256 * ldb * esz; nM = M / 256; nN = N / 256; nwg = nM * nN; G = G_; c = c_; }
    __device__ __forceinline__ bool next(int i, Unit& u) const {
        const long L = (long)i * G + c; if (L >= nwg) return false;
        int wgid = (int)L; { const int q = nwg / 8, r = nwg % 8, xcd = wgid % 8, off = wgid / 8; wgid = (xcd < r ? xcd * (q + 1) : r * (q + 1) + (xcd - r) * q) + off; }
        const int nig = 8 * nN, gid = wgid / nig, fm = gid * 8, gsz = (nM - fm) < 8 ? (nM - fm) : 8;
        u.pm = fm + ((wgid % nig) % gsz); u.pn = (wgid % nig) / gsz; u.grp = 0;
        if (mix32) { const int a = u.pn >> 4, r4 = (u.pn >> 2) & 3, r = u.pn & 3; u.pn = ((r4 & 1) << 4) | (a << 3) | ((r4 >> 1) << 2) | r; }
        u.a = A + (size_t)u.pm * tstepA; u.b = B + (size_t)u.pn * tstepB; return true;
    }
};
struct SchedGroup {
    const char* A; const char* B; size_t tstepA, tstepB, gstepA, gstepB; int nM, nN, total, G, c;
    __device__ void init(const void* A_, int lda, size_t gA, const void* B_, int ldb, size_t gB, int nM_, int nN_, int NG, int G_, int c_, int esz = 2) {
        A = (const char*)A_; B = (const char*)B_; tstepA = (size_t)256 * lda * esz; tstepB = (size_t)256 * ldb * esz; gstepA = gA; gstepB = gB; nM = nM_; nN = nN_; total = NG * nM_ * nN_; G = G_; c = c_; }
    __device__ __forceinline__ bool next(int i, Unit& u) const {
        const long L = (long)i * G + c; if (L >= total) return false;
        const int per = nM * nN, g = (int)L / per, r = (int)L % per;
        u.grp = g; u.pm = r % nM; u.pn = r / nM;
        u.a = A + (size_t)g * gstepA + (size_t)u.pm * tstepA; u.b = B + (size_t)g * gstepB + (size_t)u.pn * tstepB; return true;
    }
};
}

#define EPI_LANES int tz_ = tid_now(); asm volatile("" : "+v"(tz_)); const int wr = tz_ >> 8, wc = (tz_ >> 6) & 3, fr = tz_ & 15, fq = (tz_ >> 4) & 3;
#define EPI_ROWVALS(name, ptr, base) float name[2][4]; _Pragma("unroll") for (int ai = 0; ai < 2; ++ai) _Pragma("unroll") for (int m = 0; m < 4; ++m) name[ai][m] = (ptr)[(base) + ai * 128 + wr * 64 + m * 16 + fr];
#define EPI_FOR _Pragma("unroll") for (int ai = 0; ai < 2; ++ai) _Pragma("unroll") for (int m = 0; m < 4; ++m)
#define EPI_RL const int rl = ai * 128 + wr * 64 + m * 16 + fr;
__device__ __forceinline__ u32x4 pack8(const f32x4 a, const f32x4 b) { u32x4 w; w.x = cvt_pk_bf16(a[0], a[1]); w.y = cvt_pk_bf16(a[2], a[3]); w.z = cvt_pk_bf16(b[0], b[1]); w.w = cvt_pk_bf16(b[2], b[3]); return w; }
__device__ __forceinline__ void unpack8(const u32x4 w, f32x4& a, f32x4& b) { a = (f32x4){bf_lo(w.x), bf_hi(w.x), bf_lo(w.y), bf_hi(w.y)}; b = (f32x4){bf_lo(w.z), bf_hi(w.z), bf_lo(w.w), bf_hi(w.w)}; }

struct EpiInProj {
    static constexpr bool HAS_MID = false;
    const float* rinv; bf16_t *UA, *Q, *Kb, *V, *G; const float *qg, *kg;
    __device__ __forceinline__ void operator()(const pg::Acc& acc, const pg::Unit& u, int, int, int, int) const { EPI_LANES
        const int pn = u.pn, row0 = u.pm * 256;
        EPI_ROWVALS(rsv, rinv, row0)
        if (pn < 4) {
            EPI_FOR { EPI_RL const int tok = row0 + rl; const float rs = rsv[ai][m]; const int c = tok >> 5, tau = tok & 31;
#pragma unroll
                for (int bj = 0; bj < 2; ++bj) { const int ch = 256 * pn + 64 * wc + 32 * bj + 8 * fq, g = ch >> 4, p0 = ch & 15;
                    *(u32x4*)(UA + ((size_t)(g * NCH + c) * UAW + tau * 16 + p0)) = pack8(acc[ai][bj][m][0] * rs, acc[ai][bj][m][1] * rs); } }
        } else if (pn < 12) {
            const bool isq = pn < 8; const int col0 = 256 * (pn - (isq ? 4 : 8)) + 64 * wc; const float* gp = isq ? qg : kg; const float sc = isq ? 0.125f * LOG2E : 1.f;
            bf16_t* dst = isq ? Q : Kb;
            f32x4 gv[2][2];
#pragma unroll
            for (int bj = 0; bj < 2; ++bj)
#pragma unroll
                for (int n = 0; n < 2; ++n) gv[bj][n] = *(const f32x4*)(gp + 32 * bj + 8 * fq + 4 * n) * sc;
            EPI_FOR { EPI_RL const int tok = row0 + rl; const float rs = rsv[ai][m];
                f32x4 v[2][2]; float ss = 0.f;
#pragma unroll
                for (int bj = 0; bj < 2; ++bj)
#pragma unroll
                    for (int n = 0; n < 2; ++n) { v[bj][n] = acc[ai][bj][m][n] * rs; ss += v[bj][n][0] * v[bj][n][0] + v[bj][n][1] * v[bj][n][1] + v[bj][n][2] * v[bj][n][2] + v[bj][n][3] * v[bj][n][3]; }
                ss += __shfl_xor(ss, 16); ss += __shfl_xor(ss, 32);
                const float r = __builtin_amdgcn_rsqf(ss * (1.f / 64.f) + EPS);
#pragma unroll
                for (int bj = 0; bj < 2; ++bj)
                    *(u32x4*)(dst + (size_t)tok * 1024 + col0 + 32 * bj + 8 * fq) = pack8(v[bj][0] * r * gv[bj][0], v[bj][1] * r * gv[bj][1]); }
        } else {
            EPI_FOR { EPI_RL const int tok = row0 + rl; const float rs = rsv[ai][m];
#pragma unroll
                for (int bj = 0; bj < 2; ++bj)
                    *(u32x4*)(V + (size_t)tok * 1024 + 256 * (pn - 12) + 64 * wc + 32 * bj + 8 * fq) = pack8(acc[ai][bj][m][0] * rs, acc[ai][bj][m][1] * rs); }
        }
    }
};
struct EpiGates {
    static constexpr bool HAS_MID = false;
    const float* rinv; bf16_t* G;
    __device__ __forceinline__ void operator()(const pg::Acc& acc, const pg::Unit& u, int, int, int, int) const { EPI_LANES
        EPI_ROWVALS(rsv, rinv, u.pm * 256)
        EPI_FOR { EPI_RL const int tok = u.pm * 256 + rl; const float rs = rsv[ai][m];
#pragma unroll
            for (int bj = 0; bj < 2; ++bj) { f32x4 a = acc[ai][bj][m][0] * rs, b = acc[ai][bj][m][1] * rs;
#pragma unroll
                for (int j = 0; j < 4; ++j) { a[j] = fast_sigmoid(a[j]); b[j] = fast_sigmoid(b[j]); }
                *(u32x4*)(G + (size_t)tok * 4096 + 256 * u.pn + 64 * wc + 32 * bj + 8 * fq) = pack8(a, b); } }
    }
};
struct EpiSsum {
    static constexpr bool HAS_MID = false;
    float* SS;
    __device__ __forceinline__ void operator()(const pg::Acc& acc, const pg::Unit& u, int, int, int, int) const { EPI_LANES
        EPI_FOR { EPI_RL float* rp = SS + ((size_t)u.grp * NCH + rl) * 256 + 64 * wc + 8 * fq;
#pragma unroll
            for (int bj = 0; bj < 2; ++bj) { *(f32x4*)(rp + 32 * bj) = acc[ai][bj][m][0]; *(f32x4*)(rp + 32 * bj + 4) = acc[ai][bj][m][1]; } }
    }
};
__device__ __forceinline__ float gelu_tanh(float x) {
    const float t = 1.5957691216057308f * (x + 0.044715f * x * x * x);
    return x * fast_sigmoid(t);
}
struct EpiSsmOut {
    static constexpr bool HAS_MID = false;
    bf16_t* Y;
    __device__ __forceinline__ void operator()(const pg::Acc& acc, const pg::Unit& u, int, int, int, int) const { EPI_LANES
        EPI_FOR { EPI_RL
#pragma unroll
            for (int bj = 0; bj < 2; ++bj) { const int col = 256 * u.pn + 64 * wc + 32 * bj + 8 * fq, t = col >> 4, p0 = col & 15;
                f32x4 a = acc[ai][bj][m][0], b = acc[ai][bj][m][1];
#pragma unroll
                for (int j = 0; j < 4; ++j) { a[j] = gelu_tanh(a[j]); b[j] = gelu_tanh(b[j]); }
                *(u32x4*)(Y + (size_t)(rl * TC + t) * SSMW + u.grp * GP + p0) = pack8(a, b); } }
    }
};
struct EpiGlu {
    static constexpr bool HAS_MID = false;
    const bf16_t* Y; bf16_t* YO;
    __device__ __forceinline__ void operator()(const pg::Acc& acc, const pg::Unit& u, int, int, int, int) const { EPI_LANES
        const int colb = 256 * u.pn + 64 * wc + 8 * fq; const size_t rb = (size_t)(u.pm * 256 + wr * 64 + fr);
        u32x4 cur[2], nxt[2];
        cur[0] = *(const u32x4*)(Y + rb * SSMW + colb); cur[1] = *(const u32x4*)(Y + rb * SSMW + colb + 32);
#pragma unroll
        for (int r_ = 0; r_ < 8; ++r_) { const int ai = r_ >> 2, m = r_ & 3; const size_t tok = rb + ai * 128 + m * 16;
            if (r_ < 7) { const size_t tn = rb + ((r_ + 1) >> 2) * 128 + ((r_ + 1) & 3) * 16; nxt[0] = *(const u32x4*)(Y + tn * SSMW + colb); nxt[1] = *(const u32x4*)(Y + tn * SSMW + colb + 32); }
#pragma unroll
            for (int bj = 0; bj < 2; ++bj) { f32x4 ya, yb; unpack8(cur[bj], ya, yb);
                f32x4 a = acc[ai][bj][m][0], b = acc[ai][bj][m][1];
#pragma unroll
                for (int j = 0; j < 4; ++j) { a[j] = ya[j] * fast_sigmoid(a[j]); b[j] = yb[j] * fast_sigmoid(b[j]); }
                *(u32x4*)(YO + tok * 2048 + colb + 32 * bj) = pack8(a, b); }
            cur[0] = nxt[0]; cur[1] = nxt[1]; }
    }
};
struct EpiMerge {
    static constexpr bool HAS_MID = true;
    const bf16_t* G; bf16_t* MG;
    __device__ __forceinline__ void mid(pg::Acc& acc, const pg::Unit& u, int, int, int, int) const { EPI_LANES
        const int colb = 256 * u.pn + 64 * wc + 8 * fq; const size_t rb = (size_t)(u.pm * 256 + wr * 64 + fr);
        u32x4 cur[4], nxt[4];
#pragma unroll
        for (int q = 0; q < 4; ++q) cur[q] = *(const u32x4*)(G + rb * 4096 + (q >> 1) * 2048 + colb + 32 * (q & 1));
#pragma unroll
        for (int r_ = 0; r_ < 8; ++r_) { const int ai = r_ >> 2, m = r_ & 3;
            if (r_ < 7) { const size_t tn = rb + ((r_ + 1) >> 2) * 128 + ((r_ + 1) & 3) * 16;
#pragma unroll
                for (int q = 0; q < 4; ++q) nxt[q] = *(const u32x4*)(G + tn * 4096 + (q >> 1) * 2048 + colb + 32 * (q & 1)); }
#pragma unroll
            for (int bj = 0; bj < 2; ++bj) { f32x4 sa, sb, ga, gb; unpack8(cur[bj], sa, sb); unpack8(cur[2 + bj], ga, gb);
#pragma unroll
                for (int j = 0; j < 4; ++j) { acc[ai][bj][m][0][j] *= sa[j] * __builtin_amdgcn_rcpf(ga[j]); acc[ai][bj][m][1][j] *= sb[j] * __builtin_amdgcn_rcpf(gb[j]); } }
#pragma unroll
            for (int q = 0; q < 4; ++q) cur[q] = nxt[q];
            __builtin_amdgcn_sched_barrier(0); }
    }
    __device__ __forceinline__ void operator()(const pg::Acc& acc, const pg::Unit& u, int, int, int, int) const { EPI_LANES
        const int colb = 256 * u.pn + 64 * wc + 8 * fq; const size_t rb = (size_t)(u.pm * 256 + wr * 64 + fr);
        u32x4 cur[2], nxt[2];
        cur[0] = *(const u32x4*)(G + rb * 4096 + 2048 + colb); cur[1] = *(const u32x4*)(G + rb * 4096 + 2048 + colb + 32);
#pragma unroll
        for (int r_ = 0; r_ < 8; ++r_) { const int ai = r_ >> 2, m = r_ & 3; const size_t tok = rb + ai * 128 + m * 16;
            if (r_ < 7) { const size_t tn = rb + ((r_ + 1) >> 2) * 128 + ((r_ + 1) & 3) * 16; nxt[0] = *(const u32x4*)(G + tn * 4096 + 2048 + colb); nxt[1] = *(const u32x4*)(G + tn * 4096 + 2048 + colb + 32); }
#pragma unroll
            for (int bj = 0; bj < 2; ++bj) { f32x4 ga, gb; unpack8(cur[bj], ga, gb);
                *(u32x4*)(MG + tok * 2048 + colb + 32 * bj) = pack8(acc[ai][bj][m][0] * ga, acc[ai][bj][m][1] * gb); }
            cur[0] = nxt[0]; cur[1] = nxt[1]; }
    }
};
struct EpiOutProj {
    static constexpr bool HAS_MID = false;
    const bf16_t* XR; bf16_t* XO;
    __device__ __forceinline__ void operator()(const pg::Acc& acc, const pg::Unit& u, int, int, int, int) const { EPI_LANES
        const int colb = 256 * u.pn + 64 * wc + 8 * fq; const size_t rb = (size_t)(u.pm * 256 + wr * 64 + fr);
        u32x4 cur[2], nxt[2];
        cur[0] = *(const u32x4*)(XR + rb * 2048 + colb); cur[1] = *(const u32x4*)(XR + rb * 2048 + colb + 32);
#pragma unroll
        for (int r_ = 0; r_ < 8; ++r_) { const int ai = r_ >> 2, m = r_ & 3; const size_t tok = rb + ai * 128 + m * 16;
            if (r_ < 7) { const size_t tn = rb + ((r_ + 1) >> 2) * 128 + ((r_ + 1) & 3) * 16; nxt[0] = *(const u32x4*)(XR + tn * 2048 + colb); nxt[1] = *(const u32x4*)(XR + tn * 2048 + colb + 32); }
#pragma unroll
            for (int bj = 0; bj < 2; ++bj) { f32x4 a, b; unpack8(cur[bj], a, b);
                *(u32x4*)(XO + tok * 2048 + colb + 32 * bj) = pack8(a + acc[ai][bj][m][0], b + acc[ai][bj][m][1]); }
            cur[0] = nxt[0]; cur[1] = nxt[1]; }
    }
};
struct EpiExp1 {
    static constexpr bool HAS_MID = false;
    const float* RSL; bf16_t* H;
    __device__ __forceinline__ void operator()(const pg::Acc& acc, const pg::Unit& u, int, int, int, int) const { EPI_LANES
        EPI_ROWVALS(rsv, RSL, u.grp * CAP + u.pm * 256)
        EPI_FOR { EPI_RL const int row = u.grp * CAP + u.pm * 256 + rl; const float rs = rsv[ai][m];
            f32x4 h[2];
#pragma unroll
            for (int n = 0; n < 2; ++n)
#pragma unroll
                for (int j = 0; j < 4; ++j) { const float g = acc[ai][0][m][n][j] * rs, up = acc[ai][1][m][n][j] * rs; h[n][j] = g * fast_sigmoid(g) * up; }
            *(u32x2*)((unsigned char*)H + (size_t)row * FF + 128 * u.pn + 32 * wc + 8 * fq) = pack8_fp8(h[0] * H8_SCALE, h[1] * H8_SCALE); }
    }
};
struct EpiExp2 {
    static constexpr bool HAS_MID = false;
    const float* GATE; bf16_t* YX;
    __device__ __forceinline__ void operator()(const pg::Acc& acc, const pg::Unit& u, int, int, int, int) const { EPI_LANES
        EPI_ROWVALS(gtv, GATE, u.grp * CAP + u.pm * 256)
        EPI_FOR { EPI_RL const int row = u.grp * CAP + u.pm * 256 + rl; const float gt = gtv[ai][m];
#pragma unroll
            for (int bj = 0; bj < 2; ++bj)
                *(u32x4*)(YX + (size_t)row * D + 256 * u.pn + 64 * wc + 32 * bj + 8 * fq) = pack8(acc[ai][bj][m][0] * gt, acc[ai][bj][m][1] * gt); }
    }
};

namespace att {
constexpr int KVBLK = 64, QBLK = 32;
constexpr int SHM_T = KVBLK * 256;
constexpr int OFF_K = 0, OFF_V = 3 * SHM_T, OFF_Q = 5 * SHM_T, OFF_WS = OFF_Q + 8 * 8192, OFF_BT = OFF_WS + 8 * 64 * 4, ATT_LDS_END = OFF_BT + 2048;
#define KSWZ(row, colB) ((row) * 256 + ((colB) ^ (((row) & 7) << 4)))
#define SBAR() __builtin_amdgcn_sched_barrier(0)
__device__ __forceinline__ int crow(int r, int hi) { return (r & 3) + 8 * (r >> 2) + 4 * hi; }
__device__ __forceinline__ int v_rd_base(int lane) { return ((lane & 3) << 3) | (((lane >> 2) & 3) << 6) | (((lane >> 4) & 1) << 5) | (((lane >> 5) & 1) << 8); }
constexpr int v_rd_off(int d0, int ks, int half) { return d0 * 512 + ks * 4096 + half * 2048; }
template <int OFF> __device__ __forceinline__ s16x4 tr_read(int vb) { s16x4 r; asm volatile("ds_read_b64_tr_b16 %0, %1 offset:%2" : "=&v"(r) : "v"(vb), "i"(OFF) : "memory"); return r; }
template <int D0> __device__ __forceinline__ void pv_one(f32x16& od, int vb, bf16x8 pa0, bf16x8 pa1, bf16x8 pa2, bf16x8 pa3) {
    const s16x4 l0 = tr_read<v_rd_off(D0, 0, 0)>(vb), h0 = tr_read<v_rd_off(D0, 0, 1)>(vb), l1 = tr_read<v_rd_off(D0, 1, 0)>(vb), h1 = tr_read<v_rd_off(D0, 1, 1)>(vb);
    const s16x4 l2 = tr_read<v_rd_off(D0, 2, 0)>(vb), h2 = tr_read<v_rd_off(D0, 2, 1)>(vb), l3 = tr_read<v_rd_off(D0, 3, 0)>(vb), h3 = tr_read<v_rd_off(D0, 3, 1)>(vb);
    asm volatile("s_waitcnt lgkmcnt(0)" ::: "memory"); SBAR();
#define PK(L, H) (bf16x8){L[0], L[1], L[2], L[3], H[0], H[1], H[2], H[3]}
    od = __builtin_amdgcn_mfma_f32_32x32x16_bf16(pa0, PK(l0, h0), od, 0, 0, 0);
    od = __builtin_amdgcn_mfma_f32_32x32x16_bf16(pa1, PK(l1, h1), od, 0, 0, 0);
    od = __builtin_amdgcn_mfma_f32_32x32x16_bf16(pa2, PK(l2, h2), od, 0, 0, 0);
    od = __builtin_amdgcn_mfma_f32_32x32x16_bf16(pa3, PK(l3, h3), od, 0, 0, 0);
#undef PK
}
__device__ __forceinline__ void pv_d0(f32x16* o, int vb, bf16x8 pa0, bf16x8 pa1, bf16x8 pa2, bf16x8 pa3) {
    pv_one<0>(o[0], vb, pa0, pa1, pa2, pa3); pv_one<1>(o[1], vb, pa0, pa1, pa2, pa3); pv_one<2>(o[2], vb, pa0, pa1, pa2, pa3); pv_one<3>(o[3], vb, pa0, pa1, pa2, pa3);
}
__device__ __forceinline__ int kq_addr(int row, int c) { return (c >> 2) * 4096 + row * 64 + (((c & 3) ^ ((row >> 2) & 3)) << 4); }
template <int COMP> __device__ __forceinline__ void qkt(f32x16& p0, f32x16& p1, const LAS char* Ks, const LAS char* Qs, int kq0, int kq1) {
    p0 = (f32x16){}; p1 = (f32x16){};
    bf16x8 b0[4], b1[4], qf[4];
#define QK_LD(d0) { constexpr int chi = COMP * 2 + ((d0) >> 1); const int a = ((d0) & 1) ? kq1 : kq0; \
        b0[d0] = *(const LAS bf16x8*)(Ks + a + chi * 4096); b1[d0] = *(const LAS bf16x8*)(Ks + a + chi * 4096 + 2048); qf[d0] = *(const LAS bf16x8*)(Qs + a + chi * 2048); }
#define QK_MM(d0) { p0 = __builtin_amdgcn_mfma_f32_32x32x16_bf16(b0[d0], qf[d0], p0, 0, 0, 0); p1 = __builtin_amdgcn_mfma_f32_32x32x16_bf16(b1[d0], qf[d0], p1, 0, 0, 0); }
    QK_LD(0) QK_LD(1) SBAR();
    QK_MM(0) QK_MM(1) QK_LD(2) QK_LD(3) SBAR();
    QK_MM(2) QK_MM(3)
#undef QK_LD
#undef QK_MM
}
__device__ __forceinline__ void sm_exp(f32x16& p0, f32x16& p1, const LAS float* bt, int relb, int dq, int hi) {
    if (dq > -191 && dq < 158) {
        const LAS float* bp = bt + relb + 4 * hi;
#pragma unroll
        for (int a = 0; a < 4; ++a) {
            float t0[4], t1[4];
#pragma unroll
            for (int b = 0; b < 4; ++b) { t0[b] = bp[8 * a + b]; t1[b] = bp[32 + 8 * a + b]; }
#pragma unroll
            for (int b = 0; b < 4; ++b) { p0[4 * a + b] += t0[b]; p1[4 * a + b] += t1[b]; }
            SBAR();
        } }
#pragma unroll
    for (int r = 0; r < 16; ++r) p0[r] = __builtin_amdgcn_exp2f(p0[r]);
#pragma unroll
    for (int r = 0; r < 16; ++r) p1[r] = __builtin_amdgcn_exp2f(p1[r]);
}
__device__ __forceinline__ void sm_fin(f32x16& p0, f32x16& p1, float& l_reg, bf16x8& pa0, bf16x8& pa1, bf16x8& pa2, bf16x8& pa3) {
    float ps = 0;
#pragma unroll
    for (int r = 0; r < 16; ++r) ps += p0[r];
#pragma unroll
    for (int r = 0; r < 16; ++r) ps += p1[r];
    { auto rr = __builtin_amdgcn_permlane32_swap(__float_as_uint(ps), __float_as_uint(ps), false, false);
      ps = __uint_as_float(rr[0]) + __uint_as_float(rr[1]); }
    l_reg += ps;
#define PK4(P, BASE, OUT) do { unsigned a0 = cvt_pk_bf16(P[BASE + 0], P[BASE + 1]), a1 = cvt_pk_bf16(P[BASE + 2], P[BASE + 3]);   \
    unsigned b0 = cvt_pk_bf16(P[BASE + 4], P[BASE + 5]), b1 = cvt_pk_bf16(P[BASE + 6], P[BASE + 7]);                              \
    auto r0 = __builtin_amdgcn_permlane32_swap(a0, b0, false, false); auto r1 = __builtin_amdgcn_permlane32_swap(a1, b1, false, false); \
    u32x4 w = {r0[0], r1[0], r0[1], r1[1]}; OUT = *reinterpret_cast<bf16x8*>(&w); } while (0)
    PK4(p0, 0, pa0); PK4(p0, 8, pa1); PK4(p1, 0, pa2); PK4(p1, 8, pa3);
#undef PK4
}
__device__ __forceinline__ void attn_dual(f32x16 (&o1)[4], f32x16 (&o2)[4], const bf16_t* __restrict__ Qg, const bf16_t* __restrict__ Kh, const bf16_t* __restrict__ Vh, LAS char* lds, int q0w) {
    int tz_ = tid_now(); asm volatile("" : "+v"(tz_));
    const int tid = tz_, wid = __builtin_amdgcn_readfirstlane(tid >> 6), lane = tid & 63, r32 = lane & 31, hi = lane >> 5;
    LAS char* K_lds = lds + OFF_K; LAS char* V_lds = lds + OFF_V; LAS char* Qs = lds + OFF_Q + wid * 8192;
    const LAS float* bt = (const LAS float*)(lds + OFF_BT);
    float l1 = 0.f, l2 = 0.f;
#pragma unroll
    for (int d = 0; d < 4; ++d) { o1[d] = (f32x16){}; o2[d] = (f32x16){}; }
#pragma unroll
    for (int i = 0; i < 8; ++i) { const int ci = i * 64 + lane, row = (ci >> 2) & 31, c = (ci >> 7) * 4 + ((ci & 3) ^ ((row >> 2) & 3));
        __builtin_amdgcn_global_load_lds((const unsigned*)(Qg + (size_t)row * 1024 + c * 8), (LAS unsigned*)(Qs + i * 1024), 16, 0, 0); }
    const int kq0 = r32 * 64 + ((hi ^ ((r32 >> 2) & 3)) << 4), kq1 = r32 * 64 + (((2 + hi) ^ ((r32 >> 2) & 3)) << 4);
    unsigned ko0, vo0;
    { const int p = wid * 2;
        { const int ci = p * 64 + lane, row = (ci >> 2) & 63, c = (ci >> 8) * 4 + ((ci & 3) ^ ((row >> 2) & 3)); ko0 = (unsigned)(row * 1024 + c * 8) * 2u; }
        { const int ci = p * 64 + lane, sub = ci >> 5, kk = (sub >> 2) * 8 + ((ci >> 2) & 7), c = (sub & 3) * 32 + (ci & 3) * 8;
          const int k = (kk & ~0xC) | ((kk & 4) << 1) | ((kk & 8) >> 1); vo0 = (unsigned)(k * 1024 + c) * 2u; } }
    const unsigned pw = (unsigned)wid * 2048u;
#define DMA_K(buf, k0) do { const char* g_ = (const char*)(Kh + (size_t)(k0) * 1024); unsigned o_ = ko0; asm volatile("" : "+v"(o_)); \
    __builtin_amdgcn_global_load_lds((const unsigned*)(g_ + o_), (LAS unsigned*)(K_lds + (buf) * SHM_T + pw), 16, 0, 0); \
    __builtin_amdgcn_global_load_lds((const unsigned*)(g_ + o_ + 32768u), (LAS unsigned*)(K_lds + (buf) * SHM_T + pw + 1024), 16, 0, 0); } while (0)
#define DMA_V(buf, k0) do { const char* g_ = (const char*)(Vh + (size_t)(k0) * 1024); unsigned o_ = vo0; asm volatile("" : "+v"(o_)); \
    __builtin_amdgcn_global_load_lds((const unsigned*)(g_ + o_), (LAS unsigned*)(V_lds + (buf) * SHM_T + pw), 16, 0, 0); \
    __builtin_amdgcn_global_load_lds((const unsigned*)(g_ + o_ + 128u), (LAS unsigned*)(V_lds + (buf) * SHM_T + pw + 1024), 16, 0, 0); } while (0)
    const int vbb = (int)(size_t)V_lds + v_rd_base(lane);
    const int relq = 256 - (q0w + r32);
    f32x16 pA0, pA1, pB0, pB1; bf16x8 pa0, pa1, pa2, pa3; constexpr int NT = S / KVBLK;
    DMA_K(0, 0); DMA_K(1, KVBLK); DMA_V(0, 0);
    asm volatile("s_waitcnt vmcnt(0) lgkmcnt(0)" ::: "memory"); __syncthreads();
    qkt<0>(pA0, pA1, K_lds, Qs, kq0, kq1); sm_exp(pA0, pA1, bt, relq, 0 - q0w, hi);
    int kb = 0, vb = 0;
    int ureg = (0 - q0w <= -191) ? 0 : ((0 - q0w >= 158) ? 2 : 1);
    for (int j = 0; j < NT; ++j) {
        asm volatile("s_waitcnt vmcnt(0)" ::: "memory"); __syncthreads();
        const int kb1 = kb == 2 ? 0 : kb + 1, kb2 = kb1 == 2 ? 0 : kb1 + 1;
        if (j + 2 < NT) DMA_K(kb2, (j + 2) * KVBLK);
        if (j + 1 < NT) DMA_V(vb ^ 1, (j + 1) * KVBLK);
        const int dq = j * KVBLK - q0w;
        { const int u = (dq <= -191) ? 0 : ((dq >= 158) ? 2 : 1);
          if (u != ureg) {
              const float cp = ureg == 0 ? bt[0] : (ureg == 2 ? bt[511] : 0.f), cn = u == 0 ? bt[0] : (u == 2 ? bt[511] : 0.f);
              const float f = __builtin_amdgcn_exp2f(cp - cn);
#pragma unroll
              for (int d = 0; d < 4; ++d) { o1[d] = o1[d] * f; o2[d] = o2[d] * f; }
              l1 *= f; l2 *= f; ureg = u; } }
        sm_fin(pA0, pA1, l1, pa0, pa1, pa2, pa3); SBAR();
        qkt<1>(pB0, pB1, K_lds + kb * SHM_T, Qs, kq0, kq1); SBAR();
        pv_d0(o1, vbb + vb * SHM_T, pa0, pa1, pa2, pa3);
        sm_exp(pB0, pB1, bt, relq + j * KVBLK, dq, hi);
        sm_fin(pB0, pB1, l2, pa0, pa1, pa2, pa3); SBAR();
        if (j + 1 < NT) { qkt<0>(pA0, pA1, K_lds + kb1 * SHM_T, Qs, kq0, kq1); SBAR(); }
        pv_d0(o2, vbb + vb * SHM_T, pa0, pa1, pa2, pa3);
        if (j + 1 < NT) sm_exp(pA0, pA1, bt, relq + (j + 1) * KVBLK, dq + KVBLK, hi);
        kb = kb1; vb ^= 1;
    }
    const int ln2_ = lane_now(), r32b = ln2_ & 31, hib = ln2_ >> 5;
    LAS float* li2 = (LAS float*)(lds + OFF_WS) + wid * 64;
    if (hib == 0) li2[r32b] = l1; asm volatile("s_waitcnt lgkmcnt(0)" ::: "memory");
#pragma unroll
    for (int r = 0; r < 16; ++r) { const float rl = __builtin_amdgcn_rcpf(li2[crow(r, hib)]);
#pragma unroll
        for (int d = 0; d < 4; ++d) o1[d][r] *= rl; }
    asm volatile("s_waitcnt lgkmcnt(0)" ::: "memory");
    if (hib == 0) li2[r32b] = l2; asm volatile("s_waitcnt lgkmcnt(0)" ::: "memory");
#pragma unroll
    for (int r = 0; r < 16; ++r) { const float rl = __builtin_amdgcn_rcpf(li2[crow(r, hib)]);
#pragma unroll
        for (int d = 0; d < 4; ++d) o2[d][r] *= rl; }
#undef DMA_K
#undef DMA_V
}
}

__device__ __forceinline__ int t5_bucket(int rel) {
    const int side = rel > 0 ? 16 : 0; const int n = rel < 0 ? -rel : rel;
    if (n < 8) return side + n;
    const float v = logf((float)n / 8.0f) / 2.7725887f * 8.0f;
    int large = 8 + (int)v; large = large < 15 ? large : 15;
    return side + large;
}

struct Args { GAS const float* in[28]; GAS float* out; GAS unsigned char* ws; int ph_lo, ph_hi; };
typedef const Args __attribute__((address_space(4))) CArgs;
struct LayerW { bf16_t *WIN, *WGLU, *WBR, *WOUT, *WGU, *WD, *F, *BO; float *KTAB, *WRT; };
__device__ __forceinline__ LayerW layer_w(unsigned char* ws, int l) {
    unsigned char* b = ws + WS_LW + (size_t)l * LW_SIZE; LayerW w;
    w.WIN = (bf16_t*)(b + LW_WIN); w.WGLU = (bf16_t*)(b + LW_WGLU); w.WBR = (bf16_t*)(b + LW_WBR); w.WOUT = (bf16_t*)(b + LW_WOUT); w.WGU = (bf16_t*)(b + LW_WGU);
    w.WD = (bf16_t*)(b + LW_WD); w.F = (bf16_t*)(b + LW_F); w.BO = (bf16_t*)(b + LW_BO); w.KTAB = (float*)(b + LW_KTAB); w.WRT = (float*)(b + LW_WRT); return w;
}
enum { I_X = 0, I_WIN, I_ARE, I_AIM, I_LDT, I_BRE, I_BIM, I_CRE, I_CIM, I_SD, I_WGLU, I_WSB, I_QG, I_KG, I_LQ1, I_LK1, I_LQ2, I_LK2, I_SUBLN, I_WAB, I_RELB, I_WOUT,
       I_NMIX, I_NFFN, I_WR, I_WEG, I_WEU, I_WED };

struct TItem { const float* src; bf16_t* dst; const float* gain; int N, ldd, rowmode, f8; };
__device__ __forceinline__ void t_load(const TItem& t, f32x4 (&v)[16], int lane) {
    const int r = lane >> 4, q = lane & 15;
#pragma unroll
    for (int j = 0; j < 16; ++j) v[j] = __builtin_nontemporal_load((const f32x4*)(t.src + (size_t)(4 * j + r) * t.N + 4 * q));
}
__device__ __forceinline__ void t_lds(const f32x4 (&v)[16], LAS float* scr, int lane) {
    const int r = lane >> 4, q = lane & 15;
#pragma unroll
    for (int j = 0; j < 16; ++j) { LAS float* s = scr + (4 * j + r) * 65 + 4 * q; s[0] = v[j][0]; s[1] = v[j][1]; s[2] = v[j][2]; s[3] = v[j][3]; }
}
__device__ __forceinline__ void t_store(const TItem& t, int n0, LAS float* scr, int lane) {
    const int c = lane & 7;
    float gn[8];
#pragma unroll
    for (int i = 0; i < 8; ++i) gn[i] = t.gain ? t.gain[8 * c + i] : 1.f;
#pragma unroll
    for (int j = 0; j < 8; ++j) { const int n = (lane >> 3) + 8 * j; const LAS float* s = scr + (8 * c) * 65 + n;
        u32x4 o; o.x = cvt_pk_bf16(s[0 * 65] * gn[0], s[1 * 65] * gn[1]); o.y = cvt_pk_bf16(s[2 * 65] * gn[2], s[3 * 65] * gn[3]);
        o.z = cvt_pk_bf16(s[4 * 65] * gn[4], s[5 * 65] * gn[5]); o.w = cvt_pk_bf16(s[6 * 65] * gn[6], s[7 * 65] * gn[7]);
        const int ng = n0 + n; const int drow = t.rowmode == 0 ? ng : ((ng >> 7) * 256 + ((ng >> 5) & 3) * 64 + (ng & 31) + (t.rowmode == 2 ? 32 : 0));
        if (t.f8) { const f32x4 a = (f32x4){s[0 * 65] * gn[0], s[1 * 65] * gn[1], s[2 * 65] * gn[2], s[3 * 65] * gn[3]} * W8_SCALE, b = (f32x4){s[4 * 65] * gn[4], s[5 * 65] * gn[5], s[6 * 65] * gn[6], s[7 * 65] * gn[7]} * W8_SCALE;
            *(u32x2*)((unsigned char*)t.dst + (size_t)drow * t.ldd + 8 * c) = pack8_fp8(a, b); }
        else *(u32x4*)(t.dst + (size_t)drow * t.ldd + 8 * c) = o; }
}

constexpr int IT_WIN = (D / 64) * (INC / 64), IT_GLU = 16 * 16, IT_BR = 16 * 32, IT_OUT = 32 * 32, IT_E = 32 * 32;
constexpr int DQ_A_I = 6144, DQ_A_G = 512, DQ_B_I = 5120, DQ_B_G = 1024, DQ_C_I = 5120, DQ_C_G = 1024;
constexpr int DQ_A0 = 0, DQ_A1 = DQ_A0 + DQ_A_I, DQ_B0 = DQ_A1 + DQ_A_G, DQ_B1 = DQ_B0 + DQ_B_I, DQ_C0 = DQ_B1 + DQ_B_G, DQ_C1 = DQ_C0 + DQ_C_I, DQ_END = DQ_C1 + DQ_C_G;
constexpr int DEF_UP = DQ_END - NE * IT_E;
static_assert(DEF_UP >= 0 && DEF_UP <= NE * IT_E, "deferred share");
constexpr int IT_LAYER0 = IT_WIN + IT_GLU + 2 * IT_BR + IT_OUT + 2 * NE * IT_E - DEF_UP;
constexpr int IT_DOWN = NE * IT_E;
__device__ __forceinline__ TItem make_item(const float* src, bf16_t* dst, const float* gain, int N, int ldd, int rowmode, int f8, int r, int& n0) {
    const int nblk = N / 64, k0 = 64 * (r / nblk); n0 = 64 * (r % nblk);
    TItem t; t.src = src + (size_t)k0 * N + n0; t.dst = f8 ? (bf16_t*)((unsigned char*)dst + k0) : dst + k0; t.gain = gain ? gain + k0 : nullptr; t.N = N; t.ldd = ldd; t.rowmode = rowmode; t.f8 = f8; return t; }
struct DecMain { CArgs* ap; unsigned char* ws;
    __device__ __forceinline__ TItem operator()(int it, int& n0) const { CArgs& args = *ap;
        const int l = it / IT_LAYER0; int r = it % IT_LAYER0; const LayerW w = layer_w(ws, l);
        if (r < IT_WIN) { const bool gate = (r % (INC / 64)) >= 64;
            return gate ? make_item((const float*)args.in[I_WIN] + (size_t)l * D * INC, (bf16_t*)((unsigned char*)w.WIN + (size_t)16 * MiB - (size_t)4096 * D), (const float*)args.in[I_NMIX] + l * D, INC, D, 0, 1, r, n0)
                        : make_item((const float*)args.in[I_WIN] + (size_t)l * D * INC, w.WIN, (const float*)args.in[I_NMIX] + l * D, INC, D, 0, 0, r, n0); }
        if ((r -= IT_WIN) < IT_GLU) return make_item((const float*)args.in[I_WGLU] + (size_t)l * SSMW * SSMW, w.WGLU, nullptr, SSMW, SSMW, 0, 0, r, n0);
        if ((r -= IT_GLU) < IT_BR) return make_item((const float*)args.in[I_WSB] + (size_t)l * SSMW * D, w.WBR, nullptr, D, 2048, 0, 0, r, n0);
        if ((r -= IT_BR) < IT_BR) return make_item((const float*)args.in[I_WAB] + (size_t)l * 1024 * D, w.WBR + 1024, nullptr, D, 2048, 0, 0, r, n0);
        if ((r -= IT_BR) < IT_OUT) return make_item((const float*)args.in[I_WOUT] + (size_t)l * D * D, w.WOUT, nullptr, D, D, 0, 0, r, n0);
        r -= IT_OUT; const int which = r / (NE * IT_E), e = (r / IT_E) % NE; r = r % IT_E; const size_t eo = ((size_t)l * NE + e) * D * FF;
        return make_item((const float*)args.in[which == 0 ? I_WEG : I_WEU] + eo, (bf16_t*)((unsigned char*)w.WGU + (size_t)e * 4096 * D), (const float*)args.in[I_NFFN] + l * D, FF, D, which == 0 ? 1 : 2, 1, r, n0); } };
struct DecDown { CArgs* ap; unsigned char* ws; int l;
    __device__ __forceinline__ TItem operator()(int it, int& n0) const { CArgs& args = *ap; const LayerW w = layer_w(ws, l);
        if (it >= IT_DOWN) { const int uu = NE * IT_E - 1 - (it - IT_DOWN), e = uu / IT_E; const size_t eo = ((size_t)l * NE + e) * D * FF;
            return make_item((const float*)args.in[I_WEU] + eo, (bf16_t*)((unsigned char*)w.WGU + (size_t)e * 4096 * D), (const float*)args.in[I_NFFN] + l * D, FF, D, 2, 1, uu % IT_E, n0); }
        const int e = it / IT_E, r = it % IT_E; const size_t eo = ((size_t)l * NE + e) * D * FF;
        return make_item((const float*)args.in[I_WED] + eo, (bf16_t*)((unsigned char*)w.WD + (size_t)e * D * FF), nullptr, D, FF, 0, 1, r, n0); } };
template <class Dec> __device__ __forceinline__ void convert_items(const Dec& dec, int first, int end, int step, LAS float* scr, int lane) {
    f32x4 tv[16]; int n0c = 0, n0n = 0; TItem cur, nxt; cur.src = nullptr; cur.dst = nullptr; cur.gain = nullptr; cur.N = 0; cur.ldd = 0; cur.rowmode = 0; cur.f8 = 0; nxt = cur;
    int it = first;
    if (it < end) { cur = dec(it, n0c); t_load(cur, tv, lane); }
    for (; it < end; it += step) {
        t_lds(tv, scr, lane);
        if (it + step < end) { nxt = dec(it + step, n0n); t_load(nxt, tv, lane); }
        LDS_WAIT(); asm volatile("" ::: "memory");
        t_store(cur, n0c, scr, lane);
        LDS_WAIT(); asm volatile("" ::: "memory");
        cur = nxt; n0c = n0n; }
}

template <bool ROUTER>
__device__ __forceinline__ void row_pass(const float* xrow, bf16_t* xb, float* rinv_out, const LAS float* WtL, float* afft, int row, int lane, unsigned char* xb8 = nullptr) {
    f32x4 v[8]; float ss = 0.f;
#pragma unroll
    for (int j = 0; j < 8; ++j) { v[j] = *(const f32x4*)(xrow + 4 * lane + 256 * j); ss += v[j][0] * v[j][0] + v[j][1] * v[j][1] + v[j][2] * v[j][2] + v[j][3] * v[j][3]; }
    ss = wave_sum(ss);
    const float rinv = __builtin_amdgcn_rsqf(ss * (1.f / D) + EPS);
#pragma unroll
    for (int j = 0; j < 8; ++j) { u32x2 w; w.x = cvt_pk_bf16(v[j][0], v[j][1]); w.y = cvt_pk_bf16(v[j][2], v[j][3]); *(u32x2*)(xb + 4 * lane + 256 * j) = w; }
    if (xb8) {
#pragma unroll
        for (int j = 0; j < 8; ++j) { int w8 = 0; w8 = __builtin_amdgcn_cvt_pk_fp8_f32(v[j][0], v[j][1], w8, false); w8 = __builtin_amdgcn_cvt_pk_fp8_f32(v[j][2], v[j][3], w8, true); *(int*)(xb8 + 4 * lane + 256 * j) = w8; } }
    if (lane == 0) *rinv_out = rinv;
    if constexpr (ROUTER) {
        float lg[16];
#pragma unroll
        for (int e = 0; e < 16; ++e) { float a = 0.f;
#pragma unroll
            for (int j = 0; j < 8; ++j) { const f32x4 w = *(const LAS f32x4*)(WtL + e * 2048 + 4 * lane + 256 * j); a += v[j][0] * w[0] + v[j][1] * w[1] + v[j][2] * w[2] + v[j][3] * w[3]; }
            lg[e] = wave_sum(a) * rinv; }
        float mx = lg[0];
#pragma unroll
        for (int e = 1; e < 16; ++e) mx = fmaxf(mx, lg[e]);
        float sum = 0.f;
#pragma unroll
        for (int e = 0; e < 16; ++e) { lg[e] = __expf(lg[e] - mx); sum += lg[e]; }
        const float inv = 1.f / sum;
        float mine = 0.f;
#pragma unroll
        for (int e = 0; e < 16; ++e) mine = (lane == e) ? lg[e] * inv : mine;
        if (lane < 16) afft[(size_t)lane * S + row] = mine;
    }
}

__device__ __forceinline__ void router_row(const u32x2 (&xw)[8], float* rinv_out, const LAS float* WtL, float* afft, int row, int lane) {
    f32x4 v[8]; float ss = 0.f;
#pragma unroll
    for (int j = 0; j < 8; ++j) { const u32x2 w = xw[j]; v[j] = (f32x4){bf_lo(w.x), bf_hi(w.x), bf_lo(w.y), bf_hi(w.y)}; ss += v[j][0] * v[j][0] + v[j][1] * v[j][1] + v[j][2] * v[j][2] + v[j][3] * v[j][3]; }
    ss = wave_sum(ss);
    const float rinv = __builtin_amdgcn_rsqf(ss * (1.f / D) + EPS);
    if (lane == 0) *rinv_out = rinv;
    float lg[16];
#pragma unroll
    for (int e = 0; e < 16; ++e) { float a = 0.f;
#pragma unroll
        for (int j = 0; j < 8; ++j) { const f32x4 w = *(const LAS f32x4*)(WtL + e * 2048 + 4 * lane + 256 * j); a += v[j][0] * w[0] + v[j][1] * w[1] + v[j][2] * w[2] + v[j][3] * w[3]; }
        lg[e] = wave_sum(a) * rinv; }
    float mx = lg[0];
#pragma unroll
    for (int e = 1; e < 16; ++e) mx = fmaxf(mx, lg[e]);
    float sum = 0.f;
#pragma unroll
    for (int e = 0; e < 16; ++e) { lg[e] = __expf(lg[e] - mx); sum += lg[e]; }
    const float inv = 1.f / sum;
    float mine = 0.f;
#pragma unroll
    for (int e = 0; e < 16; ++e) mine = (lane == e) ? lg[e] * inv : mine;
    if (lane < 16) afft[(size_t)lane * S + row] = mine;
}
__device__ __forceinline__ int block_sum_i(int v, LAS int* red, int wave, int lane) {
#pragma unroll
    for (int o = 1; o < 64; o <<= 1) v += __shfl_xor(v, o);
    __syncthreads();
    if (lane == 0) red[wave] = v;
    __syncthreads();
    int t = 0;
#pragma unroll
    for (int w = 0; w < 8; ++w) t += red[w];
    return t;
}

__global__ void __launch_bounds__(512, 2) fwd(Args kargs) {
    extern __shared__ __attribute__((aligned(16))) unsigned char lds_raw[];
    LAS unsigned char* lds = (LAS unsigned char*)lds_raw;
    volatile LAS unsigned* MISC = (volatile LAS unsigned*)(lds + MISC_OFF);
    const int G = gridDim.x;
    unsigned* ctl = (unsigned*)((unsigned char*)kargs.ws + WS_CTL);
    if (threadIdx.x < 64) MISC[threadIdx.x] = 0u;
    if ((threadIdx.x & 63) == 0) *(volatile LAS int*)(unsigned)(WTAB_OFF + 4u * hw_slot()) = (int)(threadIdx.x >> 6);
    __syncthreads();
    XcdBarrier bar; bar.bar = ctl + 1024; bar.x = 0; bar.st = nullptr;
    if (!MK_PER_PHASE) bar = xcd_barrier_post(ctl + 1024, MISC + 8);
    const int lo = kargs.ph_lo, hi = kargs.ph_hi;
#ifndef PH_MASK
#define PH_MASK 0xFFFF
#endif
#define PON(b) ((PH_MASK >> (b)) & 1)
#ifndef REP_MASK
#define REP_MASK 0
#endif
#define REPS(b) (((REP_MASK >> (b)) & 1) ? 2 : 1)
#define IN(k) (lo <= (k) && (k) < hi)
#define PH_ENTER int tz0_ = tid_now(); asm volatile("" : "+v"(tz0_)); int bz0_ = blockIdx.x; asm volatile("" : "+s"(bz0_)); \
    const int tid = tz0_, lane = tid & 63, wave = __builtin_amdgcn_readfirstlane(tid >> 6), bx = bz0_, vcu = (G % 8 == 0) ? (bx % 8) * (G / 8) + bx / 8 : bx, gw = vcu * 8 + wave, NGW = G * 8; \
    (void)lane; (void)wave; (void)bx; (void)vcu; (void)gw; (void)NGW; \
      \
    CArgs* ap_ = (CArgs*)__builtin_amdgcn_kernarg_segment_ptr(); asm volatile("" : "+s"(ap_)); CArgs& args = *ap_; \
    unsigned char* const ws = (unsigned char*)args.ws; unsigned char* const act = ws + WS_ACT; unsigned char* const sm = act + A_SMALL; (void)sm; \
    bf16_t* const XB = (bf16_t*)(act + A_XB); unsigned char* const XB8 = act + A_O1; (void)XB8; bf16_t* const XB1 = (bf16_t*)(act + A_XB1); bf16_t* const UA = (bf16_t*)(act + A_UA); \
    bf16_t* const Qb = (bf16_t*)(act + A_Q); bf16_t* const Kb = (bf16_t*)(act + A_K); bf16_t* const Vb = (bf16_t*)(act + A_V); bf16_t* const Gb = (bf16_t*)(act + A_G); \
    float* const SSUM = (float*)(act + A_SSUM); bf16_t* const Yb = (bf16_t*)(act + A_Y); bf16_t* const YO = (bf16_t*)(act + A_YO); \
    bf16_t* const MG = (bf16_t*)(act + A_MG); float* const XA = (float*)(act + A_XA); bf16_t* const XG = (bf16_t*)(act + A_XG); bf16_t* const Hb = (bf16_t*)(act + A_H); bf16_t* const YX = (bf16_t*)(act + A_YX); \
    float* const RINV = (float*)(sm + SM_RINV); float* const RINV2 = (float*)(sm + SM_RINV2); float* const AFFT = (float*)(sm + SM_AFFT); int* const IDX = (int*)(sm + SM_IDX); \
    float* const GATE = (float*)(sm + SM_GATE); float* const RSL = (float*)(sm + SM_RSL); int* const INV = (int*)(sm + SM_INV); float* const LAMS = (float*)(sm + SM_LAM); \
    (void)XB; (void)XB1; (void)UA; (void)Qb; (void)Kb; (void)Vb; (void)Gb; (void)SSUM; (void)Yb; (void)YO; (void)MG; (void)XA; (void)XG; (void)Hb; (void)YX; \
    (void)RINV; (void)RINV2; (void)AFFT; (void)IDX; (void)GATE; (void)RSL; (void)INV; (void)LAMS;
#define INP(i) ((const float*)args.in[i])
#define OUTP ((float*)args.out)
#define LAYER_ENTER const LayerW w = layer_w(ws, l); const float lam_init = (l == 0) ? 0.2f : 0.35550906759f;   \
    (void)w; (void)lam_init;
#define SEAM(k) do { if (IN(k) && IN((k) + 1)) { if (!MK_PER_PHASE) xcd_barrier(bar); } } while (0)

    if (PON(0) && IN(0)) _Pragma("nounroll") for (int rep_ = 0; rep_ < REPS(0); ++rep_) { PH_ENTER
        LAS float* scr = (LAS float*)(lds + wave * 16640);
        convert_items(DecMain{ap_, ws}, gw, NL * IT_LAYER0, NGW, scr, lane);
        for (int i = gw * 64 + lane; i < NL * NE * D; i += NGW * 64) { const int l = i / (NE * D), e = (i / D) % NE, k = i % D;
            layer_w(ws, l).WRT[e * D + k] = INP(I_NFFN)[l * D + k] * INP(I_WR)[((size_t)l * D + k) * NE + e]; }
        for (int task = vcu; task < NL * NGRP * 2; task += G) {
            const int l = task / (NGRP * 2), g = (task >> 1) % NGRP, dir = task & 1;
            const size_t pb = ((size_t)(l * 2 + dir) * NGRP + g);
            LAS float* CR = (LAS float*)lds; LAS float* CI = CR + 16 * 65; LAS float* BR = CI + 16 * 65; LAS float* BI = BR + 64 * 16; LAS float* WD = BI + 64 * 16 + wave * 128;
            __syncthreads();
            for (int i = tid; i < 1024; i += 512) { const int pp = i >> 6, nn = i & 63; CR[pp * 65 + nn] = INP(I_CRE)[(pb * GP + pp) * NST + nn]; CI[pp * 65 + nn] = INP(I_CIM)[(pb * GP + pp) * NST + nn];
                BR[i] = INP(I_BRE)[pb * NST * GP + i]; BI[i] = INP(I_BIM)[pb * NST * GP + i]; }
            __syncthreads();
            const float are = INP(I_ARE)[pb * NST + lane], aim = INP(I_AIM)[pb * NST + lane], dt = expf(INP(I_LDT)[pb]);
            const float mag1 = expf(are * dt), ang1 = aim * dt, b1r = mag1 * cosf(ang1), b1i = mag1 * sinf(ang1);
            const float nr = b1r - 1.f, ni = b1i, den = are * are + aim * aim;
            const float cr = (nr * are + ni * aim) / den, ci = (ni * are - nr * aim) / den;
            const int p = lane >> 2, q0 = (lane & 3) * 4;
            for (int k = 0; k < 4; ++k) { const int dl = wave * 4 + k;
                const float magd = expf(are * dt * (float)dl), angd = aim * dt * (float)dl, pr = magd * cosf(angd), pi = magd * sinf(angd);
                WD[lane] = pr * cr - pi * ci; WD[64 + lane] = pr * ci + pi * cr;
                LDS_WAIT();
                f32x4 out = {0.f, 0.f, 0.f, 0.f};
#pragma unroll 8
                for (int n = 0; n < NST; ++n) {
                    const float wr_ = WD[n], wi_ = WD[64 + n];
                    const float c_r = CR[p * 65 + n], c_i = CI[p * 65 + n];
                    const float er = c_r * wr_ - c_i * wi_, ei = c_r * wi_ + c_i * wr_;
                    const f32x4 br = *(const LAS f32x4*)(BR + n * GP + q0), bi = *(const LAS f32x4*)(BI + n * GP + q0);
                    out += br * er - bi * ei;
                }
                *(f32x4*)(layer_w(ws, l).KTAB + ((((size_t)g * 2 + dir) * TC + dl) * GP + p) * GP + q0) = out;
                LDS_WAIT(); }
            { const LayerW w = layer_w(ws, l);
              for (int k = 0; k < 4; ++k) { const int t = wave * 4 + k;
                { const float e = dir == 0 ? (float)(t + 1) : (float)(TC - t); const float mg = expf(are * dt * e), an = aim * dt * e, pr = mg * cosf(an), pi = mg * sinf(an);
#pragma unroll
                  for (int pp = 0; pp < GP; ++pp) { const float c_r = CR[pp * 65 + lane], c_i = CI[pp * 65 + lane];
                      bf16_t* o = w.BO + ((size_t)g * 512 + t * 16 + pp) * UAW + 512 + dir * 128 + lane; o[0] = f2bf(c_r * pr - c_i * pi); o[64] = f2bf(-(c_r * pi + c_i * pr)); } }
                { const float e = dir == 0 ? (float)(TC - 1 - t) : (float)t; const float mg = expf(are * dt * e), an = aim * dt * e, pr = mg * cosf(an), pi = mg * sinf(an);
                  const float wre = pr * cr - pi * ci, wim = pr * ci + pi * cr;
                  f32x4 re[4], im[4];
#pragma unroll
                  for (int q = 0; q < 4; ++q) { const f32x4 br = *(const LAS f32x4*)(BR + lane * GP + 4 * q), bi = *(const LAS f32x4*)(BI + lane * GP + 4 * q); re[q] = br * wre - bi * wim; im[q] = bi * wre + br * wim; }
                  bf16_t* o = w.F + ((size_t)g * 256 + dir * 128 + lane) * 512 + t * 16;
                  *(u32x4*)o = pack8(re[0], re[1]); *(u32x4*)(o + 8) = pack8(re[2], re[3]);
                  *(u32x4*)(o + 64 * 512) = pack8(im[0], im[1]); *(u32x4*)(o + 64 * 512 + 8) = pack8(im[2], im[3]); } } }
        }
        __syncthreads();
        for (int m = gw; m < S; m += NGW) row_pass<false>(INP(I_X) + (size_t)m * D, XB + (size_t)m * D, RINV + m, nullptr, nullptr, m, lane, XB8 + (size_t)m * D);
        if (gw < NL) { const int l = gw; const float a = wave_sum(INP(I_LQ1)[l * QKD + lane] * INP(I_LK1)[l * QKD + lane]);
            const float b = wave_sum(INP(I_LQ2)[l * QKD + lane] * INP(I_LK2)[l * QKD + lane]);
            if (lane == 0) LAMS[l] = expf(a) - expf(b) + ((l == 0) ? 0.2f : 0.35550906759f); }
        for (int i = gw * 64 + lane; i < NH * 512; i += NGW * 64) { const int h = i >> 9, rel = (i & 511) - 256;
            ((float*)(sm + SM_BTAB))[i] = INP(I_RELB)[t5_bucket(rel) * NH + h] * LOG2E; }
    }
    SEAM(0);

    for (int l = 0; l < NL; ++l) {
        const int pbase = 2 + l * 14;
        if (PON(2) && IN(pbase + 0)) _Pragma("nounroll") for (int rep_ = 0; rep_ < REPS(2); ++rep_) { PH_ENTER LAYER_ENTER
            { pg::SchedGrid Sg; Sg.init(XB, D, w.WIN, D, S, 4096, G, bx);
              EpiInProj E{RINV, UA, Qb, Kb, Vb, Gb, INP(I_QG) + l * QKD, INP(I_KG) + l * QKD};
              pg::gemm_phase(lds, D, D, D, Sg, E); }
            { pg::SchedGrid Sg; Sg.init(XB8, D, (unsigned char*)w.WIN + (size_t)16 * MiB, D, S, 4096, G, bx, 1);
              EpiGates E{RINV, Gb};
              pg::gemm_phase<EpiGates, pg::SchedGrid, true, E8_ONE, E8_W>(lds, D, D, D, Sg, E); }
        }
        SEAM(pbase + 0);
        if (PON(3) && IN(pbase + 1)) _Pragma("nounroll") for (int rep_ = 0; rep_ < REPS(3); ++rep_) { PH_ENTER LAYER_ENTER
            pg::SchedGroup Sg; Sg.init(UA, UAW, (size_t)NCH * UAW * 2, w.F, 512, (size_t)256 * 512 * 2, 1, 1, NGRP, G, vcu);
            EpiSsum E{SSUM};
            pg::gemm_phase(lds, 512, UAW, 512, Sg, E);
            if (vcu >= NGRP) convert_items(DecDown{ap_, ws, l}, DQ_A0 + (vcu - NGRP) * 8 + wave, DQ_A1, (G - NGRP) * 8, (LAS float*)(lds + wave * 16640), lane);
            if (vcu >= NGRP) for (int gq = vcu - NGRP; gq < NGRP * 4; gq += G - NGRP) { const int g = gq >> 2, rq = gq & 3;
                LAS float* kt = (LAS float*)lds;
                __syncthreads();
                for (int i = tid; i < 2 * TC * 256 / 4; i += 512) ((LAS f32x4*)kt)[i] = ((const f32x4*)(w.KTAB + (size_t)g * 2 * TC * 256))[i];
                __syncthreads();
                for (int idx = tid; idx < 128 * 64; idx += 512) { const int rr = rq * 128 + (idx >> 6), kc = idx & 63;
                    const int t = rr >> 4, p = rr & 15, tau = kc >> 1, q0 = (kc & 1) * 8;
                    const LAS float* kf = kt; const LAS float* kb = kt + TC * 256;
                    f32x4 a, b;
                    if (tau < t) { const LAS float* s = kf + ((t - tau) * GP + p) * GP + q0; a = *(const LAS f32x4*)s; b = *(const LAS f32x4*)(s + 4); }
                    else if (tau > t) { const LAS float* s = kb + ((tau - t) * GP + p) * GP + q0; a = *(const LAS f32x4*)s; b = *(const LAS f32x4*)(s + 4); }
                    else { const LAS float* s = kf + p * GP + q0; const LAS float* s2 = kb + p * GP + q0; a = *(const LAS f32x4*)s + *(const LAS f32x4*)s2; b = *(const LAS f32x4*)(s + 4) + *(const LAS f32x4*)(s2 + 4);
                        const float dd = INP(I_SD)[l * SSMW + g * GP + p];
#pragma unroll
                        for (int j = 0; j < 4; ++j) { if (q0 + j == p) a[j] += dd; if (q0 + 4 + j == p) b[j] += dd; } }
                    *(u32x4*)(w.BO + ((size_t)g * 512 + rr) * UAW + tau * 16 + q0) = pack8(a, b); }
            }
            if (vcu < NGRP && wave < 2) {
                const int g = vcu, dir = wave; const size_t pb = ((size_t)(l * 2 + dir) * NGRP + g);
                const float are = INP(I_ARE)[pb * NST + lane], aim = INP(I_AIM)[pb * NST + lane], dt = expf(INP(I_LDT)[pb]);
                const float mg = expf(are * dt * (float)TC), an = aim * dt * (float)TC, ar = mg * cosf(an), ai = mg * sinf(an);
                float sr = 0.f, si = 0.f;
                for (int cb = 0; cb < NCH; cb += 32) {
                    float xr[32], xi[32];
#pragma unroll
                    for (int k = 0; k < 32; ++k) { const int c = dir == 0 ? cb + k : NCH - 1 - cb - k; const float* s = SSUM + ((size_t)g * NCH + c) * 256 + dir * 128 + lane; xr[k] = s[0]; xi[k] = s[64]; }
#pragma unroll
                    for (int k = 0; k < 32; ++k) { const int c = dir == 0 ? cb + k : NCH - 1 - cb - k;
                        bf16_t* o = UA + ((size_t)g * NCH + c) * UAW + 512 + dir * 128 + lane; o[0] = f2bf(sr); o[64] = f2bf(si);
                        const float nr = ar * sr - ai * si + xr[k], ni = ar * si + ai * sr + xi[k]; sr = nr; si = ni; }
                }
            }
            if (vcu < NGRP) convert_items(DecDown{ap_, ws, l}, DQ_A1 + vcu * 8 + wave, DQ_B0, NGRP * 8, (LAS float*)(lds + wave * 16640), lane);
        }
        SEAM(pbase + 1);
        if (PON(5) && IN(pbase + 3)) _Pragma("nounroll") for (int rep_ = 0; rep_ < REPS(5); ++rep_) { PH_ENTER LAYER_ENTER
            pg::SchedGroup Sg; Sg.init(UA, UAW, (size_t)NCH * UAW * 2, w.BO, UAW, (size_t)512 * UAW * 2, 1, 2, NGRP, G, vcu);
            EpiSsmOut E{Yb};
            pg::gemm_phase(lds, UAW, UAW, UAW, Sg, E);
            if (vcu >= 2 * NGRP) convert_items(DecDown{ap_, ws, l}, DQ_B0 + (vcu - 2 * NGRP) * 8 + wave, DQ_B1, (G - 2 * NGRP) * 8, (LAS float*)(lds + wave * 16640), lane);
            else convert_items(DecDown{ap_, ws, l}, DQ_B1 + vcu * 8 + wave, DQ_C0, 2 * NGRP * 8, (LAS float*)(lds + wave * 16640), lane);
        }
        SEAM(pbase + 3);
        if (PON(6) && IN(pbase + 4)) _Pragma("nounroll") for (int rep_ = 0; rep_ < REPS(6); ++rep_) { PH_ENTER LAYER_ENTER
            pg::SchedGrid Sg; Sg.init(Yb, SSMW, w.WGLU, SSMW, S, SSMW, G, bx);
            EpiGlu E{Yb, YO};
            pg::gemm_phase(lds, SSMW, SSMW, SSMW, Sg, E);
            if (bx >= 128) convert_items(DecDown{ap_, ws, l}, DQ_C0 + (bx - 128) * 8 + wave, DQ_C1, (G - 128) * 8, (LAS float*)(lds + wave * 16640), lane);
            else convert_items(DecDown{ap_, ws, l}, DQ_C1 + bx * 8 + wave, DQ_END, 128 * 8, (LAS float*)(lds + wave * 16640), lane);
        }
        SEAM(pbase + 4);
        if (PON(7) && IN(pbase + 5)) _Pragma("nounroll") for (int rep_ = 0; rep_ < REPS(7); ++rep_) { PH_ENTER LAYER_ENTER
            for (int un = vcu; un < NH * (S / 256); un += G) {
                const int h = un / (S / 256), qb = un % (S / 256);
                __syncthreads();
                { int tb = tid_now(); asm volatile("" : "+v"(tb)); ((LAS float*)(lds + att::OFF_BT))[tb] = ((const float*)(sm + SM_BTAB))[h * 512 + tb]; }
                const int q0w = qb * 256 + wave * 32;
                f32x16 o[4];
                { f32x16 o2[4];
                  att::attn_dual(o, o2, Qb + (size_t)q0w * 1024 + h * 128, Kb + h * 128, Vb + h * 128, (LAS char*)lds, q0w);
                  const float lam = LAMS[l];
#pragma unroll
                  for (int d = 0; d < 4; ++d) o[d] = o[d] - o2[d] * lam; }
                { const int tz = lane_now(), r32 = tz & 31, hi2 = tz >> 5;
                  float ssq[16];
#pragma unroll
                  for (int r = 0; r < 16; ++r) { float s = 0.f;
#pragma unroll
                    for (int d = 0; d < 4; ++d) s += o[d][r] * o[d][r];
                    s += swz_xor<1>(s); s += swz_xor<2>(s); s += swz_xor<4>(s); s += swz_xor<8>(s); s += swz_xor<16>(s);
                    ssq[r] = __builtin_amdgcn_rsqf(s * (1.f / VD) + EPS) * (1.f - lam_init); }
                  bf16_t* yo = YO + (size_t)(q0w + 4 * hi2) * 2048 + 1024 + h * 128 + r32;
#pragma unroll
                  for (int d = 0; d < 4; ++d) { const float gn = INP(I_SUBLN)[l * VD + d * 32 + r32];
#pragma unroll
                    for (int r = 0; r < 16; ++r) yo[(size_t)((r & 3) + 8 * (r >> 2)) * 2048 + d * 32] = f2bf(o[d][r] * ssq[r] * gn); } }
            }
            __syncthreads();
        }
        SEAM(pbase + 5);
        if (PON(8) && IN(pbase + 6)) _Pragma("nounroll") for (int rep_ = 0; rep_ < REPS(8); ++rep_) { PH_ENTER LAYER_ENTER
            pg::SchedGrid Sg; Sg.init(YO, 2048, w.WBR, 2048, S, D, G, bx);
            EpiMerge E{Gb, MG};
            pg::gemm_phase(lds, 2048, 2048, 2048, Sg, E);
        }
        SEAM(pbase + 6);
        if (PON(9) && IN(pbase + 7)) _Pragma("nounroll") for (int rep_ = 0; rep_ < REPS(9); ++rep_) { PH_ENTER LAYER_ENTER
            pg::SchedGrid Sg; Sg.init(MG, D, w.WOUT, D, S, D, G, bx);
            EpiOutProj E{XB, XB1};
            pg::gemm_phase(lds, D, D, D, Sg, E);
        }
        SEAM(pbase + 7);
        if (PON(10) && IN(pbase + 8)) _Pragma("nounroll") for (int rep_ = 0; rep_ < REPS(10); ++rep_) { PH_ENTER LAYER_ENTER
            LAS float* WtL = (LAS float*)lds;
            for (int i = tid; i < NE * D / 4; i += 512) ((LAS f32x4*)WtL)[i] = ((const f32x4*)w.WRT)[i];
            __syncthreads();
            { u32x2 xc[8], xn[8];
#pragma unroll
              for (int j = 0; j < 8; ++j) { xc[j] = (u32x2){0u, 0u}; xn[j] = xc[j]; }
              if (gw < S) {
#pragma unroll
                  for (int j = 0; j < 8; ++j) xc[j] = *(const u32x2*)(XB1 + (size_t)gw * D + 4 * lane + 256 * j); }
              for (int m = gw; m < S; m += NGW) { int lz = lane; asm volatile("" : "+v"(lz));
                  if (m + NGW < S) {
#pragma unroll
                      for (int j = 0; j < 8; ++j) xn[j] = *(const u32x2*)(XB1 + (size_t)(m + NGW) * D + 4 * lz + 256 * j); }
                  router_row(xc, RINV2 + m, WtL, AFFT, m, lz);
#pragma unroll
                  for (int j = 0; j < 8; ++j) xc[j] = xn[j]; } }
            __syncthreads();
        }
        SEAM(pbase + 8);
        if (PON(11) && IN(pbase + 9)) _Pragma("nounroll") for (int rep_ = 0; rep_ < REPS(11); ++rep_) { PH_ENTER LAYER_ENTER
            const int nparts = G / NE > 0 ? G / NE : 1;
            if (vcu < nparts * NE) {
                const int e = vcu / nparts, part = vcu % nparts, per = (CAP + nparts - 1) / nparts, slo = part * per, shi = (slo + per < CAP) ? slo + per : CAP;
                LAS int* red = (LAS int*)lds; LAS int* list = (LAS int*)(lds + 1024);
                unsigned bits[16]; { const float* a = AFFT + (size_t)e * S + tid * 16;
#pragma unroll
                    for (int q = 0; q < 4; ++q) { const f32x4 v = *(const f32x4*)(a + 4 * q); bits[4 * q] = __float_as_uint(v[0]); bits[4 * q + 1] = __float_as_uint(v[1]); bits[4 * q + 2] = __float_as_uint(v[2]); bits[4 * q + 3] = __float_as_uint(v[3]); } }
                unsigned T = 0u;
                for (int bit = 30; bit >= 0; --bit) { const unsigned cand = T | (1u << bit); int c = 0;
#pragma unroll
                    for (int i = 0; i < 16; ++i) c += bits[i] >= cand ? 1 : 0;
                    if (block_sum_i(c, red, wave, lane) >= CAP) T = cand; }
                int cg = 0, ce = 0;
#pragma unroll
                for (int i = 0; i < 16; ++i) { cg += bits[i] > T ? 1 : 0; ce += bits[i] == T ? 1 : 0; }
                const int need_eq = CAP - block_sum_i(cg, red, wave, lane);
                int sg = cg, se = ce;
#pragma unroll
                for (int o = 1; o < 64; o <<= 1) { const int a = __shfl_up(sg, o), b = __shfl_up(se, o); if (lane >= o) { sg += a; se += b; } }
                __syncthreads();
                if (lane == 63) { red[16 + wave] = sg; red[32 + wave] = se; }
                __syncthreads();
                int og = 0, oe = 0;
#pragma unroll
                for (int wv = 0; wv < 8; ++wv) if (wv < wave) { og += red[16 + wv]; oe += red[32 + wv]; }
                int gbef = og + sg - cg, ebef = oe + se - ce;
                const bool inv_mine = (tid * nparts) / 512 == part;
#pragma unroll
                for (int i = 0; i < 16; ++i) { const int tok = tid * 16 + i; const bool isg = bits[i] > T, ise = bits[i] == T; const bool sel = isg || (ise && ebef < need_eq);
                    const int slot = gbef + (ebef < need_eq ? ebef : need_eq);
                    if (sel && slot >= slo && slot < shi) { IDX[e * CAP + slot] = tok; GATE[e * CAP + slot] = __uint_as_float(bits[i]); RSL[e * CAP + slot] = RINV2[tok]; list[slot - slo] = tok; }
                    if (inv_mine) INV[tok * NE + e] = sel ? slot : -1;
                    gbef += isg ? 1 : 0; ebef += ise ? 1 : 0; }
                __syncthreads();
                for (int r = wave; r < shi - slo; r += 32) {
                    u32x4 t[4][4];
#pragma unroll
                    for (int q = 0; q < 4; ++q) { const int rr = (r + 8 * q < shi - slo) ? r + 8 * q : r; const u32x4* s = (const u32x4*)(XB1 + (size_t)list[rr] * D) + lane;
#pragma unroll
                        for (int j = 0; j < 4; ++j) t[q][j] = s[64 * j]; }
#pragma unroll
                    for (int q = 0; q < 4; ++q) if (r + 8 * q < shi - slo) { u32x2* d = (u32x2*)((unsigned char*)XG + (size_t)(e * CAP + slo + r + 8 * q) * D) + lane;
#pragma unroll
                        for (int j = 0; j < 4; ++j) { f32x4 a, b; unpack8(t[q][j], a, b); d[64 * j] = pack8_fp8(a, b); } } }
                __syncthreads();
            }
        }
        SEAM(pbase + 9);
        if (PON(13) && IN(pbase + 11)) _Pragma("nounroll") for (int rep_ = 0; rep_ < REPS(13); ++rep_) { PH_ENTER LAYER_ENTER
            pg::SchedGroup Sg; Sg.init(XG, D, (size_t)CAP * D, w.WGU, D, (size_t)4096 * D, 4, 16, NE, G, vcu, 1);
            EpiExp1 E{RSL, Hb};
            pg::gemm_phase<EpiExp1, pg::SchedGroup, true, E8_ONE, E8_W>(lds, D, D, D, Sg, E);
        }
        SEAM(pbase + 11);
        if (PON(14) && IN(pbase + 12)) _Pragma("nounroll") for (int rep_ = 0; rep_ < REPS(14); ++rep_) { PH_ENTER LAYER_ENTER
            pg::SchedGroup Sg; Sg.init(Hb, FF, (size_t)CAP * FF, w.WD, FF, (size_t)D * FF, 4, 8, NE, G, vcu, 1);
            EpiExp2 E{GATE, YX};
            pg::gemm_phase<EpiExp2, pg::SchedGroup, true, E8_H, E8_W>(lds, FF, FF, FF, Sg, E);
        }
        SEAM(pbase + 12);
        if (PON(15) && IN(pbase + 13)) _Pragma("nounroll") for (int rep_ = 0; rep_ < REPS(15); ++rep_) { PH_ENTER LAYER_ENTER
            { u32x2 xc[8], xn[8]; int invc = -1, invn = -1;
#pragma unroll
              for (int j = 0; j < 8; ++j) { xc[j] = (u32x2){0u, 0u}; xn[j] = xc[j]; }
              if (gw < S) { invc = INV[gw * NE + (lane & 15)];
#pragma unroll
                  for (int j = 0; j < 8; ++j) xc[j] = *(const u32x2*)(XB1 + (size_t)gw * D + 4 * lane + 256 * j); }
              for (int m = gw; m < S; m += NGW) {
                if (m + NGW < S) { invn = INV[(m + NGW) * NE + (lane & 15)];
#pragma unroll
                    for (int j = 0; j < 8; ++j) xn[j] = *(const u32x2*)(XB1 + (size_t)(m + NGW) * D + 4 * lane + 256 * j); }
                f32x4 v[8];
#pragma unroll
                for (int j = 0; j < 8; ++j) v[j] = (f32x4){bf_lo(xc[j].x), bf_hi(xc[j].x), bf_lo(xc[j].y), bf_hi(xc[j].y)};
                const int myinv = invc;
                unsigned msk = (unsigned)(__ballot(myinv >= 0) & 0xFFFFull);
                while (msk) { const int e0 = __builtin_ctz(msk); msk &= msk - 1; const bool two = msk != 0u; const int e1 = two ? __builtin_ctz(msk) : e0; if (two) msk &= msk - 1;
                    const bf16_t* y0 = YX + ((size_t)e0 * CAP + __shfl(myinv, e0)) * D; const bf16_t* y1 = YX + ((size_t)e1 * CAP + __shfl(myinv, e1)) * D;
                    u32x2 a[8], b[8];
#pragma unroll
                    for (int j = 0; j < 8; ++j) a[j] = *(const u32x2*)(y0 + 4 * lane + 256 * j);
#pragma unroll
                    for (int j = 0; j < 8; ++j) b[j] = *(const u32x2*)(y1 + 4 * lane + 256 * j);
#pragma unroll
                    for (int j = 0; j < 8; ++j) { v[j][0] += bf_lo(a[j].x); v[j][1] += bf_hi(a[j].x); v[j][2] += bf_lo(a[j].y); v[j][3] += bf_hi(a[j].y); }
                    if (two) {
#pragma unroll
                        for (int j = 0; j < 8; ++j) { v[j][0] += bf_lo(b[j].x); v[j][1] += bf_hi(b[j].x); v[j][2] += bf_lo(b[j].y); v[j][3] += bf_hi(b[j].y); } } }
                if (l + 1 < NL) {
                    float ss = 0.f;
#pragma unroll
                    for (int j = 0; j < 8; ++j) ss += v[j][0] * v[j][0] + v[j][1] * v[j][1] + v[j][2] * v[j][2] + v[j][3] * v[j][3];
                    ss = wave_sum(ss);
#pragma unroll
                    for (int j = 0; j < 8; ++j) { u32x2 wv; wv.x = cvt_pk_bf16(v[j][0], v[j][1]); wv.y = cvt_pk_bf16(v[j][2], v[j][3]); *(u32x2*)(XB + (size_t)m * D + 4 * lane + 256 * j) = wv;
                        int w8 = 0; w8 = __builtin_amdgcn_cvt_pk_fp8_f32(v[j][0], v[j][1], w8, false); w8 = __builtin_amdgcn_cvt_pk_fp8_f32(v[j][2], v[j][3], w8, true); *(int*)(XB8 + (size_t)m * D + 4 * lane + 256 * j) = w8; }
                    if (lane == 0) RINV[m] = __builtin_amdgcn_rsqf(ss * (1.f / D) + EPS);
                } else { float* orow = OUTP + (size_t)m * D;
#pragma unroll
                    for (int j = 0; j < 8; ++j) *(f32x4*)(orow + 4 * lane + 256 * j) = v[j]; }
#pragma unroll
                for (int j = 0; j < 8; ++j) xc[j] = xn[j];
                invc = invn;
              } }
        }
        SEAM(pbase + 13);
    }
#undef IN
#undef SEAM
}

#if defined(DBG_STOP)
#ifndef DBG_OFF
#define DBG_OFF A_XA
#endif
#ifndef DBG_BF16
#define DBG_BF16 0
#endif
__global__ void dbg_dump(float* out, const unsigned char* ws) {
    const unsigned char* p = ws + WS_ACT + DBG_OFF;
    for (size_t i = (size_t)blockIdx.x * 256 + threadIdx.x; i < (size_t)S * D; i += (size_t)gridDim.x * 256)
#if defined(DBG_SUM2)
        out[i] = __uint_as_float(((unsigned)((const bf16_t*)p)[i]) << 16) + __uint_as_float(((unsigned)((const bf16_t*)p)[i + (size_t)S * D]) << 16);
#else
        out[i] = DBG_BF16 ? __uint_as_float(((unsigned)((const bf16_t*)p)[i]) << 16) : ((const float*)p)[i];
#endif
}
#endif
constexpr int N_PHASES = 2 + NL * 14;
extern "C" void kernel_launch(void* const* d_in, const int* in_sizes, int n_in, void* d_out, int out_size, void* d_ws, size_t ws_size, hipStream_t stream) {
    static int grid = 0;
    if (grid == 0) {
        if (n_in != 28 || in_sizes[0] != S * D || out_size != S * D || ws_size < WS_END) { fprintf(stderr, "kernel_launch: shape/workspace mismatch (n_in %d, ws %zu, need %zu)\n", n_in, ws_size, (size_t)WS_END); grid = -1; return; }
        int dev = 0, cus = 0, per_cu = 0;
        if (hipGetDevice(&dev) != hipSuccess || hipDeviceGetAttribute(&cus, hipDeviceAttributeMultiprocessorCount, dev) != hipSuccess) { grid = -1; return; }
        if (hipFuncSetAttribute((const void*)fwd, hipFuncAttributeMaxDynamicSharedMemorySize, LDS_BYTES) != hipSuccess) { fprintf(stderr, "kernel_launch: hipFuncSetAttribute failed\n"); grid = -1; return; }
        if (hipOccupancyMaxActiveBlocksPerMultiprocessor(&per_cu, (const void*)fwd, 512, LDS_BYTES) != hipSuccess || per_cu < 1) { fprintf(stderr, "kernel_launch: occupancy query says %d\n", per_cu); }
        (void)hipGetLastError();
        grid = cus;
    }
    if (grid < 0) return;
    (void)hipMemsetAsync((char*)d_ws + WS_CTL, 0, CTL_BYTES, stream);
    Args a{};
    for (int i = 0; i < 28; ++i) a.in[i] = (GAS const float*)d_in[i];
    a.out = (GAS float*)d_out; a.ws = (GAS unsigned char*)d_ws;
#if defined(DBG_STOP)
    for (int p = 0; p < DBG_STOP; ++p) { a.ph_lo = p; a.ph_hi = p + 1; hipLaunchKernelGGL(fwd, dim3(grid), dim3(512), LDS_BYTES, stream, a); }
#if !defined(DBG_NODUMP)
    hipLaunchKernelGGL(dbg_dump, dim3(2048), dim3(256), 0, stream, (float*)d_out, (const unsigned char*)d_ws);
#endif
#elif MK_PER_PHASE
    for (int p = 0; p < N_PHASES; ++p) { a.ph_lo = p; a.ph_hi = p + 1; hipLaunchKernelGGL(fwd, dim3(grid), dim3(512), LDS_BYTES, stream, a); }
#else
    a.ph_lo = 0; a.ph_hi = N_PHASES; hipLaunchKernelGGL(fwd, dim3(grid), dim3(512), LDS_BYTES, stream, a);
#endif
    const hipError_t le = hipPeekAtLastError();
    if (le != hipSuccess) fprintf(stderr, "kernel_launch: launch failed: %s\n", hipGetErrorName(le));
}
```
